# Optimizing an MI355X kernel written in HIP

```python
import jax, jax.numpy as jnp
from jax import lax
import numpy as np


D_MODEL = 4096
BATCH = 4
SEQ = 4096
DEPTH = 4

HEAD_DIM = 128
D_MIX = D_MODEL
N_MIXERS = 4
GROUP_HEADS = D_MIX // (N_MIXERS * HEAD_DIM)
GROUP_WIDTH = GROUP_HEADS * HEAD_DIM
RET_HEADS = GROUP_HEADS
RET_CHUNK = 128
RET_ROT_BASE = 10000.0
SB_HEADS = GROUP_HEADS
SB_Q_BLOCK = 128
LRU_WIDTH = GROUP_WIDTH
LRU_BLOCKS = GROUP_HEADS
LRU_BLOCK_W = LRU_WIDTH // LRU_BLOCKS
LRU_CONV = 4
LRU_C = 8.0
NSA_HEADS = GROUP_HEADS
NSA_KV_HEADS = 2
NSA_KV_WIDTH = NSA_KV_HEADS * HEAD_DIM
CMP_LEN = 32
CMP_STRIDE = 16
CMP_HIDDEN = 256
SLC_LEN = 64
SLC_TOPK = 16
SLC_Q_BLOCK = 64
WINDOW = 512
WIN_Q_BLOCK = 128
ROPE_THETA = 500000.0
ROPE_DIMS = HEAD_DIM // 4
D_FF = 256 * ((8 * D_MODEL // 3 + 255) // 256)
MLP_CONV = 3
NORM_EPS = 1e-6
SPLIT_SIZES = tuple(4 * [GROUP_WIDTH] + 3 * [GROUP_WIDTH] + 2 * [LRU_WIDTH] + [GROUP_WIDTH] + 6 * [NSA_KV_WIDTH] + [3 * NSA_HEADS])
N_IN = sum(SPLIT_SIZES)

kernel_name = 'hybrid_parallel_heads_decoder'

F32 = jnp.float32


def rms_norm(x, w):
    xf = x.astype(F32)
    y = xf * lax.rsqrt(jnp.mean(xf * xf, axis=-1, keepdims=True) + NORM_EPS)
    return (y * w.astype(F32)).astype(x.dtype)


def rms_unit(x):
    xf = x.astype(F32)
    return xf * lax.rsqrt(jnp.mean(xf * xf, axis=-1, keepdims=True) + NORM_EPS)


def split_heads(x, n_heads):
    b, s, _ = x.shape
    return x.reshape(b, s, n_heads, -1).transpose(0, 2, 1, 3)


def merge_heads(x):
    b, h, s, d = x.shape
    return x.transpose(0, 2, 1, 3).reshape(b, s, h * d)


def apply_rotary(x, pos, inv_freq):
    half = inv_freq.shape[0]
    ang = pos.astype(F32)[:, None] * inv_freq[None, :]
    cos, sin = jnp.cos(ang), jnp.sin(ang)
    xf = x.astype(F32)
    x1, x2 = xf[..., :half], xf[..., half:2 * half]
    out = jnp.concatenate([x1 * cos - x2 * sin, x2 * cos + x1 * sin, xf[..., 2 * half:]], axis=-1)
    return out.astype(x.dtype)


def partial_rope_freqs():
    half = ROPE_DIMS // 2
    return ROPE_THETA ** (-jnp.arange(half, dtype=F32) / half)


def masked_softmax(s, mask):
    s = jnp.where(mask, s.astype(F32), -jnp.inf)
    m = jnp.max(s, axis=-1, keepdims=True)
    m = jnp.where(jnp.isfinite(m), m, 0.0)
    e = jnp.where(mask, jnp.exp(s - m), 0.0)
    return e / jnp.maximum(jnp.sum(e, axis=-1, keepdims=True), 1e-30)


def causal_dwconv(x, w, b):
    width, s = w.shape[0], x.shape[1]
    xp = jnp.pad(x, ((0, 0), (width - 1, 0), (0, 0)))
    y = b.astype(x.dtype)
    for k in range(width):
        y = y + xp[:, k:k + s] * w[k].astype(x.dtype)
    return y


def retention_chunkwise(q, k, v):
    b, h, s, d = q.shape
    c = RET_CHUNK
    n = s // c
    log_g = jnp.log(1.0 - 2.0 ** (-5.0 - jnp.arange(h, dtype=F32)))
    idx = jnp.arange(c, dtype=F32)
    rel = idx[:, None] - idx[None, :]
    inner_decay = jnp.where(rel >= 0, jnp.exp(log_g[:, None, None] * jnp.maximum(rel, 0.0)), 0.0)
    q_decay = jnp.exp(log_g[:, None] * (idx + 1.0))[..., None]
    k_decay = jnp.exp(log_g[:, None] * (c - 1.0 - idx))[..., None]
    chunk_decay = jnp.exp(log_g * c)[:, None, None]
    to_chunks = lambda t: t.reshape(b, h, n, c, d).transpose(2, 0, 1, 3, 4)

    def step(state, inp):
        qb, kb, vb = inp
        inner = jnp.einsum('bhid,bhjd->bhij', qb, kb) * inner_decay
        o = jnp.einsum('bhij,bhjd->bhid', inner, vb) + jnp.einsum('bhid,bhde->bhie', qb, state) * q_decay
        state = state * chunk_decay + jnp.einsum('bhjd,bhje->bhde', kb * k_decay, vb)
        return state, o

    state0 = jnp.zeros((b, h, d, d), F32)
    _, o = lax.scan(step, state0, (to_chunks(q), to_chunks(k), to_chunks(v)))
    return o.transpose(1, 2, 0, 3, 4).reshape(b, h, s, d)


def retention_mixer(q, k, v, g):
    s = q.shape[1]
    pos = jnp.arange(s)
    inv = 1.0 / (RET_ROT_BASE ** jnp.linspace(0.0, 1.0, HEAD_DIM // 2, dtype=F32))
    qh = apply_rotary(split_heads(q, RET_HEADS), pos, inv).astype(F32)
    kh = apply_rotary(split_heads(k, RET_HEADS), pos, inv).astype(F32) * (HEAD_DIM ** -0.5)
    vh = split_heads(v, RET_HEADS).astype(F32)
    o = rms_unit(retention_chunkwise(qh, kh, vh))
    return merge_heads(o) * jax.nn.silu(g.astype(F32))


def stick_breaking_mixer(q, k, v):
    qh = split_heads(q, SB_HEADS).astype(F32)
    kh = split_heads(k, SB_HEADS).astype(F32)
    vh = split_heads(v, SB_HEADS).astype(F32)
    b, h, s, d = qh.shape
    nb = s // SB_Q_BLOCK
    scale = d ** -0.5
    key_pos = jnp.arange(s)
    q_blocks = qh.reshape(b, h, nb, SB_Q_BLOCK, d).transpose(2, 0, 1, 3, 4)

    def block(args):
        i, qi = args
        qpos = i * SB_Q_BLOCK + jnp.arange(SB_Q_BLOCK)
        z = jnp.einsum('bhqd,bhkd->bhqk', qi, kh) * scale
        past = key_pos[None, :] < qpos[:, None]
        log_beta = jax.nn.log_sigmoid(z)
        log_stay_j = jnp.where(past, jax.nn.log_sigmoid(-z), 0.0)
        log_stay = lax.cumsum(log_stay_j, axis=3, reverse=True) - log_stay_j
        w = jnp.where(past, jnp.exp(log_beta + log_stay), 0.0)
        return jnp.einsum('bhqk,bhkd->bhqd', w, vh)

    o = lax.map(block, (jnp.arange(nb), q_blocks))
    o = o.transpose(1, 2, 0, 3, 4).reshape(b, h, s, d)
    return merge_heads(o)


def rg_lru(x, w_a, b_a, w_x, b_x, lam):
    b, s, c = x.shape
    xb = x.reshape(b, s, LRU_BLOCKS, LRU_BLOCK_W)
    r = jax.nn.sigmoid((jnp.einsum('bsnc,ncd->bsnd', xb, w_a).reshape(b, s, c) + b_a).astype(F32))
    i = jax.nn.sigmoid((jnp.einsum('bsnc,ncd->bsnd', xb, w_x).reshape(b, s, c) + b_x).astype(F32))
    log_a = LRU_C * r * jax.nn.log_sigmoid(lam.astype(F32))
    a = jnp.exp(log_a)
    pos = jnp.arange(s)[:, None]
    mult = jnp.where(pos == 0, 1.0, jnp.sqrt(jnp.maximum(-jnp.expm1(2.0 * log_a), 0.0)))
    u = mult * (i * x.astype(F32))

    def combine(left, right):
        a1, b1 = left
        a2, b2 = right
        return a1 * a2, a2 * b1 + b2

    _, hseq = lax.associative_scan(combine, (a, u), axis=1)
    return hseq


def rglru_mixer(gate_in, rec_in, conv_w, conv_b, w_a, b_a, w_x, b_x, lam):
    xr = causal_dwconv(rec_in, conv_w, conv_b)
    hseq = rg_lru(xr, w_a, b_a, w_x, b_x, lam)
    return hseq * jax.nn.gelu(gate_in.astype(F32))


def nsa_compress(x, pos_emb, w1, w2):
    s = x.shape[2]
    nc = (s - CMP_LEN) // CMP_STRIDE + 1
    idx = np.arange(nc)[:, None] * CMP_STRIDE + np.arange(CMP_LEN)[None, :]
    blocks = x[:, :, idx] + pos_emb
    hid = jax.nn.gelu(jnp.einsum('bgnld,ldh->bgnh', blocks, w1))
    return jnp.einsum('bgnh,hd->bgnd', hid, w2)


def nsa_mixer(q, kc, vc, ks, vs, kw, vw, gate_logits, q_norm_w, k_norm_w, cmp_pos, cmp_w1, cmp_w2):
    b, s, _ = q.shape
    h, g, d = NSA_HEADS, NSA_KV_HEADS, HEAD_DIM
    r = h // g
    scale = d ** -0.5
    pos = jnp.arange(s)
    inv = partial_rope_freqs()
    qg = apply_rotary(rms_norm(split_heads(q, h), q_norm_w), pos, inv).reshape(b, g, r, s, d)

    nc = (s - CMP_LEN) // CMP_STRIDE + 1
    cmp_end = jnp.arange(nc) * CMP_STRIDE + CMP_LEN - 1
    k_cmp = nsa_compress(split_heads(kc, g), cmp_pos[0], cmp_w1[0], cmp_w2[0])
    v_cmp = nsa_compress(split_heads(vc, g), cmp_pos[1], cmp_w1[1], cmp_w2[1])
    k_cmp = apply_rotary(rms_norm(k_cmp, k_norm_w[0]), cmp_end, inv)
    s_cmp = jnp.einsum('bgrtd,bgnd->bgrtn', qg, k_cmp) * scale
    p_cmp = masked_softmax(s_cmp, cmp_end[None, :] <= pos[:, None])
    o_cmp = jnp.einsum('bgrtn,bgnd->bgrtd', p_cmp, v_cmp)

    n_slc = s // SLC_LEN
    ci = np.arange(nc)[:, None] * CMP_STRIDE
    sj = np.arange(n_slc)[None, :] * SLC_LEN
    overlap = np.maximum(0, np.minimum(ci + CMP_LEN, sj + SLC_LEN) - np.maximum(ci, sj)) / CMP_STRIDE
    p_slc = jnp.einsum('bgrtn,nj->bgtj', p_cmp, jnp.asarray(overlap, F32))
    blk = jnp.arange(n_slc)[None, :]
    cur = (pos // SLC_LEN)[:, None]
    valid_blk = blk <= cur
    forced = (blk == 0) | (blk == cur) | (blk == cur - 1)
    sel_score = jnp.where(forced, jnp.inf, jnp.where(valid_blk, p_slc, -jnp.inf))
    k_sel = min(SLC_TOPK, n_slc)
    _, sel_idx = lax.top_k(sel_score, k_sel)

    ksb = apply_rotary(rms_norm(split_heads(ks, g), k_norm_w[1]), pos, inv).reshape(b, g, n_slc, SLC_LEN, d)
    vsb = split_heads(vs, g).reshape(b, g, n_slc, SLC_LEN, d)
    nq = s // SLC_Q_BLOCK
    q_blocks = qg.reshape(b, g, r, nq, SLC_Q_BLOCK, d).transpose(3, 0, 1, 2, 4, 5)
    idx_blocks = sel_idx.reshape(b, g, nq, SLC_Q_BLOCK, k_sel).transpose(2, 0, 1, 3, 4)
    b_ix = jnp.arange(b)[:, None, None, None]
    g_ix = jnp.arange(g)[None, :, None, None]

    def slc_block(args):
        c, qi, ids = args
        tq = c * SLC_Q_BLOCK + jnp.arange(SLC_Q_BLOCK)
        kb = ksb[b_ix, g_ix, ids].reshape(b, g, SLC_Q_BLOCK, k_sel * SLC_LEN, d)
        vb = vsb[b_ix, g_ix, ids].reshape(b, g, SLC_Q_BLOCK, k_sel * SLC_LEN, d)
        tok = ids[..., None] * SLC_LEN + jnp.arange(SLC_LEN)
        mask = (tok <= tq[:, None, None]).reshape(b, g, 1, SLC_Q_BLOCK, k_sel * SLC_LEN)
        sc = jnp.einsum('bgrqd,bgqnd->bgrqn', qi, kb) * scale
        p = masked_softmax(sc, mask)
        return jnp.einsum('bgrqn,bgqnd->bgrqd', p, vb)

    o_slc = lax.map(slc_block, (jnp.arange(nq), q_blocks, idx_blocks))
    o_slc = o_slc.transpose(1, 2, 3, 0, 4, 5).reshape(b, g, r, s, d)

    kwh = apply_rotary(rms_norm(split_heads(kw, g), k_norm_w[2]), pos, inv)
    vwh = split_heads(vw, g)
    pad = ((0, 0), (0, 0), (WINDOW, 0), (0, 0))
    kwp, vwp = jnp.pad(kwh, pad), jnp.pad(vwh, pad)
    nw = s // WIN_Q_BLOCK
    span = WINDOW + WIN_Q_BLOCK
    qw_blocks = qg.reshape(b, g, r, nw, WIN_Q_BLOCK, d).transpose(3, 0, 1, 2, 4, 5)

    def win_block(args):
        c, qi = args
        start = c * WIN_Q_BLOCK
        kb = lax.dynamic_slice_in_dim(kwp, start, span, axis=2)
        vb = lax.dynamic_slice_in_dim(vwp, start, span, axis=2)
        tq = start + jnp.arange(WIN_Q_BLOCK)
        kpos = start - WINDOW + jnp.arange(span)
        dist = tq[:, None] - kpos[None, :]
        mask = (dist >= 0) & (dist < WINDOW) & (kpos[None, :] >= 0)
        sc = jnp.einsum('bgrqd,bgkd->bgrqk', qi, kb) * scale
        p = masked_softmax(sc, mask)
        return jnp.einsum('bgrqk,bgkd->bgrqd', p, vb)

    o_win = lax.map(win_block, (jnp.arange(nw), qw_blocks))
    o_win = o_win.transpose(1, 2, 3, 0, 4, 5).reshape(b, g, r, s, d)

    gates = jax.nn.sigmoid(gate_logits.astype(F32)).reshape(b, s, g, r, 3).transpose(0, 2, 3, 1, 4)
    o = gates[..., 0:1] * o_cmp + gates[..., 1:2] * o_slc + gates[..., 2:3] * o_win
    return merge_heads(o.reshape(b, h, s, d))


def setup_inputs(seed: int = 0) -> dict:
    key = jax.random.key(seed)
    ks = jax.random.split(key, 24)
    L = DEPTH

    def nrm(k, shape, fan_in):
        return jax.random.normal(k, shape, F32) * (fan_in ** -0.5)

    def gain(k, shape):
        return 1.0 + 0.02 * jax.random.normal(k, shape, F32)

    def bias(k, shape):
        return 0.02 * jax.random.normal(k, shape, F32)

    a_c = jax.random.uniform(ks[9], (L, LRU_WIDTH), F32, 0.9, 0.999)
    a = a_c ** (1.0 / LRU_C)
    return {
        'x': jax.random.normal(ks[0], (BATCH, SEQ, D_MODEL), F32),
        'attn_norm_w': gain(ks[1], (L, D_MODEL)),
        'w_in': nrm(ks[2], (L, D_MODEL, N_IN), D_MODEL),
        'lru_conv_w': nrm(ks[3], (L, LRU_CONV, LRU_WIDTH), LRU_CONV),
        'lru_conv_b': bias(ks[4], (L, LRU_WIDTH)),
        'lru_w_a': nrm(ks[5], (L, LRU_BLOCKS, LRU_BLOCK_W, LRU_BLOCK_W), LRU_BLOCK_W),
        'lru_b_a': bias(ks[6], (L, LRU_WIDTH)),
        'lru_w_x': nrm(ks[7], (L, LRU_BLOCKS, LRU_BLOCK_W, LRU_BLOCK_W), LRU_BLOCK_W),
        'lru_b_x': bias(ks[8], (L, LRU_WIDTH)),
        'lru_lambda': jnp.log(a) - jnp.log1p(-a),
        'nsa_q_norm_w': gain(ks[10], (L, HEAD_DIM)),
        'nsa_k_norm_w': gain(ks[11], (L, 3, HEAD_DIM)),
        'nsa_cmp_pos': bias(ks[12], (L, 2, CMP_LEN, HEAD_DIM)),
        'nsa_cmp_w1': nrm(ks[13], (L, 2, CMP_LEN, HEAD_DIM, CMP_HIDDEN), CMP_LEN * HEAD_DIM),
        'nsa_cmp_w2': nrm(ks[14], (L, 2, CMP_HIDDEN, HEAD_DIM), CMP_HIDDEN),
        'w_out': nrm(ks[15], (L, D_MIX, D_MODEL), D_MIX),
        'mlp_norm_w': gain(ks[16], (L, D_MODEL)),
        'w_gate': nrm(ks[17], (L, D_MODEL, D_FF), D_MODEL),
        'w_up': nrm(ks[18], (L, D_MODEL, D_FF), D_MODEL),
        'mlp_conv_w': nrm(ks[19], (L, MLP_CONV, D_FF), MLP_CONV),
        'mlp_conv_b': bias(ks[20], (L, D_FF)),
        'w_down': nrm(ks[21], (L, D_FF, D_MODEL), D_FF),
    }


def reference(x, attn_norm_w, w_in, lru_conv_w, lru_conv_b, lru_w_a, lru_b_a, lru_w_x, lru_b_x, lru_lambda,
              nsa_q_norm_w, nsa_k_norm_w, nsa_cmp_pos, nsa_cmp_w1, nsa_cmp_w2, w_out, mlp_norm_w,
              w_gate, w_up, mlp_conv_w, mlp_conv_b, w_down):
    offsets = np.cumsum(SPLIT_SIZES)[:-1].tolist()
    for l in range(DEPTH):
        hn = rms_norm(x, attn_norm_w[l])
        proj = jnp.einsum('bsd,de->bse', hn, w_in[l])
        (rq, rk, rv, rg, sq, sk, sv, lg, lr, nq, nkc, nvc, nks, nvs, nkw, nvw, ngate) = jnp.split(proj, offsets, axis=-1)
        y_ret = retention_mixer(rq, rk, rv, rg)
        y_sb = stick_breaking_mixer(sq, sk, sv)
        y_lru = rglru_mixer(lg, lr, lru_conv_w[l], lru_conv_b[l], lru_w_a[l], lru_b_a[l],
                            lru_w_x[l], lru_b_x[l], lru_lambda[l])
        y_nsa = nsa_mixer(nq, nkc, nvc, nks, nvs, nkw, nvw, ngate, nsa_q_norm_w[l], nsa_k_norm_w[l],
                          nsa_cmp_pos[l], nsa_cmp_w1[l], nsa_cmp_w2[l])
        mix = jnp.concatenate([y_ret, y_sb, y_lru, y_nsa], axis=-1).astype(x.dtype)
        x = x + jnp.einsum('bse,ed->bsd', mix, w_out[l]).astype(x.dtype)
        hn = rms_norm(x, mlp_norm_w[l])
        gt = causal_dwconv(jnp.einsum('bsd,df->bsf', hn, w_gate[l]), mlp_conv_w[l], mlp_conv_b[l])
        up = jnp.einsum('bsd,df->bsf', hn, w_up[l])
        x = x + jnp.einsum('bsf,fd->bsd', jax.nn.silu(gt) * up, w_down[l]).astype(x.dtype)
    return x
```

```cpp
#include <hip/hip_runtime.h>
#include <stdint.h>
#include <stdio.h>
#define XB_TMO      128
#define XB_XCNT(j)  (256  + 64 * (j))
#define XB_XSUB(j)  (1280 + 64 * (j))
#define XB_XGEN(j)  (2304 + 64 * (j))
#define XB_TOP      3328
#define XB_TOPGEN   3392
#define XCD_BAR_WORDS 3456
#define XB_SPIN_CAP (1u << 22)
#define LAS __attribute__((address_space(3)))

__device__ __forceinline__ unsigned xb_ld(unsigned* p)              { return __hip_atomic_load(p, __ATOMIC_RELAXED, __HIP_MEMORY_SCOPE_AGENT); }
__device__ __forceinline__ unsigned xb_add(unsigned* p, unsigned v) { return __hip_atomic_fetch_add(p, v, __ATOMIC_RELAXED, __HIP_MEMORY_SCOPE_AGENT); }
__device__ __forceinline__ unsigned xb_xcc_id() { return (unsigned)__builtin_amdgcn_s_getreg((3 << 11) | 20) & 0xFu; }
#define XB_SPIN(cond, bar) do { unsigned _sp = 0; while (cond) { __builtin_amdgcn_s_sleep(1); \
    if ((++_sp & 255u) == 0u) { if (xb_ld(&(bar)[XB_TMO])) break; if (_sp > XB_SPIN_CAP) { atomicAdd(&(bar)[XB_TMO], 1u); break; } } } } while (0)

struct XcdBarrier {
    unsigned* bar; unsigned x;
    volatile LAS unsigned* st;
};

__device__ __forceinline__ XcdBarrier xcd_barrier_post(unsigned* bar, volatile LAS unsigned* st) {
    XcdBarrier b; b.bar = bar; b.x = xb_xcc_id(); b.st = st;
    if (threadIdx.x == 0) (void)xb_add(&bar[XB_XCNT(b.x)], 1u);
    return b;
}
__device__ __forceinline__ void xcd_barrier_complete(unsigned* bar, unsigned x, unsigned& nloc, unsigned& nx) {
    const unsigned G = gridDim.x * gridDim.y * gridDim.z;
    unsigned sum, cnt, mine, sp = 0u;
    for (;;) {
        sum = 0u; cnt = 0u; mine = 0u;
#pragma unroll
        for (unsigned j = 0; j < 16; ++j) { const unsigned c = xb_ld(&bar[XB_XCNT(j)]); sum += c; cnt += (c > 0u) ? 1u : 0u; mine = (j == x) ? c : mine; }
        if (sum == G) break;
        __builtin_amdgcn_s_sleep(1);
        if ((++sp & 255u) == 0u) { if (xb_ld(&bar[XB_TMO])) break; if (sp > XB_SPIN_CAP) { atomicAdd(&bar[XB_TMO], 1u); break; } }
    }
    nloc = mine > 0u ? mine : 1u; nx = cnt > 0u ? cnt : 1u;
}

__device__ __forceinline__ void xcd_barrier(const XcdBarrier& b) {
    asm volatile("s_waitcnt vmcnt(0)" ::: "memory");
    __syncthreads();
    if (threadIdx.x == 0) {
        unsigned* bar = b.bar;
        __builtin_amdgcn_s_waitcnt(0);
        unsigned nloc = b.st[0], nx = b.st[1];
        if (nloc == 0u) { xcd_barrier_complete(bar, b.x, nloc, nx); b.st[0] = nloc; b.st[1] = nx; }
        const unsigned old = xb_add(&bar[XB_XSUB(b.x)], 1u);
        const unsigned gen = old / nloc;
        if (old + 1u == (gen + 1u) * nloc) {
            __builtin_amdgcn_fence(__ATOMIC_RELEASE, "agent");
            asm volatile("s_waitcnt vmcnt(0)" ::: "memory");
            const unsigned og = xb_add(&bar[XB_TOP], 1u);
            const unsigned tg = og / nx;
            if (og + 1u == (tg + 1u) * nx) xb_add(&bar[XB_TOPGEN], 1u);
            else XB_SPIN(xb_ld(&bar[XB_TOPGEN]) == tg, bar);
            __builtin_amdgcn_fence(__ATOMIC_ACQUIRE, "agent");
            xb_add(&bar[XB_XGEN(b.x)], 1u);
            asm volatile("s_waitcnt vmcnt(0)" ::: "memory");
        } else {
            XB_SPIN(xb_ld(&bar[XB_XGEN(b.x)]) == gen, bar);
            __builtin_amdgcn_fence(__ATOMIC_ACQUIRE, "agent");
            asm volatile("s_waitcnt vmcnt(0)" ::: "memory");
        }
    }
    __syncthreads();
}
namespace pg8 {
#define PG8_LAS __attribute__((address_space(3)))
typedef unsigned short bf16_t;
typedef short bf16x8 __attribute__((ext_vector_type(8)));
typedef float f32x4 __attribute__((ext_vector_type(4)));
typedef unsigned u32x4 __attribute__((ext_vector_type(4)));
constexpr int BM = 256, BK = 64, HALF = 128, HTB = HALF * BK * 2  , STAGE_BYTES = 8 * HTB, NXCD = 8, WGM = 8;

__host__ __device__ __forceinline__ int lds_byte(int r, int c) { const int st = (r >> 4) * 2 + (c >> 5), rr = r & 15, cc = c & 31, ob = rr * 64 + cc * 2; return st * 1024 + (ob ^ (((ob >> 9) & 1) << 5)); }
__host__ __device__ __forceinline__ void stage_rc(int b, int& R, int& C) { const int st = b / 1024, sb = b % 1024, swz = sb ^ (((sb >> 9) & 1) << 5); R = (st >> 1) * 16 + swz / 64; C = (st & 1) * 32 + (swz % 64) / 2; }
__host__ __device__ __forceinline__ int perm32(int rho) { const int n = rho >> 4, i = rho & 15; return 8 * (i >> 2) + 4 * n + (i & 3); }

struct Unit { int pm, pn; };
struct Gemm { const bf16_t* A; const bf16_t* Bt; int M, N, K; };

struct StaticOrder {
    int nM, nN, nwg, G, c;
    __host__ __device__ void init(int M, int N, int G_, int c_) { nM = M / BM; nN = N / BM; nwg = nM * nN; G = G_; c = c_; }
    __host__ __device__ bool next(int i, Unit& u) const {
        const long L = (long)i * G + c; if (L >= nwg) return false;
        int wgid = (int)L; { const int q = nwg / NXCD, r = nwg % NXCD, xcd = wgid % NXCD, off = wgid / NXCD; wgid = (xcd < r ? xcd * (q + 1) : r * (q + 1) + (xcd - r) * q) + off; }
        const int nig = WGM * nN, gid = wgid / nig, fm = gid * WGM, gsz = (nM - fm) < WGM ? (nM - fm) : WGM;
        u.pm = fm + ((wgid % nig) % gsz); u.pn = (wgid % nig) / gsz; return true;
    }
    __device__ __forceinline__ void a_ready(const Unit&) const {}
    __device__ __forceinline__ void done(const Unit&) const {}
};

__device__ __forceinline__ unsigned cvt_pk_bf16(float lo, float hi) { unsigned r; asm volatile("v_cvt_pk_bf16_f32 %0, %1, %2" : "=v"(r) : "v"(lo), "v"(hi)); return r; }
typedef float f32x2 __attribute__((ext_vector_type(2)));
__device__ __forceinline__ f32x2 gelu_pk(f32x2 v) {
    const f32x2 av = __builtin_elementwise_abs(v), d = av * 0.2316418882f + 1.0f;
    f32x2 t; t.x = __builtin_amdgcn_rcpf(d.x); t.y = __builtin_amdgcn_rcpf(d.y);
    f32x2 q = t * 0.5307027145f + (-0.7265760135f); q = q * t + 0.7107068705f; q = q * t + (-0.142248368f); q = q * t + 0.127414796f; q = q * t;
    const f32x2 s = (v * v) * (-0.72134752044f);
    f32x2 e; e.x = __builtin_amdgcn_exp2f(s.x); e.y = __builtin_amdgcn_exp2f(s.y);
    const f32x2 m = v * (q * e), r = v - m;
    f32x2 o; o.x = v.x < 0.f ? m.x : r.x; o.y = v.y < 0.f ? m.y : r.y; return o;
}

template <int ACT  > struct EpiBf16 {
    static constexpr bool PERM = true, AFTER_DRAIN = false; static_assert(ACT == 0 || ACT == 1, "EpiBf16: ACT is 0 (none) or 1 (gelu_pk)");
    bf16_t* O; int ldc; const float* bias; int split_cols; size_t split_stride; float scale0;
    __device__ __forceinline__ void operator()(const f32x4 (&acc)[2][2][4][2], const Unit& u, int wr, int wc, int fr, int fq) const {
        const int row0 = u.pm * BM + wr * 64 + fr; int colt = u.pn * BM; bf16_t* base = O;
        float sc = 1.f; if (split_cols) { const int t = colt / split_cols; base += (size_t)t * split_stride; colt -= t * split_cols; if (t == 0) sc = scale0; }
        const int col0 = colt + wc * 32 + 8 * fq, bcol0 = u.pn * BM + wc * 32 + 8 * fq;
        f32x4 bv[2][2];
#pragma unroll
        for (int bj = 0; bj < 2; ++bj)
#pragma unroll
            for (int n = 0; n < 2; ++n) bv[bj][n] = bias ? *(const f32x4*)(bias + bcol0 + bj * HALF + 4 * n) : (f32x4){0.f, 0.f, 0.f, 0.f};
#pragma unroll
        for (int ai = 0; ai < 2; ++ai)
#pragma unroll
            for (int m = 0; m < 4; ++m) { bf16_t* rowp = base + (size_t)(row0 + ai * HALF + m * 16) * ldc + col0;
#pragma unroll
                for (int bj = 0; bj < 2; ++bj) { f32x4 v0 = acc[ai][bj][m][0] + bv[bj][0], v1 = acc[ai][bj][m][1] + bv[bj][1];
                    if (ACT == 1) { f32x2 a = gelu_pk((f32x2){v0[0], v0[1]}), b = gelu_pk((f32x2){v0[2], v0[3]}), c = gelu_pk((f32x2){v1[0], v1[1]}), d = gelu_pk((f32x2){v1[2], v1[3]});
                        v0 = (f32x4){a.x, a.y, b.x, b.y}; v1 = (f32x4){c.x, c.y, d.x, d.y}; }
                    v0 = v0 * sc; v1 = v1 * sc; u32x4 w; w.x = cvt_pk_bf16(v0[0], v0[1]); w.y = cvt_pk_bf16(v0[2], v0[3]); w.z = cvt_pk_bf16(v1[0], v1[1]); w.w = cvt_pk_bf16(v1[2], v1[3]);
                    *(u32x4*)(rowp + bj * HALF) = w; } }
    }
};

struct PanelStats {
    unsigned* xbuf;
    unsigned* cnt;
    unsigned* tmo;
    int ntn; float eps;
    unsigned code;
    __device__ __forceinline__ bool run(const f32x4 (&v)[2][2][4][2], const Unit& u, int wr, int wc, int fr, int fq, PG8_LAS unsigned char* lds, int wid, int lane) const {
        typedef float f32x2v __attribute__((ext_vector_type(2)));
        PG8_LAS f32x2v* P = (PG8_LAS f32x2v*)lds;
        PG8_LAS f32x2v* S = (PG8_LAS f32x2v*)(lds + 8192);
        PG8_LAS unsigned* flag = (PG8_LAS unsigned*)(lds + 8192 + 2048);
#pragma unroll
        for (int ai = 0; ai < 2; ++ai)
#pragma unroll
            for (int m = 0; m < 4; ++m) {
                float s = 0.f;
#pragma unroll
                for (int bj = 0; bj < 2; ++bj)
#pragma unroll
                    for (int n = 0; n < 2; ++n) { const f32x4 x = v[ai][bj][m][n]; s += (x[0] + x[1]) + (x[2] + x[3]); }
                s += __shfl_xor(s, 16); s += __shfl_xor(s, 32);
                const float mw = s * (1.0f / 64.0f); float q = 0.f;
#pragma unroll
                for (int bj = 0; bj < 2; ++bj)
#pragma unroll
                    for (int n = 0; n < 2; ++n) { const f32x4 d = v[ai][bj][m][n] - mw; q += (d[0] * d[0] + d[1] * d[1]) + (d[2] * d[2] + d[3] * d[3]); }
                q += __shfl_xor(q, 16); q += __shfl_xor(q, 32);
                if (fq == 0) P[(ai * HALF + wr * 64 + m * 16 + fr) * 4 + wc] = (f32x2v){mw, q};
            }
        asm volatile("s_waitcnt lgkmcnt(0)" ::: "memory"); __builtin_amdgcn_s_barrier(); asm volatile("" ::: "memory");
#if defined(BROKEN_EXCHANGE_NO_WAIT)
#warning BROKEN CONTROL BUILD: the row-statistics exchange does not wait; results are wrong by design
        if (blockIdx.x >= 64) { const long long t0_ = clock64(); while (clock64() - t0_ < 60000) __builtin_amdgcn_s_sleep(8); }
#endif
        const int row = wid * 32 + (lane & 31);
        if (lane < 32) {
            const f32x2v a = P[row * 4 + 0], b = P[row * 4 + 1], c = P[row * 4 + 2], d = P[row * 4 + 3];
            const float mt = (a.x + b.x + c.x + d.x) * 0.25f;
            const float da = a.x - mt, db = b.x - mt, dc = c.x - mt, dd = d.x - mt;
            const float m2 = (a.y + b.y) + (c.y + d.y) + 64.0f * ((da * da + db * db) + (dc * dc + dd * dd));
            unsigned long long* slot = (unsigned long long*)xbuf + ((size_t)(u.pm * BM + row) * 4 + u.pn);
            __hip_atomic_store(slot, ((unsigned long long)__float_as_uint(m2) << 32) | __float_as_uint(mt), __ATOMIC_RELAXED, __HIP_MEMORY_SCOPE_AGENT);
        }
        asm volatile("s_waitcnt vmcnt(0)" ::: "memory");
        if (lane == 0) __hip_atomic_fetch_add(cnt + 64 * u.pm, 1u, __ATOMIC_RELAXED, __HIP_MEMORY_SCOPE_AGENT);
        if (wid == 0) {
            bool dead = false; const unsigned long long t0 = __builtin_amdgcn_s_memrealtime(); const unsigned want = 8u * (unsigned)ntn;
            for (;;) {
#if defined(BROKEN_EXCHANGE_NO_WAIT)
                break;
#endif
                if ((unsigned)__builtin_amdgcn_readfirstlane(__hip_atomic_load(cnt + 64 * u.pm, __ATOMIC_RELAXED, __HIP_MEMORY_SCOPE_AGENT)) >= want) break;
                if (__builtin_amdgcn_s_memrealtime() - t0 > 2000000ull) {
                    if (lane == 0) { unsigned expect = 0u; __hip_atomic_compare_exchange_strong(tmo + 1, &expect, code | (unsigned)(u.pm & 0xff), __ATOMIC_RELAXED, __ATOMIC_RELAXED, __HIP_MEMORY_SCOPE_AGENT);
                                     __hip_atomic_store(tmo, 1u, __ATOMIC_RELAXED, __HIP_MEMORY_SCOPE_AGENT); }
                    dead = true; break; }
                __builtin_amdgcn_s_sleep(2);
            }
            __builtin_amdgcn_fence(__ATOMIC_ACQUIRE, "agent");
            if (lane == 0) flag[0] = dead ? 1u : 0u;
        }
        asm volatile("s_waitcnt vmcnt(0) lgkmcnt(0)" ::: "memory"); __builtin_amdgcn_s_barrier(); asm volatile("" ::: "memory");
        const bool bad = flag[0] != 0u;
        if (lane < 32) {
            const unsigned long long* slot = (const unsigned long long*)xbuf + (size_t)(u.pm * BM + row) * 4; float mt[4], m2[4]; float ms = 0.f;
#pragma unroll
            for (int t = 0; t < 4; ++t) { if (t < ntn) { const unsigned long long w = __hip_atomic_load(slot + t, __ATOMIC_RELAXED, __HIP_MEMORY_SCOPE_AGENT); mt[t] = __uint_as_float((unsigned)w); m2[t] = __uint_as_float((unsigned)(w >> 32)); } else { mt[t] = 0.f; m2[t] = 0.f; } ms += mt[t]; }
            const float mean = ms / (float)ntn; float q = 0.f;
#pragma unroll
            for (int t = 0; t < 4; ++t) if (t < ntn) { const float dm = mt[t] - mean; q += m2[t] + 256.0f * dm * dm; }
            S[row] = (f32x2v){mean, 1.0f / sqrtf(q / (256.0f * (float)ntn) + eps)};
        }
        asm volatile("s_waitcnt lgkmcnt(0)" ::: "memory"); __builtin_amdgcn_s_barrier(); asm volatile("" ::: "memory");
        return bad;
    }
};
struct EpiLnRes {
    static constexpr bool PERM = false, AFTER_DRAIN = true;
    const float* base; float* out; int ldc; const float* bias; PanelStats st; unsigned poison;
    __device__ __forceinline__ void fused(f32x4 (&acc)[2][2][4][2], const Unit& u, int wr, int wc, int fr, int fq, PG8_LAS unsigned char* lds, int wid, int lane) const {
        typedef float f32x2v __attribute__((ext_vector_type(2)));
        const PG8_LAS f32x2v* S = (const PG8_LAS f32x2v*)(lds + 8192);
        const int col0 = u.pn * BM + wc * 32 + 4 * fq;
#pragma unroll
        for (int bj = 0; bj < 2; ++bj)
#pragma unroll
            for (int n = 0; n < 2; ++n) { const f32x4 bv = bias ? *(const f32x4*)(bias + col0 + bj * HALF + n * 16) : (f32x4){0.f, 0.f, 0.f, 0.f};
#pragma unroll
                for (int ai = 0; ai < 2; ++ai)
#pragma unroll
                    for (int m = 0; m < 4; ++m) acc[ai][bj][m][n] += bv; }
        f32x4 pre[4][2][2];
#pragma unroll
        for (int m = 0; m < 4; ++m) { const size_t off = (size_t)(u.pm * BM + wr * 64 + m * 16 + fr) * ldc + col0;
#pragma unroll
            for (int bj = 0; bj < 2; ++bj)
#pragma unroll
                for (int n = 0; n < 2; ++n) pre[m][bj][n] = *(const f32x4*)(base + off + bj * HALF + n * 16); }
        const bool bad = st.run(acc, u, wr, wc, fr, fq, lds, wid, lane) || poison != 0u;
        const float qnan = __builtin_nanf("");
#pragma unroll
        for (int ai = 0; ai < 2; ++ai)
#pragma unroll
            for (int m = 0; m < 4; ++m) { const int r = ai * HALF + wr * 64 + m * 16 + fr; const f32x2v sr = S[r]; const size_t off = (size_t)(u.pm * BM + r) * ldc + col0;
#pragma unroll
                for (int bj = 0; bj < 2; ++bj)
#pragma unroll
                    for (int n = 0; n < 2; ++n) { const f32x4 bs = ai == 0 ? pre[m][bj][n] : *(const f32x4*)(base + off + bj * HALF + n * 16); f32x4 o = bs + (acc[ai][bj][m][n] - sr.x) * sr.y;
                        if (bad) o = (f32x4){qnan, qnan, qnan, qnan}; *(f32x4*)(out + off + bj * HALF + n * 16) = o; }
                if (m & 1) asm volatile("" ::: "memory"); }
    }
};
struct EpiLnResLn {
    static constexpr bool PERM = false, AFTER_DRAIN = true;
    const float* base; float* out; bf16_t* xn; int ldc; const float* bias; PanelStats st1, st2; unsigned poison;
    __device__ __forceinline__ void fused(f32x4 (&acc)[2][2][4][2], const Unit& u, int wr, int wc, int fr, int fq, PG8_LAS unsigned char* lds, int wid, int lane) const {
        typedef float f32x2v __attribute__((ext_vector_type(2))); typedef unsigned u32x2v __attribute__((ext_vector_type(2)));
        const PG8_LAS f32x2v* S = (const PG8_LAS f32x2v*)(lds + 8192);
        const int col0 = u.pn * BM + wc * 32 + 4 * fq;
#pragma unroll
        for (int bj = 0; bj < 2; ++bj)
#pragma unroll
            for (int n = 0; n < 2; ++n) { const f32x4 bv = bias ? *(const f32x4*)(bias + col0 + bj * HALF + n * 16) : (f32x4){0.f, 0.f, 0.f, 0.f};
#pragma unroll
                for (int ai = 0; ai < 2; ++ai)
#pragma unroll
                    for (int m = 0; m < 4; ++m) acc[ai][bj][m][n] += bv; }
        bool bad = st1.run(acc, u, wr, wc, fr, fq, lds, wid, lane) || poison != 0u;
        const float qnan = __builtin_nanf("");
#pragma unroll
        for (int ai = 0; ai < 2; ++ai)
#pragma unroll
            for (int m = 0; m < 4; ++m) { const int r = ai * HALF + wr * 64 + m * 16 + fr; const f32x2v sr = S[r]; const size_t off = (size_t)(u.pm * BM + r) * ldc + col0;
#pragma unroll
                for (int bj = 0; bj < 2; ++bj)
#pragma unroll
                    for (int n = 0; n < 2; ++n) { const f32x4 bs = *(const f32x4*)(base + off + bj * HALF + n * 16); acc[ai][bj][m][n] = bs + (acc[ai][bj][m][n] - sr.x) * sr.y; }
                asm volatile("" : "+v"(acc[ai][0][m][0]), "+v"(acc[ai][0][m][1]), "+v"(acc[ai][1][m][0]), "+v"(acc[ai][1][m][1]));
                if (m & 1) asm volatile("" ::: "memory"); }
        const bool bad1 = bad;
        bad = st2.run(acc, u, wr, wc, fr, fq, lds, wid, lane) || bad;
#pragma unroll
        for (int ai = 0; ai < 2; ++ai)
#pragma unroll
            for (int m = 0; m < 4; ++m) { const int r = ai * HALF + wr * 64 + m * 16 + fr; const f32x2v sr = S[r]; const size_t off = (size_t)(u.pm * BM + r) * ldc + col0;
#pragma unroll
                for (int bj = 0; bj < 2; ++bj)
#pragma unroll
                    for (int n = 0; n < 2; ++n) { const f32x4 x1 = acc[ai][bj][m][n]; *(f32x4*)(out + off + bj * HALF + n * 16) = bad1 ? (f32x4){qnan, qnan, qnan, qnan} : x1;
                        const f32x4 o = (x1 - sr.x) * sr.y; u32x2v w; w.x = cvt_pk_bf16(o[0], o[1]); w.y = cvt_pk_bf16(o[2], o[3]);
                        if (bad) { w.x = 0x7fc07fc0u; w.y = 0x7fc07fc0u; } *(u32x2v*)(xn + off + bj * HALF + n * 16) = w; }
                asm volatile("" ::: "memory"); }
    }
};

template <class Epi, class Sched, bool ALIGN_EPI = false, bool SP2 = false>
__device__ __forceinline__ void gemm_phase(PG8_LAS unsigned char* lds, const Gemm g, const Sched& S, const Epi& E) {
    int tid_ = threadIdx.x; asm volatile("" : "+v"(tid_));
    const int tid = tid_, wid = __builtin_amdgcn_readfirstlane(tid >> 6), lane = tid & 63, wr = wid >> 2, wc = wid & 3, fr = lane & 15, fq = lane >> 4;
    const int K = g.K, nt = K / BK;
    unsigned voffA[2], voffB[2];
#pragma unroll
    for (int i = 0; i < 2; ++i) { int R, C; stage_rc(tid * 16 + i * 8192, R, C); const int Rb = Epi::PERM ? ((R & ~31) + perm32(R & 31)) : R;
        voffA[i] = (unsigned)(R * K + C) * 2u; voffB[i] = (unsigned)(Rb * K + C) * 2u; }
    const size_t kstep = (size_t)(BK * 2);
    const size_t hstep = (size_t)HALF * K * 2;
    const size_t tstep = 2 * hstep;
    const unsigned ldsw = (unsigned)wid * 1024u;
    const int aoff = lds_byte(wr * 64 + fr, fq * 8), boff = lds_byte(wc * 32 + fr, fq * 8);
#define PG8_SA(b, h) (((b) * 2 + (h)) * HTB)
#define PG8_SB(b, h) ((4 + (b) * 2 + (h)) * HTB)
#define PG8_STAGE(bufoff, gbase, voff) do { _Pragma("unroll") for (int _i = 0; _i < 2; ++_i) \
        __builtin_amdgcn_global_load_lds((const unsigned*)((const char*)(gbase) + (voff)[_i]), (PG8_LAS unsigned*)(lds + (bufoff) + ldsw + _i * 8192), 16, 0, 0); } while (0)
#define PG8_LDA(dst, b, h) do { _Pragma("unroll") for (int m = 0; m < 4; ++m) _Pragma("unroll") for (int k = 0; k < 2; ++k) dst[m][k] = *(const PG8_LAS bf16x8*)(lds + PG8_SA(b, h) + aoff + m * 2048 + k * 1024); } while (0)
#define PG8_LDB(dst, b, h) do { _Pragma("unroll") for (int n = 0; n < 2; ++n) _Pragma("unroll") for (int k = 0; k < 2; ++k) dst[n][k] = *(const PG8_LAS bf16x8*)(lds + PG8_SB(b, h) + boff + n * 2048 + k * 1024); } while (0)
#define PG8_MMA(ai, bj, At, Bt) do { __builtin_amdgcn_s_setprio(1); _Pragma("unroll") for (int m = 0; m < 4; ++m) _Pragma("unroll") for (int n = 0; n < 2; ++n) _Pragma("unroll") for (int k = 0; k < 2; ++k) \
        acc[ai][bj][m][n] = __builtin_amdgcn_mfma_f32_16x16x32_bf16(Bt[n][k], At[m][k], acc[ai][bj][m][n], 0, 0, 0); __builtin_amdgcn_s_setprio(0); } while (0)
#define PG8_WAIT_V(n) asm volatile("s_waitcnt vmcnt(" #n ")" ::: "memory")
#define PG8_WAIT_L(n) asm volatile("s_waitcnt lgkmcnt(" #n ")" ::: "memory")
#define PG8_BAR __builtin_amdgcn_s_barrier()
#define PG8_SCHED __builtin_amdgcn_sched_barrier(0)
    Unit cur, nxt; int ui = 0;
    if (!S.next(0, cur)) return;
    f32x4 acc[2][2][4][2];
#pragma unroll
    for (int a = 0; a < 2; ++a)
#pragma unroll
        for (int b = 0; b < 2; ++b)
#pragma unroll
            for (int m = 0; m < 4; ++m)
#pragma unroll
                for (int n = 0; n < 2; ++n) acc[a][b][m][n] = (f32x4){0.f, 0.f, 0.f, 0.f};
    bf16x8 At[4][2], B0[2][2], B1[2][2];
    const char* cA = (const char*)g.A + (size_t)cur.pm * tstep; const char* cB = (const char*)g.Bt + (size_t)cur.pn * tstep;
    S.a_ready(cur);
    if constexpr (SP2) {
        PG8_STAGE(PG8_SB(0, 0), cB, voffB); PG8_STAGE(PG8_SB(0, 1), cB + hstep, voffB); PG8_STAGE(PG8_SA(0, 0), cA, voffA); PG8_STAGE(PG8_SA(0, 1), cA + hstep, voffA);
        if (wr == 1) PG8_BAR;
        PG8_WAIT_V(2); PG8_BAR;
        PG8_STAGE(PG8_SB(1, 0), cB + kstep, voffB); PG8_STAGE(PG8_SA(1, 0), cA + kstep, voffA); PG8_STAGE(PG8_SB(1, 1), cB + hstep + kstep, voffB);
        PG8_WAIT_V(6); PG8_BAR;
    } else {
        PG8_STAGE(PG8_SB(0, 0), cB, voffB); PG8_STAGE(PG8_SA(0, 0), cA, voffA); PG8_STAGE(PG8_SB(0, 1), cB + hstep, voffB); PG8_STAGE(PG8_SA(0, 1), cA + hstep, voffA);
        if (wr == 1) PG8_BAR;
        PG8_WAIT_V(4); PG8_BAR;
        PG8_STAGE(PG8_SB(1, 0), cB + kstep, voffB); PG8_STAGE(PG8_SA(1, 0), cA + kstep, voffA); PG8_STAGE(PG8_SB(1, 1), cB + hstep + kstep, voffB);
        PG8_WAIT_V(6); PG8_BAR;
    }
    for (;;) {
        const bool has_next = S.next(ui + 1, nxt);
        const char* nA = has_next ? (const char*)g.A + (size_t)nxt.pm * tstep : cA; const char* nB = has_next ? (const char*)g.Bt + (size_t)nxt.pn * tstep : cB;
        for (int t = 0; t < nt; t += 2) {
            const bool last = (t == nt - 2);
            const char* a1 = cA + (size_t)(t + 1) * kstep;
            const char* a2 = last ? nA : cA + (size_t)(t + 2) * kstep; const char* b2 = last ? nB : cB + (size_t)(t + 2) * kstep;
            const char* a3 = a2 + kstep; const char* b3 = b2 + kstep;
            if (last && has_next) S.a_ready(nxt);
            if constexpr (SP2) {
            PG8_LDB(B0, 0, 0); PG8_LDB(B1, 0, 1); PG8_SCHED; PG8_LDA(At, 0, 0); PG8_STAGE(PG8_SA(1, 1), a1 + hstep, voffA);
            PG8_WAIT_V(8); PG8_WAIT_L(0); PG8_BAR; PG8_MMA(0, 0, At, B0); PG8_MMA(0, 1, At, B1); PG8_BAR; PG8_SCHED;
            PG8_LDA(At, 0, 1); PG8_STAGE(PG8_SB(0, 0), b2, voffB); PG8_STAGE(PG8_SB(0, 1), b2 + hstep, voffB); PG8_STAGE(PG8_SA(0, 0), a2, voffA);
            PG8_WAIT_V(8); PG8_WAIT_L(0); PG8_BAR; PG8_MMA(1, 0, At, B0); PG8_MMA(1, 1, At, B1); PG8_BAR; PG8_SCHED;
            PG8_LDB(B0, 1, 0); PG8_LDB(B1, 1, 1); PG8_SCHED; PG8_LDA(At, 1, 0); PG8_STAGE(PG8_SA(0, 1), a2 + hstep, voffA);
            PG8_WAIT_V(8); PG8_WAIT_L(0); PG8_BAR; PG8_MMA(0, 0, At, B0); PG8_MMA(0, 1, At, B1); PG8_BAR; PG8_SCHED;
            PG8_LDA(At, 1, 1); PG8_STAGE(PG8_SB(1, 0), b3, voffB); PG8_STAGE(PG8_SB(1, 1), b3 + hstep, voffB); PG8_STAGE(PG8_SA(1, 0), a3, voffA);
            PG8_WAIT_V(8); PG8_WAIT_L(0); PG8_BAR; PG8_MMA(1, 0, At, B0); PG8_MMA(1, 1, At, B1); PG8_BAR; PG8_SCHED;
            } else {
            PG8_LDB(B0, 0, 0); PG8_SCHED; PG8_LDA(At, 0, 0); PG8_STAGE(PG8_SA(1, 1), a1 + hstep, voffA);
            PG8_WAIT_L(8); PG8_BAR; PG8_WAIT_L(0); PG8_MMA(0, 0, At, B0); PG8_BAR; PG8_SCHED;
            PG8_LDB(B1, 0, 1); PG8_STAGE(PG8_SB(0, 0), b2, voffB);
            PG8_BAR; PG8_WAIT_L(0); PG8_MMA(0, 1, At, B1); PG8_BAR;
            PG8_LDA(At, 0, 1); PG8_STAGE(PG8_SA(0, 0), a2, voffA);
            PG8_BAR; PG8_WAIT_L(0); PG8_MMA(1, 0, At, B0); PG8_BAR; PG8_SCHED;
            PG8_STAGE(PG8_SB(0, 1), b2 + hstep, voffB);
            PG8_WAIT_V(6); PG8_BAR; PG8_MMA(1, 1, At, B1); PG8_BAR;
            PG8_LDB(B0, 1, 0); PG8_SCHED; PG8_LDA(At, 1, 0); PG8_STAGE(PG8_SA(0, 1), a2 + hstep, voffA);
            PG8_WAIT_L(8); PG8_BAR; PG8_WAIT_L(0); PG8_MMA(0, 0, At, B0); PG8_BAR; PG8_SCHED;
            PG8_LDB(B1, 1, 1); PG8_STAGE(PG8_SB(1, 0), b3, voffB);
            PG8_BAR; PG8_WAIT_L(0); PG8_MMA(0, 1, At, B1); PG8_BAR;
            PG8_LDA(At, 1, 1); PG8_STAGE(PG8_SA(1, 0), a3, voffA);
            PG8_BAR; PG8_WAIT_L(0); PG8_MMA(1, 0, At, B0); PG8_BAR; PG8_SCHED;
            PG8_STAGE(PG8_SB(1, 1), b3 + hstep, voffB);
            PG8_WAIT_V(6); PG8_BAR; PG8_MMA(1, 1, At, B1); PG8_BAR;
            }
        }
        if constexpr (ALIGN_EPI) { if (wr == 0) PG8_BAR; }
        if constexpr (!Epi::AFTER_DRAIN) { E(acc, cur, wr, wc, fr, fq); S.done(cur); }
        if (!has_next) break;
#pragma unroll
        for (int a = 0; a < 2; ++a)
#pragma unroll
            for (int b = 0; b < 2; ++b)
#pragma unroll
                for (int m = 0; m < 4; ++m)
#pragma unroll
                    for (int n = 0; n < 2; ++n) acc[a][b][m][n] = (f32x4){0.f, 0.f, 0.f, 0.f};
        cur = nxt; cA = nA; cB = nB; ++ui;
        if constexpr (ALIGN_EPI) { if (wr == 1) PG8_BAR; }
    }
    PG8_WAIT_V(0);
    if constexpr (!ALIGN_EPI) { if (wr == 0) PG8_BAR; }
    PG8_BAR;
    if constexpr (Epi::AFTER_DRAIN) { E.fused(acc, cur, wr, wc, fr, fq, lds, wid, lane); S.done(cur); }
#undef PG8_SA
#undef PG8_SB
#undef PG8_STAGE
#undef PG8_LDA
#undef PG8_LDB
#undef PG8_MMA
#undef PG8_WAIT_V
#undef PG8_WAIT_L
#undef PG8_BAR
#undef PG8_SCHED
}
}

namespace hp {
typedef unsigned short bf16_t;
typedef short bf16x8 __attribute__((ext_vector_type(8)));
typedef short s16x4 __attribute__((ext_vector_type(4)));
typedef float f32x4 __attribute__((ext_vector_type(4)));
typedef float f32x16 __attribute__((ext_vector_type(16)));
typedef unsigned u32x4 __attribute__((ext_vector_type(4)));
typedef unsigned u32x2 __attribute__((ext_vector_type(2)));

constexpr int NB = 4, SEQ = 4096, DM = 4096, NL = 4, MT = NB * SEQ;
constexpr int NIN = 11800, NINP = 12032, DFF = 11008, NGU = 2 * DFF;
constexpr int C_RQ = 0, C_RK = 1024, C_RV = 2048, C_RG = 3072, C_SQ = 4096, C_SK = 5120, C_SV = 6144, C_LG = 7168, C_LR = 8192,
              C_NQ = 9216, C_NKC = 10240, C_NVC = 10496, C_NKS = 10752, C_NVS = 11008, C_NKW = 11264, C_NVW = 11520, C_NG = 11776;
constexpr int MIX_RET = 0, MIX_SB = 1024, MIX_LRU = 2048, MIX_NSA = 3072;
constexpr int NTHR = 512, NWAVE = 8;
constexpr int LDS_STAGE = 131072, LDS_CTL = 256, LDS_BYTES = LDS_STAGE + LDS_CTL;

enum { I_X = 0, I_ANW, I_WIN, I_LCW, I_LCB, I_LWA, I_LBA, I_LWX, I_LBX, I_LLAM, I_NQW, I_NKW, I_CPOS, I_CW1, I_CW2, I_WOUT, I_MNW, I_WG, I_WU, I_MCW, I_MCB, I_WD, N_INPUTS };

constexpr size_t al256(size_t x) { return (x + 255) & ~(size_t)255; }
constexpr size_t WS_CTL   = 0;
constexpr size_t CTL_BYTES = 65536;
constexpr size_t WS_TAB_RC = WS_CTL + CTL_BYTES;
constexpr size_t WS_TAB_RS = WS_TAB_RC + (size_t)SEQ * 64 * 4;
constexpr size_t WS_TAB_NC = WS_TAB_RS + (size_t)SEQ * 64 * 4;
constexpr size_t WS_TAB_NS = WS_TAB_NC + (size_t)SEQ * 16 * 4;
constexpr size_t WS_WIN   = WS_TAB_NS + (size_t)SEQ * 16 * 4;
constexpr size_t WS_WOUT  = WS_WIN  + (size_t)NINP * DM * 2;
constexpr size_t WS_WGU   = WS_WOUT + (size_t)DM * DM * 2;
constexpr size_t WS_WDN   = WS_WGU  + (size_t)NGU * DM * 2;
constexpr size_t WS_CW1   = WS_WDN  + (size_t)DM * DFF * 2;
constexpr size_t WS_CW2   = WS_CW1  + (size_t)2 * 4096 * 256 * 2;
constexpr size_t WS_LWA   = WS_CW2  + (size_t)2 * 256 * 128 * 2;
constexpr size_t WS_LWX   = WS_LWA  + (size_t)8 * 128 * 128 * 2;
constexpr size_t WS_HN    = WS_LWX  + (size_t)8 * 128 * 128 * 2;
constexpr size_t WS_MIX   = WS_HN   + (size_t)MT * DM * 2;
constexpr size_t WS_PROJ  = WS_MIX  + (size_t)MT * DM * 2;
constexpr size_t WS_GU    = WS_PROJ;
constexpr size_t WS_H     = WS_PROJ + (size_t)MT * NGU * 2;
constexpr size_t WS_QR    = WS_H    + (size_t)MT * DFF * 2;
constexpr size_t WS_KR    = WS_QR   + (size_t)MT * 1024 * 2;
constexpr size_t WS_QN    = WS_KR   + (size_t)MT * 1024 * 2;
constexpr size_t WS_KSN   = WS_QN   + (size_t)MT * 1024 * 2;
constexpr size_t WS_KWN   = WS_KSN  + (size_t)MT * 256 * 2;
constexpr size_t WS_KCMP  = WS_KWN  + (size_t)MT * 256 * 2;
constexpr size_t WS_VCMP  = WS_KCMP + (size_t)8 * 256 * 128 * 2;
constexpr size_t WS_ST    = WS_VCMP + (size_t)8 * 256 * 128 * 2;
constexpr size_t WS_HLOC  = WS_ST   + (size_t)32 * 32 * 128 * 128 * 2;
constexpr size_t WS_CUMA  = WS_HLOC + (size_t)MT * 1024 * 4;
constexpr size_t WS_YNSA  = WS_CUMA + (size_t)MT * 1024 * 4;
constexpr size_t WS_END   = WS_YNSA + (size_t)MT * 1024 * 4;
constexpr int CW_BAR = 0;
constexpr int CW_QUEUE = 4096;

struct Params {
    const float* in[N_INPUTS];
    float* out;
    unsigned char* ws;
    int l_lo, l_hi, ph_lo, ph_hi;
};
typedef const __attribute__((address_space(4))) Params* KP;

__device__ __forceinline__ float bf2f(unsigned short v) { return __uint_as_float(((unsigned)v) << 16); }
__device__ __forceinline__ float bflo(unsigned w) { return __uint_as_float(w << 16); }
__device__ __forceinline__ float bfhi(unsigned w) { return __uint_as_float(w & 0xffff0000u); }
__device__ __forceinline__ unsigned cvt_pk(float lo, float hi) { unsigned r; asm volatile("v_cvt_pk_bf16_f32 %0, %1, %2" : "=v"(r) : "v"(lo), "v"(hi)); return r; }
__device__ __forceinline__ unsigned short f2bf(float f) { return (unsigned short)(cvt_pk(f, 0.f) & 0xffffu); }
__device__ __forceinline__ float fexp2(float x) { return __builtin_amdgcn_exp2f(x); }
__device__ __forceinline__ float flog2(float x) { return __builtin_amdgcn_logf(x); }
__device__ __forceinline__ float frcp(float x) { return __builtin_amdgcn_rcpf(x); }
__device__ __forceinline__ float sigmoidf_(float x) { return frcp(1.f + fexp2(-x * 1.4426950408889634f)); }
__device__ __forceinline__ float gelu_tanh(float x) {
    const float u = 0.7978845608028654f * (x + 0.044715f * x * x * x);
    const float t = 1.f - 2.f * frcp(1.f + fexp2(2.f * 1.4426950408889634f * u));
    return 0.5f * x * (1.f + t);
}
__device__ __forceinline__ float wave_sum(float v) {
#pragma unroll
    for (int o = 32; o >= 1; o >>= 1) v += __shfl_xor(v, o);
    return v;
}

__device__ __forceinline__ unsigned off_b(unsigned row, unsigned ch) { return 256u * row + 16u * (ch ^ (((row & 3u) << 2) | ((row >> 2) & 3u))); }
__device__ __forceinline__ bf16x8 row_frag(const LAS unsigned char* tile, int r0, int s, int lane) {
    return *(const LAS bf16x8*)(tile + off_b((unsigned)(r0 + (lane & 31)), (unsigned)(2 * s + (lane >> 5))));
}
__device__ __forceinline__ unsigned lds_addr(const LAS unsigned char* p) { return (unsigned)(size_t)p; }
__device__ __forceinline__ unsigned tr_off_nat(int lane, int c, int ks, int t) {
    const unsigned h = lane >> 5, blk = (lane >> 4) & 1, q = (lane & 15) >> 2, p = lane & 3;
    return off_b(16u * ks + 8u * h + 4u * t + q, 4u * c + 2u * blk + (p >> 1)) + 8u * (p & 1);
}
__device__ __forceinline__ unsigned tr_off_acc(int lane, int c, int ks, int t) {
    const unsigned h = lane >> 5, blk = (lane >> 4) & 1, q = (lane & 15) >> 2, p = lane & 3;
    return off_b(16u * ks + 8u * t + 4u * h + q, 4u * c + 2u * blk + (p >> 1)) + 8u * (p & 1);
}
__device__ __forceinline__ bf16x8 tr_read2(unsigned a0, unsigned a1) {
    s16x4 lo, hi;
    asm volatile("ds_read_b64_tr_b16 %0, %2\n\tds_read_b64_tr_b16 %1, %3\n\ts_waitcnt lgkmcnt(0)" : "=&v"(lo), "=&v"(hi) : "v"(a0), "v"(a1) : "memory");
    return __builtin_shufflevector(lo, hi, 0, 1, 2, 3, 4, 5, 6, 7);
}
__device__ __forceinline__ bf16x8 tr_frag_nat(const LAS unsigned char* tile, int c, int ks, int lane) {
    const unsigned b = lds_addr(tile);
    return tr_read2(b + tr_off_nat(lane, c, ks, 0), b + tr_off_nat(lane, c, ks, 1));
}
struct TrAcc { unsigned a[4][2]; };
__device__ __forceinline__ void tr_acc_init(TrAcc& A, int lane) {
#pragma unroll
    for (int c = 0; c < 4; ++c)
#pragma unroll
        for (int t = 0; t < 2; ++t) A.a[c][t] = tr_off_acc(lane, c, 0, t);
}
__device__ __forceinline__ void pv_step(f32x16 (&o)[4], unsigned vb  , const TrAcc& A, bf16x8 pf) {
    s16x4 d0, d1, d2, d3, d4, d5, d6, d7;
    asm volatile("ds_read_b64_tr_b16 %0, %8\n\tds_read_b64_tr_b16 %1, %9\n\tds_read_b64_tr_b16 %2, %10\n\tds_read_b64_tr_b16 %3, %11\n\t"
                 "ds_read_b64_tr_b16 %4, %12\n\tds_read_b64_tr_b16 %5, %13\n\tds_read_b64_tr_b16 %6, %14\n\tds_read_b64_tr_b16 %7, %15\n\ts_waitcnt lgkmcnt(0)"
                 : "=&v"(d0), "=&v"(d1), "=&v"(d2), "=&v"(d3), "=&v"(d4), "=&v"(d5), "=&v"(d6), "=&v"(d7)
                 : "v"(vb + A.a[0][0]), "v"(vb + A.a[0][1]), "v"(vb + A.a[1][0]), "v"(vb + A.a[1][1]), "v"(vb + A.a[2][0]), "v"(vb + A.a[2][1]), "v"(vb + A.a[3][0]), "v"(vb + A.a[3][1]) : "memory");
    o[0] = __builtin_amdgcn_mfma_f32_32x32x16_bf16(__builtin_shufflevector(d0, d1, 0, 1, 2, 3, 4, 5, 6, 7), pf, o[0], 0, 0, 0);
    o[1] = __builtin_amdgcn_mfma_f32_32x32x16_bf16(__builtin_shufflevector(d2, d3, 0, 1, 2, 3, 4, 5, 6, 7), pf, o[1], 0, 0, 0);
    o[2] = __builtin_amdgcn_mfma_f32_32x32x16_bf16(__builtin_shufflevector(d4, d5, 0, 1, 2, 3, 4, 5, 6, 7), pf, o[2], 0, 0, 0);
    o[3] = __builtin_amdgcn_mfma_f32_32x32x16_bf16(__builtin_shufflevector(d6, d7, 0, 1, 2, 3, 4, 5, 6, 7), pf, o[3], 0, 0, 0);
}
__device__ __forceinline__ f32x16 qk_block(const LAS unsigned char* ktile, int kb, const bf16x8 (&qf)[8], int lane) {
    f32x16 acc;
#pragma unroll
    for (int i = 0; i < 16; ++i) acc[i] = 0.f;
#pragma unroll
    for (int s = 0; s < 8; ++s) acc = __builtin_amdgcn_mfma_f32_32x32x16_bf16(row_frag(ktile, 32 * kb, s, lane), qf[s], acc, 0, 0, 0);
    return acc;
}
__device__ __forceinline__ bf16x8 pack8(const f32x16& p, int s2) {
    u32x4 w; w.x = cvt_pk(p[8 * s2 + 0], p[8 * s2 + 1]); w.y = cvt_pk(p[8 * s2 + 2], p[8 * s2 + 3]); w.z = cvt_pk(p[8 * s2 + 4], p[8 * s2 + 5]); w.w = cvt_pk(p[8 * s2 + 6], p[8 * s2 + 7]);
    return __builtin_bit_cast(bf16x8, w);
}
template <int ROWS> struct TileRegs { u32x4 r[ROWS * 16 / NTHR]; };
template <int ROWS> __device__ __forceinline__ void tile_load(TileRegs<ROWS>& R, const bf16_t* src, size_t ld, int tid) {
#pragma unroll
    for (int i = 0; i < ROWS * 16 / NTHR; ++i) { const int c = tid + NTHR * i; R.r[i] = *(const u32x4*)(src + (size_t)(c >> 4) * ld + (c & 15) * 8); }
}
template <int ROWS> __device__ __forceinline__ void tile_store(LAS unsigned char* tile, const TileRegs<ROWS>& R, int tid) {
#pragma unroll
    for (int i = 0; i < ROWS * 16 / NTHR; ++i) { const int c = tid + NTHR * i; *(LAS u32x4*)(tile + off_b((unsigned)(c >> 4), (unsigned)(c & 15))) = R.r[i]; }
}
template <int ROWS> __device__ __forceinline__ void tile_stage(LAS unsigned char* tile, const bf16_t* src, size_t ld, int tid) {
    TileRegs<ROWS> R; tile_load<ROWS>(R, src, ld, tid); tile_store<ROWS>(tile, R, tid);
}
__device__ __forceinline__ int next_task(unsigned* ctr, volatile LAS int* slot, int tid) {
    __syncthreads();
    if (tid == 0) *slot = (int)__hip_atomic_fetch_add(ctr, 1u, __ATOMIC_RELAXED, __HIP_MEMORY_SCOPE_AGENT);
    __syncthreads();
    return *slot;
}

__device__ __forceinline__ void ph_convert(KP p, int l, LAS unsigned char* lds, int tid, int bid, int G) {
    asm volatile("" : "+v"(tid), "+s"(p));
    LAS float* T = (LAS float*)lds;
    bf16_t* WINb = (bf16_t*)(p->ws + WS_WIN); bf16_t* WOUTb = (bf16_t*)(p->ws + WS_WOUT); bf16_t* WGUb = (bf16_t*)(p->ws + WS_WGU); bf16_t* WDNb = (bf16_t*)(p->ws + WS_WDN);
    for (int t = bid; t < 49152; t += G) {
        const float* W; int K, N, ntn; bf16_t* Bt; int tt = t;
        if (tt < 12032) { W = p->in[I_WIN] + (size_t)l * 4096 * NIN; K = 4096; N = NIN; Bt = WINb; ntn = 188; }
        else if ((tt -= 12032) < 4096) { W = p->in[I_WOUT] + (size_t)l * 4096 * 4096; K = 4096; N = 4096; Bt = WOUTb; ntn = 64; }
        else if ((tt -= 4096) < 11008) { W = p->in[I_WG] + (size_t)l * 4096 * DFF; K = 4096; N = DFF; Bt = WGUb; ntn = 172; }
        else if ((tt -= 11008) < 11008) { W = p->in[I_WU] + (size_t)l * 4096 * DFF; K = 4096; N = DFF; Bt = WGUb + (size_t)DFF * 4096; ntn = 172; }
        else { tt -= 11008; W = p->in[I_WD] + (size_t)l * DFF * 4096; K = DFF; N = 4096; Bt = WDNb; ntn = 64; }
        const int kt = tt / ntn, nt = tt - kt * ntn, k0 = kt * 64, n0 = nt * 64;
        const int r = tid >> 4, c4 = (tid & 15) * 4;
#pragma unroll
        for (int i = 0; i < 2; ++i) {
            const int k = k0 + r + 32 * i, n = n0 + c4;
            f32x4 v = (f32x4){0.f, 0.f, 0.f, 0.f};
            if (n < N) v = *(const f32x4*)(W + (size_t)k * N + n);
#pragma unroll
            for (int j = 0; j < 4; ++j) T[(c4 + j) * 65 + r + 32 * i] = v[j];
        }
        __syncthreads();
        {
            const int nl = tid >> 3, k8 = (tid & 7) * 8;
            float v[8];
#pragma unroll
            for (int j = 0; j < 8; ++j) v[j] = T[nl * 65 + k8 + j];
            u32x4 w; w.x = cvt_pk(v[0], v[1]); w.y = cvt_pk(v[2], v[3]); w.z = cvt_pk(v[4], v[5]); w.w = cvt_pk(v[6], v[7]);
            *(u32x4*)(Bt + (size_t)(n0 + nl) * K + k0 + k8) = w;
        }
        __syncthreads();
    }
    {
        const size_t gtid = (size_t)bid * NTHR + tid, gstride = (size_t)G * NTHR;
        const float* s1 = p->in[I_CW1] + (size_t)l * 2 * 4096 * 256; bf16_t* d1 = (bf16_t*)(p->ws + WS_CW1);
        for (size_t i = gtid; i < (size_t)2 * 4096 * 256 / 4; i += gstride) { const f32x4 v = *(const f32x4*)(s1 + i * 4); u32x2 w; w.x = cvt_pk(v[0], v[1]); w.y = cvt_pk(v[2], v[3]); *(u32x2*)(d1 + i * 4) = w; }
        const float* s2 = p->in[I_CW2] + (size_t)l * 2 * 256 * 128; bf16_t* d2 = (bf16_t*)(p->ws + WS_CW2);
        for (size_t i = gtid; i < (size_t)2 * 256 * 128 / 4; i += gstride) { const f32x4 v = *(const f32x4*)(s2 + i * 4); u32x2 w; w.x = cvt_pk(v[0], v[1]); w.y = cvt_pk(v[2], v[3]); *(u32x2*)(d2 + i * 4) = w; }
        const float* s3 = p->in[I_LWA] + (size_t)l * 8 * 128 * 128; bf16_t* d3 = (bf16_t*)(p->ws + WS_LWA);
        for (size_t i = gtid; i < (size_t)8 * 128 * 128 / 4; i += gstride) { const f32x4 v = *(const f32x4*)(s3 + i * 4); u32x2 w; w.x = cvt_pk(v[0], v[1]); w.y = cvt_pk(v[2], v[3]); *(u32x2*)(d3 + i * 4) = w; }
        const float* s4 = p->in[I_LWX] + (size_t)l * 8 * 128 * 128; bf16_t* d4 = (bf16_t*)(p->ws + WS_LWX);
        for (size_t i = gtid; i < (size_t)8 * 128 * 128 / 4; i += gstride) { const f32x4 v = *(const f32x4*)(s4 + i * 4); u32x2 w; w.x = cvt_pk(v[0], v[1]); w.y = cvt_pk(v[2], v[3]); *(u32x2*)(d4 + i * 4) = w; }
    }
}

__device__ __forceinline__ void sincos_acc(double x, float& sn, float& cs) {
    const double kf = rint(x * 0.63661977236758134308);
    const double r = fma(-kf, 6.123233995736766036e-17, fma(-kf, 1.5707963267948965580, x));
    const double z = r * r;
    const double sr = r + r * z * (-0.166666666416265235595 + z * (0.0083333293858894631756 + z * (-0.000198393348360966317347 + z * 0.0000027183114939898219064)));
    const double cr = 1.0 + z * (-0.499999997251031003120 + z * (0.0416666233237390631894 + z * (-0.00138867637746099294692 + z * 0.0000243904487962774090654)));
    const int n = ((int)kf) & 3;
    const double s = (n == 0) ? sr : (n == 1) ? cr : (n == 2) ? -sr : -cr;
    const double c = (n == 0) ? cr : (n == 1) ? -sr : (n == 2) ? -cr : sr;
    sn = (float)s; cs = (float)c;
}
__device__ __forceinline__ void ph_tables(KP p, int tid, int bid, int G) {
    asm volatile("" : "+v"(tid), "+s"(p));
    float* rc = (float*)(p->ws + WS_TAB_RC); float* rs = (float*)(p->ws + WS_TAB_RS); float* nc = (float*)(p->ws + WS_TAB_NC); float* ns = (float*)(p->ws + WS_TAB_NS);
    const int gtid = bid * NTHR + tid, gstride = G * NTHR;
    for (int i = gtid; i < SEQ * 64; i += gstride) {
        const int pos = i >> 6, f = i & 63;
        const double inv = exp2(-((double)f / 63.0) * 13.287712379549449);
        float s, c; sincos_acc((double)pos * inv, s, c); rc[i] = c; rs[i] = s;
    }
    for (int i = gtid; i < SEQ * 16; i += gstride) {
        const int pos = i >> 4, f = i & 15;
        const double inv = exp2(-((double)f / 16.0) * 18.931568569324174);
        float s, c; sincos_acc((double)pos * inv, s, c); nc[i] = c; ns[i] = s;
    }
}

__device__ __forceinline__ void ph_rmsnorm(const float* x, const float* w, bf16_t* hn, int tid, int bid, int G) {
    asm volatile("" : "+v"(tid));
    const int lane = tid & 63, wave = tid >> 6;
    for (int row = bid * NWAVE + wave; row < MT; row += G * NWAVE) {
        const float* xr = x + (size_t)row * DM;
        f32x4 v[16]; float ss = 0.f;
#pragma unroll
        for (int i = 0; i < 16; ++i) { v[i] = *(const f32x4*)(xr + (i * 64 + lane) * 4); ss += v[i][0] * v[i][0] + v[i][1] * v[i][1] + v[i][2] * v[i][2] + v[i][3] * v[i][3]; }
        ss = wave_sum(ss);
        const float r = 1.0f / sqrtf(ss * (1.0f / DM) + 1e-6f);
#pragma unroll
        for (int i = 0; i < 16; ++i) {
            const f32x4 g = *(const f32x4*)(w + (i * 64 + lane) * 4);
            u32x2 o; o.x = cvt_pk(v[i][0] * r * g[0], v[i][1] * r * g[1]); o.y = cvt_pk(v[i][2] * r * g[2], v[i][3] * r * g[3]);
            *(u32x2*)(hn + (size_t)row * DM + (i * 64 + lane) * 4) = o;
        }
    }
}

__device__ __forceinline__ void ph_mlp_act(KP p, int l, int tid, int bid, int G) {
    asm volatile("" : "+v"(tid), "+s"(p));
    const bf16_t* GU = (const bf16_t*)(p->ws + WS_GU); bf16_t* H = (bf16_t*)(p->ws + WS_H);
    const float* cw = p->in[I_MCW] + (size_t)l * 3 * DFF; const float* cb = p->in[I_MCB] + (size_t)l * DFF;
    constexpr int NFG = DFF / 8, NTG = MT / 8;
    for (int it = bid * NTHR + tid; it < NFG * NTG; it += G * NTHR) {
        const int tg = it / NFG, fg = it - tg * NFG, f0 = fg * 8, t0 = tg * 8;
        float w0[8], w1[8], w2[8], bb[8];
#pragma unroll
        for (int j = 0; j < 8; j += 4) {
            const f32x4 a = *(const f32x4*)(cw + f0 + j), b = *(const f32x4*)(cw + DFF + f0 + j), c = *(const f32x4*)(cw + 2 * DFF + f0 + j), d = *(const f32x4*)(cb + f0 + j);
#pragma unroll
            for (int q = 0; q < 4; ++q) { w0[j + q] = a[q]; w1[j + q] = b[q]; w2[j + q] = c[q]; bb[j + q] = d[q]; }
        }
        float gm2[8], gm1[8];
        const bool first = (t0 & (SEQ - 1)) == 0;
        {
            u32x4 a = (u32x4){0u, 0u, 0u, 0u}, b = (u32x4){0u, 0u, 0u, 0u};
            if (!first) { a = *(const u32x4*)(GU + (size_t)(t0 - 2) * NGU + f0); b = *(const u32x4*)(GU + (size_t)(t0 - 1) * NGU + f0); }
#pragma unroll
            for (int q = 0; q < 4; ++q) { gm2[2 * q] = bflo(a[q]); gm2[2 * q + 1] = bfhi(a[q]); gm1[2 * q] = bflo(b[q]); gm1[2 * q + 1] = bfhi(b[q]); }
        }
#pragma unroll
        for (int i = 0; i < 8; ++i) {
            const u32x4 gv = *(const u32x4*)(GU + (size_t)(t0 + i) * NGU + f0), uv = *(const u32x4*)(GU + (size_t)(t0 + i) * NGU + DFF + f0);
            float g0[8], up[8], hv[8];
#pragma unroll
            for (int q = 0; q < 4; ++q) { g0[2 * q] = bflo(gv[q]); g0[2 * q + 1] = bfhi(gv[q]); up[2 * q] = bflo(uv[q]); up[2 * q + 1] = bfhi(uv[q]); }
#pragma unroll
            for (int j = 0; j < 8; ++j) { const float y = bb[j] + w0[j] * gm2[j] + w1[j] * gm1[j] + w2[j] * g0[j]; hv[j] = y * sigmoidf_(y) * up[j]; gm2[j] = gm1[j]; gm1[j] = g0[j]; }
            u32x4 o; o.x = cvt_pk(hv[0], hv[1]); o.y = cvt_pk(hv[2], hv[3]); o.z = cvt_pk(hv[4], hv[5]); o.w = cvt_pk(hv[6], hv[7]);
            *(u32x4*)(H + (size_t)(t0 + i) * DFF + f0) = o;
        }
    }
}

struct EpiResid {
    static constexpr bool PERM = false, AFTER_DRAIN = false;
    const float* base; float* out; int ldc;
    __device__ __forceinline__ void operator()(const pg8::f32x4 (&acc)[2][2][4][2], const pg8::Unit& u, int wr, int wc, int fr, int fq) const {
        const int row0 = u.pm * 256 + wr * 64 + fr, col0 = u.pn * 256 + wc * 32 + 4 * fq;
#pragma unroll
        for (int ai = 0; ai < 2; ++ai)
#pragma unroll
            for (int m = 0; m < 4; ++m) { const size_t off = (size_t)(row0 + ai * 128 + m * 16) * ldc + col0;
#pragma unroll
                for (int bj = 0; bj < 2; ++bj)
#pragma unroll
                    for (int n = 0; n < 2; ++n) { const pg8::f32x4 bs = *(const pg8::f32x4*)(base + off + bj * 128 + n * 16); *(pg8::f32x4*)(out + off + bj * 128 + n * 16) = bs + acc[ai][bj][m][n]; }
                asm volatile("" ::: "memory"); }
    }
};

__device__ __forceinline__ void ph_prep_elem(KP p, int l, int tid, int bid, int G) {
    asm volatile("" : "+v"(tid), "+s"(p));
    const int lane = tid & 63, wave = tid >> 6;
    const bf16_t* PROJ = (const bf16_t*)(p->ws + WS_PROJ);
    bf16_t* QR = (bf16_t*)(p->ws + WS_QR); bf16_t* KR = (bf16_t*)(p->ws + WS_KR); bf16_t* QN = (bf16_t*)(p->ws + WS_QN); bf16_t* KSN = (bf16_t*)(p->ws + WS_KSN); bf16_t* KWN = (bf16_t*)(p->ws + WS_KWN);
    const float* rc = (const float*)(p->ws + WS_TAB_RC); const float* rs = (const float*)(p->ws + WS_TAB_RS); const float* nc = (const float*)(p->ws + WS_TAB_NC); const float* ns = (const float*)(p->ws + WS_TAB_NS);
    const float* qw = p->in[I_NQW] + (size_t)l * 128; const float* kw = p->in[I_NKW] + (size_t)l * 3 * 128;
    for (int it = bid * NWAVE + wave; it < MT * 20; it += G * NWAVE) {
        const int tok = it / 20, kind = it - tok * 20, b = tok >> 12, s = tok & (SEQ - 1);
        const bf16_t* prow = PROJ + (size_t)tok * NINP;
        if (kind < 8) {
            const int h = kind;
            const float c = rc[s * 64 + lane], sn = rs[s * 64 + lane];
            const float lg2 = log2f(1.0f - exp2f(-5.0f - (float)h));
            const float e = (float)((s & 127) + 1) * lg2;
            const float dq = exp2f(e), dk = exp2f(-e) * 0.08838834764831845f;
            const float q1 = bf2f(prow[C_RQ + h * 128 + lane]), q2 = bf2f(prow[C_RQ + h * 128 + 64 + lane]);
            const float k1 = bf2f(prow[C_RK + h * 128 + lane]), k2 = bf2f(prow[C_RK + h * 128 + 64 + lane]);
            const size_t o = ((size_t)(b * 8 + h) * SEQ + s) * 128;
            QR[o + lane] = f2bf((q1 * c - q2 * sn) * dq); QR[o + 64 + lane] = f2bf((q2 * c + q1 * sn) * dq);
            KR[o + lane] = f2bf((k1 * c - k2 * sn) * dk); KR[o + 64 + lane] = f2bf((k2 * c + k1 * sn) * dk);
        } else {
            int col; const float* w; bf16_t* dst;
            if (kind < 16) { const int hd = kind - 8; col = C_NQ + hd * 128; w = qw; dst = QN + ((size_t)(b * 8 + hd) * SEQ + s) * 128; }
            else if (kind < 18) { const int g = kind - 16; col = C_NKS + g * 128; w = kw + 128; dst = KSN + ((size_t)(b * 2 + g) * SEQ + s) * 128; }
            else { const int g = kind - 18; col = C_NKW + g * 128; w = kw + 256; dst = KWN + ((size_t)(b * 2 + g) * SEQ + s) * 128; }
            const float x1 = bf2f(prow[col + lane]), x2 = bf2f(prow[col + 64 + lane]);
            const float ss = wave_sum(x1 * x1 + x2 * x2);
            const float r = 1.0f / sqrtf(ss * (1.0f / 128.0f) + 1e-6f);
            float y1 = x1 * r * w[lane]; const float y2 = x2 * r * w[64 + lane];
            const float pr = __shfl_xor(y1, 16);
            if (lane < 32) {
                const float c = nc[s * 16 + (lane & 15)], sn = ns[s * 16 + (lane & 15)];
                y1 = (lane < 16) ? (y1 * c - pr * sn) : (y1 * c + pr * sn);
            }
            dst[lane] = f2bf(y1); dst[64 + lane] = f2bf(y2);
        }
    }
}

__device__ __forceinline__ void lru_c1_task(KP p, int l, int task, LAS unsigned char* lds, int tid) {
    asm volatile("" : "+v"(tid), "+s"(p));
    const int lane = tid & 63, wave = __builtin_amdgcn_readfirstlane(tid >> 6), hh = lane >> 5;
    const int ck = task & 63, n = (task >> 6) & 7, b = task >> 9, s0 = ck * 64;
    const bf16_t* PROJ = (const bf16_t*)(p->ws + WS_PROJ);
    LAS unsigned char* XB = lds;
    LAS float* X32 = (LAS float*)(lds + 16384);
    LAS unsigned char* WA = lds + 49152;
    LAS unsigned char* WX = lds + 81920;
    tile_stage<128>(WA, (const bf16_t*)(p->ws + WS_LWA) + (size_t)n * 128 * 128, 128, tid);
    tile_stage<128>(WX, (const bf16_t*)(p->ws + WS_LWX) + (size_t)n * 128 * 128, 128, tid);
    {
        const int tt = tid >> 3, c0 = (tid & 7) * 16, ch0 = n * 128 + c0;
        const float* cw = p->in[I_LCW] + (size_t)l * 4 * 1024; const float* cb = p->in[I_LCB] + (size_t)l * 1024;
        float acc[16];
#pragma unroll
        for (int j = 0; j < 16; j += 4) { const f32x4 v = *(const f32x4*)(cb + ch0 + j); acc[j] = v[0]; acc[j + 1] = v[1]; acc[j + 2] = v[2]; acc[j + 3] = v[3]; }
#pragma unroll
        for (int k = 0; k < 4; ++k) {
            const int s = s0 + tt - 3 + k;
            if (s >= 0) {
                const bf16_t* src = PROJ + (size_t)(b * SEQ + s) * NINP + C_LR + ch0;
                const u32x4 v0 = *(const u32x4*)src, v1 = *(const u32x4*)(src + 8);
#pragma unroll
                for (int j = 0; j < 16; j += 4) {
                    const f32x4 w = *(const f32x4*)(cw + k * 1024 + ch0 + j);
                    const unsigned a = (j < 8) ? v0[(j >> 1) & 3] : v1[(j >> 1) & 3], bq = (j < 8) ? v0[((j >> 1) + 1) & 3] : v1[((j >> 1) + 1) & 3];
                    acc[j] += w[0] * bflo(a); acc[j + 1] += w[1] * bfhi(a); acc[j + 2] += w[2] * bflo(bq); acc[j + 3] += w[3] * bfhi(bq);
                }
            }
        }
#pragma unroll
        for (int j = 0; j < 16; j += 4) *(LAS f32x4*)(X32 + tt * 128 + c0 + j) = (f32x4){acc[j], acc[j + 1], acc[j + 2], acc[j + 3]};
        u32x4 o0, o1;
        o0.x = cvt_pk(acc[0], acc[1]); o0.y = cvt_pk(acc[2], acc[3]); o0.z = cvt_pk(acc[4], acc[5]); o0.w = cvt_pk(acc[6], acc[7]);
        o1.x = cvt_pk(acc[8], acc[9]); o1.y = cvt_pk(acc[10], acc[11]); o1.z = cvt_pk(acc[12], acc[13]); o1.w = cvt_pk(acc[14], acc[15]);
        *(LAS u32x4*)(XB + off_b((unsigned)tt, (unsigned)(c0 >> 3))) = o0; *(LAS u32x4*)(XB + off_b((unsigned)tt, (unsigned)(c0 >> 3) + 1u)) = o1;
    }
    __syncthreads();
    const int tb = wave >> 2, db = wave & 3;
    f32x16 ca, cx;
#pragma unroll
    for (int i = 0; i < 16; ++i) { ca[i] = 0.f; cx[i] = 0.f; }
#pragma unroll
    for (int s = 0; s < 8; ++s) {
        const bf16x8 a = row_frag(XB, 32 * tb, s, lane);
        const bf16x8 ba = tr_frag_nat(WA, db, s, lane), bx = tr_frag_nat(WX, db, s, lane);
        ca = __builtin_amdgcn_mfma_f32_32x32x16_bf16(a, ba, ca, 0, 0, 0);
        cx = __builtin_amdgcn_mfma_f32_32x32x16_bf16(a, bx, cx, 0, 0, 0);
    }
    __syncthreads();
    {
        const int d = 32 * db + (lane & 31), ch = n * 128 + d;
        const float ba = p->in[I_LBA][(size_t)l * 1024 + ch], bx = p->in[I_LBX][(size_t)l * 1024 + ch], lam = p->in[I_LLAM][(size_t)l * 1024 + ch];
        const float lsl = fminf(lam, 0.f) - log1pf(expf(-fabsf(lam)));
        LAS float* AA = (LAS float*)WA; LAS float* UU = (LAS float*)WX;
#pragma unroll
        for (int r = 0; r < 16; ++r) {
            const int tok = 32 * tb + (r & 3) + 8 * (r >> 2) + 4 * hh;
            const float rg = sigmoidf_(ca[r] + ba), ig = sigmoidf_(cx[r] + bx);
            const float la = 8.0f * rg * lsl;
            const float a = expf(la);
            const float x2 = 2.0f * la;
            const float em1 = (x2 > -0.1f) ? x2 * (1.f + x2 * 0.5f * (1.f + x2 * (1.f / 3.f) * (1.f + x2 * 0.25f * (1.f + x2 * 0.2f)))) : (expf(x2) - 1.0f);
            float mult = sqrtf(fmaxf(-em1, 0.f));
            if (s0 + tok == 0) mult = 1.0f;
            AA[tok * 128 + d] = a; UU[tok * 128 + d] = mult * ig * X32[tok * 128 + d];
        }
    }
    __syncthreads();
    if (tid < 128) {
        const LAS float* AA = (const LAS float*)WA; const LAS float* UU = (const LAS float*)WX;
        float* hl = (float*)(p->ws + WS_HLOC) + (size_t)(b * SEQ + s0) * 1024 + n * 128 + tid;
        float* cu = (float*)(p->ws + WS_CUMA) + (size_t)(b * SEQ + s0) * 1024 + n * 128 + tid;
        float h = 0.f, P = 1.f;
#pragma unroll 8
        for (int t = 0; t < 64; ++t) { const float a = AA[t * 128 + tid], u = UU[t * 128 + tid]; h = a * h + u; P *= a; hl[(size_t)t * 1024] = h; cu[(size_t)t * 1024] = P; }
    }
}

__device__ __forceinline__ void lru_c3_task(KP p, int task, LAS unsigned char* lds, int tid) {
    asm volatile("" : "+v"(tid), "+s"(p));
    const int ck = task & 63, n = (task >> 6) & 7, b = task >> 9, s0 = ck * 64;
    const float* HL = (const float*)(p->ws + WS_HLOC); const float* CU = (const float*)(p->ws + WS_CUMA);
    const bf16_t* PROJ = (const bf16_t*)(p->ws + WS_PROJ); bf16_t* MIX = (bf16_t*)(p->ws + WS_MIX);
    LAS float* Hin = (LAS float*)lds;
    if (tid < 128) {
        float H = 0.f;
        const size_t base = (size_t)(b * SEQ + 63) * 1024 + n * 128 + tid;
        for (int c = 0; c < ck; ++c) { const float a = CU[base + (size_t)c * 64 * 1024], hv = HL[base + (size_t)c * 64 * 1024]; H = a * H + hv; }
        Hin[tid] = H;
    }
    __syncthreads();
    const int c4 = (tid & 31) * 4;
    const f32x4 hin = *(const LAS f32x4*)(Hin + c4);
#pragma unroll
    for (int i = 0; i < 4; ++i) {
        const int tok = (tid >> 5) + 16 * i;
        const size_t row = (size_t)(b * SEQ + s0 + tok);
        const f32x4 hl = *(const f32x4*)(HL + row * 1024 + n * 128 + c4), cu = *(const f32x4*)(CU + row * 1024 + n * 128 + c4);
        const u32x2 gv = *(const u32x2*)(PROJ + row * NINP + C_LG + n * 128 + c4);
        const float g0 = bflo(gv.x), g1 = bfhi(gv.x), g2 = bflo(gv.y), g3 = bfhi(gv.y);
        u32x2 o; o.x = cvt_pk((hl[0] + cu[0] * hin[0]) * gelu_tanh(g0), (hl[1] + cu[1] * hin[1]) * gelu_tanh(g1));
        o.y = cvt_pk((hl[2] + cu[2] * hin[2]) * gelu_tanh(g2), (hl[3] + cu[3] * hin[3]) * gelu_tanh(g3));
        *(u32x2*)(MIX + row * DM + MIX_LRU + n * 128 + c4) = o;
    }
}

__device__ __forceinline__ void cmp_task(KP p, int l, int task, LAS unsigned char* lds, int tid) {
    asm volatile("" : "+v"(tid), "+s"(p));
    const int lane = tid & 63, wave = __builtin_amdgcn_readfirstlane(tid >> 6), hh = lane >> 5;
    const int rt = task & 7, bg = (task >> 3) & 7, kv = task >> 6, b = bg >> 1, g = bg & 1, n0 = rt * 32;
    const bf16_t* PROJ = (const bf16_t*)(p->ws + WS_PROJ);
    const bf16_t* W1 = (const bf16_t*)(p->ws + WS_CW1) + (size_t)kv * 4096 * 256;
    const bf16_t* W2 = (const bf16_t*)(p->ws + WS_CW2) + (size_t)kv * 256 * 128;
    const float* pos = p->in[I_CPOS] + ((size_t)l * 2 + kv) * 32 * 128;
    const int col = (kv ? C_NVC : C_NKC) + g * 128;
    LAS unsigned char* AT = lds;
    LAS unsigned char* B0 = lds + 8192;
    LAS unsigned char* B1 = lds + 40960;
    LAS unsigned char* H0 = lds + 73728;
    LAS unsigned char* H1 = lds + 81920;
    f32x16 acc;
#pragma unroll
    for (int i = 0; i < 16; ++i) acc[i] = 0.f;
    for (int li = 0; li < 32; ++li) {
        __syncthreads();
        {
            const int row = tid >> 4, ch = tid & 15, n = n0 + row;
            u32x4 o = (u32x4){0u, 0u, 0u, 0u};
            if (n < 255) {
                const u32x4 v = *(const u32x4*)(PROJ + (size_t)(b * SEQ + 16 * n + li) * NINP + col + ch * 8);
                const f32x4 p0 = *(const f32x4*)(pos + li * 128 + ch * 8), p1 = *(const f32x4*)(pos + li * 128 + ch * 8 + 4);
                o.x = cvt_pk(bflo(v.x) + p0[0], bfhi(v.x) + p0[1]); o.y = cvt_pk(bflo(v.y) + p0[2], bfhi(v.y) + p0[3]);
                o.z = cvt_pk(bflo(v.z) + p1[0], bfhi(v.z) + p1[1]); o.w = cvt_pk(bflo(v.w) + p1[2], bfhi(v.w) + p1[3]);
            }
            *(LAS u32x4*)(AT + off_b((unsigned)row, (unsigned)ch)) = o;
        }
#pragma unroll
        for (int i = 0; i < 8; ++i) {
            const int c = tid + NTHR * i, d = c >> 5, hc = c & 31;
            const u32x4 v = *(const u32x4*)(W1 + (size_t)(li * 128 + d) * 256 + hc * 8);
            *(LAS u32x4*)(((hc >> 4) ? B1 : B0) + off_b((unsigned)d, (unsigned)(hc & 15))) = v;
        }
        __syncthreads();
        const LAS unsigned char* Bt = (wave >> 2) ? B1 : B0;
#pragma unroll
        for (int s = 0; s < 8; ++s) acc = __builtin_amdgcn_mfma_f32_32x32x16_bf16(row_frag(AT, 0, s, lane), tr_frag_nat(Bt, wave & 3, s, lane), acc, 0, 0, 0);
    }
    {
        LAS unsigned char* Ht = (wave >> 2) ? H1 : H0;
        const int cc = 32 * (wave & 3) + (lane & 31);
#pragma unroll
        for (int r = 0; r < 16; ++r) {
            const int n = (r & 3) + 8 * (r >> 2) + 4 * hh;
            *(LAS unsigned short*)(Ht + off_b((unsigned)n, (unsigned)(cc >> 3)) + 2 * (cc & 7)) = f2bf(gelu_tanh(acc[r]));
        }
    }
    __syncthreads();
#pragma unroll
    for (int i = 0; i < 8; ++i) {
        const int c = tid + NTHR * i, hr = c >> 4, ch = c & 15;
        const u32x4 v = *(const u32x4*)(W2 + (size_t)hr * 128 + ch * 8);
        *(LAS u32x4*)(((hr >> 7) ? B1 : B0) + off_b((unsigned)(hr & 127), (unsigned)ch)) = v;
    }
    __syncthreads();
    if (wave == 0) {
        f32x16 o[4];
#pragma unroll
        for (int db = 0; db < 4; ++db) {
#pragma unroll
            for (int i = 0; i < 16; ++i) o[db][i] = 0.f;
#pragma unroll
            for (int ks = 0; ks < 16; ++ks)
                o[db] = __builtin_amdgcn_mfma_f32_32x32x16_bf16(tr_frag_nat((ks >> 3) ? B1 : B0, db, ks & 7, lane), row_frag((ks >> 3) ? H1 : H0, 0, ks & 7, lane), o[db], 0, 0, 0);
        }
        const int n = n0 + (lane & 31);
        bf16_t* dst = (bf16_t*)(p->ws + (kv ? WS_VCMP : WS_KCMP)) + ((size_t)bg * 256 + n) * 128;
        if (kv == 0) {
            float ss = 0.f;
#pragma unroll
            for (int db = 0; db < 4; ++db)
#pragma unroll
                for (int r = 0; r < 16; ++r) ss += o[db][r] * o[db][r];
            ss += __shfl_xor(ss, 32);
            const float rn = 1.0f / sqrtf(ss * (1.0f / 128.0f) + 1e-6f);
            const float* kw = p->in[I_NKW] + (size_t)l * 3 * 128;
#pragma unroll
            for (int db = 0; db < 4; ++db)
#pragma unroll
                for (int r = 0; r < 16; ++r) o[db][r] *= rn * kw[32 * db + (r & 3) + 8 * (r >> 2) + 4 * hh];
            const int cp = 16 * n + 31;
            if (n < 255) {
                const float* nc = (const float*)(p->ws + WS_TAB_NC) + cp * 16; const float* ns = (const float*)(p->ws + WS_TAB_NS) + cp * 16;
#pragma unroll
                for (int a = 0; a < 2; ++a)
#pragma unroll
                    for (int q = 0; q < 4; ++q) {
                        const int i = 8 * a + 4 * hh + q;
                        const float c = nc[i], sn = ns[i], x1 = o[0][4 * a + q], x2 = o[0][4 * (a + 2) + q];
                        o[0][4 * a + q] = x1 * c - x2 * sn; o[0][4 * (a + 2) + q] = x2 * c + x1 * sn;
                    }
            }
        }
#pragma unroll
        for (int db = 0; db < 4; ++db)
#pragma unroll
            for (int a = 0; a < 4; ++a) {
                u32x2 w; w.x = cvt_pk(o[db][4 * a], o[db][4 * a + 1]); w.y = cvt_pk(o[db][4 * a + 2], o[db][4 * a + 3]);
                if (n >= 255) { w.x = 0u; w.y = 0u; }
                *(u32x2*)(dst + 32 * db + 8 * a + 4 * hh) = w;
            }
    }
}

__device__ __forceinline__ float softmax_block(f32x16& sa, unsigned vm, float& m, float& l, float scl) {
    float mx = m;
#pragma unroll
    for (int r = 0; r < 16; ++r) { const float s2 = sa[r] * scl; sa[r] = s2; if ((vm >> r) & 1u) mx = fmaxf(mx, s2); }
    mx = fmaxf(mx, __shfl_xor(mx, 32));
    const float alpha = fexp2(m - mx);
    float ps = 0.f;
#pragma unroll
    for (int r = 0; r < 16; ++r) { const float pv = ((vm >> r) & 1u) ? fexp2(sa[r] - mx) : 0.f; sa[r] = pv; ps += pv; }
    l = l * alpha + ps; m = mx;
    return alpha;
}
__device__ __forceinline__ void scale_o(f32x16 (&o)[4], float a) {
#pragma unroll
    for (int c = 0; c < 4; ++c)
#pragma unroll
        for (int r = 0; r < 16; ++r) o[c][r] *= a;
}
__device__ __forceinline__ void zero_o(f32x16 (&o)[4]) {
#pragma unroll
    for (int c = 0; c < 4; ++c)
#pragma unroll
        for (int r = 0; r < 16; ++r) o[c][r] = 0.f;
}
__device__ __forceinline__ void pv_block(f32x16 (&o)[4], const LAS unsigned char* vt, const TrAcc& TA, const f32x16& pp, int kb) {
    const unsigned vb = lds_addr(vt);
    pv_step(o, vb + 4096u * (unsigned)(2 * kb), TA, pack8(pp, 0));
    pv_step(o, vb + 4096u * (unsigned)(2 * kb + 1), TA, pack8(pp, 1));
}

__device__ __forceinline__ void nsa_task(KP p, int task, LAS unsigned char* lds, int tid) {
    asm volatile("" : "+v"(tid), "+s"(p));
    const int lane = tid & 63, wave = __builtin_amdgcn_readfirstlane(tid >> 6), hh = lane >> 5;
    const int qb = 63 - (task >> 3), bg = task & 7, b = bg >> 1, g = bg & 1, t0 = qb * 64;
    const int hd = g * 4 + (wave >> 1), ql = 32 * (wave & 1) + (lane & 31), tq = t0 + ql;
    const bf16_t* PROJ = (const bf16_t*)(p->ws + WS_PROJ);
    LAS unsigned char* KT = lds; LAS unsigned char* VT = lds + 16384;
    LAS float* PS = (LAS float*)(lds + 32768);
    LAS unsigned* SM = (LAS unsigned*)(lds + 32768 + 64 * 66 * 4);
    LAS unsigned* UN = SM + 128;
    bf16x8 qf[8];
    {
        const bf16_t* qsrc = (const bf16_t*)(p->ws + WS_QN) + ((size_t)(b * 8 + hd) * SEQ + tq) * 128;
#pragma unroll
        for (int s = 0; s < 8; ++s) qf[s] = *(const bf16x8*)(qsrc + 16 * s + 8 * hh);
    }
    TrAcc TA; tr_acc_init(TA, lane);
    const float SCL = 0.08838834764831845f * 1.4426950408889634f;
    const size_t tokrow = (size_t)(b * SEQ + tq);
    const float gt0 = sigmoidf_(bf2f(PROJ[tokrow * NINP + C_NG + hd * 3 + 0])), gt1 = sigmoidf_(bf2f(PROJ[tokrow * NINP + C_NG + hd * 3 + 1])), gt2 = sigmoidf_(bf2f(PROJ[tokrow * NINP + C_NG + hd * 3 + 2]));
    float* yrow = (float*)(p->ws + WS_YNSA) + tokrow * 1024 + hd * 128;
    for (int i = tid; i < 64 * 66; i += NTHR) PS[i] = 0.f;
    if (tid < 2) UN[tid] = 0u;
    f32x16 o[4];

    {
        const bf16_t* kc = (const bf16_t*)(p->ws + WS_KCMP) + (size_t)bg * 256 * 128; const bf16_t* vc = (const bf16_t*)(p->ws + WS_VCMP) + (size_t)bg * 256 * 128;
        const int nv = ((t0 + 32) >> 4) + 1, ntile = (nv + 63) >> 6;
        float m = -1e30f, lsum = 0.f;
        for (int tile = 0; tile < ntile; ++tile) {
            __syncthreads(); tile_stage<64>(KT, kc + (size_t)tile * 64 * 128, 128, tid); __syncthreads();
#pragma unroll 1
            for (int kb = 0; kb < 2; ++kb) { f32x16 sa = qk_block(KT, kb, qf, lane); unsigned vm = 0u;
#pragma unroll
                for (int r = 0; r < 16; ++r) { const int n = 64 * tile + 32 * kb + (r & 3) + 8 * (r >> 2) + 4 * hh; if (16 * n + 31 <= tq) vm |= 1u << r; }
                (void)softmax_block(sa, vm, m, lsum, SCL); }
        }
        lsum += __shfl_xor(lsum, 32);
        const float inv = lsum > 0.f ? 1.0f / lsum : 0.f;
        zero_o(o);
        for (int tile = 0; tile < ntile; ++tile) {
            __syncthreads(); tile_stage<64>(KT, kc + (size_t)tile * 64 * 128, 128, tid); tile_stage<64>(VT, vc + (size_t)tile * 64 * 128, 128, tid); __syncthreads();
#pragma unroll 1
            for (int kb = 0; kb < 2; ++kb) { f32x16 sa = qk_block(KT, kb, qf, lane);
#pragma unroll
                for (int r = 0; r < 16; ++r) { const int n = 64 * tile + 32 * kb + (r & 3) + 8 * (r >> 2) + 4 * hh; sa[r] = (16 * n + 31 <= tq) ? fexp2(sa[r] * SCL - m) * inv : 0.f; }
#pragma unroll
                for (int a = 0; a < 4; ++a) {
                    const int j = 16 * tile + 8 * kb + 2 * a + hh;
                    const float p3 = sa[4 * a + 3], mainv = 2.0f * (sa[4 * a] + sa[4 * a + 1] + sa[4 * a + 2]) + p3;
                    __hip_atomic_fetch_add(PS + ql * 66 + j, mainv, __ATOMIC_RELAXED, __HIP_MEMORY_SCOPE_WORKGROUP);
                    __hip_atomic_fetch_add(PS + ql * 66 + j + 1, p3, __ATOMIC_RELAXED, __HIP_MEMORY_SCOPE_WORKGROUP);
                }
                pv_block(o, VT, TA, sa, kb); }
        }
#pragma unroll
        for (int c = 0; c < 4; ++c)
#pragma unroll
            for (int a = 0; a < 4; ++a) *(f32x4*)(yrow + 32 * c + 8 * a + 4 * hh) = (f32x4){o[c][4 * a] * gt0, o[c][4 * a + 1] * gt0, o[c][4 * a + 2] * gt0, o[c][4 * a + 3] * gt0};
    }
    __syncthreads();
    for (int qi = 0; qi < 8; ++qi) {
        const int q = 8 * wave + qi, cur = qb;
        const float v = PS[q * 66 + lane];
        const bool forced = (lane == 0) || (lane == cur) || (lane == cur - 1);
        const float key = forced ? __builtin_inff() : ((lane <= cur) ? v : -__builtin_inff());
        int rank = 0;
#pragma unroll
        for (int i = 0; i < 64; ++i) { const float ki = __uint_as_float(__builtin_amdgcn_readlane(__float_as_uint(key), i)); rank += ((ki > key) || (ki == key && i < lane)) ? 1 : 0; }
        const unsigned long long msk = __ballot(rank < 16);
        if (lane == 0) { SM[2 * q] = (unsigned)msk; SM[2 * q + 1] = (unsigned)(msk >> 32); __hip_atomic_fetch_or(UN, (unsigned)msk, __ATOMIC_RELAXED, __HIP_MEMORY_SCOPE_WORKGROUP); __hip_atomic_fetch_or(UN + 1, (unsigned)(msk >> 32), __ATOMIC_RELAXED, __HIP_MEMORY_SCOPE_WORKGROUP); }
    }
    {
        const bf16_t* kw = (const bf16_t*)(p->ws + WS_KWN) + (size_t)bg * SEQ * 128; const bf16_t* vw = PROJ + (size_t)b * SEQ * NINP + C_NVW + g * 128;
        float m = -1e30f, lsum = 0.f; zero_o(o);
        for (int j = (qb >= 8 ? qb - 8 : 0); j <= qb; ++j) {
            __syncthreads(); tile_stage<64>(KT, kw + (size_t)j * 64 * 128, 128, tid); tile_stage<64>(VT, vw + (size_t)j * 64 * NINP, NINP, tid); __syncthreads();
#pragma unroll 1
            for (int kb = 0; kb < 2; ++kb) { f32x16 sa = qk_block(KT, kb, qf, lane); unsigned vm = 0u;
#pragma unroll
                for (int r = 0; r < 16; ++r) { const int kp = 64 * j + 32 * kb + (r & 3) + 8 * (r >> 2) + 4 * hh; const int dist = tq - kp; if (dist >= 0 && dist < 512) vm |= 1u << r; }
                const float alpha = softmax_block(sa, vm, m, lsum, SCL);
                scale_o(o, alpha);
                pv_block(o, VT, TA, sa, kb); }
        }
        lsum += __shfl_xor(lsum, 32);
        const float sc = gt2 / lsum;
#pragma unroll
        for (int c = 0; c < 4; ++c)
#pragma unroll
            for (int a = 0; a < 4; ++a) { float* yp = yrow + 32 * c + 8 * a + 4 * hh; const f32x4 y = *(const f32x4*)yp; *(f32x4*)yp = y + (f32x4){o[c][4 * a] * sc, o[c][4 * a + 1] * sc, o[c][4 * a + 2] * sc, o[c][4 * a + 3] * sc}; }
    }
    {
        const bf16_t* ks = (const bf16_t*)(p->ws + WS_KSN) + (size_t)bg * SEQ * 128; const bf16_t* vs = PROJ + (size_t)b * SEQ * NINP + C_NVS + g * 128;
        __syncthreads();
        const unsigned long long mysel = (unsigned long long)SM[2 * ql] | ((unsigned long long)SM[2 * ql + 1] << 32);
        const unsigned long long un = (unsigned long long)UN[0] | ((unsigned long long)UN[1] << 32);
        float m = -1e30f, lsum = 0.f; zero_o(o);
        for (int j = 0; j <= qb; ++j) {
            if (!((un >> j) & 1ull)) continue;
            __syncthreads(); tile_stage<64>(KT, ks + (size_t)j * 64 * 128, 128, tid); tile_stage<64>(VT, vs + (size_t)j * 64 * NINP, NINP, tid); __syncthreads();
            const bool sel = (mysel >> j) & 1ull;
#pragma unroll 1
            for (int kb = 0; kb < 2; ++kb) { f32x16 sa = qk_block(KT, kb, qf, lane); unsigned vm = 0u;
#pragma unroll
                for (int r = 0; r < 16; ++r) { const int kp = 64 * j + 32 * kb + (r & 3) + 8 * (r >> 2) + 4 * hh; if (sel && kp <= tq) vm |= 1u << r; }
                const float alpha = softmax_block(sa, vm, m, lsum, SCL);
                scale_o(o, alpha);
                pv_block(o, VT, TA, sa, kb); }
        }
        lsum += __shfl_xor(lsum, 32);
        const float sc = gt1 / lsum;
        bf16_t* mrow = (bf16_t*)(p->ws + WS_MIX) + tokrow * DM + MIX_NSA + hd * 128;
#pragma unroll
        for (int c = 0; c < 4; ++c)
#pragma unroll
            for (int a = 0; a < 4; ++a) {
                const f32x4 y = *(const f32x4*)(yrow + 32 * c + 8 * a + 4 * hh);
                u32x2 w; w.x = cvt_pk(y[0] + o[c][4 * a] * sc, y[1] + o[c][4 * a + 1] * sc); w.y = cvt_pk(y[2] + o[c][4 * a + 2] * sc, y[3] + o[c][4 * a + 3] * sc);
                *(u32x2*)(mrow + 32 * c + 8 * a + 4 * hh) = w;
            }
    }
}

constexpr float SB_THR = 40.0f;
__device__ __forceinline__ void sb_task(KP p, int task, LAS unsigned char* lds, int tid) {
    asm volatile("" : "+v"(tid), "+s"(p));
    const int lane = tid & 63, wave = __builtin_amdgcn_readfirstlane(tid >> 6), hh = lane >> 5;
    const int bh = task >> 4, b = bh >> 3, h = bh & 7, Q0 = (task & 15) * 256;
    const bf16_t* PROJ = (const bf16_t*)(p->ws + WS_PROJ);
    const bf16_t* base = PROJ + (size_t)b * SEQ * NINP + h * 128;
    LAS unsigned char* KT = lds; LAS unsigned char* VT = lds + 16384; volatile LAS int* FL = (volatile LAS int*)(lds + 32768);
    const int tq = Q0 + 32 * wave + (lane & 31);
    bf16x8 qf[8];
#pragma unroll
    for (int s = 0; s < 8; ++s) qf[s] = *(const bf16x8*)(base + (size_t)tq * NINP + C_SQ + 16 * s + 8 * hh);
    TrAcc TA; tr_acc_init(TA, lane);
    f32x16 o[4]; zero_o(o);
    float Lc = 0.f; bool wdone = false;
    if (tid < 8) FL[tid] = 0;
    const float SC = 0.08838834764831845f, L2E = 1.4426950408889634f, LN2 = 0.6931471805599453f;
    for (int jt = (Q0 >> 6) + 3; jt >= 0; --jt) {
        __syncthreads();
        if (FL[0] & FL[1] & FL[2] & FL[3] & FL[4] & FL[5] & FL[6] & FL[7]) break;
        tile_stage<64>(KT, base + (size_t)jt * 64 * NINP + C_SK, NINP, tid); tile_stage<64>(VT, base + (size_t)jt * 64 * NINP + C_SV, NINP, tid);
        __syncthreads();
        const int k0 = jt * 64;
        if (!wdone && k0 < Q0 + 32 * wave + 31) {
            const unsigned vb = lds_addr(VT);
#pragma unroll 1
            for (int kbi = 0; kbi < 2; ++kbi) {
                const int kb = 1 - kbi;
                f32x16 sa = qk_block(KT, kb, qf, lane), ls;
#pragma unroll
                for (int r = 0; r < 16; ++r) {
                    const int key = k0 + 32 * kb + (r & 3) + 8 * (r >> 2) + 4 * hh;
                    const float z = sa[r] * SC;
                    const float lp = flog2(1.0f + fexp2(-fabsf(z) * L2E)) * LN2;
                    const float lb = fminf(z, 0.f) - lp;
                    sa[r] = lb; ls[r] = (key < tq) ? (lb - z) : 0.f;
                }
                float gs[4], og[4], after[4];
#pragma unroll
                for (int a = 0; a < 4; ++a) { gs[a] = (ls[4 * a] + ls[4 * a + 1]) + (ls[4 * a + 2] + ls[4 * a + 3]); og[a] = __shfl_xor(gs[a], 32); }
                float run = 0.f;
#pragma unroll
                for (int a = 3; a >= 0; --a) { after[a] = run; run += gs[a] + og[a]; }
#pragma unroll
                for (int a = 0; a < 4; ++a) {
                    float suf = Lc + after[a] + (hh == 0 ? og[a] : 0.f);
#pragma unroll
                    for (int q = 3; q >= 0; --q) {
                        const int r = 4 * a + q, key = k0 + 32 * kb + q + 8 * a + 4 * hh;
                        const float w = (key < tq) ? fexp2((sa[r] + suf) * L2E) : 0.f;
                        suf += ls[r];
                        sa[r] = w;
                    }
                }
                Lc += run;
                pv_step(o, vb + 4096u * (unsigned)(2 * kb), TA, pack8(sa, 0));
                pv_step(o, vb + 4096u * (unsigned)(2 * kb + 1), TA, pack8(sa, 1));
            }
            wdone = __all(Lc < -SB_THR);
            if (lane == 0) FL[wave] = wdone ? 1 : 0;
        }
    }
    bf16_t* mrow = (bf16_t*)(p->ws + WS_MIX) + (size_t)(b * SEQ + tq) * DM + MIX_SB + h * 128;
#pragma unroll
    for (int c = 0; c < 4; ++c)
#pragma unroll
        for (int a = 0; a < 4; ++a) { u32x2 w; w.x = cvt_pk(o[c][4 * a], o[c][4 * a + 1]); w.y = cvt_pk(o[c][4 * a + 2], o[c][4 * a + 3]); *(u32x2*)(mrow + 32 * c + 8 * a + 4 * hh) = w; }
}

__device__ __forceinline__ void ret_state_task(KP p, int task, LAS unsigned char* lds, int tid) {
    asm volatile("" : "+v"(tid), "+s"(p));
    const int lane = tid & 63, wave = __builtin_amdgcn_readfirstlane(tid >> 6), hh = lane >> 5;
    const int eh = task & 1, bh = task >> 1, b = bh >> 3, h = bh & 7;
    const bf16_t* KR = (const bf16_t*)(p->ws + WS_KR) + (size_t)bh * SEQ * 128;
    const bf16_t* V = (const bf16_t*)(p->ws + WS_PROJ) + (size_t)b * SEQ * NINP + C_RV + h * 128;
    bf16_t* ST = (bf16_t*)(p->ws + WS_ST) + (size_t)bh * 32 * 128 * 128;
    LAS unsigned char* KT = lds; LAS unsigned char* VT = lds + 32768;
    const int eb = wave >> 2, db = wave & 3;
    const float gC = exp2f(128.0f * log2f(1.0f - exp2f(-5.0f - (float)h)));
    f32x16 acc;
#pragma unroll
    for (int i = 0; i < 16; ++i) acc[i] = 0.f;
    for (int c = 0; c < 32; ++c) {
        {
            bf16_t* dst = ST + (size_t)c * 128 * 128 + 32 * db + (lane & 31);
#pragma unroll
            for (int r = 0; r < 16; ++r) { const int e = 64 * eh + 32 * eb + (r & 3) + 8 * (r >> 2) + 4 * hh; dst[(size_t)e * 128] = f2bf(acc[r]); }
        }
        if (c == 31) break;
        __syncthreads();
        tile_stage<128>(KT, KR + (size_t)c * 128 * 128, 128, tid); tile_stage<128>(VT, V + (size_t)c * 128 * NINP, NINP, tid);
        __syncthreads();
#pragma unroll
        for (int ks = 0; ks < 8; ++ks)
            acc = __builtin_amdgcn_mfma_f32_32x32x16_bf16(tr_frag_nat(VT, 2 * eh + eb, ks, lane), tr_frag_nat(KT, db, ks, lane), acc, 0, 0, 0);
#pragma unroll
        for (int i = 0; i < 16; ++i) acc[i] *= gC;
    }
}

__device__ __forceinline__ void ret_out_task(KP p, int task, LAS unsigned char* lds, int tid) {
    asm volatile("" : "+v"(tid), "+s"(p));
    const int lane = tid & 63, wave = __builtin_amdgcn_readfirstlane(tid >> 6), hh = lane >> 5;
    const int bh = task >> 4, cp = task & 15, b = bh >> 3, h = bh & 7;
    const int cw = wave >> 2, ib = wave & 3, c = 2 * cp + cw, s = 128 * c + 32 * ib + (lane & 31);
    const bf16_t* PROJ = (const bf16_t*)(p->ws + WS_PROJ);
    const bf16_t* KR = (const bf16_t*)(p->ws + WS_KR) + (size_t)bh * SEQ * 128;
    const bf16_t* V = PROJ + (size_t)b * SEQ * NINP + C_RV + h * 128;
    const bf16_t* ST = (const bf16_t*)(p->ws + WS_ST) + (size_t)bh * 32 * 128 * 128;
    LAS unsigned char* KT = lds; LAS unsigned char* VT = lds + 16384;
    bf16x8 qf[8];
    {
        const bf16_t* qsrc = (const bf16_t*)(p->ws + WS_QR) + ((size_t)bh * SEQ + s) * 128;
#pragma unroll
        for (int k = 0; k < 8; ++k) qf[k] = *(const bf16x8*)(qsrc + 16 * k + 8 * hh);
    }
    TrAcc TA; tr_acc_init(TA, lane);
    f32x16 o[4]; zero_o(o);
    for (int kt = 0; kt < 4; ++kt) {
        __syncthreads();
        const size_t krow = (size_t)(2 * cp + (kt >> 1)) * 128 + (kt & 1) * 64;
        tile_stage<64>(KT, KR + krow * 128, 128, tid); tile_stage<64>(VT, V + krow * NINP, NINP, tid);
        __syncthreads();
        if ((kt >> 1) == cw) {
#pragma unroll
            for (int kb = 0; kb < 2; ++kb) {
                const int jb = 2 * (kt & 1) + kb;
                if (jb <= ib) {
                    f32x16 sa = qk_block(KT, kb, qf, lane);
                    if (jb == ib) {
#pragma unroll
                        for (int r = 0; r < 16; ++r) { const int kl = (r & 3) + 8 * (r >> 2) + 4 * hh; if (kl > (lane & 31)) sa[r] = 0.f; }
                    }
                    const unsigned vb = lds_addr(VT);
                    pv_step(o, vb + 4096u * (unsigned)(2 * kb), TA, pack8(sa, 0));
                    pv_step(o, vb + 4096u * (unsigned)(2 * kb + 1), TA, pack8(sa, 1));
                }
            }
        }
    }
    for (int st = 0; st < 4; ++st) {
        __syncthreads();
        tile_stage<64>(KT, ST + ((size_t)(2 * cp + (st >> 1)) * 128 + (st & 1) * 64) * 128, 128, tid);
        __syncthreads();
        if ((st >> 1) == cw) {
#pragma unroll
            for (int eb = 0; eb < 2; ++eb)
#pragma unroll
                for (int k = 0; k < 8; ++k) o[2 * (st & 1) + eb] = __builtin_amdgcn_mfma_f32_32x32x16_bf16(row_frag(KT, 32 * eb, k, lane), qf[k], o[2 * (st & 1) + eb], 0, 0, 0);
        }
    }
    float ss = 0.f;
#pragma unroll
    for (int cc = 0; cc < 4; ++cc)
#pragma unroll
        for (int r = 0; r < 16; ++r) ss += o[cc][r] * o[cc][r];
    ss += __shfl_xor(ss, 32);
    const float rn = 1.0f / sqrtf(ss * (1.0f / 128.0f) + 1e-6f);
    const size_t tok = (size_t)(b * SEQ + s);
    const bf16_t* grow = PROJ + tok * NINP + C_RG + h * 128;
    bf16_t* mrow = (bf16_t*)(p->ws + WS_MIX) + tok * DM + MIX_RET + h * 128;
#pragma unroll
    for (int cc = 0; cc < 4; ++cc)
#pragma unroll
        for (int a = 0; a < 4; ++a) {
            const u32x2 gv = *(const u32x2*)(grow + 32 * cc + 8 * a + 4 * hh);
            const float g0 = bflo(gv.x), g1 = bfhi(gv.x), g2 = bflo(gv.y), g3 = bfhi(gv.y);
            u32x2 w; w.x = cvt_pk(o[cc][4 * a] * rn * g0 * sigmoidf_(g0), o[cc][4 * a + 1] * rn * g1 * sigmoidf_(g1));
            w.y = cvt_pk(o[cc][4 * a + 2] * rn * g2 * sigmoidf_(g2), o[cc][4 * a + 3] * rn * g3 * sigmoidf_(g3));
            *(u32x2*)(mrow + 32 * cc + 8 * a + 4 * hh) = w;
        }
}

#ifndef HP_SP2
#define HP_SP2 true
#endif
#ifndef HP_ALIGN
#define HP_ALIGN true
#endif
enum { PH_CONV = 0, PH_GEMM_IN, PH_PREP, PH_MIX1, PH_MIX2, PH_GEMM_OUT, PH_NORM2, PH_GEMM_GU, PH_ACT, PH_GEMM_DN, N_PHASES };

__global__ void __launch_bounds__(NTHR, 2) hybrid_fwd(Params p_arg) {
    extern __shared__ __attribute__((aligned(16))) unsigned char lds_raw[];
    LAS unsigned char* lds = (LAS unsigned char*)lds_raw;
    const int tid0 = threadIdx.x, bid = blockIdx.x, G = gridDim.x;
    volatile LAS unsigned* CT = (volatile LAS unsigned*)(lds + LDS_STAGE);
    if (tid0 < 8) CT[tid0] = 0u;
    __syncthreads();
    const KP kp = (KP)__builtin_amdgcn_kernarg_segment_ptr();
    unsigned* ctl = (unsigned*)(kp->ws + WS_CTL);
    const int l_lo = kp->l_lo, l_hi = kp->l_hi, ph_lo = kp->ph_lo, ph_hi = kp->ph_hi;
    const bool multi = (l_hi - l_lo) > 1 || (ph_hi - ph_lo) > 1;
    XcdBarrier bar; bar.bar = ctl + CW_BAR; bar.x = 0; bar.st = CT;
    if (multi) bar = xcd_barrier_post(ctl + CW_BAR, CT);
    volatile LAS int* slot = (volatile LAS int*)(CT + 4);

#define PH_ON(k) (ph_lo <= (k) && (k) < ph_hi)
#define WSP(T, off) ((T*)(p->ws + (off)))
#define SEAM() do { if (multi) xcd_barrier(bar); } while (0)
#ifndef DIS_TAB
    if (l_lo == 0 && PH_ON(PH_CONV)) ph_tables(kp, tid0, bid, G);
#endif
    for (int l = l_lo; l < l_hi; ++l) {
        KP p = kp; asm volatile("" : "+s"(p));
        unsigned* qctr = ctl + CW_QUEUE + 64 * (l * 8);
        int tid = tid0; asm volatile("" : "+v"(tid));
        if (PH_ON(PH_CONV)) {
#ifndef DIS_CONV
            ph_convert(p, l, lds, tid, bid, G);
#endif
            ph_rmsnorm((l == 0) ? p->in[I_X] : p->out, p->in[I_ANW] + (size_t)l * DM, WSP(bf16_t, WS_HN), tid, bid, G);
            SEAM();
        }
        if (PH_ON(PH_GEMM_IN)) {
            pg8::Gemm g{WSP(bf16_t, WS_HN), WSP(bf16_t, WS_WIN), MT, NINP, DM}; pg8::StaticOrder S; S.init(MT, NINP, G, bid);
            pg8::EpiBf16<0> E{WSP(bf16_t, WS_PROJ), NINP, nullptr, 0, 0, 1.f};
#if !defined(DIS_GEMM) && !defined(DIS_G1)
            pg8::gemm_phase<pg8::EpiBf16<0>, pg8::StaticOrder, HP_ALIGN, HP_SP2>(lds, g, S, E);
#endif
            SEAM();
        }
        if (PH_ON(PH_PREP)) {
            ph_prep_elem(p, l, tid, bid, G);
#ifndef DIS_CMP
            for (;;) { const int t = next_task(qctr, slot, tid); if (t >= 128) break; cmp_task(p, l, t, lds, tid); }
#endif
#ifndef DIS_C1
            for (;;) { const int t = next_task(qctr + 64, slot, tid); if (t >= 2048) break; lru_c1_task(p, l, t, lds, tid); }
#endif
            SEAM();
        }
        if (PH_ON(PH_MIX1)) {
#ifndef DIS_RS
            for (;;) { const int t = next_task(qctr + 128, slot, tid); if (t >= 64) break; ret_state_task(p, t, lds, tid); }
#endif
#ifndef DIS_NSA
            for (;;) { const int t = next_task(qctr + 192, slot, tid); if (t >= 512) break; nsa_task(p, t, lds, tid); }
#endif
#ifndef DIS_SB
            for (;;) { const int t = next_task(qctr + 256, slot, tid); if (t >= 512) break; sb_task(p, t, lds, tid); }
#endif
#ifndef DIS_C3
            for (;;) { const int t = next_task(qctr + 320, slot, tid); if (t >= 2048) break; lru_c3_task(p, t, lds, tid); }
#endif
            SEAM();
        }
        if (PH_ON(PH_MIX2)) {
#ifndef DIS_RO
            for (int t = bid; t < 512; t += G) { __syncthreads(); ret_out_task(p, t, lds, tid); }
#endif
            SEAM();
        }
        if (PH_ON(PH_GEMM_OUT)) {
            pg8::Gemm g{WSP(bf16_t, WS_MIX), WSP(bf16_t, WS_WOUT), MT, DM, DM}; pg8::StaticOrder S; S.init(MT, DM, G, bid);
            EpiResid E{(l == 0) ? p->in[I_X] : p->out, p->out, DM};
#if !defined(DIS_GEMM) && !defined(DIS_G2)
            pg8::gemm_phase<EpiResid, pg8::StaticOrder, HP_ALIGN, HP_SP2>(lds, g, S, E);
#endif
            SEAM();
        }
        if (PH_ON(PH_NORM2)) {
            ph_rmsnorm(p->out, p->in[I_MNW] + (size_t)l * DM, WSP(bf16_t, WS_HN), tid, bid, G);
            SEAM();
        }
        if (PH_ON(PH_GEMM_GU)) {
            pg8::Gemm g{WSP(bf16_t, WS_HN), WSP(bf16_t, WS_WGU), MT, NGU, DM}; pg8::StaticOrder S; S.init(MT, NGU, G, bid);
            pg8::EpiBf16<0> E{WSP(bf16_t, WS_GU), NGU, nullptr, 0, 0, 1.f};
#if !defined(DIS_GEMM) && !defined(DIS_G3)
            pg8::gemm_phase<pg8::EpiBf16<0>, pg8::StaticOrder, HP_ALIGN, HP_SP2>(lds, g, S, E);
#endif
            SEAM();
        }
        if (PH_ON(PH_ACT)) {
            ph_mlp_act(p, l, tid, bid, G);
            SEAM();
        }
        if (PH_ON(PH_GEMM_DN)) {
            pg8::Gemm g{WSP(bf16_t, WS_H), WSP(bf16_t, WS_WDN), MT, DM, DFF}; pg8::StaticOrder S; S.init(MT, DM, G, bid);
            EpiResid E{p->out, p->out, DM};
#if !defined(DIS_GEMM) && !defined(DIS_G4)
            pg8::gemm_phase<EpiResid, pg8::StaticOrder, HP_ALIGN, HP_SP2>(lds, g, S, E);
#endif
            if (l + 1 < l_hi) SEAM();
        }
    }
#undef PH_ON
#undef SEAM
#undef WSP
}
}

#ifndef HP_N_LAUNCH_MODE
#define HP_N_LAUNCH_MODE 0
#endif
extern "C" void kernel_launch(void* const* d_in, const int* in_sizes, int n_in, void* d_out, int out_size, void* d_ws, size_t ws_size, hipStream_t stream) {
    using namespace hp;
    static int grid = 0;
    if (grid == 0) {
        if (n_in != N_INPUTS || out_size != MT * DM || ws_size < WS_END) { fprintf(stderr, "kernel_launch: unexpected problem (n_in %d, out %d, ws %zu, need %zu)\n", n_in, out_size, ws_size, (size_t)WS_END); grid = -1; return; }
        int dev = 0, cus = 0, per_cu = 0;
        if (hipGetDevice(&dev) != hipSuccess || hipDeviceGetAttribute(&cus, hipDeviceAttributeMultiprocessorCount, dev) != hipSuccess) { grid = -1; return; }
        if (hipFuncSetAttribute((const void*)hybrid_fwd, hipFuncAttributeMaxDynamicSharedMemorySize, LDS_BYTES) != hipSuccess) { fprintf(stderr, "kernel_launch: hipFuncSetAttribute failed\n"); grid = -1; return; }
        if (hipOccupancyMaxActiveBlocksPerMultiprocessor(&per_cu, (const void*)hybrid_fwd, NTHR, LDS_BYTES) != hipSuccess || per_cu < 1) { fprintf(stderr, "kernel_launch: occupancy query says %d\n", per_cu); (void)hipGetLastError(); per_cu = 1; }
        grid = cus;
    }
    if (grid < 0) return;
    (void)hipMemsetAsync((char*)d_ws + WS_CTL, 0, CTL_BYTES, stream);
    Params p{};
    for (int i = 0; i < N_INPUTS; ++i) p.in[i] = (const float*)d_in[i];
    p.out = (float*)d_out; p.ws = (unsigned char*)d_ws;
#if HP_N_LAUNCH_MODE == 0
    p.l_lo = 0; p.l_hi = NL; p.ph_lo = 0; p.ph_hi = N_PHASES;
    hipLaunchKernelGGL(hybrid_fwd, dim3(grid), dim3(NTHR), LDS_BYTES, stream, p);
#else
    for (int l = 0; l < NL; ++l)
        for (int ph = 0; ph < N_PHASES; ++ph) { p.l_lo = l; p.l_hi = l + 1; p.ph_lo = ph; p.ph_hi = ph + 1; hipLaunchKernelGGL(hybrid_fwd, dim3(grid), dim3(NTHR), LDS_BYTES, stream, p); }
#endif
}
```

```cpp
#include <hip/hip_runtime.h>
#include <stdint.h>
#include <stdio.h>
#define XB_TMO      128
#define XB_XCNT(j)  (256  + 64 * (j))
#define XB_XSUB(j)  (1280 + 64 * (j))
#define XB_XGEN(j)  (2304 + 64 * (j))
#define XB_TOP      3328
#define XB_TOPGEN   3392
#define XCD_BAR_WORDS 3456
#define XB_SPIN_CAP (1u << 22)
#define LAS __attribute__((address_space(3)))

__device__ __forceinline__ unsigned xb_ld(unsigned* p)              { return __hip_atomic_load(p, __ATOMIC_RELAXED, __HIP_MEMORY_SCOPE_AGENT); }
__device__ __forceinline__ unsigned xb_add(unsigned* p, unsigned v) { return __hip_atomic_fetch_add(p, v, __ATOMIC_RELAXED, __HIP_MEMORY_SCOPE_AGENT); }
__device__ __forceinline__ unsigned xb_xcc_id() { return (unsigned)__builtin_amdgcn_s_getreg((3 << 11) | 20) & 0xFu; }
#define XB_SPIN(cond, bar) do { unsigned _sp = 0; while (cond) { __builtin_amdgcn_s_sleep(1); \
    if ((++_sp & 255u) == 0u) { if (xb_ld(&(bar)[XB_TMO])) break; if (_sp > XB_SPIN_CAP) { atomicAdd(&(bar)[XB_TMO], 1u); break; } } } } while (0)

struct XcdBarrier {
    unsigned* bar; unsigned x;
    volatile LAS unsigned* st;
};

__device__ __forceinline__ XcdBarrier xcd_barrier_post(unsigned* bar, volatile LAS unsigned* st) {
    XcdBarrier b; b.bar = bar; b.x = xb_xcc_id(); b.st = st;
    if (threadIdx.x == 0) (void)xb_add(&bar[XB_XCNT(b.x)], 1u);
    return b;
}
__device__ __forceinline__ void xcd_barrier_complete(unsigned* bar, unsigned x, unsigned& nloc, unsigned& nx) {
    const unsigned G = gridDim.x * gridDim.y * gridDim.z;
    unsigned sum, cnt, mine, sp = 0u;
    for (;;) {
        sum = 0u; cnt = 0u; mine = 0u;
#pragma unroll
        for (unsigned j = 0; j < 16; ++j) { const unsigned c = xb_ld(&bar[XB_XCNT(j)]); sum += c; cnt += (c > 0u) ? 1u : 0u; mine = (j == x) ? c : mine; }
        if (sum == G) break;
        __builtin_amdgcn_s_sleep(1);
        if ((++sp & 255u) == 0u) { if (xb_ld(&bar[XB_TMO])) break; if (sp > XB_SPIN_CAP) { atomicAdd(&bar[XB_TMO], 1u); break; } }
    }
    nloc = mine > 0u ? mine : 1u; nx = cnt > 0u ? cnt : 1u;
}

__device__ __forceinline__ void xcd_barrier(const XcdBarrier& b) {
    asm volatile("s_waitcnt vmcnt(0)" ::: "memory");
    __syncthreads();
    if (threadIdx.x == 0) {
        unsigned* bar = b.bar;
        __builtin_amdgcn_s_waitcnt(0);
        unsigned nloc = b.st[0], nx = b.st[1];
        if (nloc == 0u) { xcd_barrier_complete(bar, b.x, nloc, nx); b.st[0] = nloc; b.st[1] = nx; }
        const unsigned old = xb_add(&bar[XB_XSUB(b.x)], 1u);
        const unsigned gen = old / nloc;
        if (old + 1u == (gen + 1u) * nloc) {
            __builtin_amdgcn_fence(__ATOMIC_RELEASE, "agent");
            asm volatile("s_waitcnt vmcnt(0)" ::: "memory");
            const unsigned og = xb_add(&bar[XB_TOP], 1u);
            const unsigned tg = og / nx;
            if (og + 1u == (tg + 1u) * nx) xb_add(&bar[XB_TOPGEN], 1u);
            else XB_SPIN(xb_ld(&bar[XB_TOPGEN]) == tg, bar);
            __builtin_amdgcn_fence(__ATOMIC_ACQUIRE, "agent");
            xb_add(&bar[XB_XGEN(b.x)], 1u);
            asm volatile("s_waitcnt vmcnt(0)" ::: "memory");
        } else {
            XB_SPIN(xb_ld(&bar[XB_XGEN(b.x)]) == gen, bar);
            __builtin_amdgcn_fence(__ATOMIC_ACQUIRE, "agent");
            asm volatile("s_waitcnt vmcnt(0)" ::: "memory");
        }
    }
    __syncthreads();
}
#ifndef PG8_WGM
#define PG8_WGM 8
#endif
namespace pg8 {
#define PG8_LAS __attribute__((address_space(3)))
typedef unsigned short bf16_t;
typedef short bf16x8 __attribute__((ext_vector_type(8)));
typedef float f32x4 __attribute__((ext_vector_type(4)));
typedef unsigned u32x4 __attribute__((ext_vector_type(4)));
constexpr int BM = 256, BK = 64, HALF = 128, HTB = HALF * BK * 2  , STAGE_BYTES = 8 * HTB, NXCD = 8, WGM = PG8_WGM;

__host__ __device__ __forceinline__ int lds_byte(int r, int c) { const int st = (r >> 4) * 2 + (c >> 5), rr = r & 15, cc = c & 31, ob = rr * 64 + cc * 2; return st * 1024 + (ob ^ (((ob >> 9) & 1) << 5)); }
__host__ __device__ __forceinline__ void stage_rc(int b, int& R, int& C) { const int st = b / 1024, sb = b % 1024, swz = sb ^ (((sb >> 9) & 1) << 5); R = (st >> 1) * 16 + swz / 64; C = (st & 1) * 32 + (swz % 64) / 2; }
__host__ __device__ __forceinline__ int perm32(int rho) { const int n = rho >> 4, i = rho & 15; return 8 * (i >> 2) + 4 * n + (i & 3); }

struct Unit { int pm, pn; };
struct Gemm { const bf16_t* A; const bf16_t* Bt; int M, N, K; };

struct StaticOrder {
    int nM, nN, nwg, G, c;
    __host__ __device__ void init(int M, int N, int G_, int c_) { nM = M / BM; nN = N / BM; nwg = nM * nN; G = G_; c = c_; }
    __host__ __device__ bool next(int i, Unit& u) const {
        const long L = (long)i * G + c; if (L >= nwg) return false;
        int wgid = (int)L; { const int q = nwg / NXCD, r = nwg % NXCD, xcd = wgid % NXCD, off = wgid / NXCD; wgid = (xcd < r ? xcd * (q + 1) : r * (q + 1) + (xcd - r) * q) + off; }
        const int nig = WGM * nN, gid = wgid / nig, fm = gid * WGM, gsz = (nM - fm) < WGM ? (nM - fm) : WGM;
        u.pm = fm + ((wgid % nig) % gsz); u.pn = (wgid % nig) / gsz; return true;
    }
    __device__ __forceinline__ void a_ready(const Unit&) const {}
    __device__ __forceinline__ void done(const Unit&) const {}
};

__device__ __forceinline__ unsigned cvt_pk_bf16(float lo, float hi) { unsigned r; asm volatile("v_cvt_pk_bf16_f32 %0, %1, %2" : "=v"(r) : "v"(lo), "v"(hi)); return r; }
typedef float f32x2 __attribute__((ext_vector_type(2)));
__device__ __forceinline__ f32x2 gelu_pk(f32x2 v) {
    const f32x2 av = __builtin_elementwise_abs(v), d = av * 0.2316418882f + 1.0f;
    f32x2 t; t.x = __builtin_amdgcn_rcpf(d.x); t.y = __builtin_amdgcn_rcpf(d.y);
    f32x2 q = t * 0.5307027145f + (-0.7265760135f); q = q * t + 0.7107068705f; q = q * t + (-0.142248368f); q = q * t + 0.127414796f; q = q * t;
    const f32x2 s = (v * v) * (-0.72134752044f);
    f32x2 e; e.x = __builtin_amdgcn_exp2f(s.x); e.y = __builtin_amdgcn_exp2f(s.y);
    const f32x2 m = v * (q * e), r = v - m;
    f32x2 o; o.x = v.x < 0.f ? m.x : r.x; o.y = v.y < 0.f ? m.y : r.y; return o;
}

template <int ACT  > struct EpiBf16 {
    static constexpr bool PERM = true, AFTER_DRAIN = false; static_assert(ACT == 0 || ACT == 1, "EpiBf16: ACT is 0 (none) or 1 (gelu_pk)");
    bf16_t* O; int ldc; const float* bias; int split_cols; size_t split_stride; float scale0;
    __device__ __forceinline__ void operator()(const f32x4 (&acc)[2][2][4][2], const Unit& u, int wr, int wc, int fr, int fq) const {
        const int row0 = u.pm * BM + wr * 64 + fr; int colt = u.pn * BM; bf16_t* base = O;
        float sc = 1.f; if (split_cols) { const int t = colt / split_cols; base += (size_t)t * split_stride; colt -= t * split_cols; if (t == 0) sc = scale0; }
        const int col0 = colt + wc * 32 + 8 * fq, bcol0 = u.pn * BM + wc * 32 + 8 * fq;
        f32x4 bv[2][2];
#pragma unroll
        for (int bj = 0; bj < 2; ++bj)
#pragma unroll
            for (int n = 0; n < 2; ++n) bv[bj][n] = bias ? *(const f32x4*)(bias + bcol0 + bj * HALF + 4 * n) : (f32x4){0.f, 0.f, 0.f, 0.f};
#pragma unroll
        for (int ai = 0; ai < 2; ++ai)
#pragma unroll
            for (int m = 0; m < 4; ++m) { bf16_t* rowp = base + (size_t)(row0 + ai * HALF + m * 16) * ldc + col0;
#pragma unroll
                for (int bj = 0; bj < 2; ++bj) { f32x4 v0 = acc[ai][bj][m][0] + bv[bj][0], v1 = acc[ai][bj][m][1] + bv[bj][1];
                    if (ACT == 1) { f32x2 a = gelu_pk((f32x2){v0[0], v0[1]}), b = gelu_pk((f32x2){v0[2], v0[3]}), c = gelu_pk((f32x2){v1[0], v1[1]}), d = gelu_pk((f32x2){v1[2], v1[3]});
                        v0 = (f32x4){a.x, a.y, b.x, b.y}; v1 = (f32x4){c.x, c.y, d.x, d.y}; }
                    v0 = v0 * sc; v1 = v1 * sc; u32x4 w; w.x = cvt_pk_bf16(v0[0], v0[1]); w.y = cvt_pk_bf16(v0[2], v0[3]); w.z = cvt_pk_bf16(v1[0], v1[1]); w.w = cvt_pk_bf16(v1[2], v1[3]);
                    *(u32x4*)(rowp + bj * HALF) = w; } }
    }
};

struct PanelStats {
    unsigned* xbuf;
    unsigned* cnt;
    unsigned* tmo;
    int ntn; float eps;
    unsigned code;
    __device__ __forceinline__ bool run(const f32x4 (&v)[2][2][4][2], const Unit& u, int wr, int wc, int fr, int fq, PG8_LAS unsigned char* lds, int wid, int lane) const {
        typedef float f32x2v __attribute__((ext_vector_type(2)));
        PG8_LAS f32x2v* P = (PG8_LAS f32x2v*)lds;
        PG8_LAS f32x2v* S = (PG8_LAS f32x2v*)(lds + 8192);
        PG8_LAS unsigned* flag = (PG8_LAS unsigned*)(lds + 8192 + 2048);
#pragma unroll
        for (int ai = 0; ai < 2; ++ai)
#pragma unroll
            for (int m = 0; m < 4; ++m) {
                float s = 0.f;
#pragma unroll
                for (int bj = 0; bj < 2; ++bj)
#pragma unroll
                    for (int n = 0; n < 2; ++n) { const f32x4 x = v[ai][bj][m][n]; s += (x[0] + x[1]) + (x[2] + x[3]); }
                s += __shfl_xor(s, 16); s += __shfl_xor(s, 32);
                const float mw = s * (1.0f / 64.0f); float q = 0.f;
#pragma unroll
                for (int bj = 0; bj < 2; ++bj)
#pragma unroll
                    for (int n = 0; n < 2; ++n) { const f32x4 d = v[ai][bj][m][n] - mw; q += (d[0] * d[0] + d[1] * d[1]) + (d[2] * d[2] + d[3] * d[3]); }
                q += __shfl_xor(q, 16); q += __shfl_xor(q, 32);
                if (fq == 0) P[(ai * HALF + wr * 64 + m * 16 + fr) * 4 + wc] = (f32x2v){mw, q};
            }
        asm volatile("s_waitcnt lgkmcnt(0)" ::: "memory"); __builtin_amdgcn_s_barrier(); asm volatile("" ::: "memory");
#if defined(BROKEN_EXCHANGE_NO_WAIT)
#warning BROKEN CONTROL BUILD: the row-statistics exchange does not wait; results are wrong by design
        if (blockIdx.x >= 64) { const long long t0_ = clock64(); while (clock64() - t0_ < 60000) __builtin_amdgcn_s_sleep(8); }
#endif
        const int row = wid * 32 + (lane & 31);
        if (lane < 32) {
            const f32x2v a = P[row * 4 + 0], b = P[row * 4 + 1], c = P[row * 4 + 2], d = P[row * 4 + 3];
            const float mt = (a.x + b.x + c.x + d.x) * 0.25f;
            const float da = a.x - mt, db = b.x - mt, dc = c.x - mt, dd = d.x - mt;
            const float m2 = (a.y + b.y) + (c.y + d.y) + 64.0f * ((da * da + db * db) + (dc * dc + dd * dd));
            unsigned long long* slot = (unsigned long long*)xbuf + ((size_t)(u.pm * BM + row) * 4 + u.pn);
            __hip_atomic_store(slot, ((unsigned long long)__float_as_uint(m2) << 32) | __float_as_uint(mt), __ATOMIC_RELAXED, __HIP_MEMORY_SCOPE_AGENT);
        }
        asm volatile("s_waitcnt vmcnt(0)" ::: "memory");
        if (lane == 0) __hip_atomic_fetch_add(cnt + 64 * u.pm, 1u, __ATOMIC_RELAXED, __HIP_MEMORY_SCOPE_AGENT);
        if (wid == 0) {
            bool dead = false; const unsigned long long t0 = __builtin_amdgcn_s_memrealtime(); const unsigned want = 8u * (unsigned)ntn;
            for (;;) {
#if defined(BROKEN_EXCHANGE_NO_WAIT)
                break;
#endif
                if ((unsigned)__builtin_amdgcn_readfirstlane(__hip_atomic_load(cnt + 64 * u.pm, __ATOMIC_RELAXED, __HIP_MEMORY_SCOPE_AGENT)) >= want) break;
                if (__builtin_amdgcn_s_memrealtime() - t0 > 2000000ull) {
                    if (lane == 0) { unsigned expect = 0u; __hip_atomic_compare_exchange_strong(tmo + 1, &expect, code | (unsigned)(u.pm & 0xff), __ATOMIC_RELAXED, __ATOMIC_RELAXED, __HIP_MEMORY_SCOPE_AGENT);
                                     __hip_atomic_store(tmo, 1u, __ATOMIC_RELAXED, __HIP_MEMORY_SCOPE_AGENT); }
                    dead = true; break; }
                __builtin_amdgcn_s_sleep(2);
            }
            __builtin_amdgcn_fence(__ATOMIC_ACQUIRE, "agent");
            if (lane == 0) flag[0] = dead ? 1u : 0u;
        }
        asm volatile("s_waitcnt vmcnt(0) lgkmcnt(0)" ::: "memory"); __builtin_amdgcn_s_barrier(); asm volatile("" ::: "memory");
        const bool bad = flag[0] != 0u;
        if (lane < 32) {
            const unsigned long long* slot = (const unsigned long long*)xbuf + (size_t)(u.pm * BM + row) * 4; float mt[4], m2[4]; float ms = 0.f;
#pragma unroll
            for (int t = 0; t < 4; ++t) { if (t < ntn) { const unsigned long long w = __hip_atomic_load(slot + t, __ATOMIC_RELAXED, __HIP_MEMORY_SCOPE_AGENT); mt[t] = __uint_as_float((unsigned)w); m2[t] = __uint_as_float((unsigned)(w >> 32)); } else { mt[t] = 0.f; m2[t] = 0.f; } ms += mt[t]; }
            const float mean = ms / (float)ntn; float q = 0.f;
#pragma unroll
            for (int t = 0; t < 4; ++t) if (t < ntn) { const float dm = mt[t] - mean; q += m2[t] + 256.0f * dm * dm; }
            S[row] = (f32x2v){mean, 1.0f / sqrtf(q / (256.0f * (float)ntn) + eps)};
        }
        asm volatile("s_waitcnt lgkmcnt(0)" ::: "memory"); __builtin_amdgcn_s_barrier(); asm volatile("" ::: "memory");
        return bad;
    }
};
struct EpiLnRes {
    static constexpr bool PERM = false, AFTER_DRAIN = true;
    const float* base; float* out; int ldc; const float* bias; PanelStats st; unsigned poison;
    __device__ __forceinline__ void fused(f32x4 (&acc)[2][2][4][2], const Unit& u, int wr, int wc, int fr, int fq, PG8_LAS unsigned char* lds, int wid, int lane) const {
        typedef float f32x2v __attribute__((ext_vector_type(2)));
        const PG8_LAS f32x2v* S = (const PG8_LAS f32x2v*)(lds + 8192);
        const int col0 = u.pn * BM + wc * 32 + 4 * fq;
#pragma unroll
        for (int bj = 0; bj < 2; ++bj)
#pragma unroll
            for (int n = 0; n < 2; ++n) { const f32x4 bv = bias ? *(const f32x4*)(bias + col0 + bj * HALF + n * 16) : (f32x4){0.f, 0.f, 0.f, 0.f};
#pragma unroll
                for (int ai = 0; ai < 2; ++ai)
#pragma unroll
                    for (int m = 0; m < 4; ++m) acc[ai][bj][m][n] += bv; }
        f32x4 pre[4][2][2];
#pragma unroll
        for (int m = 0; m < 4; ++m) { const size_t off = (size_t)(u.pm * BM + wr * 64 + m * 16 + fr) * ldc + col0;
#pragma unroll
            for (int bj = 0; bj < 2; ++bj)
#pragma unroll
                for (int n = 0; n < 2; ++n) pre[m][bj][n] = *(const f32x4*)(base + off + bj * HALF + n * 16); }
        const bool bad = st.run(acc, u, wr, wc, fr, fq, lds, wid, lane) || poison != 0u;
        const float qnan = __builtin_nanf("");
#pragma unroll
        for (int ai = 0; ai < 2; ++ai)
#pragma unroll
            for (int m = 0; m < 4; ++m) { const int r = ai * HALF + wr * 64 + m * 16 + fr; const f32x2v sr = S[r]; const size_t off = (size_t)(u.pm * BM + r) * ldc + col0;
#pragma unroll
                for (int bj = 0; bj < 2; ++bj)
#pragma unroll
                    for (int n = 0; n < 2; ++n) { const f32x4 bs = ai == 0 ? pre[m][bj][n] : *(const f32x4*)(base + off + bj * HALF + n * 16); f32x4 o = bs + (acc[ai][bj][m][n] - sr.x) * sr.y;
                        if (bad) o = (f32x4){qnan, qnan, qnan, qnan}; *(f32x4*)(out + off + bj * HALF + n * 16) = o; }
                if (m & 1) asm volatile("" ::: "memory"); }
    }
};
struct EpiLnResLn {
    static constexpr bool PERM = false, AFTER_DRAIN = true;
    const float* base; float* out; bf16_t* xn; int ldc; const float* bias; PanelStats st1, st2; unsigned poison;
    __device__ __forceinline__ void fused(f32x4 (&acc)[2][2][4][2], const Unit& u, int wr, int wc, int fr, int fq, PG8_LAS unsigned char* lds, int wid, int lane) const {
        typedef float f32x2v __attribute__((ext_vector_type(2))); typedef unsigned u32x2v __attribute__((ext_vector_type(2)));
        const PG8_LAS f32x2v* S = (const PG8_LAS f32x2v*)(lds + 8192);
        const int col0 = u.pn * BM + wc * 32 + 4 * fq;
#pragma unroll
        for (int bj = 0; bj < 2; ++bj)
#pragma unroll
            for (int n = 0; n < 2; ++n) { const f32x4 bv = bias ? *(const f32x4*)(bias + col0 + bj * HALF + n * 16) : (f32x4){0.f, 0.f, 0.f, 0.f};
#pragma unroll
                for (int ai = 0; ai < 2; ++ai)
#pragma unroll
                    for (int m = 0; m < 4; ++m) acc[ai][bj][m][n] += bv; }
        bool bad = st1.run(acc, u, wr, wc, fr, fq, lds, wid, lane) || poison != 0u;
        const float qnan = __builtin_nanf("");
#pragma unroll
        for (int ai = 0; ai < 2; ++ai)
#pragma unroll
            for (int m = 0; m < 4; ++m) { const int r = ai * HALF + wr * 64 + m * 16 + fr; const f32x2v sr = S[r]; const size_t off = (size_t)(u.pm * BM + r) * ldc + col0;
#pragma unroll
                for (int bj = 0; bj < 2; ++bj)
#pragma unroll
                    for (int n = 0; n < 2; ++n) { const f32x4 bs = *(const f32x4*)(base + off + bj * HALF + n * 16); acc[ai][bj][m][n] = bs + (acc[ai][bj][m][n] - sr.x) * sr.y; }
                asm volatile("" : "+v"(acc[ai][0][m][0]), "+v"(acc[ai][0][m][1]), "+v"(acc[ai][1][m][0]), "+v"(acc[ai][1][m][1]));
                if (m & 1) asm volatile("" ::: "memory"); }
        const bool bad1 = bad;
        bad = st2.run(acc, u, wr, wc, fr, fq, lds, wid, lane) || bad;
#pragma unroll
        for (int ai = 0; ai < 2; ++ai)
#pragma unroll
            for (int m = 0; m < 4; ++m) { const int r = ai * HALF + wr * 64 + m * 16 + fr; const f32x2v sr = S[r]; const size_t off = (size_t)(u.pm * BM + r) * ldc + col0;
#pragma unroll
                for (int bj = 0; bj < 2; ++bj)
#pragma unroll
                    for (int n = 0; n < 2; ++n) { const f32x4 x1 = acc[ai][bj][m][n]; *(f32x4*)(out + off + bj * HALF + n * 16) = bad1 ? (f32x4){qnan, qnan, qnan, qnan} : x1;
                        const f32x4 o = (x1 - sr.x) * sr.y; u32x2v w; w.x = cvt_pk_bf16(o[0], o[1]); w.y = cvt_pk_bf16(o[2], o[3]);
                        if (bad) { w.x = 0x7fc07fc0u; w.y = 0x7fc07fc0u; } *(u32x2v*)(xn + off + bj * HALF + n * 16) = w; }
                asm volatile("" ::: "memory"); }
    }
};

template <class Epi, class Sched, bool ALIGN_EPI = false, bool SP2 = false>
__device__ __forceinline__ void gemm_phase(PG8_LAS unsigned char* lds, const Gemm g, const Sched& S, const Epi& E, int tid_) {
    asm volatile("" : "+v"(tid_));
    const int tid = tid_, wid = __builtin_amdgcn_readfirstlane(tid >> 6), lane = tid & 63, wr = wid >> 2, wc = wid & 3, fr = lane & 15, fq = lane >> 4;
    const int K = g.K, nt = K / BK;
    unsigned voffA[2], voffB[2];
#pragma unroll
    for (int i = 0; i < 2; ++i) { int R, C; stage_rc(tid * 16 + i * 8192, R, C); const int Rb = Epi::PERM ? ((R & ~31) + perm32(R & 31)) : R;
        voffA[i] = (unsigned)(R * K + C) * 2u; voffB[i] = (unsigned)(Rb * K + C) * 2u; }
    const size_t kstep = (size_t)(BK * 2);
    const size_t hstep = (size_t)HALF * K * 2;
    const size_t tstep = 2 * hstep;
    const unsigned ldsw = (unsigned)wid * 1024u;
    const int aoff = lds_byte(wr * 64 + fr, fq * 8), boff = lds_byte(wc * 32 + fr, fq * 8);
#define PG8_SA(b, h) (((b) * 2 + (h)) * HTB)
#define PG8_SB(b, h) ((4 + (b) * 2 + (h)) * HTB)
#define PG8_STAGE(bufoff, gbase, voff) do { _Pragma("unroll") for (int _i = 0; _i < 2; ++_i) \
        __builtin_amdgcn_global_load_lds((const unsigned*)((const char*)(gbase) + (voff)[_i]), (PG8_LAS unsigned*)(lds + (bufoff) + ldsw + _i * 8192), 16, 0, 0); } while (0)
#define PG8_LDA(dst, b, h) do { _Pragma("unroll") for (int m = 0; m < 4; ++m) _Pragma("unroll") for (int k = 0; k < 2; ++k) dst[m][k] = *(const PG8_LAS bf16x8*)(lds + PG8_SA(b, h) + aoff + m * 2048 + k * 1024); } while (0)
#define PG8_LDB(dst, b, h) do { _Pragma("unroll") for (int n = 0; n < 2; ++n) _Pragma("unroll") for (int k = 0; k < 2; ++k) dst[n][k] = *(const PG8_LAS bf16x8*)(lds + PG8_SB(b, h) + boff + n * 2048 + k * 1024); } while (0)
#define PG8_MMA(ai, bj, At, Bt) do { __builtin_amdgcn_s_setprio(1); _Pragma("unroll") for (int m = 0; m < 4; ++m) _Pragma("unroll") for (int n = 0; n < 2; ++n) _Pragma("unroll") for (int k = 0; k < 2; ++k) \
        acc[ai][bj][m][n] = __builtin_amdgcn_mfma_f32_16x16x32_bf16(Bt[n][k], At[m][k], acc[ai][bj][m][n], 0, 0, 0); __builtin_amdgcn_s_setprio(0); } while (0)
#define PG8_WAIT_V(n) asm volatile("s_waitcnt vmcnt(" #n ")" ::: "memory")
#define PG8_WAIT_L(n) asm volatile("s_waitcnt lgkmcnt(" #n ")" ::: "memory")
#define PG8_BAR __builtin_amdgcn_s_barrier()
#define PG8_SCHED __builtin_amdgcn_sched_barrier(0)
    Unit cur, nxt; int ui = 0;
    if (!S.next(0, cur)) return;
    f32x4 acc[2][2][4][2];
#pragma unroll
    for (int a = 0; a < 2; ++a)
#pragma unroll
        for (int b = 0; b < 2; ++b)
#pragma unroll
            for (int m = 0; m < 4; ++m)
#pragma unroll
                for (int n = 0; n < 2; ++n) acc[a][b][m][n] = (f32x4){0.f, 0.f, 0.f, 0.f};
    bf16x8 At[4][2], B0[2][2], B1[2][2];
    const char* cA = (const char*)g.A + (size_t)cur.pm * tstep; const char* cB = (const char*)g.Bt + (size_t)cur.pn * tstep;
    S.a_ready(cur);
    if constexpr (SP2) {
        PG8_STAGE(PG8_SB(0, 0), cB, voffB); PG8_STAGE(PG8_SB(0, 1), cB + hstep, voffB); PG8_STAGE(PG8_SA(0, 0), cA, voffA); PG8_STAGE(PG8_SA(0, 1), cA + hstep, voffA);
        if (wr == 1) PG8_BAR;
        PG8_WAIT_V(2); PG8_BAR;
        PG8_STAGE(PG8_SB(1, 0), cB + kstep, voffB); PG8_STAGE(PG8_SA(1, 0), cA + kstep, voffA); PG8_STAGE(PG8_SB(1, 1), cB + hstep + kstep, voffB);
        PG8_WAIT_V(6); PG8_BAR;
    } else {
        PG8_STAGE(PG8_SB(0, 0), cB, voffB); PG8_STAGE(PG8_SA(0, 0), cA, voffA); PG8_STAGE(PG8_SB(0, 1), cB + hstep, voffB); PG8_STAGE(PG8_SA(0, 1), cA + hstep, voffA);
        if (wr == 1) PG8_BAR;
        PG8_WAIT_V(4); PG8_BAR;
        PG8_STAGE(PG8_SB(1, 0), cB + kstep, voffB); PG8_STAGE(PG8_SA(1, 0), cA + kstep, voffA); PG8_STAGE(PG8_SB(1, 1), cB + hstep + kstep, voffB);
        PG8_WAIT_V(6); PG8_BAR;
    }
    for (;;) {
        const bool has_next = S.next(ui + 1, nxt);
        const char* nA = has_next ? (const char*)g.A + (size_t)nxt.pm * tstep : cA; const char* nB = has_next ? (const char*)g.Bt + (size_t)nxt.pn * tstep : cB;
        for (int t = 0; t < nt; t += 2) {
            const bool last = (t == nt - 2);
            const char* a1 = cA + (size_t)(t + 1) * kstep;
            const char* a2 = last ? nA : cA + (size_t)(t + 2) * kstep; const char* b2 = last ? nB : cB + (size_t)(t + 2) * kstep;
            const char* a3 = a2 + kstep; const char* b3 = b2 + kstep;
            if (last && has_next) S.a_ready(nxt);
            if constexpr (SP2) {
            PG8_LDB(B0, 0, 0); PG8_LDB(B1, 0, 1); PG8_SCHED; PG8_LDA(At, 0, 0); PG8_STAGE(PG8_SA(1, 1), a1 + hstep, voffA);
            PG8_WAIT_V(8); PG8_WAIT_L(0); PG8_BAR; PG8_MMA(0, 0, At, B0); PG8_MMA(0, 1, At, B1); PG8_BAR; PG8_SCHED;
            PG8_LDA(At, 0, 1); PG8_STAGE(PG8_SB(0, 0), b2, voffB); PG8_STAGE(PG8_SB(0, 1), b2 + hstep, voffB); PG8_STAGE(PG8_SA(0, 0), a2, voffA);
            PG8_WAIT_V(8); PG8_WAIT_L(0); PG8_BAR; PG8_MMA(1, 0, At, B0); PG8_MMA(1, 1, At, B1); PG8_BAR; PG8_SCHED;
            PG8_LDB(B0, 1, 0); PG8_LDB(B1, 1, 1); PG8_SCHED; PG8_LDA(At, 1, 0); PG8_STAGE(PG8_SA(0, 1), a2 + hstep, voffA);
            PG8_WAIT_V(8); PG8_WAIT_L(0); PG8_BAR; PG8_MMA(0, 0, At, B0); PG8_MMA(0, 1, At, B1); PG8_BAR; PG8_SCHED;
            PG8_LDA(At, 1, 1); PG8_STAGE(PG8_SB(1, 0), b3, voffB); PG8_STAGE(PG8_SB(1, 1), b3 + hstep, voffB); PG8_STAGE(PG8_SA(1, 0), a3, voffA);
            PG8_WAIT_V(8); PG8_WAIT_L(0); PG8_BAR; PG8_MMA(1, 0, At, B0); PG8_MMA(1, 1, At, B1); PG8_BAR; PG8_SCHED;
            } else {
            PG8_LDB(B0, 0, 0); PG8_SCHED; PG8_LDA(At, 0, 0); PG8_STAGE(PG8_SA(1, 1), a1 + hstep, voffA);
            PG8_WAIT_L(8); PG8_BAR; PG8_WAIT_L(0); PG8_MMA(0, 0, At, B0); PG8_BAR; PG8_SCHED;
            PG8_LDB(B1, 0, 1); PG8_STAGE(PG8_SB(0, 0), b2, voffB);
            PG8_BAR; PG8_WAIT_L(0); PG8_MMA(0, 1, At, B1); PG8_BAR;
            PG8_LDA(At, 0, 1); PG8_STAGE(PG8_SA(0, 0), a2, voffA);
            PG8_BAR; PG8_WAIT_L(0); PG8_MMA(1, 0, At, B0); PG8_BAR; PG8_SCHED;
            PG8_STAGE(PG8_SB(0, 1), b2 + hstep, voffB);
            PG8_WAIT_V(6); PG8_BAR; PG8_MMA(1, 1, At, B1); PG8_BAR;
            PG8_LDB(B0, 1, 0); PG8_SCHED; PG8_LDA(At, 1, 0); PG8_STAGE(PG8_SA(0, 1), a2 + hstep, voffA);
            PG8_WAIT_L(8); PG8_BAR; PG8_WAIT_L(0); PG8_MMA(0, 0, At, B0); PG8_BAR; PG8_SCHED;
            PG8_LDB(B1, 1, 1); PG8_STAGE(PG8_SB(1, 0), b3, voffB);
            PG8_BAR; PG8_WAIT_L(0); PG8_MMA(0, 1, At, B1); PG8_BAR;
            PG8_LDA(At, 1, 1); PG8_STAGE(PG8_SA(1, 0), a3, voffA);
            PG8_BAR; PG8_WAIT_L(0); PG8_MMA(1, 0, At, B0); PG8_BAR; PG8_SCHED;
            PG8_STAGE(PG8_SB(1, 1), b3 + hstep, voffB);
            PG8_WAIT_V(6); PG8_BAR; PG8_MMA(1, 1, At, B1); PG8_BAR;
            }
        }
        if constexpr (ALIGN_EPI) { if (wr == 0) PG8_BAR; }
        if constexpr (!Epi::AFTER_DRAIN) { E(acc, cur, wr, wc, fr, fq); S.done(cur); }
        if (!has_next) break;
#pragma unroll
        for (int a = 0; a < 2; ++a)
#pragma unroll
            for (int b = 0; b < 2; ++b)
#pragma unroll
                for (int m = 0; m < 4; ++m)
#pragma unroll
                    for (int n = 0; n < 2; ++n) acc[a][b][m][n] = (f32x4){0.f, 0.f, 0.f, 0.f};
        cur = nxt; cA = nA; cB = nB; ++ui;
        if constexpr (ALIGN_EPI) { if (wr == 1) PG8_BAR; }
    }
    PG8_WAIT_V(0);
    if constexpr (!ALIGN_EPI) { if (wr == 0) PG8_BAR; }
    PG8_BAR;
    if constexpr (Epi::AFTER_DRAIN) { E.fused(acc, cur, wr, wc, fr, fq, lds, wid, lane); S.done(cur); }
#undef PG8_SA
#undef PG8_SB
#undef PG8_STAGE
#undef PG8_LDA
#undef PG8_LDB
#undef PG8_MMA
#undef PG8_WAIT_V
#undef PG8_WAIT_L
#undef PG8_BAR
#undef PG8_SCHED
}
}

namespace hp {
typedef unsigned short bf16_t;
typedef short bf16x8 __attribute__((ext_vector_type(8)));
typedef short s16x4 __attribute__((ext_vector_type(4)));
typedef float f32x4 __attribute__((ext_vector_type(4)));
typedef float f32x16 __attribute__((ext_vector_type(16)));
typedef unsigned u32x4 __attribute__((ext_vector_type(4)));
typedef unsigned u32x2 __attribute__((ext_vector_type(2)));

constexpr int NB = 4, SEQ = 4096, DM = 4096, NL = 4, MT = NB * SEQ;
constexpr int NIN = 11800, NINP = 12032, DFF = 11008, NGU = 2 * DFF;
constexpr int C_RQ = 0, C_RK = 1024, C_RV = 2048, C_RG = 3072, C_SQ = 4096, C_SK = 5120, C_SV = 6144, C_LG = 7168, C_LR = 8192,
              C_NQ = 9216, C_NKC = 10240, C_NVC = 10496, C_NKS = 10752, C_NVS = 11008, C_NKW = 11264, C_NVW = 11520, C_NG = 11776;
constexpr int MIX_RET = 0, MIX_SB = 1024, MIX_LRU = 2048, MIX_NSA = 3072;
constexpr int NTHR = 512, NWAVE = 8;
constexpr int LDS_STAGE = 131072, LDS_CTL = 256, RT_PANELS = 24, LDS_RT = RT_PANELS * 256 * 4, LDS_BYTES = LDS_STAGE + LDS_CTL + LDS_RT;

enum { I_X = 0, I_ANW, I_WIN, I_LCW, I_LCB, I_LWA, I_LBA, I_LWX, I_LBX, I_LLAM, I_NQW, I_NKW, I_CPOS, I_CW1, I_CW2, I_WOUT, I_MNW, I_WG, I_WU, I_MCW, I_MCB, I_WD, N_INPUTS };

constexpr size_t al256(size_t x) { return (x + 255) & ~(size_t)255; }
constexpr size_t WS_CTL   = 0;
constexpr size_t CTL_BYTES = 65536;
constexpr size_t WS_RSS   = WS_CTL + CTL_BYTES;
constexpr size_t WS_TAB_RC = WS_RSS + (size_t)2 * MT * 64 * 4;
constexpr size_t WS_TAB_RS = WS_TAB_RC + (size_t)SEQ * 64 * 4;
constexpr size_t WS_TAB_NC = WS_TAB_RS + (size_t)SEQ * 64 * 4;
constexpr size_t WS_TAB_NS = WS_TAB_NC + (size_t)SEQ * 16 * 4;
constexpr size_t WS_WIN   = WS_TAB_NS + (size_t)SEQ * 16 * 4;
constexpr size_t WS_WOUT  = WS_WIN  + (size_t)NINP * DM * 2;
constexpr size_t WS_WGU   = WS_WOUT + (size_t)DM * DM * 2;
constexpr size_t WS_WDN   = WS_WGU  + (size_t)NGU * DM * 2;
constexpr size_t WS_CW1   = WS_WDN  + (size_t)DM * DFF * 2;
constexpr size_t WS_CW2   = WS_CW1  + (size_t)2 * 4096 * 256 * 2;
constexpr size_t WS_LWA   = WS_CW2  + (size_t)2 * 256 * 128 * 2;
constexpr size_t WS_LWX   = WS_LWA  + (size_t)8 * 128 * 128 * 2;
constexpr size_t WS_HN    = WS_LWX  + (size_t)8 * 128 * 128 * 2;
constexpr size_t WS_MIX   = WS_HN   + (size_t)MT * DM * 2;
constexpr size_t WS_PROJ  = WS_MIX  + (size_t)MT * DM * 2;
constexpr size_t WS_GU    = WS_PROJ;
constexpr size_t WS_H     = WS_PROJ + (size_t)MT * NGU * 2;
constexpr size_t WS_QR    = WS_H    + (size_t)MT * DFF * 2;
constexpr size_t WS_KR    = WS_QR   + (size_t)MT * 1024 * 2;
constexpr size_t WS_QN    = WS_KR   + (size_t)MT * 1024 * 2;
constexpr size_t WS_KSN   = WS_QN   + (size_t)MT * 1024 * 2;
constexpr size_t WS_KWN   = WS_KSN  + (size_t)MT * 256 * 2;
constexpr size_t WS_KCMP  = WS_KWN  + (size_t)MT * 256 * 2;
constexpr size_t WS_VCMP  = WS_KCMP + (size_t)8 * 256 * 128 * 2;
constexpr size_t WS_ST    = WS_VCMP + (size_t)8 * 256 * 128 * 2;
constexpr size_t WS_HLOC  = WS_ST   + (size_t)32 * 32 * 128 * 128 * 2;
constexpr size_t WS_CUMA  = WS_HLOC + (size_t)MT * 1024 * 4;
constexpr size_t WS_YNSA  = WS_CUMA + (size_t)MT * 1024 * 4;
constexpr size_t WS_GT    = WS_YNSA + (size_t)MT * 1024 * 4;
constexpr size_t WS_GH    = WS_GT   + (size_t)256 * 2 * DFF * 2;
constexpr size_t WS_UH    = WS_GH   + (size_t)256 * 2 * DFF * 2;
constexpr size_t WS_CPOS  = WS_UH   + (size_t)256 * 2 * DFF * 2;
constexpr size_t WS_WDN2  = WS_CPOS + 2 * 256 * 4;
constexpr size_t WS_END   = WS_WDN2 + (size_t)DM * DFF * 2;
constexpr int CW_BAR = 0;
constexpr int CW_RSFLAG = 8192;
constexpr int CW_QUEUE = 4096;

struct Params {
    const float* in[N_INPUTS];
    float* out;
    unsigned char* ws;
    int l_lo, l_hi, ph_lo, ph_hi;
};
typedef const __attribute__((address_space(4))) Params* KP;

__device__ __forceinline__ float bf2f(unsigned short v) { return __uint_as_float(((unsigned)v) << 16); }
__device__ __forceinline__ float bflo(unsigned w) { return __uint_as_float(w << 16); }
__device__ __forceinline__ float bfhi(unsigned w) { return __uint_as_float(w & 0xffff0000u); }
__device__ __forceinline__ unsigned cvt_pk(float lo, float hi) { unsigned r; asm volatile("v_cvt_pk_bf16_f32 %0, %1, %2" : "=v"(r) : "v"(lo), "v"(hi)); return r; }
__device__ __forceinline__ unsigned short f2bf(float f) { return (unsigned short)(cvt_pk(f, 0.f) & 0xffffu); }
__device__ __forceinline__ float fexp2(float x) { return __builtin_amdgcn_exp2f(x); }
__device__ __forceinline__ float flog2(float x) { return __builtin_amdgcn_logf(x); }
__device__ __forceinline__ float frcp(float x) { return __builtin_amdgcn_rcpf(x); }
__device__ __forceinline__ float sigmoidf_(float x) { return frcp(1.f + fexp2(-x * 1.4426950408889634f)); }
__device__ __forceinline__ float gelu_tanh(float x) {
    const float u = 0.7978845608028654f * (x + 0.044715f * x * x * x);
    const float t = 1.f - 2.f * frcp(1.f + fexp2(2.f * 1.4426950408889634f * u));
    return 0.5f * x * (1.f + t);
}
__device__ __forceinline__ float half_max(float v) { auto r = __builtin_amdgcn_permlane32_swap(__float_as_uint(v), __float_as_uint(v), false, false); return fmaxf(__uint_as_float(r[0]), __uint_as_float(r[1])); }
__device__ __forceinline__ float half_sum(float v) { auto r = __builtin_amdgcn_permlane32_swap(__float_as_uint(v), __float_as_uint(v), false, false); return __uint_as_float(r[0]) + __uint_as_float(r[1]); }
__device__ __forceinline__ float wave_sum(float v) {
#pragma unroll
    for (int o = 32; o >= 1; o >>= 1) v += __shfl_xor(v, o);
    return v;
}

__device__ __forceinline__ unsigned off_b(unsigned row, unsigned ch) { return 256u * row + 16u * (ch ^ (((row & 3u) << 2) | ((row >> 2) & 3u))); }
__device__ __forceinline__ bf16x8 row_frag(const LAS unsigned char* tile, int r0, int s, int lane) {
    return *(const LAS bf16x8*)(tile + off_b((unsigned)(r0 + (lane & 31)), (unsigned)(2 * s + (lane >> 5))));
}
__device__ __forceinline__ unsigned lds_addr(const LAS unsigned char* p) { return (unsigned)(size_t)p; }
__device__ __forceinline__ unsigned tr_off_nat(int lane, int c, int ks, int t) {
    const unsigned h = lane >> 5, blk = (lane >> 4) & 1, q = (lane & 15) >> 2, p = lane & 3;
    return off_b(16u * ks + 8u * h + 4u * t + q, 4u * c + 2u * blk + (p >> 1)) + 8u * (p & 1);
}
__device__ __forceinline__ unsigned tr_off_acc(int lane, int c, int ks, int t) {
    const unsigned h = lane >> 5, blk = (lane >> 4) & 1, q = (lane & 15) >> 2, p = lane & 3;
    return off_b(16u * ks + 8u * t + 4u * h + q, 4u * c + 2u * blk + (p >> 1)) + 8u * (p & 1);
}
__device__ __forceinline__ bf16x8 tr_read2(unsigned a0, unsigned a1) {
    s16x4 lo, hi;
    asm volatile("ds_read_b64_tr_b16 %0, %2\n\tds_read_b64_tr_b16 %1, %3\n\ts_waitcnt lgkmcnt(0)" : "=&v"(lo), "=&v"(hi) : "v"(a0), "v"(a1) : "memory");
    return __builtin_shufflevector(lo, hi, 0, 1, 2, 3, 4, 5, 6, 7);
}
__device__ __forceinline__ void tr_frag_nat2(const LAS unsigned char* t0, const LAS unsigned char* t1, int c, int ks, int lane, bf16x8& f0, bf16x8& f1) {
    const unsigned o0 = tr_off_nat(lane, c, ks, 0), o1 = tr_off_nat(lane, c, ks, 1), b0 = lds_addr(t0), b1 = lds_addr(t1);
    s16x4 l0, h0, l1, h1;
    asm volatile("ds_read_b64_tr_b16 %0, %4\n\tds_read_b64_tr_b16 %1, %5\n\tds_read_b64_tr_b16 %2, %6\n\tds_read_b64_tr_b16 %3, %7\n\ts_waitcnt lgkmcnt(0)"
                 : "=&v"(l0), "=&v"(h0), "=&v"(l1), "=&v"(h1) : "v"(b0 + o0), "v"(b0 + o1), "v"(b1 + o0), "v"(b1 + o1) : "memory");
    f0 = __builtin_shufflevector(l0, h0, 0, 1, 2, 3, 4, 5, 6, 7); f1 = __builtin_shufflevector(l1, h1, 0, 1, 2, 3, 4, 5, 6, 7);
}
__device__ __forceinline__ bf16x8 tr_frag_nat(const LAS unsigned char* tile, int c, int ks, int lane) {
    const unsigned b = lds_addr(tile);
    return tr_read2(b + tr_off_nat(lane, c, ks, 0), b + tr_off_nat(lane, c, ks, 1));
}
struct TrAcc { unsigned a[4][2]; };
__device__ __forceinline__ void tr_acc_init(TrAcc& A, int lane) {
#pragma unroll
    for (int c = 0; c < 4; ++c)
#pragma unroll
        for (int t = 0; t < 2; ++t) A.a[c][t] = tr_off_acc(lane, c, 0, t);
}
__device__ __forceinline__ void pv_step(f32x16 (&o)[4], unsigned vb  , const TrAcc& A, bf16x8 pf) {
    s16x4 d0, d1, d2, d3, d4, d5, d6, d7;
    asm volatile("ds_read_b64_tr_b16 %0, %8\n\tds_read_b64_tr_b16 %1, %9\n\tds_read_b64_tr_b16 %2, %10\n\tds_read_b64_tr_b16 %3, %11\n\t"
                 "ds_read_b64_tr_b16 %4, %12\n\tds_read_b64_tr_b16 %5, %13\n\tds_read_b64_tr_b16 %6, %14\n\tds_read_b64_tr_b16 %7, %15\n\ts_waitcnt lgkmcnt(0)"
                 : "=&v"(d0), "=&v"(d1), "=&v"(d2), "=&v"(d3), "=&v"(d4), "=&v"(d5), "=&v"(d6), "=&v"(d7)
                 : "v"(vb + A.a[0][0]), "v"(vb + A.a[0][1]), "v"(vb + A.a[1][0]), "v"(vb + A.a[1][1]), "v"(vb + A.a[2][0]), "v"(vb + A.a[2][1]), "v"(vb + A.a[3][0]), "v"(vb + A.a[3][1]) : "memory");
    o[0] = __builtin_amdgcn_mfma_f32_32x32x16_bf16(__builtin_shufflevector(d0, d1, 0, 1, 2, 3, 4, 5, 6, 7), pf, o[0], 0, 0, 0);
    o[1] = __builtin_amdgcn_mfma_f32_32x32x16_bf16(__builtin_shufflevector(d2, d3, 0, 1, 2, 3, 4, 5, 6, 7), pf, o[1], 0, 0, 0);
    o[2] = __builtin_amdgcn_mfma_f32_32x32x16_bf16(__builtin_shufflevector(d4, d5, 0, 1, 2, 3, 4, 5, 6, 7), pf, o[2], 0, 0, 0);
    o[3] = __builtin_amdgcn_mfma_f32_32x32x16_bf16(__builtin_shufflevector(d6, d7, 0, 1, 2, 3, 4, 5, 6, 7), pf, o[3], 0, 0, 0);
}
__device__ __forceinline__ f32x16 qk_block(const LAS unsigned char* ktile, int kb, const bf16x8 (&qf)[8], int lane) {
    f32x16 acc;
#pragma unroll
    for (int i = 0; i < 16; ++i) acc[i] = 0.f;
#pragma unroll
    for (int s = 0; s < 8; ++s) acc = __builtin_amdgcn_mfma_f32_32x32x16_bf16(row_frag(ktile, 32 * kb, s, lane), qf[s], acc, 0, 0, 0);
    return acc;
}
__device__ __forceinline__ void qk_tile(const LAS unsigned char* ktile, const bf16x8 (&qf)[8], int lane, f32x16& s0, f32x16& s1) {
#pragma unroll
    for (int i = 0; i < 16; ++i) { s0[i] = 0.f; s1[i] = 0.f; }
#pragma unroll
    for (int s = 0; s < 8; ++s) {
        const bf16x8 a0 = row_frag(ktile, 0, s, lane), a1 = row_frag(ktile, 32, s, lane);
        s0 = __builtin_amdgcn_mfma_f32_32x32x16_bf16(a0, qf[s], s0, 0, 0, 0);
        s1 = __builtin_amdgcn_mfma_f32_32x32x16_bf16(a1, qf[s], s1, 0, 0, 0);
    }
}
struct KFrag4 { bf16x8 a, b, c, d; };
__device__ __forceinline__ void k_issue4(KFrag4& f, unsigned a0, unsigned a1, unsigned a2, unsigned a3) {
    asm volatile("ds_read_b128 %0, %4\n\tds_read_b128 %1, %5\n\tds_read_b128 %2, %6\n\tds_read_b128 %3, %7" : "=&v"(f.a), "=&v"(f.b), "=&v"(f.c), "=&v"(f.d) : "v"(a0), "v"(a1), "v"(a2), "v"(a3) : "memory");
}
__device__ __forceinline__ void k_wait4(KFrag4& f) { asm volatile("s_waitcnt lgkmcnt(4)" : "+v"(f.a), "+v"(f.b), "+v"(f.c), "+v"(f.d) :: "memory"); }
__device__ __forceinline__ void k_wait0(KFrag4& f) { asm volatile("s_waitcnt lgkmcnt(0)" : "+v"(f.a), "+v"(f.b), "+v"(f.c), "+v"(f.d) :: "memory"); }
__device__ __forceinline__ void qk_tile_pipe(const LAS unsigned char* ktile, const bf16x8 (&qf)[8], int lane, f32x16& s0, f32x16& s1) {
#pragma unroll
    for (int i = 0; i < 16; ++i) { s0[i] = 0.f; s1[i] = 0.f; }
    const unsigned kb = lds_addr(ktile), r0 = (unsigned)(lane & 31), h = (unsigned)(lane >> 5);
#define KA_(row_, s_) (kb + off_b((row_), 2u * (s_) + h))
    KFrag4 A, B;
    k_issue4(A, KA_(r0, 0), KA_(r0, 1), KA_(r0, 2), KA_(r0, 3));
    k_issue4(B, KA_(r0, 4), KA_(r0, 5), KA_(r0, 6), KA_(r0, 7));
    k_wait4(A);
    s0 = __builtin_amdgcn_mfma_f32_32x32x16_bf16(A.a, qf[0], s0, 0, 0, 0); s0 = __builtin_amdgcn_mfma_f32_32x32x16_bf16(A.b, qf[1], s0, 0, 0, 0);
    s0 = __builtin_amdgcn_mfma_f32_32x32x16_bf16(A.c, qf[2], s0, 0, 0, 0); s0 = __builtin_amdgcn_mfma_f32_32x32x16_bf16(A.d, qf[3], s0, 0, 0, 0);
    k_issue4(A, KA_(r0 + 32u, 0), KA_(r0 + 32u, 1), KA_(r0 + 32u, 2), KA_(r0 + 32u, 3));
    k_wait4(B);
    s0 = __builtin_amdgcn_mfma_f32_32x32x16_bf16(B.a, qf[4], s0, 0, 0, 0); s0 = __builtin_amdgcn_mfma_f32_32x32x16_bf16(B.b, qf[5], s0, 0, 0, 0);
    s0 = __builtin_amdgcn_mfma_f32_32x32x16_bf16(B.c, qf[6], s0, 0, 0, 0); s0 = __builtin_amdgcn_mfma_f32_32x32x16_bf16(B.d, qf[7], s0, 0, 0, 0);
    k_issue4(B, KA_(r0 + 32u, 4), KA_(r0 + 32u, 5), KA_(r0 + 32u, 6), KA_(r0 + 32u, 7));
    k_wait4(A);
    s1 = __builtin_amdgcn_mfma_f32_32x32x16_bf16(A.a, qf[0], s1, 0, 0, 0); s1 = __builtin_amdgcn_mfma_f32_32x32x16_bf16(A.b, qf[1], s1, 0, 0, 0);
    s1 = __builtin_amdgcn_mfma_f32_32x32x16_bf16(A.c, qf[2], s1, 0, 0, 0); s1 = __builtin_amdgcn_mfma_f32_32x32x16_bf16(A.d, qf[3], s1, 0, 0, 0);
    k_wait0(B);
    s1 = __builtin_amdgcn_mfma_f32_32x32x16_bf16(B.a, qf[4], s1, 0, 0, 0); s1 = __builtin_amdgcn_mfma_f32_32x32x16_bf16(B.b, qf[5], s1, 0, 0, 0);
    s1 = __builtin_amdgcn_mfma_f32_32x32x16_bf16(B.c, qf[6], s1, 0, 0, 0); s1 = __builtin_amdgcn_mfma_f32_32x32x16_bf16(B.d, qf[7], s1, 0, 0, 0);
#undef KA_
}
__device__ __forceinline__ f32x16 qk_block_pipe(const LAS unsigned char* ktile, int kb, const bf16x8 (&qf)[8], int lane) {
    f32x16 acc;
#pragma unroll
    for (int i = 0; i < 16; ++i) acc[i] = 0.f;
    const unsigned kbase = lds_addr(ktile), r0 = (unsigned)(32 * kb + (lane & 31)), h = (unsigned)(lane >> 5);
#define KA_(s_) (kbase + off_b(r0, 2u * (s_) + h))
    KFrag4 A, B;
    k_issue4(A, KA_(0), KA_(1), KA_(2), KA_(3));
    k_issue4(B, KA_(4), KA_(5), KA_(6), KA_(7));
    k_wait4(A);
    acc = __builtin_amdgcn_mfma_f32_32x32x16_bf16(A.a, qf[0], acc, 0, 0, 0); acc = __builtin_amdgcn_mfma_f32_32x32x16_bf16(A.b, qf[1], acc, 0, 0, 0);
    acc = __builtin_amdgcn_mfma_f32_32x32x16_bf16(A.c, qf[2], acc, 0, 0, 0); acc = __builtin_amdgcn_mfma_f32_32x32x16_bf16(A.d, qf[3], acc, 0, 0, 0);
    k_wait0(B);
    acc = __builtin_amdgcn_mfma_f32_32x32x16_bf16(B.a, qf[4], acc, 0, 0, 0); acc = __builtin_amdgcn_mfma_f32_32x32x16_bf16(B.b, qf[5], acc, 0, 0, 0);
    acc = __builtin_amdgcn_mfma_f32_32x32x16_bf16(B.c, qf[6], acc, 0, 0, 0); acc = __builtin_amdgcn_mfma_f32_32x32x16_bf16(B.d, qf[7], acc, 0, 0, 0);
#undef KA_
    return acc;
}
__device__ __forceinline__ bf16x8 pack8(const f32x16& p, int s2) {
    u32x4 w; w.x = cvt_pk(p[8 * s2 + 0], p[8 * s2 + 1]); w.y = cvt_pk(p[8 * s2 + 2], p[8 * s2 + 3]); w.z = cvt_pk(p[8 * s2 + 4], p[8 * s2 + 5]); w.w = cvt_pk(p[8 * s2 + 6], p[8 * s2 + 7]);
    return __builtin_bit_cast(bf16x8, w);
}
template <int ROWS> struct TileRegs { u32x4 r[ROWS * 16 / NTHR]; };
template <int ROWS> __device__ __forceinline__ void tile_load(TileRegs<ROWS>& R, const bf16_t* src, size_t ld, int tid) {
#pragma unroll
    for (int i = 0; i < ROWS * 16 / NTHR; ++i) { const int c = tid + NTHR * i; R.r[i] = *(const u32x4*)(src + (size_t)(c >> 4) * ld + (c & 15) * 8); }
}
template <int ROWS> __device__ __forceinline__ void tile_store(LAS unsigned char* tile, const TileRegs<ROWS>& R, int tid) {
#pragma unroll
    for (int i = 0; i < ROWS * 16 / NTHR; ++i) { const int c = tid + NTHR * i; *(LAS u32x4*)(tile + off_b((unsigned)(c >> 4), (unsigned)(c & 15))) = R.r[i]; }
}
template <int ROWS> __device__ __forceinline__ void tile_stage(LAS unsigned char* tile, const bf16_t* src, size_t ld, int tid) {
    TileRegs<ROWS> R; tile_load<ROWS>(R, src, ld, tid); tile_store<ROWS>(tile, R, tid);
}
__device__ __forceinline__ void unpack8(const u32x4 v, float (&x)[8]) {
    x[0] = bflo(v.x); x[1] = bfhi(v.x); x[2] = bflo(v.y); x[3] = bfhi(v.y); x[4] = bflo(v.z); x[5] = bfhi(v.z); x[6] = bflo(v.w); x[7] = bfhi(v.w);
}
__device__ __forceinline__ u32x4 pack8f(const float (&x)[8]) {
    u32x4 w; w.x = cvt_pk(x[0], x[1]); w.y = cvt_pk(x[2], x[3]); w.z = cvt_pk(x[4], x[5]); w.w = cvt_pk(x[6], x[7]); return w;
}
__device__ __forceinline__ void ld8f(const float* src, float (&x)[8]) {
    const f32x4 a = *(const f32x4*)src, b = *(const f32x4*)(src + 4);
    x[0] = a[0]; x[1] = a[1]; x[2] = a[2]; x[3] = a[3]; x[4] = b[0]; x[5] = b[1]; x[6] = b[2]; x[7] = b[3];
}
__device__ __forceinline__ void tile_dma64(LAS unsigned char* tile, const bf16_t* src, size_t ld, int tid, int wave) {
#pragma unroll
    for (int i = 0; i < 2; ++i) {
        const int c = tid + NTHR * i, row = c >> 4, pos = c & 15, ch = pos ^ (((row & 3) << 2) | ((row >> 2) & 3));
        __builtin_amdgcn_global_load_lds((const unsigned*)(src + (size_t)row * ld + ch * 8), (LAS unsigned*)(tile + (wave * 64 + NTHR * i) * 16), 16, 0, 0);
    }
}
__device__ __forceinline__ int lane_id_now() { int l; asm volatile("v_mbcnt_lo_u32_b32 %0, -1, 0\n\tv_mbcnt_hi_u32_b32 %0, -1, %0" : "=v"(l)); return l; }
__device__ __forceinline__ int next_task_n(unsigned* ctr, int n, volatile LAS int* slot, int tid) {
    __syncthreads();
    if (tid == 0) { int v = (int)__hip_atomic_load(ctr, __ATOMIC_RELAXED, __HIP_MEMORY_SCOPE_AGENT); if (v < n) v = (int)__hip_atomic_fetch_add(ctr, 1u, __ATOMIC_RELAXED, __HIP_MEMORY_SCOPE_AGENT); *slot = v < n ? v : n; }
    __syncthreads();
    return *slot;
}
__device__ __forceinline__ int next_task(unsigned* ctr, volatile LAS int* slot, int tid) {
    __syncthreads();
    if (tid == 0) *slot = (int)__hip_atomic_fetch_add(ctr, 1u, __ATOMIC_RELAXED, __HIP_MEMORY_SCOPE_AGENT);
    __syncthreads();
    return *slot;
}
#define QUEUE_LOOP(ctr_, n_, ...) do { int t = next_task((ctr_), slot, tid); while (t < (n_)) { \
        int nx_ = 0; if (tid == 0) nx_ = (int)__hip_atomic_fetch_add((ctr_), 1u, __ATOMIC_RELAXED, __HIP_MEMORY_SCOPE_AGENT); \
        { __VA_ARGS__; } \
        __syncthreads(); if (tid == 0) *slot = nx_; __syncthreads(); t = *slot; } } while (0)

struct CvTask { const float* W; const float* gain; bf16_t* Bt; int K, N, k0, n0, gu; };
__device__ __forceinline__ CvTask cv_task(KP p, int l, int t8) {
    CvTask c; int tt = t8, ntn;
    c.gu = 0;
    c.gain = nullptr;
    if (tt < 1504) { c.W = p->in[I_WIN] + (size_t)l * 4096 * NIN; c.K = 4096; c.N = NIN; c.Bt = (bf16_t*)(p->ws + WS_WIN); ntn = 47; c.gain = p->in[I_ANW] + (size_t)l * DM; }
    else if ((tt -= 1504) < 512) { c.W = p->in[I_WOUT] + (size_t)l * 4096 * 4096; c.K = 4096; c.N = 4096; c.Bt = (bf16_t*)(p->ws + WS_WOUT); ntn = 16; }
    else if ((tt -= 512) < 1376) { c.W = p->in[I_WG] + (size_t)l * 4096 * DFF; c.K = 4096; c.N = DFF; c.Bt = (bf16_t*)(p->ws + WS_WGU); ntn = 43; c.gain = p->in[I_MNW] + (size_t)l * DM; c.gu = 1; }
    else if ((tt -= 1376) < 1376) { c.W = p->in[I_WU] + (size_t)l * 4096 * DFF; c.K = 4096; c.N = DFF; c.Bt = (bf16_t*)(p->ws + WS_WGU); ntn = 43; c.gain = p->in[I_MNW] + (size_t)l * DM; c.gu = 2; }
    else { tt -= 1376; c.W = p->in[I_WD] + (size_t)l * DFF * 4096; c.K = DFF; c.N = 4096; c.Bt = (bf16_t*)(p->ws + ((l & 1) ? WS_WDN2 : WS_WDN)); ntn = 16; }
    const int kt = tt / ntn, nt = tt - kt * ntn; c.k0 = kt * 128; c.n0 = nt * 256;
    return c;
}
__device__ __forceinline__ void cv_load(const CvTask& c, f32x4 (&v)[2][4][2], int tid) {
    const int r = tid >> 4, c4 = (tid & 15) * 4;
#pragma unroll
    for (int kk = 0; kk < 2; ++kk)
#pragma unroll
        for (int sub = 0; sub < 4; ++sub)
#pragma unroll
            for (int i = 0; i < 2; ++i) {
                const int k = c.k0 + 64 * kk + 2 * r + i, n = c.n0 + 64 * sub + c4;
                v[kk][sub][i] = (f32x4){0.f, 0.f, 0.f, 0.f};
                if (n < c.N) v[kk][sub][i] = __builtin_nontemporal_load((const f32x4*)(c.W + (size_t)k * c.N + n));
            }
}
__device__ __forceinline__ void cv_store(const CvTask& c, const f32x4 (&v)[2][4][2], LAS unsigned* T, int tid) {
    const int r = tid >> 4, c4 = (tid & 15) * 4;
#pragma unroll
    for (int kk = 0; kk < 2; ++kk) {
        float g0 = 1.f, g1 = 1.f;
        if (c.gain) { g0 = c.gain[c.k0 + 64 * kk + 2 * r]; g1 = c.gain[c.k0 + 64 * kk + 2 * r + 1]; }
#pragma unroll
        for (int sub = 0; sub < 4; ++sub)
#pragma unroll
            for (int j = 0; j < 4; ++j) T[((kk * 4 + sub) * 64 + c4 + j) * 33 + r] = cvt_pk(v[kk][sub][0][j] * g0, v[kk][sub][1][j] * g1);
    }
    __syncthreads();
    {
        const int nl = tid >> 3, kq = (tid & 7) * 4;
#pragma unroll
        for (int kk = 0; kk < 2; ++kk)
#pragma unroll
            for (int sub = 0; sub < 4; ++sub) {
                const LAS unsigned* s = T + ((kk * 4 + sub) * 64 + nl) * 33 + kq;
                u32x4 w; w.x = s[0]; w.y = s[1]; w.z = s[2]; w.w = s[3];
                const int n = c.n0 + 64 * sub;
                const int drow = c.gu ? 256 * (n >> 7) + 128 * (c.gu - 1) + (n & 127) + nl : n + nl;
                *(u32x4*)(c.Bt + (size_t)drow * c.K + c.k0 + 64 * kk + 2 * kq) = w;
            }
    }
    __syncthreads();
}
__device__ __forceinline__ void convert_range(KP p, int l, int t, int tend, int step, LAS unsigned char* lds, int tid) {
    asm volatile("" : "+v"(tid), "+s"(p));
    if (t >= tend) return;
    LAS unsigned* T0 = (LAS unsigned*)lds;
    f32x4 va[2][4][2], vb[2][4][2];
    __syncthreads();
    CvTask A = cv_task(p, l, t), B = A; cv_load(A, va, tid);
    for (;;) {
        const int t1 = t + step; const bool h1 = t1 < tend;
        if (h1) { B = cv_task(p, l, t1); cv_load(B, vb, tid); }
        cv_store(A, va, T0, tid);
        if (!h1) break;
        t = t1 + step; const bool h0 = t < tend;
        if (h0) { A = cv_task(p, l, t); cv_load(A, va, tid); }
        cv_store(B, vb, T0, tid);
        if (!h0) break;
    }
}
__device__ __forceinline__ void convert_small(KP p, int l, int tid, int bid, int G) {
    asm volatile("" : "+v"(tid), "+s"(p));
    {
        const size_t gtid = (size_t)bid * NTHR + tid, gstride = (size_t)G * NTHR;
        const float* s1 = p->in[I_CW1] + (size_t)l * 2 * 4096 * 256; bf16_t* d1 = (bf16_t*)(p->ws + WS_CW1);
        for (size_t i = gtid; i < (size_t)2 * 4096 * 256 / 4; i += gstride) { const f32x4 v = *(const f32x4*)(s1 + i * 4); u32x2 w; w.x = cvt_pk(v[0], v[1]); w.y = cvt_pk(v[2], v[3]); *(u32x2*)(d1 + i * 4) = w; }
        const float* s2 = p->in[I_CW2] + (size_t)l * 2 * 256 * 128; bf16_t* d2 = (bf16_t*)(p->ws + WS_CW2);
        for (size_t i = gtid; i < (size_t)2 * 256 * 128 / 4; i += gstride) { const f32x4 v = *(const f32x4*)(s2 + i * 4); u32x2 w; w.x = cvt_pk(v[0], v[1]); w.y = cvt_pk(v[2], v[3]); *(u32x2*)(d2 + i * 4) = w; }
        const float* s3 = p->in[I_LWA] + (size_t)l * 8 * 128 * 128; bf16_t* d3 = (bf16_t*)(p->ws + WS_LWA);
        for (size_t i = gtid; i < (size_t)8 * 128 * 128 / 4; i += gstride) { const f32x4 v = *(const f32x4*)(s3 + i * 4); u32x2 w; w.x = cvt_pk(v[0], v[1]); w.y = cvt_pk(v[2], v[3]); *(u32x2*)(d3 + i * 4) = w; }
        {
            const int lane = tid & 63, wave = tid >> 6; float* cp = (float*)(p->ws + WS_CPOS);
            for (int o = bid * NWAVE + wave; o < 512; o += G * NWAVE) {
                const int kv = o >> 8, h = o & 255; const float* ps = p->in[I_CPOS] + ((size_t)l * 2 + kv) * 4096; const float* w = s1 + (size_t)kv * 4096 * 256 + h;
                float a = 0.f;
                for (int k = lane; k < 4096; k += 64) a += ps[k] * w[(size_t)k * 256];
                a = wave_sum(a);
                if (lane == 0) cp[o] = a;
            }
        }
        const float* s4 = p->in[I_LWX] + (size_t)l * 8 * 128 * 128; bf16_t* d4 = (bf16_t*)(p->ws + WS_LWX);
        for (size_t i = gtid; i < (size_t)8 * 128 * 128 / 4; i += gstride) { const f32x4 v = *(const f32x4*)(s4 + i * 4); u32x2 w; w.x = cvt_pk(v[0], v[1]); w.y = cvt_pk(v[2], v[3]); *(u32x2*)(d4 + i * 4) = w; }
    }
}

__device__ __forceinline__ void sincos_acc(double x, float& sn, float& cs) {
    const double kf = rint(x * 0.63661977236758134308);
    const double r = fma(-kf, 6.123233995736766036e-17, fma(-kf, 1.5707963267948965580, x));
    const double z = r * r;
    const double sr = r + r * z * (-0.166666666416265235595 + z * (0.0083333293858894631756 + z * (-0.000198393348360966317347 + z * 0.0000027183114939898219064)));
    const double cr = 1.0 + z * (-0.499999997251031003120 + z * (0.0416666233237390631894 + z * (-0.00138867637746099294692 + z * 0.0000243904487962774090654)));
    const int n = ((int)kf) & 3;
    const double s = (n == 0) ? sr : (n == 1) ? cr : (n == 2) ? -sr : -cr;
    const double c = (n == 0) ? cr : (n == 1) ? -sr : (n == 2) ? -cr : sr;
    sn = (float)s; cs = (float)c;
}
__device__ __forceinline__ void ph_tables(KP p, int tid, int bid, int G) {
    asm volatile("" : "+v"(tid), "+s"(p));
    float* rc = (float*)(p->ws + WS_TAB_RC); float* rs = (float*)(p->ws + WS_TAB_RS); float* nc = (float*)(p->ws + WS_TAB_NC); float* ns = (float*)(p->ws + WS_TAB_NS);
    const int gtid = bid * NTHR + tid, gstride = G * NTHR;
    for (int i = gtid; i < SEQ * 64; i += gstride) {
        const int pos = i >> 6, f = i & 63;
        const double inv = exp2(-((double)f / 63.0) * 13.287712379549449);
        float s, c; sincos_acc((double)pos * inv, s, c); rc[i] = c; rs[i] = s;
    }
    for (int i = gtid; i < SEQ * 16; i += gstride) {
        const int pos = i >> 4, f = i & 15;
        const double inv = exp2(-((double)f / 16.0) * 18.931568569324174);
        float s, c; sincos_acc((double)pos * inv, s, c); nc[i] = c; ns[i] = s;
    }
}

__device__ __forceinline__ void ph_rmsnorm(const float* x, const float* w, bf16_t* hn, int tid, int bid, int G) {
    asm volatile("" : "+v"(tid));
    const int lane = tid & 63, wave = tid >> 6;
    for (int row = bid * NWAVE + wave; row < MT; row += G * NWAVE) {
        const float* xr = x + (size_t)row * DM;
        f32x4 v[16]; float ss = 0.f;
#pragma unroll
        for (int i = 0; i < 16; ++i) { v[i] = *(const f32x4*)(xr + (i * 64 + lane) * 4); ss += v[i][0] * v[i][0] + v[i][1] * v[i][1] + v[i][2] * v[i][2] + v[i][3] * v[i][3]; }
        ss = wave_sum(ss);
        const float r = 1.0f / sqrtf(ss * (1.0f / DM) + 1e-6f);
#pragma unroll
        for (int i = 0; i < 16; ++i) {
            const f32x4 g = *(const f32x4*)(w + (i * 64 + lane) * 4);
            u32x2 o; o.x = cvt_pk(v[i][0] * r * g[0], v[i][1] * r * g[1]); o.y = cvt_pk(v[i][2] * r * g[2], v[i][3] * r * g[3]);
            *(u32x2*)(hn + (size_t)row * DM + (i * 64 + lane) * 4) = o;
        }
    }
}

__device__ __forceinline__ void ph_mlp_act(KP p, int l, int tid, int bid, int G) {
    asm volatile("" : "+v"(tid), "+s"(p));
    const bf16_t* GU = (const bf16_t*)(p->ws + WS_GU); bf16_t* H = (bf16_t*)(p->ws + WS_H);
    const float* cw = p->in[I_MCW] + (size_t)l * 3 * DFF; const float* cb = p->in[I_MCB] + (size_t)l * DFF;
    constexpr int NFG = DFF / 8, NTG = MT / 8;
    for (int it = bid * NTHR + tid; it < NFG * NTG; it += G * NTHR) {
        const int tg = it / NFG, fg = it - tg * NFG, f0 = fg * 8, t0 = tg * 8;
        float w0[8], w1[8], w2[8], bb[8];
#pragma unroll
        for (int j = 0; j < 8; j += 4) {
            const f32x4 a = *(const f32x4*)(cw + f0 + j), b = *(const f32x4*)(cw + DFF + f0 + j), c = *(const f32x4*)(cw + 2 * DFF + f0 + j), d = *(const f32x4*)(cb + f0 + j);
#pragma unroll
            for (int q = 0; q < 4; ++q) { w0[j + q] = a[q]; w1[j + q] = b[q]; w2[j + q] = c[q]; bb[j + q] = d[q]; }
        }
        float gm2[8], gm1[8];
        const bool first = (t0 & (SEQ - 1)) == 0;
        {
            u32x4 a = (u32x4){0u, 0u, 0u, 0u}, b = (u32x4){0u, 0u, 0u, 0u};
            if (!first) { a = *(const u32x4*)(GU + (size_t)(t0 - 2) * NGU + f0); b = *(const u32x4*)(GU + (size_t)(t0 - 1) * NGU + f0); }
#pragma unroll
            for (int q = 0; q < 4; ++q) { gm2[2 * q] = bflo(a[q]); gm2[2 * q + 1] = bfhi(a[q]); gm1[2 * q] = bflo(b[q]); gm1[2 * q + 1] = bfhi(b[q]); }
        }
#pragma unroll
        for (int i = 0; i < 8; ++i) {
            const u32x4 gv = *(const u32x4*)(GU + (size_t)(t0 + i) * NGU + f0), uv = *(const u32x4*)(GU + (size_t)(t0 + i) * NGU + DFF + f0);
            float g0[8], up[8], hv[8];
#pragma unroll
            for (int q = 0; q < 4; ++q) { g0[2 * q] = bflo(gv[q]); g0[2 * q + 1] = bfhi(gv[q]); up[2 * q] = bflo(uv[q]); up[2 * q + 1] = bfhi(uv[q]); }
#pragma unroll
            for (int j = 0; j < 8; ++j) { const float y = bb[j] + w0[j] * gm2[j] + w1[j] * gm1[j] + w2[j] * g0[j]; hv[j] = y * sigmoidf_(y) * up[j]; gm2[j] = gm1[j]; gm1[j] = g0[j]; }
            u32x4 o; o.x = cvt_pk(hv[0], hv[1]); o.y = cvt_pk(hv[2], hv[3]); o.z = cvt_pk(hv[4], hv[5]); o.w = cvt_pk(hv[6], hv[7]);
            *(u32x4*)(H + (size_t)(t0 + i) * DFF + f0) = o;
        }
    }
}

struct EpiResid {
    static constexpr bool PERM = false, AFTER_DRAIN = false;
    const float* base; float* out; int ldc;
    __device__ __forceinline__ void operator()(const pg8::f32x4 (&acc)[2][2][4][2], const pg8::Unit& u, int wr, int wc, int fr, int fq) const {
        const int row0 = u.pm * 256 + wr * 64 + fr, col0 = u.pn * 256 + wc * 32 + 4 * fq;
#pragma unroll
        for (int ai = 0; ai < 2; ++ai)
#pragma unroll
            for (int m = 0; m < 4; ++m) { const size_t off = (size_t)(row0 + ai * 128 + m * 16) * ldc + col0;
#pragma unroll
                for (int bj = 0; bj < 2; ++bj)
#pragma unroll
                    for (int n = 0; n < 2; ++n) { const pg8::f32x4 bs = *(const pg8::f32x4*)(base + off + bj * 128 + n * 16); *(pg8::f32x4*)(out + off + bj * 128 + n * 16) = bs + acc[ai][bj][m][n]; }
                asm volatile("" ::: "memory"); }
    }
};

__device__ __forceinline__ void ph_xcvt(const float* x, bf16_t* xb, float* rowss, int tid, int bid, int G) {
    asm volatile("" : "+v"(tid));
    const int lane = tid & 63, wave = tid >> 6;
    for (int row = bid * NWAVE + wave; row < MT; row += G * NWAVE) {
        const float* xr = x + (size_t)row * DM;
        float ss = 0.f;
#pragma unroll
        for (int i = 0; i < 16; ++i) { const f32x4 v = *(const f32x4*)(xr + (i * 64 + lane) * 4); ss += v[0] * v[0] + v[1] * v[1] + v[2] * v[2] + v[3] * v[3];
            u32x2 o; o.x = cvt_pk(v[0], v[1]); o.y = cvt_pk(v[2], v[3]); *(u32x2*)(xb + (size_t)row * DM + (i * 64 + lane) * 4) = o; }
        ss = wave_sum(ss);
        rowss[(size_t)lane * MT + row] = (lane == 0) ? ss : 0.f;
    }
}
#ifdef EPI_NT
#define EPI_STORE16(ptr_, v_) __builtin_nontemporal_store((v_), (u32x4*)(ptr_))
#else
#define EPI_STORE16(ptr_, v_) (*(u32x4*)(ptr_) = (v_))
#endif
struct EpiBf16RS {
    static constexpr bool PERM = true, AFTER_DRAIN = false;
    bf16_t* O; int ldc; const LAS float* rt; int rbase;
    __device__ __forceinline__ void operator()(const pg8::f32x4 (&acc)[2][2][4][2], const pg8::Unit& u, int wr, int wc, int fr, int fq) const {
        const int row0 = u.pm * 256 + wr * 64 + fr, col0 = u.pn * 256 + wc * 32 + 8 * fq;
#pragma unroll
        for (int ai = 0; ai < 2; ++ai)
#pragma unroll
            for (int m = 0; m < 4; ++m) { const int row = row0 + ai * 128 + m * 16; const float rs = rt[row - rbase]; bf16_t* rowp = O + (size_t)row * ldc + col0;
#pragma unroll
                for (int bj = 0; bj < 2; ++bj) { const pg8::f32x4 v0 = acc[ai][bj][m][0] * rs, v1 = acc[ai][bj][m][1] * rs;
                    u32x4 w; w.x = cvt_pk(v0[0], v0[1]); w.y = cvt_pk(v0[2], v0[3]); w.z = cvt_pk(v1[0], v1[1]); w.w = cvt_pk(v1[2], v1[3]);
                    EPI_STORE16(rowp + bj * 128, w); } }
    }
};
__device__ __forceinline__ void in_gate_cols(KP p, int row0, const float* rowss, LAS unsigned char* lds, int tid) {
    asm volatile("" : "+v"(tid), "+s"(p));
    const int lane = tid & 63, wave = __builtin_amdgcn_readfirstlane(tid >> 6), hh = lane >> 5, rb = wave & 3, kh = wave >> 2;
    const bf16_t* arow = (const bf16_t*)(p->ws + WS_HN) + (size_t)(row0 + 32 * rb + (lane & 31)) * DM + kh * 2048 + 8 * hh;
    const bf16_t* brow = (const bf16_t*)(p->ws + WS_WIN) + (size_t)(C_NG + (lane & 31)) * DM + kh * 2048 + 8 * hh;
    f32x16 acc;
#pragma unroll
    for (int i = 0; i < 16; ++i) acc[i] = 0.f;
    bf16x8 a0[4], b0[4], a1[4], b1[4];
#pragma unroll
    for (int s8 = 0; s8 < 4; ++s8) { a0[s8] = *(const bf16x8*)(arow + 16 * s8); b0[s8] = *(const bf16x8*)(brow + 16 * s8); }
#pragma unroll 1
    for (int k0 = 0; k0 < 2048; k0 += 128) {
#pragma unroll
        for (int s8 = 0; s8 < 4; ++s8) { a1[s8] = *(const bf16x8*)(arow + k0 + 64 + 16 * s8); b1[s8] = *(const bf16x8*)(brow + k0 + 64 + 16 * s8); }
#pragma unroll
        for (int s8 = 0; s8 < 4; ++s8) acc = __builtin_amdgcn_mfma_f32_32x32x16_bf16(a0[s8], b0[s8], acc, 0, 0, 0);
        if (k0 + 128 < 2048) {
#pragma unroll
            for (int s8 = 0; s8 < 4; ++s8) { a0[s8] = *(const bf16x8*)(arow + k0 + 128 + 16 * s8); b0[s8] = *(const bf16x8*)(brow + k0 + 128 + 16 * s8); }
        }
#pragma unroll
        for (int s8 = 0; s8 < 4; ++s8) acc = __builtin_amdgcn_mfma_f32_32x32x16_bf16(a1[s8], b1[s8], acc, 0, 0, 0);
    }
    __syncthreads();
    LAS float* RED = (LAS float*)lds;
    LAS float* RS = RED + 4 * 16 * 64;
    if (tid < 128) { float t = 0.f;
#pragma unroll 16
        for (int i = 0; i < 64; ++i) t += rowss[(size_t)i * MT + row0 + tid];
        RS[tid] = 1.0f / sqrtf(t * (1.0f / DM) + 1e-6f); }
    if (kh == 1) {
#pragma unroll
        for (int r = 0; r < 16; ++r) RED[(rb * 16 + r) * 64 + lane] = acc[r];
    }
    __syncthreads();
    if (kh == 0) {
        bf16_t* PROJ = (bf16_t*)(p->ws + WS_PROJ);
        const int n = lane & 31;
#pragma unroll
        for (int r = 0; r < 16; ++r) {
            const int rl = 32 * rb + (r & 3) + 8 * (r >> 2) + 4 * hh;
            const float v = (acc[r] + RED[(rb * 16 + r) * 64 + lane]) * RS[rl];
            if (n < 24) PROJ[(size_t)(row0 + rl) * NINP + C_NG + n] = f2bf(v);
        }
    }
    __syncthreads();
}
struct EpiResid2 {
    static constexpr bool PERM = false, AFTER_DRAIN = false;
    const float* base; float* out; bf16_t* xb; float* rowss; int ldc; int wx;
    __device__ __forceinline__ void operator()(const pg8::f32x4 (&acc)[2][2][4][2], const pg8::Unit& u, int wr, int wc, int fr, int fq) const {
        const int row0 = u.pm * 256 + wr * 64 + fr, col0 = u.pn * 256 + wc * 32 + 4 * fq;
#pragma unroll
        for (int ai = 0; ai < 2; ++ai)
#pragma unroll
            for (int m = 0; m < 4; ++m) { const int row = row0 + ai * 128 + m * 16; const size_t off = (size_t)row * ldc + col0; float ss = 0.f;
#pragma unroll
                for (int bj = 0; bj < 2; ++bj)
#pragma unroll
                    for (int n = 0; n < 2; ++n) { const pg8::f32x4 bs = *(const pg8::f32x4*)(base + off + bj * 128 + n * 16); const pg8::f32x4 o = bs + acc[ai][bj][m][n];
                        *(pg8::f32x4*)(out + off + bj * 128 + n * 16) = o;
                        if (wx) { u32x2 w; w.x = cvt_pk(o[0], o[1]); w.y = cvt_pk(o[2], o[3]); *(u32x2*)(xb + off + bj * 128 + n * 16) = w; ss += (o[0] * o[0] + o[1] * o[1]) + (o[2] * o[2] + o[3] * o[3]); } }
                if (wx) { ss += __shfl_xor(ss, 16); ss += __shfl_xor(ss, 32); if (fq == 0) rowss[(size_t)(u.pn * 4 + wc) * MT + row] = ss; }
                asm volatile("" ::: "memory"); }
    }
};

template <class Sched> __device__ __forceinline__ int fill_rstd_table(const Sched& S, const float* rowss, LAS float* rt, int tid) {
    int lo = 1 << 30, hi = -1; pg8::Unit u;
    for (int i = 0; S.next(i, u); ++i) { lo = u.pm < lo ? u.pm : lo; hi = u.pm > hi ? u.pm : hi; }
    if (hi < 0) return 0;
    int n = (hi - lo + 1) * 256; if (n > RT_PANELS * 256) n = RT_PANELS * 256;
    for (int r4 = tid * 4; r4 < n; r4 += NTHR * 4) {
        const float* s = rowss + (size_t)lo * 256 + r4; f32x4 t = (f32x4){0.f, 0.f, 0.f, 0.f};
#pragma unroll 16
        for (int i = 0; i < 64; ++i) t += *(const f32x4*)(s + (size_t)i * MT);
#pragma unroll
        for (int q = 0; q < 4; ++q) rt[r4 + q] = 1.0f / sqrtf(t[q] * (1.0f / DM) + 1e-6f);
    }
    __syncthreads();
    return lo * 256;
}

__device__ __forceinline__ float dpp_ror1(float v) { return __int_as_float(__builtin_amdgcn_update_dpp(0, __float_as_int(v), 0x121, 0xf, 0xf, false)); }
__device__ __forceinline__ float dpp_ror2(float v) { return __int_as_float(__builtin_amdgcn_update_dpp(0, __float_as_int(v), 0x122, 0xf, 0xf, false)); }
struct EpiGateUp {
    static constexpr bool PERM = true, AFTER_DRAIN = false;
    bf16_t* H; const LAS float* rt; int rbase; const float* cw; const float* cb; bf16_t* GT; bf16_t* GH; bf16_t* UH;
    __device__ __forceinline__ void operator()(const pg8::f32x4 (&acc)[2][2][4][2], const pg8::Unit& u, int wr, int wc, int fr, int fq) const {
        const int f0 = u.pn * 128 + wc * 32 + 8 * fq;
        float w0[8], w1[8], w2[8], bb[8];
#pragma unroll
        for (int j = 0; j < 8; j += 4) {
            const f32x4 a = *(const f32x4*)(cw + f0 + j), b = *(const f32x4*)(cw + DFF + f0 + j), c = *(const f32x4*)(cw + 2 * DFF + f0 + j), d = *(const f32x4*)(cb + f0 + j);
#pragma unroll
            for (int q = 0; q < 4; ++q) { w0[j + q] = a[q]; w1[j + q] = b[q]; w2[j + q] = c[q]; bb[j + q] = d[q]; }
        }
#pragma unroll
        for (int ai = 0; ai < 2; ++ai) {
            const int c64 = u.pm * 4 + ai * 2 + wr;
            float gp[8];
#pragma unroll
            for (int j = 0; j < 8; ++j) gp[j] = 0.f;
#pragma unroll
            for (int m = 0; m < 4; ++m) {
                const int row = u.pm * 256 + ai * 128 + wr * 64 + m * 16 + fr;
                const float rs = rt[row - rbase];
                float g[8], uu[8], hv[8];
#pragma unroll
                for (int j = 0; j < 8; ++j) { g[j] = acc[ai][0][m][j >> 2][j & 3] * rs; uu[j] = acc[ai][1][m][j >> 2][j & 3] * rs; }
#pragma unroll
                for (int j = 0; j < 8; ++j) {
                    const float a1 = dpp_ror1(g[j]), a2 = dpp_ror2(g[j]), b1 = dpp_ror1(gp[j]), b2 = dpp_ror2(gp[j]);
                    const float g1 = (fr >= 1) ? a1 : b1, g2 = (fr >= 2) ? a2 : b2;
                    const float y = bb[j] + w0[j] * g2 + w1[j] * g1 + w2[j] * g[j];
                    hv[j] = y * sigmoidf_(y) * uu[j];
                }
                u32x4 hw; hw.x = cvt_pk(hv[0], hv[1]); hw.y = cvt_pk(hv[2], hv[3]); hw.z = cvt_pk(hv[4], hv[5]); hw.w = cvt_pk(hv[6], hv[7]);
                if (m > 0 || fr >= 2) EPI_STORE16(H + (size_t)row * DFF + f0, hw);
                if ((m == 0 && fr < 2) || (m == 3 && fr >= 14)) {
                    u32x4 gw; gw.x = cvt_pk(g[0], g[1]); gw.y = cvt_pk(g[2], g[3]); gw.z = cvt_pk(g[4], g[5]); gw.w = cvt_pk(g[6], g[7]);
                    if (m == 0) { u32x4 uw; uw.x = cvt_pk(uu[0], uu[1]); uw.y = cvt_pk(uu[2], uu[3]); uw.z = cvt_pk(uu[4], uu[5]); uw.w = cvt_pk(uu[6], uu[7]);
                        *(u32x4*)(GH + ((size_t)c64 * 2 + fr) * DFF + f0) = gw; *(u32x4*)(UH + ((size_t)c64 * 2 + fr) * DFF + f0) = uw; }
                    else *(u32x4*)(GT + ((size_t)c64 * 2 + (fr - 14)) * DFF + f0) = gw;
                }
#pragma unroll
                for (int j = 0; j < 8; ++j) gp[j] = g[j];
            }
        }
    }
};
__device__ __forceinline__ void ph_mlp_fix(KP p, int l, int tid, int bid, int G) {
    asm volatile("" : "+v"(tid), "+s"(p));
    const bf16_t* GT = (const bf16_t*)(p->ws + WS_GT); const bf16_t* GH = (const bf16_t*)(p->ws + WS_GH); const bf16_t* UH = (const bf16_t*)(p->ws + WS_UH); bf16_t* H = (bf16_t*)(p->ws + WS_H);
    const float* cw = p->in[I_MCW] + (size_t)l * 3 * DFF; const float* cb = p->in[I_MCB] + (size_t)l * DFF;
    constexpr int NFG = DFF / 8;
    for (int it = bid * NTHR + tid; it < NFG * 256; it += G * NTHR) {
        const int c64 = it / NFG, fg = it - c64 * NFG, f0 = fg * 8;
        float w0[8], w1[8], w2[8], bb[8], gm2[8], gm1[8], g0[8], g1[8], u0[8], u1[8], h0[8], h1[8];
        ld8f(cw + f0, w0); ld8f(cw + DFF + f0, w1); ld8f(cw + 2 * DFF + f0, w2); ld8f(cb + f0, bb);
        if ((c64 & 63) == 0) {
#pragma unroll
            for (int j = 0; j < 8; ++j) { gm2[j] = 0.f; gm1[j] = 0.f; }
        } else { unpack8(*(const u32x4*)(GT + ((size_t)(c64 - 1) * 2 + 0) * DFF + f0), gm2); unpack8(*(const u32x4*)(GT + ((size_t)(c64 - 1) * 2 + 1) * DFF + f0), gm1); }
        unpack8(*(const u32x4*)(GH + ((size_t)c64 * 2 + 0) * DFF + f0), g0); unpack8(*(const u32x4*)(GH + ((size_t)c64 * 2 + 1) * DFF + f0), g1);
        unpack8(*(const u32x4*)(UH + ((size_t)c64 * 2 + 0) * DFF + f0), u0); unpack8(*(const u32x4*)(UH + ((size_t)c64 * 2 + 1) * DFF + f0), u1);
#pragma unroll
        for (int j = 0; j < 8; ++j) {
            const float y0 = bb[j] + w0[j] * gm2[j] + w1[j] * gm1[j] + w2[j] * g0[j], y1 = bb[j] + w0[j] * gm1[j] + w1[j] * g0[j] + w2[j] * g1[j];
            h0[j] = y0 * sigmoidf_(y0) * u0[j]; h1[j] = y1 * sigmoidf_(y1) * u1[j];
        }
        *(u32x4*)(H + (size_t)(c64 * 64) * DFF + f0) = pack8f(h0); *(u32x4*)(H + (size_t)(c64 * 64 + 1) * DFF + f0) = pack8f(h1);
    }
}

struct EpiResid3 {
    static constexpr bool PERM = true, AFTER_DRAIN = false;
    const float* basef; bf16_t* xb; float* outf; float* rowss; int dry = 0;
    __device__ __forceinline__ void operator()(const pg8::f32x4 (&acc)[2][2][4][2], const pg8::Unit& u, int wr, int wc, int fr, int fq) const {
        const int row0 = u.pm * 256 + wr * 64 + fr, col0 = u.pn * 256 + wc * 32 + 8 * fq;
#pragma unroll
        for (int ai = 0; ai < 2; ++ai) {
            u32x4 bw[4][2];
            if (!basef) {
#pragma unroll
                for (int m = 0; m < 4; ++m) { const size_t off = (size_t)(row0 + ai * 128 + m * 16) * DM + col0;
#pragma unroll
                    for (int bj = 0; bj < 2; ++bj) bw[m][bj] = *(const u32x4*)(xb + off + bj * 128); }
            }
#pragma unroll
            for (int m = 0; m < 4; ++m) { const int row = row0 + ai * 128 + m * 16; const size_t off = (size_t)row * DM + col0; float ss = 0.f;
#pragma unroll
                for (int bj = 0; bj < 2; ++bj) {
                    float x[8];
                    if (basef) ld8f(basef + off + bj * 128, x); else unpack8(bw[m][bj], x);
#pragma unroll
                    for (int j = 0; j < 8; ++j) { x[j] += acc[ai][bj][m][j >> 2][j & 3]; ss += x[j] * x[j]; }
                    if (outf) { *(f32x4*)(outf + off + bj * 128) = (f32x4){x[0], x[1], x[2], x[3]}; *(f32x4*)(outf + off + bj * 128 + 4) = (f32x4){x[4], x[5], x[6], x[7]}; }
                    if (!outf) *(u32x4*)(xb + off + bj * 128) = pack8f(x);
                }
                if (!outf) { ss += __shfl_xor(ss, 16); ss += __shfl_xor(ss, 32); if (fq == 0) rowss[(size_t)(u.pn * 4 + wc) * MT + row] = ss; }
            }
        }
    }
};

__device__ __forceinline__ void ph_prep_elem(KP p, int l, int tid, int bid, int G) {
    asm volatile("" : "+v"(tid), "+s"(p));
    const int lane = tid & 63, wave = tid >> 6, hi = lane >> 3, j = lane & 7;
    const bf16_t* PROJ = (const bf16_t*)(p->ws + WS_PROJ);
    const float* rc = (const float*)(p->ws + WS_TAB_RC); const float* rs = (const float*)(p->ws + WS_TAB_RS); const float* nc = (const float*)(p->ws + WS_TAB_NC); const float* ns = (const float*)(p->ws + WS_TAB_NS);
    for (int it = bid * NWAVE + wave; it < MT * 2; it += G * NWAVE) {
        const int tok = it >> 1, grp = (it & 1) ? 3 : 1, b = tok >> 12, s = tok & (SEQ - 1);
        const bf16_t* prow = PROJ + (size_t)tok * NINP;
        if (grp < 2) {
            const int h = hi;
            const bf16_t* src = prow + (grp ? C_RK : C_RQ) + h * 128 + 8 * j;
            float x1[8], x2[8], c[8], sn[8];
            unpack8(*(const u32x4*)src, x1); unpack8(*(const u32x4*)(src + 64), x2);
            ld8f(rc + s * 64 + 8 * j, c); ld8f(rs + s * 64 + 8 * j, sn);
            const float lg2 = log2f(1.0f - exp2f(-5.0f - (float)h));
            const float e = (float)((s & 127) + 1) * lg2;
            const float d = grp ? fexp2(-e) * 0.08838834764831845f : fexp2(e);
            float o1[8], o2[8];
#pragma unroll
            for (int i = 0; i < 8; ++i) { o1[i] = (x1[i] * c[i] - x2[i] * sn[i]) * d; o2[i] = (x2[i] * c[i] + x1[i] * sn[i]) * d; }
            bf16_t* dst = (bf16_t*)(p->ws + (grp ? WS_KR : WS_QR)) + ((size_t)(b * 8 + h) * SEQ + s) * 128 + 8 * j;
            *(u32x4*)dst = pack8f(o1); *(u32x4*)(dst + 64) = pack8f(o2);
        } else {
            int col; const float* w; bf16_t* dst; bool act = true;
            if (grp == 2) { col = C_NQ + hi * 128; w = p->in[I_NQW] + (size_t)l * 128; dst = (bf16_t*)(p->ws + WS_QN) + ((size_t)(b * 8 + hi) * SEQ + s) * 128; }
            else if (hi < 2) { col = C_NKS + hi * 128; w = p->in[I_NKW] + (size_t)l * 3 * 128 + 128; dst = (bf16_t*)(p->ws + WS_KSN) + ((size_t)(b * 2 + hi) * SEQ + s) * 128; }
            else if (hi < 4) { col = C_NKW + (hi - 2) * 128; w = p->in[I_NKW] + (size_t)l * 3 * 128 + 256; dst = (bf16_t*)(p->ws + WS_KWN) + ((size_t)(b * 2 + hi - 2) * SEQ + s) * 128; }
            else { act = false; col = C_NQ; w = p->in[I_NQW]; dst = (bf16_t*)(p->ws + WS_QN); }
            float x1[8], x2[8], w1[8], w2[8];
            unpack8(*(const u32x4*)(prow + col + 8 * j), x1); unpack8(*(const u32x4*)(prow + col + 64 + 8 * j), x2);
            ld8f(w + 8 * j, w1); ld8f(w + 64 + 8 * j, w2);
            float ss = 0.f;
#pragma unroll
            for (int i = 0; i < 8; ++i) ss += x1[i] * x1[i] + x2[i] * x2[i];
            ss += __shfl_xor(ss, 1); ss += __shfl_xor(ss, 2); ss += __shfl_xor(ss, 4);
            const float r = 1.0f / sqrtf(ss * (1.0f / 128.0f) + 1e-6f);
            const float qs = (grp == 2) ? 0.08838834764831845f * 1.4426950408889634f : 1.0f;
            float c[8], sn[8], y1[8], y2[8], pr[8];
            ld8f(nc + s * 16 + 8 * (j & 1), c); ld8f(ns + s * 16 + 8 * (j & 1), sn);
#pragma unroll
            for (int i = 0; i < 8; ++i) { y1[i] = x1[i] * (r * qs) * w1[i]; y2[i] = x2[i] * (r * qs) * w2[i]; }
#pragma unroll
            for (int i = 0; i < 8; ++i) pr[i] = __shfl_xor(y1[i], 2);
            if (j < 4) {
#pragma unroll
                for (int i = 0; i < 8; ++i) y1[i] = (j < 2) ? (y1[i] * c[i] - pr[i] * sn[i]) : (y1[i] * c[i] + pr[i] * sn[i]);
            }
            if (act) { *(u32x4*)(dst + 8 * j) = pack8f(y1); *(u32x4*)(dst + 64 + 8 * j) = pack8f(y2); }
        }
    }
}

__device__ __forceinline__ void lru_c1_task(KP p, int l, int task, LAS unsigned char* lds, int tid) {
    asm volatile("" : "+v"(tid), "+s"(p));
    const int lane = tid & 63, wave = __builtin_amdgcn_readfirstlane(tid >> 6), hh = lane >> 5;
    const int grp = task & 15, n = (task >> 4) & 7, b = task >> 7;
    const bf16_t* PROJ = (const bf16_t*)(p->ws + WS_PROJ);
    LAS unsigned char* XB = lds;
    LAS float* AA = (LAS float*)lds;
    LAS float* X32 = (LAS float*)(lds + 32768);
    LAS unsigned char* WA = lds + 65536;
    LAS unsigned char* WX = lds + 98304;
    LAS float* SM = (LAS float*)(lds + LDS_STAGE + LDS_CTL);
    LAS float* CH = SM; LAS float* CP = SM + 128; LAS float* SH = SM + 256; LAS float* SP = SM + 768;
    tile_stage<128>(WA, (const bf16_t*)(p->ws + WS_LWA) + (size_t)n * 128 * 128, 128, tid);
    tile_stage<128>(WX, (const bf16_t*)(p->ws + WS_LWX) + (size_t)n * 128 * 128, 128, tid);
    if (tid < 128) { CH[tid] = 0.f; CP[tid] = 1.f; }
    const int tb = wave >> 2, db = wave & 3, dd = 32 * db + (lane & 31), chd = n * 128 + dd;
    const float ba = p->in[I_LBA][(size_t)l * 1024 + chd], bx = p->in[I_LBX][(size_t)l * 1024 + chd], lam = p->in[I_LLAM][(size_t)l * 1024 + chd];
    const float lsl = fminf(lam, 0.f) - log1pf(expf(-fabsf(lam)));
    const int ctt = tid >> 3, cc0 = (tid & 7) * 16, cch0 = n * 128 + cc0;
    float cwr[4][16], cbr[16];
    {
        const float* cw = p->in[I_LCW] + (size_t)l * 4 * 1024; const float* cb = p->in[I_LCB] + (size_t)l * 1024;
#pragma unroll
        for (int j = 0; j < 16; j += 4) { const f32x4 v = *(const f32x4*)(cb + cch0 + j); cbr[j] = v[0]; cbr[j + 1] = v[1]; cbr[j + 2] = v[2]; cbr[j + 3] = v[3]; }
#pragma unroll
        for (int k = 0; k < 4; ++k)
#pragma unroll
            for (int j = 0; j < 16; j += 4) { const f32x4 v = *(const f32x4*)(cw + k * 1024 + cch0 + j); cwr[k][j] = v[0]; cwr[k][j + 1] = v[1]; cwr[k][j + 2] = v[2]; cwr[k][j + 3] = v[3]; }
    }
    u32x4 rw[4][2];
#define C1_LOADROWS(s0_) do { _Pragma("unroll") for (int k = 0; k < 4; ++k) { const int s_ = (s0_) + ctt - 3 + k; rw[k][0] = (u32x4){0u, 0u, 0u, 0u}; rw[k][1] = (u32x4){0u, 0u, 0u, 0u}; \
        if (s_ >= 0) { const bf16_t* src = PROJ + (size_t)(b * SEQ + s_) * NINP + C_LR + cch0; rw[k][0] = *(const u32x4*)src; rw[k][1] = *(const u32x4*)(src + 8); } } } while (0)
    C1_LOADROWS(grp * 4 * 64);
    for (int ck = 0; ck < 4; ++ck) {
        const int s0 = (grp * 4 + ck) * 64;
        __syncthreads();
        {
            float acc[16];
#pragma unroll
            for (int j = 0; j < 16; ++j) acc[j] = cbr[j];
#pragma unroll
            for (int k = 0; k < 4; ++k)
#pragma unroll
                for (int j = 0; j < 16; j += 2) { const unsigned w = rw[k][j >> 3][(j >> 1) & 3]; acc[j] += cwr[k][j] * bflo(w); acc[j + 1] += cwr[k][j + 1] * bfhi(w); }
            if (ck + 1 < 4) C1_LOADROWS(s0 + 64);
#pragma unroll
            for (int j = 0; j < 16; j += 4) *(LAS f32x4*)(X32 + ctt * 128 + cc0 + j) = (f32x4){acc[j], acc[j + 1], acc[j + 2], acc[j + 3]};
            u32x4 o0, o1;
            o0.x = cvt_pk(acc[0], acc[1]); o0.y = cvt_pk(acc[2], acc[3]); o0.z = cvt_pk(acc[4], acc[5]); o0.w = cvt_pk(acc[6], acc[7]);
            o1.x = cvt_pk(acc[8], acc[9]); o1.y = cvt_pk(acc[10], acc[11]); o1.z = cvt_pk(acc[12], acc[13]); o1.w = cvt_pk(acc[14], acc[15]);
            *(LAS u32x4*)(XB + off_b((unsigned)ctt, (unsigned)(cc0 >> 3))) = o0; *(LAS u32x4*)(XB + off_b((unsigned)ctt, (unsigned)(cc0 >> 3) + 1u)) = o1;
        }
        __syncthreads();
        f32x16 ca, cx;
#pragma unroll
        for (int i = 0; i < 16; ++i) { ca[i] = 0.f; cx[i] = 0.f; }
#pragma unroll
        for (int s = 0; s < 8; ++s) {
            const bf16x8 a = row_frag(XB, 32 * tb, s, lane);
            bf16x8 bfa, bfx; tr_frag_nat2(WA, WX, db, s, lane, bfa, bfx);
            ca = __builtin_amdgcn_mfma_f32_32x32x16_bf16(a, bfa, ca, 0, 0, 0);
            cx = __builtin_amdgcn_mfma_f32_32x32x16_bf16(a, bfx, cx, 0, 0, 0);
        }
        __syncthreads();
#pragma unroll
        for (int r = 0; r < 16; ++r) {
            const int tok = 32 * tb + (r & 3) + 8 * (r >> 2) + 4 * hh;
            const float rg = sigmoidf_(ca[r] + ba), ig = sigmoidf_(cx[r] + bx);
            const float la = 8.0f * rg * lsl;
            const float a = expf(la);
            const float x2 = 2.0f * la;
            const float em1 = (x2 > -0.1f) ? x2 * (1.f + x2 * 0.5f * (1.f + x2 * (1.f / 3.f) * (1.f + x2 * 0.25f * (1.f + x2 * 0.2f)))) : (expf(x2) - 1.0f);
            float mult = sqrtf(fmaxf(-em1, 0.f));
            if (s0 + tok == 0) mult = 1.0f;
            AA[tok * 128 + dd] = a; X32[tok * 128 + dd] = mult * ig * X32[tok * 128 + dd];
        }
        __syncthreads();
        {
            const int ch = tid & 127, seg = tid >> 7;
            float hl[16], pl[16]; float h = 0.f, P = 1.f;
#pragma unroll
            for (int t = 0; t < 16; ++t) { const float a = AA[(16 * seg + t) * 128 + ch], u = X32[(16 * seg + t) * 128 + ch]; h = a * h + u; P *= a; hl[t] = h; pl[t] = P; }
            SH[seg * 128 + ch] = h; SP[seg * 128 + ch] = P;
            __syncthreads();
            float Hin = CH[ch], Pin = CP[ch];
#pragma unroll
            for (int s2 = 0; s2 < 3; ++s2) if (s2 < seg) { const float sp = SP[s2 * 128 + ch]; Hin = sp * Hin + SH[s2 * 128 + ch]; Pin *= sp; }
            bf16_t* hlg = (bf16_t*)(p->ws + WS_HLOC) + (size_t)(b * SEQ + s0 + 16 * seg) * 1024 + n * 128 + ch;
            bf16_t* cug = (bf16_t*)(p->ws + WS_CUMA) + (size_t)(b * SEQ + s0 + 16 * seg) * 1024 + n * 128 + ch;
            float hlast = 0.f, plast = 0.f;
#pragma unroll
            for (int t = 0; t < 16; ++t) { hlast = hl[t] + pl[t] * Hin; plast = pl[t] * Pin; hlg[(size_t)t * 1024] = f2bf(hlast); cug[(size_t)t * 1024] = f2bf(plast); }
            __syncthreads();
            if (seg == 3) { CH[ch] = hlast; CP[ch] = plast; }
        }
    }
#undef C1_LOADROWS
}

__device__ __forceinline__ void lru_c3_task(KP p, int task, LAS unsigned char* lds, int tid) {
    asm volatile("" : "+v"(tid), "+s"(p));
    const int grp = task & 15, n = (task >> 4) & 7, b = task >> 7, s0 = grp * 256;
    const bf16_t* HL = (const bf16_t*)(p->ws + WS_HLOC); const bf16_t* CU = (const bf16_t*)(p->ws + WS_CUMA);
    const bf16_t* PROJ = (const bf16_t*)(p->ws + WS_PROJ); bf16_t* MIX = (bf16_t*)(p->ws + WS_MIX);
    LAS float* Hin = (LAS float*)lds;
    if (tid < 128) {
        float H = 0.f;
        const size_t base = (size_t)(b * SEQ + 255) * 1024 + n * 128 + tid;
        for (int c = 0; c < grp; ++c) { const float a = bf2f(CU[base + (size_t)c * 256 * 1024]), hv = bf2f(HL[base + (size_t)c * 256 * 1024]); H = a * H + hv; }
        Hin[tid] = H;
    }
    __syncthreads();
    const int c4 = (tid & 31) * 4;
    const f32x4 hin = *(const LAS f32x4*)(Hin + c4);
#pragma unroll 4
    for (int i = 0; i < 16; ++i) {
        const int tok = (tid >> 5) + 16 * i;
        const size_t row = (size_t)(b * SEQ + s0 + tok);
        const u32x2 hlw = *(const u32x2*)(HL + row * 1024 + n * 128 + c4), cuw = *(const u32x2*)(CU + row * 1024 + n * 128 + c4);
        const f32x4 hl = (f32x4){bflo(hlw.x), bfhi(hlw.x), bflo(hlw.y), bfhi(hlw.y)}, cu = (f32x4){bflo(cuw.x), bfhi(cuw.x), bflo(cuw.y), bfhi(cuw.y)};
        const u32x2 gv = *(const u32x2*)(PROJ + row * NINP + C_LG + n * 128 + c4);
        const float g0 = bflo(gv.x), g1 = bfhi(gv.x), g2 = bflo(gv.y), g3 = bfhi(gv.y);
        u32x2 o; o.x = cvt_pk((hl[0] + cu[0] * hin[0]) * gelu_tanh(g0), (hl[1] + cu[1] * hin[1]) * gelu_tanh(g1));
        o.y = cvt_pk((hl[2] + cu[2] * hin[2]) * gelu_tanh(g2), (hl[3] + cu[3] * hin[3]) * gelu_tanh(g3));
        *(u32x2*)(MIX + row * DM + MIX_LRU + n * 128 + c4) = o;
    }
}

__device__ __forceinline__ void tr_nat4(const LAS unsigned char* tile, int ks, int lane, bf16x8 (&f)[4]) {
    const unsigned b = lds_addr(tile);
    s16x4 d0, d1, d2, d3, d4, d5, d6, d7;
    asm volatile("ds_read_b64_tr_b16 %0, %8\n\tds_read_b64_tr_b16 %1, %9\n\tds_read_b64_tr_b16 %2, %10\n\tds_read_b64_tr_b16 %3, %11\n\t"
                 "ds_read_b64_tr_b16 %4, %12\n\tds_read_b64_tr_b16 %5, %13\n\tds_read_b64_tr_b16 %6, %14\n\tds_read_b64_tr_b16 %7, %15\n\ts_waitcnt lgkmcnt(0)"
                 : "=&v"(d0), "=&v"(d1), "=&v"(d2), "=&v"(d3), "=&v"(d4), "=&v"(d5), "=&v"(d6), "=&v"(d7)
                 : "v"(b + tr_off_nat(lane, 0, ks, 0)), "v"(b + tr_off_nat(lane, 0, ks, 1)), "v"(b + tr_off_nat(lane, 1, ks, 0)), "v"(b + tr_off_nat(lane, 1, ks, 1)),
                   "v"(b + tr_off_nat(lane, 2, ks, 0)), "v"(b + tr_off_nat(lane, 2, ks, 1)), "v"(b + tr_off_nat(lane, 3, ks, 0)), "v"(b + tr_off_nat(lane, 3, ks, 1)) : "memory");
    f[0] = __builtin_shufflevector(d0, d1, 0, 1, 2, 3, 4, 5, 6, 7); f[1] = __builtin_shufflevector(d2, d3, 0, 1, 2, 3, 4, 5, 6, 7);
    f[2] = __builtin_shufflevector(d4, d5, 0, 1, 2, 3, 4, 5, 6, 7); f[3] = __builtin_shufflevector(d6, d7, 0, 1, 2, 3, 4, 5, 6, 7);
}
__device__ __forceinline__ void cmp_task(KP p, int l, int task, LAS unsigned char* lds, int tid) {
    asm volatile("" : "+v"(tid), "+s"(p));
    const int lane = tid & 63, wave = __builtin_amdgcn_readfirstlane(tid >> 6), hh = lane >> 5;
    const int rh = task & 1, bg = (task >> 1) & 7, kv = task >> 4, b = bg >> 1, g = bg & 1, n0 = rh * 128;
    const bf16_t* PROJ = (const bf16_t*)(p->ws + WS_PROJ);
    const bf16_t* W1 = (const bf16_t*)(p->ws + WS_CW1) + (size_t)kv * 4096 * 256;
    const bf16_t* W2 = (const bf16_t*)(p->ws + WS_CW2) + (size_t)kv * 256 * 128;
    const int col = (kv ? C_NVC : C_NKC) + g * 128;
    const int rb = wave & 3, hc = wave >> 2, nrow = n0 + 32 * rb + (lane & 31);
    const bool rowok = nrow < 255;
    const bf16_t* arow = PROJ + (size_t)(b * SEQ + 16 * (rowok ? nrow : 0)) * NINP + col + 8 * hh;
    f32x16 acc[4];
#pragma unroll
    for (int c = 0; c < 4; ++c)
#pragma unroll
        for (int i = 0; i < 16; ++i) acc[c][i] = 0.f;
#define CMP_ISSUE(li_, buf_) do { _Pragma("unroll") for (int hf = 0; hf < 2; ++hf) _Pragma("unroll") for (int rr = 0; rr < 2; ++rr) \
        tile_dma64(lds + (buf_) * 65536 + hf * 32768 + rr * 16384, W1 + (size_t)((li_) * 128 + rr * 64) * 256 + hf * 128, 256, tid, wave); } while (0)
    bf16x8 af[8], an[8];
    __syncthreads();
    CMP_ISSUE(0, 0);
#pragma unroll
    for (int s = 0; s < 8; ++s) af[s] = *(const bf16x8*)(arow + 16 * s);
    asm volatile("s_waitcnt vmcnt(0)" ::: "memory");
    __syncthreads();
    for (int li = 0; li < 32; ++li) {
        const int buf = li & 1;
        if (li + 1 < 32) {
            CMP_ISSUE(li + 1, buf ^ 1);
#pragma unroll
            for (int s = 0; s < 8; ++s) an[s] = *(const bf16x8*)(arow + (size_t)(li + 1) * NINP + 16 * s);
        }
        const LAS unsigned char* Bt = lds + buf * 65536 + hc * 32768;
#pragma unroll
        for (int s = 0; s < 8; ++s) {
            bf16x8 bf[4]; tr_nat4(Bt, s, lane, bf);
#pragma unroll
            for (int c = 0; c < 4; ++c) acc[c] = __builtin_amdgcn_mfma_f32_32x32x16_bf16(af[s], bf[c], acc[c], 0, 0, 0);
        }
        if (li + 1 < 32) {
            asm volatile("s_waitcnt vmcnt(0)" ::: "memory");
#pragma unroll
            for (int s = 0; s < 8; ++s) af[s] = an[s];
            __syncthreads();
        }
    }
#undef CMP_ISSUE
    __syncthreads();
    LAS unsigned char* HI = lds;
    LAS unsigned char* W2I = lds + 65536;
#pragma unroll
    for (int hf = 0; hf < 2; ++hf)
#pragma unroll
        for (int rr = 0; rr < 2; ++rr) tile_dma64(W2I + hf * 32768 + rr * 16384, W2 + (size_t)(hf * 128 + rr * 64) * 128, 128, tid, wave);
    {
        const float* cp = (const float*)(p->ws + WS_CPOS) + kv * 256 + hc * 128;
        LAS unsigned char* Ht = HI + hc * 32768;
#pragma unroll
        for (int c = 0; c < 4; ++c) {
            const int cc = 32 * c + (lane & 31); const float cpv = cp[cc];
#pragma unroll
            for (int r = 0; r < 16; ++r) {
                const int n = 32 * rb + (r & 3) + 8 * (r >> 2) + 4 * hh;
                const bool ok = n0 + n < 255;
                *(LAS unsigned short*)(Ht + off_b((unsigned)n, (unsigned)(cc >> 3)) + 2 * (cc & 7)) = ok ? f2bf(gelu_tanh(acc[c][r] + cpv)) : (unsigned short)0;
            }
        }
    }
    asm volatile("s_waitcnt vmcnt(0)" ::: "memory");
    __syncthreads();
    {
        const int nb = wave & 3, dh = wave >> 2;
        f32x16 o[2];
#pragma unroll
        for (int q = 0; q < 2; ++q) {
#pragma unroll
            for (int i = 0; i < 16; ++i) o[q][i] = 0.f;
#pragma unroll
            for (int ks = 0; ks < 16; ++ks)
                o[q] = __builtin_amdgcn_mfma_f32_32x32x16_bf16(tr_frag_nat(W2I + (ks >> 3) * 32768, 2 * dh + q, ks & 7, lane), row_frag(HI + (ks >> 3) * 32768, 32 * nb, ks & 7, lane), o[q], 0, 0, 0);
        }
        const int n = n0 + 32 * nb + (lane & 31);
        bf16_t* dst = (bf16_t*)(p->ws + (kv ? WS_VCMP : WS_KCMP)) + ((size_t)bg * 256 + n) * 128;
        if (kv == 0) {
            LAS float* SS = (LAS float*)(lds + LDS_STAGE + LDS_CTL);
            float ss = 0.f;
#pragma unroll
            for (int q = 0; q < 2; ++q)
#pragma unroll
                for (int r = 0; r < 16; ++r) ss += o[q][r] * o[q][r];
            ss = half_sum(ss);
            if (hh == 0) SS[dh * 128 + 32 * nb + (lane & 31)] = ss;
            __syncthreads();
            const float tot = SS[32 * nb + (lane & 31)] + SS[128 + 32 * nb + (lane & 31)];
            const float rn = 1.0f / sqrtf(tot * (1.0f / 128.0f) + 1e-6f);
            const float* kw = p->in[I_NKW] + (size_t)l * 3 * 128;
#pragma unroll
            for (int q = 0; q < 2; ++q)
#pragma unroll
                for (int r = 0; r < 16; ++r) o[q][r] *= rn * kw[32 * (2 * dh + q) + (r & 3) + 8 * (r >> 2) + 4 * hh];
            if (dh == 0 && n < 255) {
                const int cpz = 16 * n + 31;
                const float* nc = (const float*)(p->ws + WS_TAB_NC) + cpz * 16; const float* ns = (const float*)(p->ws + WS_TAB_NS) + cpz * 16;
#pragma unroll
                for (int a = 0; a < 2; ++a)
#pragma unroll
                    for (int q = 0; q < 4; ++q) {
                        const int i = 8 * a + 4 * hh + q;
                        const float c = nc[i], sn = ns[i], x1 = o[0][4 * a + q], x2 = o[0][4 * (a + 2) + q];
                        o[0][4 * a + q] = x1 * c - x2 * sn; o[0][4 * (a + 2) + q] = x2 * c + x1 * sn;
                    }
            }
        }
#pragma unroll
        for (int q = 0; q < 2; ++q)
#pragma unroll
            for (int a = 0; a < 4; ++a) {
                u32x2 w; w.x = cvt_pk(o[q][4 * a], o[q][4 * a + 1]); w.y = cvt_pk(o[q][4 * a + 2], o[q][4 * a + 3]);
                if (n >= 255) { w.x = 0u; w.y = 0u; }
                *(u32x2*)(dst + 32 * (2 * dh + q) + 8 * a + 4 * hh) = w;
            }
    }
}

__device__ __forceinline__ float softmax_block(f32x16& sa, float& m, float& l) {
    float mx = m;
#pragma unroll
    for (int r = 0; r < 16; ++r) mx = fmaxf(mx, sa[r]);
    mx = half_max(mx);
    const float alpha = fexp2(m - mx);
    float ps = 0.f;
#pragma unroll
    for (int r = 0; r < 16; ++r) { const float pv = fexp2(sa[r] - mx); sa[r] = pv; ps += pv; }
    l = l * alpha + ps; m = mx;
    return alpha;
}
__device__ __forceinline__ void scale_o(f32x16 (&o)[4], float a) {
#pragma unroll
    for (int c = 0; c < 4; ++c)
#pragma unroll
        for (int r = 0; r < 16; ++r) o[c][r] *= a;
}
__device__ __forceinline__ void zero_o(f32x16 (&o)[4]) {
#pragma unroll
    for (int c = 0; c < 4; ++c)
#pragma unroll
        for (int r = 0; r < 16; ++r) o[c][r] = 0.f;
}
__device__ __forceinline__ void pv_block(f32x16 (&o)[4], const LAS unsigned char* vt, const TrAcc& TA, const f32x16& pp, int kb) {
    const unsigned vb = lds_addr(vt);
    pv_step(o, vb + 4096u * (unsigned)(2 * kb), TA, pack8(pp, 0));
    pv_step(o, vb + 4096u * (unsigned)(2 * kb + 1), TA, pack8(pp, 1));
}

struct VFrag { s16x4 d0, d1, d2, d3, d4, d5, d6, d7; };
__device__ __forceinline__ void v_issue(VFrag& f, unsigned vb, const TrAcc& A) {
    asm volatile("ds_read_b64_tr_b16 %0, %8\n\tds_read_b64_tr_b16 %1, %9\n\tds_read_b64_tr_b16 %2, %10\n\tds_read_b64_tr_b16 %3, %11\n\t"
                 "ds_read_b64_tr_b16 %4, %12\n\tds_read_b64_tr_b16 %5, %13\n\tds_read_b64_tr_b16 %6, %14\n\tds_read_b64_tr_b16 %7, %15"
                 : "=&v"(f.d0), "=&v"(f.d1), "=&v"(f.d2), "=&v"(f.d3), "=&v"(f.d4), "=&v"(f.d5), "=&v"(f.d6), "=&v"(f.d7)
                 : "v"(vb + A.a[0][0]), "v"(vb + A.a[0][1]), "v"(vb + A.a[1][0]), "v"(vb + A.a[1][1]), "v"(vb + A.a[2][0]), "v"(vb + A.a[2][1]), "v"(vb + A.a[3][0]), "v"(vb + A.a[3][1]) : "memory");
}
__device__ __forceinline__ void v_wait(VFrag& f) {
    asm volatile("s_waitcnt lgkmcnt(0)" : "+v"(f.d0), "+v"(f.d1), "+v"(f.d2), "+v"(f.d3), "+v"(f.d4), "+v"(f.d5), "+v"(f.d6), "+v"(f.d7) :: "memory");
}
__device__ __forceinline__ void v_mma(f32x16 (&o)[4], const VFrag& f, bf16x8 pf) {
    o[0] = __builtin_amdgcn_mfma_f32_32x32x16_bf16(__builtin_shufflevector(f.d0, f.d1, 0, 1, 2, 3, 4, 5, 6, 7), pf, o[0], 0, 0, 0);
    o[1] = __builtin_amdgcn_mfma_f32_32x32x16_bf16(__builtin_shufflevector(f.d2, f.d3, 0, 1, 2, 3, 4, 5, 6, 7), pf, o[1], 0, 0, 0);
    o[2] = __builtin_amdgcn_mfma_f32_32x32x16_bf16(__builtin_shufflevector(f.d4, f.d5, 0, 1, 2, 3, 4, 5, 6, 7), pf, o[2], 0, 0, 0);
    o[3] = __builtin_amdgcn_mfma_f32_32x32x16_bf16(__builtin_shufflevector(f.d6, f.d7, 0, 1, 2, 3, 4, 5, 6, 7), pf, o[3], 0, 0, 0);
}

constexpr float NSA_DEFER = 8.0f;
template <int MODE>
__device__ __forceinline__ void nsa_branch(unsigned long long tmask, const bf16_t* ksrc, size_t kld, const bf16_t* vsrc, size_t vld, const bf16_t* nk, size_t nkld, const bf16_t* nv, size_t nvld, int& buf,
                                           LAS unsigned char* lds, const bf16x8 (&qf)[8], const TrAcc& TA,
                                           f32x16 (&o)[4], float& m, float& lsum, float inv, int tq, unsigned long long mysel, LAS unsigned* PS, int ql, int tid, int lane, int wave) {
    constexpr bool HASV = MODE != 0;
    const int hh = lane >> 5;
    const int qb = tq >> 6, tqmin = tq & ~31;
    int j = __builtin_ctzll(tmask); tmask &= tmask - 1;
    asm volatile("s_waitcnt vmcnt(0)" ::: "memory");
    __syncthreads();
    for (;;) {
        const bool more = tmask != 0ull;
        const int jn = more ? __builtin_ctzll(tmask) : 0; tmask &= tmask - 1;
        {
            LAS unsigned char* nb = lds + (buf ^ 1) * 32768;
            if (more) { tile_dma64(nb, ksrc + (size_t)jn * 64 * kld, kld, tid, wave); if (HASV) tile_dma64(nb + 16384, vsrc + (size_t)jn * 64 * vld, vld, tid, wave); }
            else if (nk) { tile_dma64(nb, nk, nkld, tid, wave); if (nv) tile_dma64(nb + 16384, nv, nvld, tid, wave); }
        }
        const LAS unsigned char* KT = lds + buf * 32768; const LAS unsigned char* VT = KT + 16384;
        const bool sel = MODE == 3 ? (bool)((mysel >> j) & 1ull) : true;
        f32x16 sa[2];
        qk_tile_pipe(KT, qf, lane, sa[0], sa[1]);
        VFrag fa;
        if (HASV) v_issue(fa, lds_addr(VT), TA);
#pragma unroll
        for (int kb = 0; kb < 2; ++kb) {
            bool need_mask;
            if (MODE < 2) need_mask = 16 * (64 * j + 32 * kb + 31) + 31 > tqmin; else if (MODE == 2) need_mask = (j == qb) || (j + 8 == qb); else need_mask = (j == qb);
            if (need_mask) {
#pragma unroll
                for (int r = 0; r < 16; ++r) {
                    const int kp = 64 * j + 32 * kb + (r & 3) + 8 * (r >> 2) + 4 * hh;
                    bool ok;
                    if (MODE < 2) ok = 16 * kp + 31 <= tq; else if (MODE == 2) ok = (tq - kp >= 0) && (tq - kp < 512); else ok = kp <= tq;
                    sa[kb][r] = ok ? sa[kb][r] : -__builtin_inff();
                }
            }
        }
        if (MODE == 3 && !__all(sel)) {
#pragma unroll
            for (int kb = 0; kb < 2; ++kb)
#pragma unroll
                for (int r = 0; r < 16; ++r) sa[kb][r] = sel ? sa[kb][r] : -__builtin_inff();
        }
        if (MODE == 1) {
#pragma unroll
            for (int kb = 0; kb < 2; ++kb) {
#pragma unroll
                for (int r = 0; r < 16; ++r) sa[kb][r] = fexp2(sa[kb][r] - m) * inv;
#pragma unroll
                for (int a = 0; a < 4; ++a) {
                    const int jj = 16 * j + 8 * kb + 2 * a + hh;
                    const float p3 = sa[kb][4 * a + 3], mainv = 2.0f * (sa[kb][4 * a] + sa[kb][4 * a + 1] + sa[kb][4 * a + 2]) + p3;
                    __hip_atomic_fetch_add(PS + ql * 66 + jj, (unsigned)(mainv * 268435456.0f + 0.5f), __ATOMIC_RELAXED, __HIP_MEMORY_SCOPE_WORKGROUP);
                    __hip_atomic_fetch_add(PS + ql * 66 + jj + 1, (unsigned)(p3 * 268435456.0f + 0.5f), __ATOMIC_RELAXED, __HIP_MEMORY_SCOPE_WORKGROUP);
                }
            }
        } else {
            float mx = m;
#pragma unroll
            for (int r = 0; r < 16; ++r) mx = fmaxf(mx, fmaxf(sa[0][r], sa[1][r]));
            mx = half_max(mx);
            float alpha = 1.0f;
            if (!__all(mx - m <= NSA_DEFER)) { alpha = fexp2(m - mx); m = mx; if (HASV) scale_o(o, alpha); }
            float ps = 0.f;
#pragma unroll
            for (int kb = 0; kb < 2; ++kb)
#pragma unroll
                for (int r = 0; r < 16; ++r) { const float pv = fexp2(sa[kb][r] - m); sa[kb][r] = pv; ps += pv; }
            lsum = lsum * alpha + ps;
        }
        if (HASV) {
            const unsigned vb = lds_addr(VT);
            VFrag fb;
            v_wait(fa); v_issue(fb, vb + 4096u, TA); v_mma(o, fa, pack8(sa[0], 0));
            v_wait(fb); v_issue(fa, vb + 8192u, TA); v_mma(o, fb, pack8(sa[0], 1));
            v_wait(fa); v_issue(fb, vb + 12288u, TA); v_mma(o, fa, pack8(sa[1], 0));
            v_wait(fb); v_mma(o, fb, pack8(sa[1], 1));
        }
        buf ^= 1;
        if (!more) break;
        asm volatile("s_waitcnt vmcnt(0)" ::: "memory");
        __syncthreads();
        j = jn;
    }
}

__device__ __forceinline__ void nsa_task(KP p, int nsa_layer, int task, LAS unsigned char* lds, int tid) {
    asm volatile("" : "+v"(tid), "+s"(p));
    const int lane = tid & 63, wave = __builtin_amdgcn_readfirstlane(tid >> 6), hh = lane >> 5;
    const int qb = 63 - (task >> 3), bg = task & 7, b = bg >> 1, g = bg & 1, t0 = qb * 64;
    const int hd = g * 4 + (wave >> 1), ql = 32 * (wave & 1) + (lane & 31), tq = t0 + ql;
    const bf16_t* PROJ = (const bf16_t*)(p->ws + WS_PROJ);
    LAS unsigned* PS = (LAS unsigned*)(lds + 65536);
    LAS unsigned* SM = (LAS unsigned*)(lds + LDS_STAGE + LDS_CTL);
    LAS u32x2* YL = (LAS u32x2*)(lds + 65536) + wave * 1024 + lane;
    LAS unsigned* UN = SM + 128;
    const bf16_t* kc = (const bf16_t*)(p->ws + WS_KCMP) + (size_t)bg * 256 * 128; const bf16_t* vc = (const bf16_t*)(p->ws + WS_VCMP) + (size_t)bg * 256 * 128;
    const bf16_t* kw = (const bf16_t*)(p->ws + WS_KWN) + (size_t)bg * SEQ * 128; const bf16_t* vw = PROJ + (size_t)b * SEQ * NINP + C_NVW + g * 128;
    const bf16_t* ks = (const bf16_t*)(p->ws + WS_KSN) + (size_t)bg * SEQ * 128; const bf16_t* vs = PROJ + (size_t)b * SEQ * NINP + C_NVS + g * 128;
    int buf = 0;
    tile_dma64(lds, kc, 128, tid, wave);
    bf16x8 qf[8];
    {
        const bf16_t* qsrc = PROJ + (size_t)(b * SEQ + tq) * NINP + C_NQ + hd * 128 + 8 * hh;
        const float* qw = p->in[I_NQW] + (size_t)nsa_layer * 128 + 8 * hh;
        float x[8][8]; float ss = 0.f;
#pragma unroll
        for (int s8 = 0; s8 < 8; ++s8) { unpack8(*(const u32x4*)(qsrc + 16 * s8), x[s8]);
#pragma unroll
            for (int j = 0; j < 8; ++j) ss += x[s8][j] * x[s8][j]; }
        ss = half_sum(ss);
        const float r = (1.0f / sqrtf(ss * (1.0f / 128.0f) + 1e-6f)) * (0.08838834764831845f * 1.4426950408889634f);
#pragma unroll
        for (int s8 = 0; s8 < 8; ++s8) { float w[8]; ld8f(qw + 16 * s8, w);
#pragma unroll
            for (int j = 0; j < 8; ++j) x[s8][j] *= r * w[j]; }
        {
            float c[8], sn[8]; ld8f((const float*)(p->ws + WS_TAB_NC) + tq * 16 + 8 * hh, c); ld8f((const float*)(p->ws + WS_TAB_NS) + tq * 16 + 8 * hh, sn);
#pragma unroll
            for (int j = 0; j < 8; ++j) { const float x1 = x[0][j], x2 = x[1][j]; x[0][j] = x1 * c[j] - x2 * sn[j]; x[1][j] = x2 * c[j] + x1 * sn[j]; }
        }
#pragma unroll
        for (int s8 = 0; s8 < 8; ++s8) qf[s8] = __builtin_bit_cast(bf16x8, pack8f(x[s8]));
    }
    const size_t tokrow = (size_t)(b * SEQ + tq);
    const unsigned short graw0 = PROJ[tokrow * NINP + C_NG + hd * 3 + 0], graw1 = PROJ[tokrow * NINP + C_NG + hd * 3 + 1], graw2 = PROJ[tokrow * NINP + C_NG + hd * 3 + 2];
    TrAcc TA; tr_acc_init(TA, lane);
    if (wave >= 4) __builtin_amdgcn_s_setprio(1);
    for (int i = tid; i < 64 * 66; i += NTHR) PS[i] = 0u;
    if (tid < 2) UN[tid] = 0u;
    f32x16 o[4];
    const int jw0 = (qb >= 8 ? qb - 8 : 0);
    {
        const int nv = ((t0 + 32) >> 4) + 1, ntile = (nv + 63) >> 6;
        const unsigned long long tm = (1ull << ntile) - 1ull;
        float m = -1e30f, lsum = 0.f;
        nsa_branch<0>(tm, kc, 128, vc, 128, kc, 128, vc, 128, buf, lds, qf, TA, o, m, lsum, 0.f, tq, 0ull, PS, ql, tid, lane, wave);
        lsum = half_sum(lsum);
        const float inv = lsum > 0.f ? 1.0f / lsum : 0.f;
        zero_o(o);
        nsa_branch<1>(tm, kc, 128, vc, 128, kw + (size_t)jw0 * 64 * 128, 128, vw + (size_t)jw0 * 64 * NINP, NINP, buf, lds, qf, TA, o, m, lsum, inv, tq, 0ull, PS, ql, tid, lane, wave);
    }
    __syncthreads();
    for (int qi = 0; qi < 8; ++qi) {
        const int q = 8 * wave + qi, cur = qb;
        const unsigned v = PS[q * 66 + lane];
        const bool forced = (lane == 0) || (lane == cur) || (lane == cur - 1);
        const unsigned key = forced ? 0xffffffffu : ((lane <= cur) ? v + 1u : 0u);
        int rank = 0;
#pragma unroll
        for (int i = 0; i < 64; ++i) { const unsigned ki = (unsigned)__builtin_amdgcn_readlane((int)key, i); rank += ((ki > key) || (ki == key && i < lane)) ? 1 : 0; }
        const unsigned long long msk = __ballot(rank < 16);
        if (lane == 0) { SM[2 * q] = (unsigned)msk; SM[2 * q + 1] = (unsigned)(msk >> 32); __hip_atomic_fetch_or(UN, (unsigned)msk, __ATOMIC_RELAXED, __HIP_MEMORY_SCOPE_WORKGROUP); __hip_atomic_fetch_or(UN + 1, (unsigned)(msk >> 32), __ATOMIC_RELAXED, __HIP_MEMORY_SCOPE_WORKGROUP); }
    }
    const unsigned long long upto = (qb == 63) ? ~0ull : ((2ull << qb) - 1ull);
    __syncthreads();
    {
        const float gt0 = sigmoidf_(bf2f(graw0));
#pragma unroll
        for (int c = 0; c < 4; ++c)
#pragma unroll
            for (int a = 0; a < 4; ++a) { u32x2 w; w.x = cvt_pk(o[c][4 * a] * gt0, o[c][4 * a + 1] * gt0); w.y = cvt_pk(o[c][4 * a + 2] * gt0, o[c][4 * a + 3] * gt0); YL[(c * 4 + a) * 64] = w; }
    }
    const unsigned long long mysel = (unsigned long long)SM[2 * ql] | ((unsigned long long)SM[2 * ql + 1] << 32);
    const unsigned long long un = ((unsigned long long)UN[0] | ((unsigned long long)UN[1] << 32)) & upto;
    const int js0 = __builtin_ctzll(un);
    {
        float m = -1e30f, lsum = 0.f; zero_o(o);
        const unsigned long long tm = upto & ~((qb >= 8) ? ((1ull << (qb - 8)) - 1ull) : 0ull);
        nsa_branch<2>(tm, kw, 128, vw, NINP, ks + (size_t)js0 * 64 * 128, 128, vs + (size_t)js0 * 64 * NINP, NINP, buf, lds, qf, TA, o, m, lsum, 0.f, tq, 0ull, PS, ql, tid, lane, wave);
        lsum = half_sum(lsum);
        const float sc = sigmoidf_(bf2f(graw2)) / lsum;
#pragma unroll
        for (int c = 0; c < 4; ++c)
#pragma unroll
            for (int a = 0; a < 4; ++a) { const u32x2 y = YL[(c * 4 + a) * 64];
                u32x2 w; w.x = cvt_pk(bflo(y.x) + o[c][4 * a] * sc, bfhi(y.x) + o[c][4 * a + 1] * sc); w.y = cvt_pk(bflo(y.y) + o[c][4 * a + 2] * sc, bfhi(y.y) + o[c][4 * a + 3] * sc); YL[(c * 4 + a) * 64] = w; }
    }
    {
        float m = -1e30f, lsum = 0.f; zero_o(o);
        nsa_branch<3>(un, ks, 128, vs, NINP, nullptr, 0, nullptr, 0, buf, lds, qf, TA, o, m, lsum, 0.f, tq, mysel, PS, ql, tid, lane, wave);
        lsum = half_sum(lsum);
        const float sc = sigmoidf_(bf2f(graw1)) / lsum;
        bf16_t* mrow = (bf16_t*)(p->ws + WS_MIX) + tokrow * DM + MIX_NSA + hd * 128;
#pragma unroll
        for (int c = 0; c < 4; ++c)
#pragma unroll
            for (int a = 0; a < 4; ++a) {
                const u32x2 y = YL[(c * 4 + a) * 64];
                u32x2 w; w.x = cvt_pk(bflo(y.x) + o[c][4 * a] * sc, bfhi(y.x) + o[c][4 * a + 1] * sc); w.y = cvt_pk(bflo(y.y) + o[c][4 * a + 2] * sc, bfhi(y.y) + o[c][4 * a + 3] * sc);
                *(u32x2*)(mrow + 32 * c + 8 * a + 4 * hh) = w;
            }
    }
    __builtin_amdgcn_s_setprio(0);
}

constexpr float SB_THR = 40.0f;
__device__ __forceinline__ void sb_task(KP p, int task, LAS unsigned char* lds, int tid) {
    asm volatile("" : "+v"(tid), "+s"(p));
    const int lane = tid & 63, wave = __builtin_amdgcn_readfirstlane(tid >> 6), hh = lane >> 5;
    const int bh = task >> 4, b = bh >> 3, h = bh & 7, Q0 = (task & 15) * 256;
    const bf16_t* PROJ = (const bf16_t*)(p->ws + WS_PROJ);
    const bf16_t* base = PROJ + (size_t)b * SEQ * NINP + h * 128;
    volatile LAS int* FL = (volatile LAS int*)(lds + 65536);
    const int tq = Q0 + 32 * wave + (lane & 31);
    int jt = (Q0 >> 6) + 3, buf = 0;
    tile_dma64(lds, base + (size_t)jt * 64 * NINP + C_SK, NINP, tid, wave); tile_dma64(lds + 16384, base + (size_t)jt * 64 * NINP + C_SV, NINP, tid, wave);
    bf16x8 qf[8];
#pragma unroll
    for (int s = 0; s < 8; ++s) qf[s] = *(const bf16x8*)(base + (size_t)tq * NINP + C_SQ + 16 * s + 8 * hh);
    TrAcc TA; tr_acc_init(TA, lane);
    f32x16 o[4]; zero_o(o);
    float Lc = 0.f; bool wdone = false;
    if (tid < 8) FL[tid] = 0;
    const float SC = 0.08838834764831845f, L2E = 1.4426950408889634f, LN2 = 0.6931471805599453f;
    asm volatile("s_waitcnt vmcnt(0)" ::: "memory");
    __syncthreads();
    for (;;) {
        if (FL[0] & FL[1] & FL[2] & FL[3] & FL[4] & FL[5] & FL[6] & FL[7]) break;
        if (jt > 0) { LAS unsigned char* nb = lds + (buf ^ 1) * 32768; tile_dma64(nb, base + (size_t)(jt - 1) * 64 * NINP + C_SK, NINP, tid, wave); tile_dma64(nb + 16384, base + (size_t)(jt - 1) * 64 * NINP + C_SV, NINP, tid, wave); }
        const LAS unsigned char* KT = lds + buf * 32768; const LAS unsigned char* VT = KT + 16384;
        const int k0 = jt * 64;
        if (!wdone && k0 < Q0 + 32 * wave + 31) {
            const unsigned vb = lds_addr(VT);
#pragma unroll 1
            for (int kbi = 0; kbi < 2; ++kbi) {
                const int kb = 1 - kbi;
                f32x16 sa = qk_block(KT, kb, qf, lane), ls;
#pragma unroll
                for (int r = 0; r < 16; ++r) {
                    const int key = k0 + 32 * kb + (r & 3) + 8 * (r >> 2) + 4 * hh;
                    const float z = sa[r] * SC;
                    const float lp = flog2(1.0f + fexp2(-fabsf(z) * L2E)) * LN2;
                    const float lb = fminf(z, 0.f) - lp;
                    sa[r] = lb; ls[r] = (key < tq) ? (lb - z) : 0.f;
                }
                float gsum[4], ghi[4], after[4];
#pragma unroll
                for (int a = 0; a < 4; ++a) { const float gsv = (ls[4 * a] + ls[4 * a + 1]) + (ls[4 * a + 2] + ls[4 * a + 3]);
                    auto rr = __builtin_amdgcn_permlane32_swap(__float_as_uint(gsv), __float_as_uint(gsv), false, false);
                    ghi[a] = __uint_as_float(rr[1]); gsum[a] = __uint_as_float(rr[0]) + ghi[a]; }
                float run = 0.f;
#pragma unroll
                for (int a = 3; a >= 0; --a) { after[a] = run; run += gsum[a]; }
#pragma unroll
                for (int a = 0; a < 4; ++a) {
                    float suf = Lc + after[a] + (hh == 0 ? ghi[a] : 0.f);
#pragma unroll
                    for (int q = 3; q >= 0; --q) {
                        const int r = 4 * a + q, key = k0 + 32 * kb + q + 8 * a + 4 * hh;
                        const float w = (key < tq) ? fexp2((sa[r] + suf) * L2E) : 0.f;
                        suf += ls[r];
                        sa[r] = w;
                    }
                }
                Lc += run;
                pv_step(o, vb + 4096u * (unsigned)(2 * kb), TA, pack8(sa, 0));
                pv_step(o, vb + 4096u * (unsigned)(2 * kb + 1), TA, pack8(sa, 1));
            }
            wdone = __all(Lc < -SB_THR);
            if (lane == 0) FL[wave] = wdone ? 1 : 0;
        }
        if (jt == 0) break;
        asm volatile("s_waitcnt vmcnt(0)" ::: "memory");
        __syncthreads();
        --jt; buf ^= 1;
    }
    bf16_t* mrow = (bf16_t*)(p->ws + WS_MIX) + (size_t)(b * SEQ + tq) * DM + MIX_SB + h * 128;
#pragma unroll
    for (int c = 0; c < 4; ++c)
#pragma unroll
        for (int a = 0; a < 4; ++a) { u32x2 w; w.x = cvt_pk(o[c][4 * a], o[c][4 * a + 1]); w.y = cvt_pk(o[c][4 * a + 2], o[c][4 * a + 3]); *(u32x2*)(mrow + 32 * c + 8 * a + 4 * hh) = w; }
}

__device__ __forceinline__ void ret_state_task(KP p, int task, LAS unsigned char* lds, int tid, unsigned* rsflag) {
    asm volatile("" : "+v"(tid), "+s"(p));
    const int lane = tid & 63, wave = __builtin_amdgcn_readfirstlane(tid >> 6), hh = lane >> 5;
    const int eh = task & 1, bh = task >> 1, b = bh >> 3, h = bh & 7;
    const bf16_t* KR = (const bf16_t*)(p->ws + WS_KR) + (size_t)bh * SEQ * 128;
    const bf16_t* V = (const bf16_t*)(p->ws + WS_PROJ) + (size_t)b * SEQ * NINP + C_RV + h * 128;
    bf16_t* ST = (bf16_t*)(p->ws + WS_ST) + (size_t)bh * 32 * 128 * 128;
    const int eb = wave >> 2, db = wave & 3;
    const float gC = exp2f(128.0f * log2f(1.0f - exp2f(-5.0f - (float)h)));
    f32x16 acc;
#pragma unroll
    for (int i = 0; i < 16; ++i) acc[i] = 0.f;
#define RS_ISSUE(c_, nb_) do { _Pragma("unroll") for (int rr = 0; rr < 2; ++rr) { tile_dma64((nb_) + rr * 16384, KR + ((size_t)(c_) * 128 + rr * 64) * 128, 128, tid, wave); \
        tile_dma64((nb_) + 32768 + rr * 16384, V + ((size_t)(c_) * 128 + rr * 64) * NINP, NINP, tid, wave); } } while (0)
    __syncthreads();
    RS_ISSUE(0, lds);
    for (int c = 0; c < 32; ++c) {
        {
            bf16_t* dst = ST + (size_t)c * 128 * 128 + 32 * db + (lane & 31);
#pragma unroll
            for (int r = 0; r < 16; ++r) { const int e = 64 * eh + 32 * eb + (r & 3) + 8 * (r >> 2) + 4 * hh; dst[(size_t)e * 128] = f2bf(acc[r]); }
        }
        if (c == 31) break;
        asm volatile("s_waitcnt vmcnt(0)" ::: "memory");
        __syncthreads();
        if (c + 1 < 31) { LAS unsigned char* nb = lds + ((c + 1) & 1) * 65536; RS_ISSUE(c + 1, nb); }
        const LAS unsigned char* KT = lds + (c & 1) * 65536; const LAS unsigned char* VT = KT + 32768;
#pragma unroll
        for (int ks = 0; ks < 8; ++ks) {
            const unsigned ov0 = tr_off_nat(lane, 2 * eh + eb, ks, 0), ov1 = tr_off_nat(lane, 2 * eh + eb, ks, 1), ok0 = tr_off_nat(lane, db, ks, 0), ok1 = tr_off_nat(lane, db, ks, 1);
            s16x4 v0, v1, k0, k1;
            asm volatile("ds_read_b64_tr_b16 %0, %4\n\tds_read_b64_tr_b16 %1, %5\n\tds_read_b64_tr_b16 %2, %6\n\tds_read_b64_tr_b16 %3, %7\n\ts_waitcnt lgkmcnt(0)"
                         : "=&v"(v0), "=&v"(v1), "=&v"(k0), "=&v"(k1) : "v"(lds_addr(VT) + ov0), "v"(lds_addr(VT) + ov1), "v"(lds_addr(KT) + ok0), "v"(lds_addr(KT) + ok1) : "memory");
            acc = __builtin_amdgcn_mfma_f32_32x32x16_bf16(__builtin_shufflevector(v0, v1, 0, 1, 2, 3, 4, 5, 6, 7), __builtin_shufflevector(k0, k1, 0, 1, 2, 3, 4, 5, 6, 7), acc, 0, 0, 0);
        }
#pragma unroll
        for (int i = 0; i < 16; ++i) acc[i] *= gC;
    }
#undef RS_ISSUE
    asm volatile("s_waitcnt vmcnt(0)" ::: "memory");
    __syncthreads();
    if (tid == 0) { __builtin_amdgcn_fence(__ATOMIC_RELEASE, "agent"); asm volatile("s_waitcnt vmcnt(0)" ::: "memory"); __hip_atomic_fetch_add(rsflag + 64 * bh, 1u, __ATOMIC_RELAXED, __HIP_MEMORY_SCOPE_AGENT); }
}

__device__ __forceinline__ void ret_out_task(KP p, int task, LAS unsigned char* lds, int tid, unsigned* rsflag) {
    asm volatile("" : "+v"(tid), "+s"(p));
    const int lane = tid & 63, wave = __builtin_amdgcn_readfirstlane(tid >> 6), hh = lane >> 5;
    const int bh = task >> 4, cp = task & 15, b = bh >> 3, h = bh & 7;
    const int cw = wave >> 2, ib = wave & 3, c = 2 * cp + cw, s = 128 * c + 32 * ib + (lane & 31);
    const bf16_t* PROJ = (const bf16_t*)(p->ws + WS_PROJ);
    const bf16_t* KR = (const bf16_t*)(p->ws + WS_KR) + (size_t)bh * SEQ * 128;
    const bf16_t* V = PROJ + (size_t)b * SEQ * NINP + C_RV + h * 128;
    const bf16_t* ST = (const bf16_t*)(p->ws + WS_ST) + (size_t)bh * 32 * 128 * 128;
#define RET_ISSUE(st_, nb_) do { _Pragma("unroll") for (int cwi = 0; cwi < 2; ++cwi) { const size_t cc_ = (size_t)(2 * cp + cwi); \
        if ((st_) < 2) { const size_t krow = cc_ * 128 + (st_) * 64; tile_dma64((nb_) + cwi * 32768, KR + krow * 128, 128, tid, wave); tile_dma64((nb_) + cwi * 32768 + 16384, V + krow * NINP, NINP, tid, wave); } \
        else tile_dma64((nb_) + cwi * 32768, ST + (cc_ * 128 + ((st_) - 2) * 64) * 128, 128, tid, wave); } } while (0)
    RET_ISSUE(0, lds);
    bf16x8 qf[8];
    {
        const bf16_t* qsrc = PROJ + (size_t)(b * SEQ + s) * NINP + C_RQ + h * 128 + 8 * hh;
        const float* rc = (const float*)(p->ws + WS_TAB_RC) + s * 64 + 8 * hh; const float* rs = (const float*)(p->ws + WS_TAB_RS) + s * 64 + 8 * hh;
        const float dq = fexp2((float)((s & 127) + 1) * log2f(1.0f - exp2f(-5.0f - (float)h)));
#pragma unroll
        for (int s8 = 0; s8 < 4; ++s8) {
            float x1[8], x2[8], c[8], sn[8], o1[8], o2[8];
            unpack8(*(const u32x4*)(qsrc + 16 * s8), x1); unpack8(*(const u32x4*)(qsrc + 64 + 16 * s8), x2);
            ld8f(rc + 16 * s8, c); ld8f(rs + 16 * s8, sn);
#pragma unroll
            for (int j = 0; j < 8; ++j) { o1[j] = (x1[j] * c[j] - x2[j] * sn[j]) * dq; o2[j] = (x2[j] * c[j] + x1[j] * sn[j]) * dq; }
            qf[s8] = __builtin_bit_cast(bf16x8, pack8f(o1)); qf[s8 + 4] = __builtin_bit_cast(bf16x8, pack8f(o2));
        }
    }
    TrAcc TA; tr_acc_init(TA, lane);
    f32x16 o[4]; zero_o(o);
    if (tid == 0) {
        unsigned spins = 0;
        while (__hip_atomic_load(rsflag + 64 * bh, __ATOMIC_RELAXED, __HIP_MEMORY_SCOPE_AGENT) < 2u && ++spins < (1u << 24)) __builtin_amdgcn_s_sleep(8);
        __builtin_amdgcn_fence(__ATOMIC_ACQUIRE, "agent");
        asm volatile("s_waitcnt vmcnt(0)" ::: "memory");
    }
    const size_t tok = (size_t)(b * SEQ + s);
    u32x2 gvr[4][4];
    {
        const bf16_t* grow = PROJ + tok * NINP + C_RG + h * 128;
#pragma unroll
        for (int cc = 0; cc < 4; ++cc)
#pragma unroll
            for (int a = 0; a < 4; ++a) gvr[cc][a] = *(const u32x2*)(grow + 32 * cc + 8 * a + 4 * hh);
    }
    asm volatile("s_waitcnt vmcnt(0)" ::: "memory");
    __syncthreads();
#pragma unroll
    for (int st = 0; st < 4; ++st) {
        if (st + 1 < 4) { LAS unsigned char* nb = lds + ((st + 1) & 1) * 65536; RET_ISSUE(st + 1, nb); }
        const LAS unsigned char* KT = lds + (st & 1) * 65536 + cw * 32768; const LAS unsigned char* VT = KT + 16384;
        if (st < 2) {
#pragma unroll
            for (int kb = 0; kb < 2; ++kb) {
                const int jb = 2 * st + kb;
                if (jb <= ib) {
                    f32x16 sa = qk_block(KT, kb, qf, lane);
                    if (jb == ib) {
#pragma unroll
                        for (int r = 0; r < 16; ++r) { const int kl = (r & 3) + 8 * (r >> 2) + 4 * hh; if (kl > (lane & 31)) sa[r] = 0.f; }
                    }
                    const unsigned vb = lds_addr(VT);
                    pv_step(o, vb + 4096u * (unsigned)(2 * kb), TA, pack8(sa, 0));
                    pv_step(o, vb + 4096u * (unsigned)(2 * kb + 1), TA, pack8(sa, 1));
                }
            }
        } else {
#pragma unroll
            for (int eb = 0; eb < 2; ++eb)
#pragma unroll
                for (int k = 0; k < 8; ++k) o[2 * (st - 2) + eb] = __builtin_amdgcn_mfma_f32_32x32x16_bf16(row_frag(KT, 32 * eb, k, lane), qf[k], o[2 * (st - 2) + eb], 0, 0, 0);
        }
        if (st + 1 < 4) { asm volatile("s_waitcnt vmcnt(0)" ::: "memory"); __syncthreads(); }
    }
#undef RET_ISSUE
    float ss = 0.f;
#pragma unroll
    for (int cc = 0; cc < 4; ++cc)
#pragma unroll
        for (int r = 0; r < 16; ++r) ss += o[cc][r] * o[cc][r];
    ss = half_sum(ss);
    const float rn = 1.0f / sqrtf(ss * (1.0f / 128.0f) + 1e-6f);
    bf16_t* mrow = (bf16_t*)(p->ws + WS_MIX) + tok * DM + MIX_RET + h * 128;
#ifndef REPS_RETEPI
#define REPS_RETEPI 1
#endif
    for (int rr = 0; rr < REPS_RETEPI; ++rr)
#pragma unroll
    for (int cc = 0; cc < 4; ++cc)
#pragma unroll
        for (int a = 0; a < 4; ++a) {
            const u32x2 gv = gvr[cc][a];
            const float g0 = bflo(gv.x), g1 = bfhi(gv.x), g2 = bflo(gv.y), g3 = bfhi(gv.y);
            u32x2 w; w.x = cvt_pk(o[cc][4 * a] * rn * g0 * sigmoidf_(g0), o[cc][4 * a + 1] * rn * g1 * sigmoidf_(g1));
            w.y = cvt_pk(o[cc][4 * a + 2] * rn * g2 * sigmoidf_(g2), o[cc][4 * a + 3] * rn * g3 * sigmoidf_(g3));
            *(u32x2*)(mrow + 32 * cc + 8 * a + 4 * hh) = w;
        }
}

#ifndef HP_SP2
#define HP_SP2 true
#endif
#ifndef HP_ALIGN
#define HP_ALIGN true
#endif
#ifndef REPS_CMP
#define REPS_CMP 1
#endif
#ifndef REPS_C1
#define REPS_C1 1
#endif
#ifndef REPS_RS
#define REPS_RS 1
#endif
#ifndef REPS_NSA
#define REPS_NSA 1
#endif
#ifndef REPS_SB
#define REPS_SB 1
#endif
#ifndef REPS_C3
#define REPS_C3 1
#endif
#ifndef REPS_PE
#define REPS_PE 1
#endif
#ifndef REP_CONV
#define REP_CONV 1
#endif
#ifndef REP_GIN
#define REP_GIN 1
#endif
#ifndef REPS_RO
#define REPS_RO 1
#endif
#ifndef REP_PREP
#define REP_PREP 1
#endif
#ifndef REP_MIX1
#define REP_MIX1 1
#endif
#ifndef REP_MIX2
#define REP_MIX2 1
#endif
#ifndef REP_NORM2
#define REP_NORM2 1
#endif
#ifndef REP_GGU
#define REP_GGU 1
#endif
#ifndef REP_ACT
#define REP_ACT 1
#endif
#ifndef IN_MIDCONV
#define IN_MIDCONV 0
#endif
struct SegOrder {
    pg8::StaticOrder S; int i0, n;
    __device__ __forceinline__ bool next(int i, pg8::Unit& u) const { return i < n && S.next(i0 + i, u); }
    __device__ __forceinline__ void a_ready(const pg8::Unit&) const {}
    __device__ __forceinline__ void done(const pg8::Unit&) const {}
};
#ifndef IN_SKINNY
#define IN_SKINNY 0
#endif
#ifndef GU_TAIL_N
#define GU_TAIL_N 2016
#endif
#ifndef IN_TAIL_N
#define IN_TAIL_N 1024
#endif
#ifndef IN_TAIL_N0
#define IN_TAIL_N0 1024
#endif
static_assert(GU_TAIL_N <= 2016 && IN_TAIL_N0 >= 512 && (GU_TAIL_N > 1504 ? GU_TAIL_N : 1504) + IN_TAIL_N >= 2016, "conversion task placement");
enum { PH_CONV = 0, PH_GEMM_IN, PH_PREP, PH_MIX1, PH_MIX2, PH_GEMM_OUT, PH_GEMM_GU, PH_ACT, PH_GEMM_DN, N_PHASES };

__global__ void __launch_bounds__(NTHR, 2) hybrid_fwd(Params p_arg) {
    extern __shared__ __attribute__((aligned(16))) unsigned char lds_raw[];
    LAS unsigned char* lds = (LAS unsigned char*)lds_raw;
    const int wave0 = __builtin_amdgcn_readfirstlane(threadIdx.x >> 6), bid = blockIdx.x, G = gridDim.x;
#define TID0() (wave0 * 64 + lane_id_now())
    volatile LAS unsigned* CT = (volatile LAS unsigned*)(lds + LDS_STAGE);
    { const int t0_ = TID0(); if (t0_ < 8) CT[t0_] = 0u; }
    __syncthreads();
    const KP kp = (KP)__builtin_amdgcn_kernarg_segment_ptr();
    unsigned* ctl = (unsigned*)(kp->ws + WS_CTL);
    const int l_lo = kp->l_lo, l_hi = kp->l_hi, ph_lo = kp->ph_lo, ph_hi = kp->ph_hi;
    const bool multi = (l_hi - l_lo) > 1 || (ph_hi - ph_lo) > 1;
    XcdBarrier bar; bar.bar = ctl + CW_BAR; bar.x = 0; bar.st = CT;
    if (multi) bar = xcd_barrier_post(ctl + CW_BAR, CT);
    volatile LAS int* slot = (volatile LAS int*)(CT + 4);

#define PH_ON(k) (ph_lo <= (k) && (k) < ph_hi)
#define WSP(T, off) ((T*)(p->ws + (off)))
#ifndef REP_SEAM
#define REP_SEAM 1
#endif
#define SEAM() do { if (multi) for (int sr_ = 0; sr_ < REP_SEAM; ++sr_) xcd_barrier(bar); } while (0)
#define ARRIVE_ALL(ctr_, tid_) do { asm volatile("s_waitcnt vmcnt(0)" ::: "memory"); __syncthreads(); \
        if ((tid_) == 0) { __builtin_amdgcn_fence(__ATOMIC_RELEASE, "agent"); asm volatile("s_waitcnt vmcnt(0)" ::: "memory"); __hip_atomic_fetch_add((ctr_), 1u, __ATOMIC_RELAXED, __HIP_MEMORY_SCOPE_AGENT); } } while (0)
#define WAIT_ALL(ctr_, tid_) do { if ((tid_) == 0) { unsigned spins_ = 0; \
            while (__hip_atomic_load((ctr_), __ATOMIC_RELAXED, __HIP_MEMORY_SCOPE_AGENT) < (unsigned)G && ++spins_ < (1u << 24)) __builtin_amdgcn_s_sleep(8); \
            __builtin_amdgcn_fence(__ATOMIC_ACQUIRE, "agent"); asm volatile("s_waitcnt vmcnt(0)" ::: "memory"); } \
        __syncthreads(); } while (0)
#ifndef SPLIT_SEAMS
#define SPLIT_SEAMS 1
#endif
#define SEAM_FILL(i_, lo_, hi_, last_rep_) do { const int tid_s = TID0(); \
        if (multi && SPLIT_SEAMS && (last_rep_)) { ARRIVE_ALL(qctr + 448 + 16 * (i_), tid_s); convert_range(p, l, (lo_) + bid, (hi_), G, lds, tid_s); WAIT_ALL(qctr + 448 + 16 * (i_), tid_s); } \
        else { convert_range(p, l, (lo_) + bid, (hi_), G, lds, tid_s); SEAM(); } } while (0)
#ifndef DIS_TAB
    if (l_lo == 0 && PH_ON(PH_CONV)) ph_tables(kp, TID0(), bid, G);
#endif
    for (int l = l_lo; l < l_hi; ++l) {
        KP p = kp; asm volatile("" : "+s"(p));
        const int vis_lo = (l == 0) ? 1504 + IN_TAIL_N0 : (GU_TAIL_N > 1504 ? GU_TAIL_N : 1504) + IN_TAIL_N, vis_mid = (vis_lo + 4768) / 2;
        unsigned* qctr = ctl + CW_QUEUE + 1024 * l;
        if (PH_ON(PH_CONV)) for (int rep = 0; rep < REP_CONV; ++rep) {
            const int tid = TID0();
#ifndef DIS_CONV
            convert_range(p, l, ((l == 0) ? 0 : (GU_TAIL_N < 1504 ? GU_TAIL_N : 1504)) + bid, 1504, G, lds, tid);
            convert_small(p, l, tid, bid, G);
#endif
            if (l == 0) ph_xcvt(p->in[I_X], WSP(bf16_t, WS_HN), WSP(float, WS_RSS), tid, bid, G);
            SEAM();
        }
        if (PH_ON(PH_GEMM_IN)) for (int rep = 0; rep < REP_GIN; ++rep) {
            const int tid = TID0();
            constexpr int nin_g = IN_SKINNY ? C_NG : NINP;
            pg8::Gemm g{WSP(bf16_t, WS_HN), WSP(bf16_t, WS_WIN), MT, nin_g, DM}; pg8::StaticOrder S; S.init(MT, nin_g, G, bid);
            LAS float* rt = (LAS float*)(lds + LDS_STAGE + LDS_CTL);
            const int rbase = fill_rstd_table(S, WSP(float, WS_RSS), rt, tid);
            EpiBf16RS E{WSP(bf16_t, WS_PROJ), NINP, rt, rbase};
#if !defined(DIS_GEMM) && !defined(DIS_G1)
#if IN_MIDCONV
            {
                const int cut = 1 + (bid & 7);
                SegOrder Sa{S, 0, cut}, Sb{S, cut, 1 << 20};
                pg8::gemm_phase<EpiBf16RS, SegOrder, HP_ALIGN, HP_SP2>(lds, g, Sa, E, tid);
                convert_range(p, l, vis_lo + bid, 4768, G, lds, tid);
                __syncthreads();
                pg8::gemm_phase<EpiBf16RS, SegOrder, HP_ALIGN, HP_SP2>(lds, g, Sb, E, tid);
            }
#else
            pg8::gemm_phase<EpiBf16RS, pg8::StaticOrder, HP_ALIGN, HP_SP2>(lds, g, S, E, tid);
#endif
#endif
#ifndef DIS_CONV
            {
                const int nwg = (MT / 256) * (nin_g / 256), first_short = nwg - ((nwg + G - 1) / G - 1) * G;
                if (IN_SKINNY) {
                    int rp0, rstep;
                    if (G == 256) { const int j = bid >> 3, x = bid & 7; rp0 = bid >= 128 ? 2 * (8 * x + (j & 7)) + ((j >> 3) & 1) : 128; rstep = 128; }
                    else if (first_short < G) { rp0 = bid >= first_short ? bid - first_short : 128; rstep = G - first_short; }
                    else { rp0 = bid; rstep = G; }
                    for (int rp = rp0; rp < 128; rp += rstep) in_gate_cols(p, rp * 128, WSP(float, WS_RSS), lds, tid);
                }
                const int in_lo = (l == 0) ? 1504 : (GU_TAIL_N > 1504 ? GU_TAIL_N : 1504), in_hi = in_lo + ((l == 0) ? IN_TAIL_N0 : IN_TAIL_N);
                if (first_short < G && bid >= first_short) convert_range(p, l, in_lo + (bid - first_short), in_hi, G - first_short, lds, tid);
                else if (first_short >= G) convert_range(p, l, in_lo + bid, in_hi, G, lds, tid);
            }
#endif
#if IN_MIDCONV
            SEAM();
#else
            SEAM_FILL(1, vis_lo, vis_mid, rep + 1 == REP_GIN);
#endif
        }
        if (PH_ON(PH_PREP)) for (int rep = 0; rep < REP_PREP; ++rep) {
            unsigned* qc = qctr + 512 * rep;
            for (int r2 = 0; r2 < REPS_PE; ++r2) ph_prep_elem(p, l, TID0(), bid, G);
#ifndef DIS_CMP
            { const int tid = TID0();
            for (int r2 = 0; r2 < REPS_CMP; ++r2) for (;;) { const int t = next_task(qc + 512 * r2, slot, tid); if (t >= 32) break; cmp_task(p, l, t, lds, tid); }
            }
#endif
#ifndef DIS_C1
            { const int tid = TID0();
            for (int r2 = 0; r2 < REPS_C1; ++r2) for (;;) { const int t = next_task(qc + 64 + 512 * r2, slot, tid); if (t >= 512) break; lru_c1_task(p, l, t, lds, tid); }
            }
#endif
            const bool split_pm = multi && PH_ON(PH_MIX1) && rep + 1 == REP_PREP;
            if (split_pm) { const int tid = TID0(); ARRIVE_ALL(qctr + 448, tid); }
#ifndef DIS_SB
            { const int tid = TID0();
            for (int r2 = 0; r2 < REPS_SB; ++r2) for (;;) { const int t = next_task(qc + 256 + 512 * r2, slot, tid); if (t >= 512) break; sb_task(p, t, lds, tid); }
            }
#endif
            if (split_pm) { const int tid = TID0(); WAIT_ALL(qctr + 448, tid);
            } else SEAM();
        }
        if (PH_ON(PH_MIX1)) for (int rep = 0; rep < REP_MIX1; ++rep) {
            unsigned* qc = qctr + 512 * rep;
#ifndef DIS_RS
            { const int tid = TID0();
            for (int r2 = 0; r2 < REPS_RS; ++r2) for (;;) { const int t = next_task(qc + 128 + 512 * r2, slot, tid); if (t >= 64) break; ret_state_task(p, t, lds, tid, ctl + CW_RSFLAG + 2048 * l); }
            }
#endif
#ifndef DIS_NSA
            { const int tid = TID0();
            for (int r2 = 0; r2 < REPS_NSA; ++r2) for (;;) { const int t = next_task(qc + 192 + 512 * r2, slot, tid); if (t >= 512) break; nsa_task(p, l, t, lds, tid); }
            }
#endif
#ifndef DIS_RO
            { const int tid = TID0();
            for (int r2 = 0; r2 < REPS_RO; ++r2) for (;;) { const int t = next_task(qc + 384 + 512 * r2, slot, tid); if (t >= 512) break; ret_out_task(p, t, lds, tid, ctl + CW_RSFLAG + 2048 * l); }
            }
#endif
#ifndef DIS_C3
            { const int tid = TID0();
            for (int r2 = 0; r2 < REPS_C3; ++r2) for (;;) { const int t = next_task(qc + 320 + 512 * r2, slot, tid); if (t >= 512) break; lru_c3_task(p, t, lds, tid); }
            }
#endif
#if IN_MIDCONV
            SEAM();
#else
            SEAM_FILL(2, vis_mid, 4768, rep + 1 == REP_MIX1);
#endif
        }
        if (PH_ON(PH_GEMM_OUT)) {
            const int tid = TID0();
            pg8::Gemm g{WSP(bf16_t, WS_MIX), WSP(bf16_t, WS_WOUT), MT, DM, DM}; pg8::StaticOrder S; S.init(MT, DM, G, bid);
            EpiResid3 E{(l == 0) ? p->in[I_X] : nullptr, WSP(bf16_t, WS_HN), nullptr, WSP(float, WS_RSS) + (size_t)MT * 64};
#if !defined(DIS_GEMM) && !defined(DIS_G2)
#ifdef REP_GOUT
            for (int rp = 1; rp < REP_GOUT; ++rp) { EpiResid3 E2{(l == 0) ? p->in[I_X] : nullptr, WSP(bf16_t, WS_HN), WSP(float, WS_PROJ), WSP(float, WS_RSS) + (size_t)MT * 64, 1};
                pg8::gemm_phase<EpiResid3, pg8::StaticOrder, HP_ALIGN, HP_SP2>(lds, g, S, E2, tid); SEAM(); }
#endif
            pg8::gemm_phase<EpiResid3, pg8::StaticOrder, HP_ALIGN, HP_SP2>(lds, g, S, E, tid);
#endif
            SEAM_FILL(3, 4768, (l + 1 == NL) ? 4768 : 6144, true);
        }
        if (PH_ON(PH_GEMM_GU)) for (int rep = 0; rep < REP_GGU; ++rep) {
            const int tid = TID0();
            pg8::Gemm g{WSP(bf16_t, WS_HN), WSP(bf16_t, WS_WGU), MT, NGU, DM}; pg8::StaticOrder S; S.init(MT, NGU, G, bid);
            LAS float* rt = (LAS float*)(lds + LDS_STAGE + LDS_CTL);
            const int rbase = fill_rstd_table(S, WSP(float, WS_RSS) + (size_t)MT * 64, rt, tid);
            EpiGateUp E{WSP(bf16_t, WS_H), rt, rbase, p->in[I_MCW] + (size_t)l * 3 * DFF, p->in[I_MCB] + (size_t)l * DFF, WSP(bf16_t, WS_GT), WSP(bf16_t, WS_GH), WSP(bf16_t, WS_UH)};
#if !defined(DIS_GEMM) && !defined(DIS_G3)
            pg8::gemm_phase<EpiGateUp, pg8::StaticOrder, HP_ALIGN, HP_SP2>(lds, g, S, E, tid);
#endif
#ifndef DIS_CONV
            if (rep == 0) {
                const int nwg = (MT / 256) * (NGU / 256), first_short = nwg - ((nwg + G - 1) / G - 1) * G;
                const int ll = (l + 1 < NL) ? l + 1 : l, t_lo = (l + 1 < NL) ? 0 : 4768, t_hi = (l + 1 < NL) ? GU_TAIL_N : 6144;
                if (first_short < G && bid >= first_short) convert_range(p, ll, t_lo + bid - first_short, t_hi, G - first_short, lds, tid);
                else if (first_short >= G) convert_range(p, ll, t_lo + bid, t_hi, G, lds, tid);
            }
#endif
            SEAM();
        }
        if (PH_ON(PH_ACT)) for (int rep = 0; rep < REP_ACT; ++rep) {
            const int tid = TID0();
            ph_mlp_fix(p, l, tid, bid, G);
            SEAM();
        }
        if (PH_ON(PH_GEMM_DN)) {
            const int tid = TID0();
            pg8::Gemm g{WSP(bf16_t, WS_H), WSP(bf16_t, (l & 1) ? WS_WDN2 : WS_WDN), MT, DM, DFF}; pg8::StaticOrder S; S.init(MT, DM, G, bid);
            EpiResid3 E{nullptr, WSP(bf16_t, WS_HN), (l + 1 < NL) ? nullptr : p->out, WSP(float, WS_RSS)};
#if !defined(DIS_GEMM) && !defined(DIS_G4)
#ifdef REP_GDN
            for (int rp = 1; rp < REP_GDN; ++rp) { EpiResid3 E2{nullptr, WSP(bf16_t, WS_HN), WSP(float, WS_PROJ), WSP(float, WS_RSS), 1};
                pg8::gemm_phase<EpiResid3, pg8::StaticOrder, HP_ALIGN, HP_SP2>(lds, g, S, E2, tid); SEAM(); }
#endif
            pg8::gemm_phase<EpiResid3, pg8::StaticOrder, HP_ALIGN, HP_SP2>(lds, g, S, E, tid);
#endif
            if (l + 1 < l_hi && !(multi && PH_ON(PH_CONV) && REP_CONV == 1)) SEAM();
        }
    }
#undef PH_ON
#undef SEAM
#undef WSP
#undef TID0
}
}

#ifndef HP_N_LAUNCH_MODE
#define HP_N_LAUNCH_MODE 0
#endif
extern "C" void kernel_launch(void* const* d_in, const int* in_sizes, int n_in, void* d_out, int out_size, void* d_ws, size_t ws_size, hipStream_t stream) {
    using namespace hp;
    static int grid = 0;
    if (grid == 0) {
        if (n_in != N_INPUTS || out_size != MT * DM || ws_size < WS_END) { fprintf(stderr, "kernel_launch: unexpected problem (n_in %d, out %d, ws %zu, need %zu)\n", n_in, out_size, ws_size, (size_t)WS_END); grid = -1; return; }
        int dev = 0, cus = 0, per_cu = 0;
        if (hipGetDevice(&dev) != hipSuccess || hipDeviceGetAttribute(&cus, hipDeviceAttributeMultiprocessorCount, dev) != hipSuccess) { grid = -1; return; }
        if (hipFuncSetAttribute((const void*)hybrid_fwd, hipFuncAttributeMaxDynamicSharedMemorySize, LDS_BYTES) != hipSuccess) { fprintf(stderr, "kernel_launch: hipFuncSetAttribute failed\n"); grid = -1; return; }
        if (hipOccupancyMaxActiveBlocksPerMultiprocessor(&per_cu, (const void*)hybrid_fwd, NTHR, LDS_BYTES) != hipSuccess || per_cu < 1) { fprintf(stderr, "kernel_launch: occupancy query says %d\n", per_cu); (void)hipGetLastError(); per_cu = 1; }
        grid = cus;
    }
    if (grid < 0) return;
    (void)hipMemsetAsync((char*)d_ws + WS_CTL, 0, CTL_BYTES, stream);
    Params p{};
    for (int i = 0; i < N_INPUTS; ++i) p.in[i] = (const float*)d_in[i];
    p.out = (float*)d_out; p.ws = (unsigned char*)d_ws;
#if HP_N_LAUNCH_MODE == 0
    p.l_lo = 0; p.l_hi = NL; p.ph_lo = 0; p.ph_hi = N_PHASES;
    hipLaunchKernelGGL(hybrid_fwd, dim3(grid), dim3(NTHR), LDS_BYTES, stream, p);
#else
    for (int l = 0; l < NL; ++l)
        for (int ph = 0; ph < N_PHASES; ++ph) { p.l_lo = l; p.l_hi = l + 1; p.ph_lo = ph; p.ph_hi = ph + 1; hipLaunchKernelGGL(hybrid_fwd, dim3(grid), dim3(NTHR), LDS_BYTES, stream, p); }
#endif
}
```

```cpp
#include <hip/hip_runtime.h>
#include <stdint.h>
#include <stdio.h>
#define XB_TMO      128
#define XB_XCNT(j)  (256  + 64 * (j))
#define XB_XSUB(j)  (1280 + 64 * (j))
#define XB_XGEN(j)  (2304 + 64 * (j))
#define XB_TOP      3328
#define XB_TOPGEN   3392
#define XCD_BAR_WORDS 3456
#define XB_SPIN_CAP (1u << 22)
#define LAS __attribute__((address_space(3)))

__device__ __forceinline__ unsigned xb_ld(unsigned* p)              { return __hip_atomic_load(p, __ATOMIC_RELAXED, __HIP_MEMORY_SCOPE_AGENT); }
__device__ __forceinline__ unsigned xb_add(unsigned* p, unsigned v) { return __hip_atomic_fetch_add(p, v, __ATOMIC_RELAXED, __HIP_MEMORY_SCOPE_AGENT); }
__device__ __forceinline__ unsigned xb_xcc_id() { return (unsigned)__builtin_amdgcn_s_getreg((3 << 11) | 20) & 0xFu; }
#define XB_SPIN(cond, bar) do { unsigned _sp = 0; while (cond) { __builtin_amdgcn_s_sleep(1); \
    if ((++_sp & 255u) == 0u) { if (xb_ld(&(bar)[XB_TMO])) break; if (_sp > XB_SPIN_CAP) { atomicAdd(&(bar)[XB_TMO], 1u); break; } } } } while (0)

struct XcdBarrier {
    unsigned* bar; unsigned x;
    volatile LAS unsigned* st;
};

__device__ __forceinline__ XcdBarrier xcd_barrier_post(unsigned* bar, volatile LAS unsigned* st) {
    XcdBarrier b; b.bar = bar; b.x = xb_xcc_id(); b.st = st;
    if (threadIdx.x == 0) (void)xb_add(&bar[XB_XCNT(b.x)], 1u);
    return b;
}
__device__ __forceinline__ void xcd_barrier_complete(unsigned* bar, unsigned x, unsigned& nloc, unsigned& nx) {
    const unsigned G = gridDim.x * gridDim.y * gridDim.z;
    unsigned sum, cnt, mine, sp = 0u;
    for (;;) {
        sum = 0u; cnt = 0u; mine = 0u;
#pragma unroll
        for (unsigned j = 0; j < 16; ++j) { const unsigned c = xb_ld(&bar[XB_XCNT(j)]); sum += c; cnt += (c > 0u) ? 1u : 0u; mine = (j == x) ? c : mine; }
        if (sum == G) break;
        __builtin_amdgcn_s_sleep(1);
        if ((++sp & 255u) == 0u) { if (xb_ld(&bar[XB_TMO])) break; if (sp > XB_SPIN_CAP) { atomicAdd(&bar[XB_TMO], 1u); break; } }
    }
    nloc = mine > 0u ? mine : 1u; nx = cnt > 0u ? cnt : 1u;
}

__device__ __forceinline__ void xcd_barrier(const XcdBarrier& b) {
    asm volatile("s_waitcnt vmcnt(0)" ::: "memory");
    __syncthreads();
    if (threadIdx.x == 0) {
        unsigned* bar = b.bar;
        __builtin_amdgcn_s_waitcnt(0);
        unsigned nloc = b.st[0], nx = b.st[1];
        if (nloc == 0u) { xcd_barrier_complete(bar, b.x, nloc, nx); b.st[0] = nloc; b.st[1] = nx; }
        const unsigned old = xb_add(&bar[XB_XSUB(b.x)], 1u);
        const unsigned gen = old / nloc;
        if (old + 1u == (gen + 1u) * nloc) {
            __builtin_amdgcn_fence(__ATOMIC_RELEASE, "agent");
            asm volatile("s_waitcnt vmcnt(0)" ::: "memory");
            const unsigned og = xb_add(&bar[XB_TOP], 1u);
            const unsigned tg = og / nx;
            if (og + 1u == (tg + 1u) * nx) xb_add(&bar[XB_TOPGEN], 1u);
            else XB_SPIN(xb_ld(&bar[XB_TOPGEN]) == tg, bar);
            __builtin_amdgcn_fence(__ATOMIC_ACQUIRE, "agent");
            xb_add(&bar[XB_XGEN(b.x)], 1u);
            asm volatile("s_waitcnt vmcnt(0)" ::: "memory");
        } else {
            XB_SPIN(xb_ld(&bar[XB_XGEN(b.x)]) == gen, bar);
            __builtin_amdgcn_fence(__ATOMIC_ACQUIRE, "agent");
            asm volatile("s_waitcnt vmcnt(0)" ::: "memory");
        }
    }
    __syncthreads();
}
#ifndef PG8_WGM
#define PG8_WGM 8
#endif
namespace pg8 {
#define PG8_LAS __attribute__((address_space(3)))
typedef unsigned short bf16_t;
typedef short bf16x8 __attribute__((ext_vector_type(8)));
typedef float f32x4 __attribute__((ext_vector_type(4)));
typedef unsigned u32x4 __attribute__((ext_vector_type(4)));
constexpr int BM = 256, BK = 64, HALF = 128, HTB = HALF * BK * 2  , STAGE_BYTES = 8 * HTB, NXCD = 8, WGM = PG8_WGM;

__host__ __device__ __forceinline__ int lds_byte(int r, int c) { const int st = (r >> 4) * 2 + (c >> 5), rr = r & 15, cc = c & 31, ob = rr * 64 + cc * 2; return st * 1024 + (ob ^ (((ob >> 9) & 1) << 5)); }
__host__ __device__ __forceinline__ void stage_rc(int b, int& R, int& C) { const int st = b / 1024, sb = b % 1024, swz = sb ^ (((sb >> 9) & 1) << 5); R = (st >> 1) * 16 + swz / 64; C = (st & 1) * 32 + (swz % 64) / 2; }
__host__ __device__ __forceinline__ int perm32(int rho) { const int n = rho >> 4, i = rho & 15; return 8 * (i >> 2) + 4 * n + (i & 3); }

struct Unit { int pm, pn; };
struct Gemm { const bf16_t* A; const bf16_t* Bt; int M, N, K; };

struct StaticOrder {
    int nM, nN, nwg, G, c;
    __host__ __device__ void init(int M, int N, int G_, int c_) { nM = M / BM; nN = N / BM; nwg = nM * nN; G = G_; c = c_; }
    __host__ __device__ bool next(int i, Unit& u) const {
        const long L = (long)i * G + c; if (L >= nwg) return false;
        int wgid = (int)L; { const int q = nwg / NXCD, r = nwg % NXCD, xcd = wgid % NXCD, off = wgid / NXCD; wgid = (xcd < r ? xcd * (q + 1) : r * (q + 1) + (xcd - r) * q) + off; }
        const int nig = WGM * nN, gid = wgid / nig, fm = gid * WGM, gsz = (nM - fm) < WGM ? (nM - fm) : WGM;
        u.pm = fm + ((wgid % nig) % gsz); u.pn = (wgid % nig) / gsz; return true;
    }
    __device__ __forceinline__ void a_ready(const Unit&) const {}
    __device__ __forceinline__ void done(const Unit&) const {}
};

__device__ __forceinline__ unsigned cvt_pk_bf16(float lo, float hi) { unsigned r; asm volatile("v_cvt_pk_bf16_f32 %0, %1, %2" : "=v"(r) : "v"(lo), "v"(hi)); return r; }
typedef float f32x2 __attribute__((ext_vector_type(2)));
__device__ __forceinline__ f32x2 gelu_pk(f32x2 v) {
    const f32x2 av = __builtin_elementwise_abs(v), d = av * 0.2316418882f + 1.0f;
    f32x2 t; t.x = __builtin_amdgcn_rcpf(d.x); t.y = __builtin_amdgcn_rcpf(d.y);
    f32x2 q = t * 0.5307027145f + (-0.7265760135f); q = q * t + 0.7107068705f; q = q * t + (-0.142248368f); q = q * t + 0.127414796f; q = q * t;
    const f32x2 s = (v * v) * (-0.72134752044f);
    f32x2 e; e.x = __builtin_amdgcn_exp2f(s.x); e.y = __builtin_amdgcn_exp2f(s.y);
    const f32x2 m = v * (q * e), r = v - m;
    f32x2 o; o.x = v.x < 0.f ? m.x : r.x; o.y = v.y < 0.f ? m.y : r.y; return o;
}

template <int ACT  > struct EpiBf16 {
    static constexpr bool PERM = true, AFTER_DRAIN = false; static_assert(ACT == 0 || ACT == 1, "EpiBf16: ACT is 0 (none) or 1 (gelu_pk)");
    bf16_t* O; int ldc; const float* bias; int split_cols; size_t split_stride; float scale0;
    __device__ __forceinline__ void operator()(const f32x4 (&acc)[2][2][4][2], const Unit& u, int wr, int wc, int fr, int fq) const {
        const int row0 = u.pm * BM + wr * 64 + fr; int colt = u.pn * BM; bf16_t* base = O;
        float sc = 1.f; if (split_cols) { const int t = colt / split_cols; base += (size_t)t * split_stride; colt -= t * split_cols; if (t == 0) sc = scale0; }
        const int col0 = colt + wc * 32 + 8 * fq, bcol0 = u.pn * BM + wc * 32 + 8 * fq;
        f32x4 bv[2][2];
#pragma unroll
        for (int bj = 0; bj < 2; ++bj)
#pragma unroll
            for (int n = 0; n < 2; ++n) bv[bj][n] = bias ? *(const f32x4*)(bias + bcol0 + bj * HALF + 4 * n) : (f32x4){0.f, 0.f, 0.f, 0.f};
#pragma unroll
        for (int ai = 0; ai < 2; ++ai)
#pragma unroll
            for (int m = 0; m < 4; ++m) { bf16_t* rowp = base + (size_t)(row0 + ai * HALF + m * 16) * ldc + col0;
#pragma unroll
                for (int bj = 0; bj < 2; ++bj) { f32x4 v0 = acc[ai][bj][m][0] + bv[bj][0], v1 = acc[ai][bj][m][1] + bv[bj][1];
                    if (ACT == 1) { f32x2 a = gelu_pk((f32x2){v0[0], v0[1]}), b = gelu_pk((f32x2){v0[2], v0[3]}), c = gelu_pk((f32x2){v1[0], v1[1]}), d = gelu_pk((f32x2){v1[2], v1[3]});
                        v0 = (f32x4){a.x, a.y, b.x, b.y}; v1 = (f32x4){c.x, c.y, d.x, d.y}; }
                    v0 = v0 * sc; v1 = v1 * sc; u32x4 w; w.x = cvt_pk_bf16(v0[0], v0[1]); w.y = cvt_pk_bf16(v0[2], v0[3]); w.z = cvt_pk_bf16(v1[0], v1[1]); w.w = cvt_pk_bf16(v1[2], v1[3]);
                    *(u32x4*)(rowp + bj * HALF) = w; } }
    }
};

struct PanelStats {
    unsigned* xbuf;
    unsigned* cnt;
    unsigned* tmo;
    int ntn; float eps;
    unsigned code;
    __device__ __forceinline__ bool run(const f32x4 (&v)[2][2][4][2], const Unit& u, int wr, int wc, int fr, int fq, PG8_LAS unsigned char* lds, int wid, int lane) const {
        typedef float f32x2v __attribute__((ext_vector_type(2)));
        PG8_LAS f32x2v* P = (PG8_LAS f32x2v*)lds;
        PG8_LAS f32x2v* S = (PG8_LAS f32x2v*)(lds + 8192);
        PG8_LAS unsigned* flag = (PG8_LAS unsigned*)(lds + 8192 + 2048);
#pragma unroll
        for (int ai = 0; ai < 2; ++ai)
#pragma unroll
            for (int m = 0; m < 4; ++m) {
                float s = 0.f;
#pragma unroll
                for (int bj = 0; bj < 2; ++bj)
#pragma unroll
                    for (int n = 0; n < 2; ++n) { const f32x4 x = v[ai][bj][m][n]; s += (x[0] + x[1]) + (x[2] + x[3]); }
                s += __shfl_xor(s, 16); s += __shfl_xor(s, 32);
                const float mw = s * (1.0f / 64.0f); float q = 0.f;
#pragma unroll
                for (int bj = 0; bj < 2; ++bj)
#pragma unroll
                    for (int n = 0; n < 2; ++n) { const f32x4 d = v[ai][bj][m][n] - mw; q += (d[0] * d[0] + d[1] * d[1]) + (d[2] * d[2] + d[3] * d[3]); }
                q += __shfl_xor(q, 16); q += __shfl_xor(q, 32);
                if (fq == 0) P[(ai * HALF + wr * 64 + m * 16 + fr) * 4 + wc] = (f32x2v){mw, q};
            }
        asm volatile("s_waitcnt lgkmcnt(0)" ::: "memory"); __builtin_amdgcn_s_barrier(); asm volatile("" ::: "memory");
#if defined(BROKEN_EXCHANGE_NO_WAIT)
#warning BROKEN CONTROL BUILD: the row-statistics exchange does not wait; results are wrong by design
        if (blockIdx.x >= 64) { const long long t0_ = clock64(); while (clock64() - t0_ < 60000) __builtin_amdgcn_s_sleep(8); }
#endif
        const int row = wid * 32 + (lane & 31);
        if (lane < 32) {
            const f32x2v a = P[row * 4 + 0], b = P[row * 4 + 1], c = P[row * 4 + 2], d = P[row * 4 + 3];
            const float mt = (a.x + b.x + c.x + d.x) * 0.25f;
            const float da = a.x - mt, db = b.x - mt, dc = c.x - mt, dd = d.x - mt;
            const float m2 = (a.y + b.y) + (c.y + d.y) + 64.0f * ((da * da + db * db) + (dc * dc + dd * dd));
            unsigned long long* slot = (unsigned long long*)xbuf + ((size_t)(u.pm * BM + row) * 4 + u.pn);
            __hip_atomic_store(slot, ((unsigned long long)__float_as_uint(m2) << 32) | __float_as_uint(mt), __ATOMIC_RELAXED, __HIP_MEMORY_SCOPE_AGENT);
        }
        asm volatile("s_waitcnt vmcnt(0)" ::: "memory");
        if (lane == 0) __hip_atomic_fetch_add(cnt + 64 * u.pm, 1u, __ATOMIC_RELAXED, __HIP_MEMORY_SCOPE_AGENT);
        if (wid == 0) {
            bool dead = false; const unsigned long long t0 = __builtin_amdgcn_s_memrealtime(); const unsigned want = 8u * (unsigned)ntn;
            for (;;) {
#if defined(BROKEN_EXCHANGE_NO_WAIT)
                break;
#endif
                if ((unsigned)__builtin_amdgcn_readfirstlane(__hip_atomic_load(cnt + 64 * u.pm, __ATOMIC_RELAXED, __HIP_MEMORY_SCOPE_AGENT)) >= want) break;
                if (__builtin_amdgcn_s_memrealtime() - t0 > 2000000ull) {
                    if (lane == 0) { unsigned expect = 0u; __hip_atomic_compare_exchange_strong(tmo + 1, &expect, code | (unsigned)(u.pm & 0xff), __ATOMIC_RELAXED, __ATOMIC_RELAXED, __HIP_MEMORY_SCOPE_AGENT);
                                     __hip_atomic_store(tmo, 1u, __ATOMIC_RELAXED, __HIP_MEMORY_SCOPE_AGENT); }
                    dead = true; break; }
                __builtin_amdgcn_s_sleep(2);
            }
            __builtin_amdgcn_fence(__ATOMIC_ACQUIRE, "agent");
            if (lane == 0) flag[0] = dead ? 1u : 0u;
        }
        asm volatile("s_waitcnt vmcnt(0) lgkmcnt(0)" ::: "memory"); __builtin_amdgcn_s_barrier(); asm volatile("" ::: "memory");
        const bool bad = flag[0] != 0u;
        if (lane < 32) {
            const unsigned long long* slot = (const unsigned long long*)xbuf + (size_t)(u.pm * BM + row) * 4; float mt[4], m2[4]; float ms = 0.f;
#pragma unroll
            for (int t = 0; t < 4; ++t) { if (t < ntn) { const unsigned long long w = __hip_atomic_load(slot + t, __ATOMIC_RELAXED, __HIP_MEMORY_SCOPE_AGENT); mt[t] = __uint_as_float((unsigned)w); m2[t] = __uint_as_float((unsigned)(w >> 32)); } else { mt[t] = 0.f; m2[t] = 0.f; } ms += mt[t]; }
            const float mean = ms / (float)ntn; float q = 0.f;
#pragma unroll
            for (int t = 0; t < 4; ++t) if (t < ntn) { const float dm = mt[t] - mean; q += m2[t] + 256.0f * dm * dm; }
            S[row] = (f32x2v){mean, 1.0f / sqrtf(q / (256.0f * (float)ntn) + eps)};
        }
        asm volatile("s_waitcnt lgkmcnt(0)" ::: "memory"); __builtin_amdgcn_s_barrier(); asm volatile("" ::: "memory");
        return bad;
    }
};
struct EpiLnRes {
    static constexpr bool PERM = false, AFTER_DRAIN = true;
    const float* base; float* out; int ldc; const float* bias; PanelStats st; unsigned poison;
    __device__ __forceinline__ void fused(f32x4 (&acc)[2][2][4][2], const Unit& u, int wr, int wc, int fr, int fq, PG8_LAS unsigned char* lds, int wid, int lane) const {
        typedef float f32x2v __attribute__((ext_vector_type(2)));
        const PG8_LAS f32x2v* S = (const PG8_LAS f32x2v*)(lds + 8192);
        const int col0 = u.pn * BM + wc * 32 + 4 * fq;
#pragma unroll
        for (int bj = 0; bj < 2; ++bj)
#pragma unroll
            for (int n = 0; n < 2; ++n) { const f32x4 bv = bias ? *(const f32x4*)(bias + col0 + bj * HALF + n * 16) : (f32x4){0.f, 0.f, 0.f, 0.f};
#pragma unroll
                for (int ai = 0; ai < 2; ++ai)
#pragma unroll
                    for (int m = 0; m < 4; ++m) acc[ai][bj][m][n] += bv; }
        f32x4 pre[4][2][2];
#pragma unroll
        for (int m = 0; m < 4; ++m) { const size_t off = (size_t)(u.pm * BM + wr * 64 + m * 16 + fr) * ldc + col0;
#pragma unroll
            for (int bj = 0; bj < 2; ++bj)
#pragma unroll
                for (int n = 0; n < 2; ++n) pre[m][bj][n] = *(const f32x4*)(base + off + bj * HALF + n * 16); }
        const bool bad = st.run(acc, u, wr, wc, fr, fq, lds, wid, lane) || poison != 0u;
        const float qnan = __builtin_nanf("");
#pragma unroll
        for (int ai = 0; ai < 2; ++ai)
#pragma unroll
            for (int m = 0; m < 4; ++m) { const int r = ai * HALF + wr * 64 + m * 16 + fr; const f32x2v sr = S[r]; const size_t off = (size_t)(u.pm * BM + r) * ldc + col0;
#pragma unroll
                for (int bj = 0; bj < 2; ++bj)
#pragma unroll
                    for (int n = 0; n < 2; ++n) { const f32x4 bs = ai == 0 ? pre[m][bj][n] : *(const f32x4*)(base + off + bj * HALF + n * 16); f32x4 o = bs + (acc[ai][bj][m][n] - sr.x) * sr.y;
                        if (bad) o = (f32x4){qnan, qnan, qnan, qnan}; *(f32x4*)(out + off + bj * HALF + n * 16) = o; }
                if (m & 1) asm volatile("" ::: "memory"); }
    }
};
struct EpiLnResLn {
    static constexpr bool PERM = false, AFTER_DRAIN = true;
    const float* base; float* out; bf16_t* xn; int ldc; const float* bias; PanelStats st1, st2; unsigned poison;
    __device__ __forceinline__ void fused(f32x4 (&acc)[2][2][4][2], const Unit& u, int wr, int wc, int fr, int fq, PG8_LAS unsigned char* lds, int wid, int lane) const {
        typedef float f32x2v __attribute__((ext_vector_type(2))); typedef unsigned u32x2v __attribute__((ext_vector_type(2)));
        const PG8_LAS f32x2v* S = (const PG8_LAS f32x2v*)(lds + 8192);
        const int col0 = u.pn * BM + wc * 32 + 4 * fq;
#pragma unroll
        for (int bj = 0; bj < 2; ++bj)
#pragma unroll
            for (int n = 0; n < 2; ++n) { const f32x4 bv = bias ? *(const f32x4*)(bias + col0 + bj * HALF + n * 16) : (f32x4){0.f, 0.f, 0.f, 0.f};
#pragma unroll
                for (int ai = 0; ai < 2; ++ai)
#pragma unroll
                    for (int m = 0; m < 4; ++m) acc[ai][bj][m][n] += bv; }
        bool bad = st1.run(acc, u, wr, wc, fr, fq, lds, wid, lane) || poison != 0u;
        const float qnan = __builtin_nanf("");
#pragma unroll
        for (int ai = 0; ai < 2; ++ai)
#pragma unroll
            for (int m = 0; m < 4; ++m) { const int r = ai * HALF + wr * 64 + m * 16 + fr; const f32x2v sr = S[r]; const size_t off = (size_t)(u.pm * BM + r) * ldc + col0;
#pragma unroll
                for (int bj = 0; bj < 2; ++bj)
#pragma unroll
                    for (int n = 0; n < 2; ++n) { const f32x4 bs = *(const f32x4*)(base + off + bj * HALF + n * 16); acc[ai][bj][m][n] = bs + (acc[ai][bj][m][n] - sr.x) * sr.y; }
                asm volatile("" : "+v"(acc[ai][0][m][0]), "+v"(acc[ai][0][m][1]), "+v"(acc[ai][1][m][0]), "+v"(acc[ai][1][m][1]));
                if (m & 1) asm volatile("" ::: "memory"); }
        const bool bad1 = bad;
        bad = st2.run(acc, u, wr, wc, fr, fq, lds, wid, lane) || bad;
#pragma unroll
        for (int ai = 0; ai < 2; ++ai)
#pragma unroll
            for (int m = 0; m < 4; ++m) { const int r = ai * HALF + wr * 64 + m * 16 + fr; const f32x2v sr = S[r]; const size_t off = (size_t)(u.pm * BM + r) * ldc + col0;
#pragma unroll
                for (int bj = 0; bj < 2; ++bj)
#pragma unroll
                    for (int n = 0; n < 2; ++n) { const f32x4 x1 = acc[ai][bj][m][n]; *(f32x4*)(out + off + bj * HALF + n * 16) = bad1 ? (f32x4){qnan, qnan, qnan, qnan} : x1;
                        const f32x4 o = (x1 - sr.x) * sr.y; u32x2v w; w.x = cvt_pk_bf16(o[0], o[1]); w.y = cvt_pk_bf16(o[2], o[3]);
                        if (bad) { w.x = 0x7fc07fc0u; w.y = 0x7fc07fc0u; } *(u32x2v*)(xn + off + bj * HALF + n * 16) = w; }
                asm volatile("" ::: "memory"); }
    }
};

template <class Epi, class Sched, bool ALIGN_EPI = false, bool SP2 = false>
__device__ __forceinline__ void gemm_phase(PG8_LAS unsigned char* lds, const Gemm g, const Sched& S, const Epi& E, int tid_) {
    asm volatile("" : "+v"(tid_));
    const int tid = tid_, wid = __builtin_amdgcn_readfirstlane(tid >> 6), lane = tid & 63, wr = wid >> 2, wc = wid & 3, fr = lane & 15, fq = lane >> 4;
    const int K = g.K, nt = K / BK;
    unsigned voffA[2], voffB[2];
#pragma unroll
    for (int i = 0; i < 2; ++i) { int R, C; stage_rc(tid * 16 + i * 8192, R, C); const int Rb = Epi::PERM ? ((R & ~31) + perm32(R & 31)) : R;
        voffA[i] = (unsigned)(R * K + C) * 2u; voffB[i] = (unsigned)(Rb * K + C) * 2u; }
    const size_t kstep = (size_t)(BK * 2);
    const size_t hstep = (size_t)HALF * K * 2;
    const size_t tstep = 2 * hstep;
    const unsigned ldsw = (unsigned)wid * 1024u;
    const int aoff = lds_byte(wr * 64 + fr, fq * 8), boff = lds_byte(wc * 32 + fr, fq * 8);
#define PG8_SA(b, h) (((b) * 2 + (h)) * HTB)
#define PG8_SB(b, h) ((4 + (b) * 2 + (h)) * HTB)
#define PG8_STAGE(bufoff, gbase, voff) do { _Pragma("unroll") for (int _i = 0; _i < 2; ++_i) \
        __builtin_amdgcn_global_load_lds((const unsigned*)((const char*)(gbase) + (voff)[_i]), (PG8_LAS unsigned*)(lds + (bufoff) + ldsw + _i * 8192), 16, 0, 0); } while (0)
#define PG8_LDA(dst, b, h) do { _Pragma("unroll") for (int m = 0; m < 4; ++m) _Pragma("unroll") for (int k = 0; k < 2; ++k) dst[m][k] = *(const PG8_LAS bf16x8*)(lds + PG8_SA(b, h) + aoff + m * 2048 + k * 1024); } while (0)
#define PG8_LDB(dst, b, h) do { _Pragma("unroll") for (int n = 0; n < 2; ++n) _Pragma("unroll") for (int k = 0; k < 2; ++k) dst[n][k] = *(const PG8_LAS bf16x8*)(lds + PG8_SB(b, h) + boff + n * 2048 + k * 1024); } while (0)
#define PG8_MMA(ai, bj, At, Bt) do { __builtin_amdgcn_s_setprio(1); _Pragma("unroll") for (int m = 0; m < 4; ++m) _Pragma("unroll") for (int n = 0; n < 2; ++n) _Pragma("unroll") for (int k = 0; k < 2; ++k) \
        acc[ai][bj][m][n] = __builtin_amdgcn_mfma_f32_16x16x32_bf16(Bt[n][k], At[m][k], acc[ai][bj][m][n], 0, 0, 0); __builtin_amdgcn_s_setprio(0); } while (0)
#define PG8_WAIT_V(n) asm volatile("s_waitcnt vmcnt(" #n ")" ::: "memory")
#define PG8_WAIT_L(n) asm volatile("s_waitcnt lgkmcnt(" #n ")" ::: "memory")
#define PG8_BAR __builtin_amdgcn_s_barrier()
#define PG8_SCHED __builtin_amdgcn_sched_barrier(0)
    Unit cur, nxt; int ui = 0;
    if (!S.next(0, cur)) return;
    f32x4 acc[2][2][4][2];
#pragma unroll
    for (int a = 0; a < 2; ++a)
#pragma unroll
        for (int b = 0; b < 2; ++b)
#pragma unroll
            for (int m = 0; m < 4; ++m)
#pragma unroll
                for (int n = 0; n < 2; ++n) acc[a][b][m][n] = (f32x4){0.f, 0.f, 0.f, 0.f};
    bf16x8 At[4][2], B0[2][2], B1[2][2];
    const char* cA = (const char*)g.A + (size_t)cur.pm * tstep; const char* cB = (const char*)g.Bt + (size_t)cur.pn * tstep;
    S.a_ready(cur);
    if constexpr (SP2) {
        PG8_STAGE(PG8_SB(0, 0), cB, voffB); PG8_STAGE(PG8_SB(0, 1), cB + hstep, voffB); PG8_STAGE(PG8_SA(0, 0), cA, voffA); PG8_STAGE(PG8_SA(0, 1), cA + hstep, voffA);
        if (wr == 1) PG8_BAR;
        PG8_WAIT_V(2); PG8_BAR;
        PG8_STAGE(PG8_SB(1, 0), cB + kstep, voffB); PG8_STAGE(PG8_SA(1, 0), cA + kstep, voffA); PG8_STAGE(PG8_SB(1, 1), cB + hstep + kstep, voffB);
        PG8_WAIT_V(6); PG8_BAR;
    } else {
        PG8_STAGE(PG8_SB(0, 0), cB, voffB); PG8_STAGE(PG8_SA(0, 0), cA, voffA); PG8_STAGE(PG8_SB(0, 1), cB + hstep, voffB); PG8_STAGE(PG8_SA(0, 1), cA + hstep, voffA);
        if (wr == 1) PG8_BAR;
        PG8_WAIT_V(4); PG8_BAR;
        PG8_STAGE(PG8_SB(1, 0), cB + kstep, voffB); PG8_STAGE(PG8_SA(1, 0), cA + kstep, voffA); PG8_STAGE(PG8_SB(1, 1), cB + hstep + kstep, voffB);
        PG8_WAIT_V(6); PG8_BAR;
    }
    for (;;) {
        const bool has_next = S.next(ui + 1, nxt);
        const char* nA = has_next ? (const char*)g.A + (size_t)nxt.pm * tstep : cA; const char* nB = has_next ? (const char*)g.Bt + (size_t)nxt.pn * tstep : cB;
        for (int t = 0; t < nt; t += 2) {
            const bool last = (t == nt - 2);
            const char* a1 = cA + (size_t)(t + 1) * kstep;
            const char* a2 = last ? nA : cA + (size_t)(t + 2) * kstep; const char* b2 = last ? nB : cB + (size_t)(t + 2) * kstep;
            const char* a3 = a2 + kstep; const char* b3 = b2 + kstep;
            if (last && has_next) S.a_ready(nxt);
            if constexpr (SP2) {
            PG8_LDB(B0, 0, 0); PG8_LDB(B1, 0, 1); PG8_SCHED; PG8_LDA(At, 0, 0); PG8_STAGE(PG8_SA(1, 1), a1 + hstep, voffA);
            PG8_WAIT_V(8); PG8_WAIT_L(0); PG8_BAR; PG8_MMA(0, 0, At, B0); PG8_MMA(0, 1, At, B1); PG8_BAR; PG8_SCHED;
            PG8_LDA(At, 0, 1); PG8_STAGE(PG8_SB(0, 0), b2, voffB); PG8_STAGE(PG8_SB(0, 1), b2 + hstep, voffB); PG8_STAGE(PG8_SA(0, 0), a2, voffA);
            PG8_WAIT_V(8); PG8_WAIT_L(0); PG8_BAR; PG8_MMA(1, 0, At, B0); PG8_MMA(1, 1, At, B1); PG8_BAR; PG8_SCHED;
            PG8_LDB(B0, 1, 0); PG8_LDB(B1, 1, 1); PG8_SCHED; PG8_LDA(At, 1, 0); PG8_STAGE(PG8_SA(0, 1), a2 + hstep, voffA);
            PG8_WAIT_V(8); PG8_WAIT_L(0); PG8_BAR; PG8_MMA(0, 0, At, B0); PG8_MMA(0, 1, At, B1); PG8_BAR; PG8_SCHED;
            PG8_LDA(At, 1, 1); PG8_STAGE(PG8_SB(1, 0), b3, voffB); PG8_STAGE(PG8_SB(1, 1), b3 + hstep, voffB); PG8_STAGE(PG8_SA(1, 0), a3, voffA);
            PG8_WAIT_V(8); PG8_WAIT_L(0); PG8_BAR; PG8_MMA(1, 0, At, B0); PG8_MMA(1, 1, At, B1); PG8_BAR; PG8_SCHED;
            } else {
            PG8_LDB(B0, 0, 0); PG8_SCHED; PG8_LDA(At, 0, 0); PG8_STAGE(PG8_SA(1, 1), a1 + hstep, voffA);
            PG8_WAIT_L(8); PG8_BAR; PG8_WAIT_L(0); PG8_MMA(0, 0, At, B0); PG8_BAR; PG8_SCHED;
            PG8_LDB(B1, 0, 1); PG8_STAGE(PG8_SB(0, 0), b2, voffB);
            PG8_BAR; PG8_WAIT_L(0); PG8_MMA(0, 1, At, B1); PG8_BAR;
            PG8_LDA(At, 0, 1); PG8_STAGE(PG8_SA(0, 0), a2, voffA);
            PG8_BAR; PG8_WAIT_L(0); PG8_MMA(1, 0, At, B0); PG8_BAR; PG8_SCHED;
            PG8_STAGE(PG8_SB(0, 1), b2 + hstep, voffB);
            PG8_WAIT_V(6); PG8_BAR; PG8_MMA(1, 1, At, B1); PG8_BAR;
            PG8_LDB(B0, 1, 0); PG8_SCHED; PG8_LDA(At, 1, 0); PG8_STAGE(PG8_SA(0, 1), a2 + hstep, voffA);
            PG8_WAIT_L(8); PG8_BAR; PG8_WAIT_L(0); PG8_MMA(0, 0, At, B0); PG8_BAR; PG8_SCHED;
            PG8_LDB(B1, 1, 1); PG8_STAGE(PG8_SB(1, 0), b3, voffB);
            PG8_BAR; PG8_WAIT_L(0); PG8_MMA(0, 1, At, B1); PG8_BAR;
            PG8_LDA(At, 1, 1); PG8_STAGE(PG8_SA(1, 0), a3, voffA);
            PG8_BAR; PG8_WAIT_L(0); PG8_MMA(1, 0, At, B0); PG8_BAR; PG8_SCHED;
            PG8_STAGE(PG8_SB(1, 1), b3 + hstep, voffB);
            PG8_WAIT_V(6); PG8_BAR; PG8_MMA(1, 1, At, B1); PG8_BAR;
            }
        }
        if constexpr (ALIGN_EPI) { if (wr == 0) PG8_BAR; }
        if constexpr (!Epi::AFTER_DRAIN) { E(acc, cur, wr, wc, fr, fq); S.done(cur); }
        if (!has_next) break;
#pragma unroll
        for (int a = 0; a < 2; ++a)
#pragma unroll
            for (int b = 0; b < 2; ++b)
#pragma unroll
                for (int m = 0; m < 4; ++m)
#pragma unroll
                    for (int n = 0; n < 2; ++n) acc[a][b][m][n] = (f32x4){0.f, 0.f, 0.f, 0.f};
        cur = nxt; cA = nA; cB = nB; ++ui;
        if constexpr (ALIGN_EPI) { if (wr == 1) PG8_BAR; }
    }
    PG8_WAIT_V(0);
    if constexpr (!ALIGN_EPI) { if (wr == 0) PG8_BAR; }
    PG8_BAR;
    if constexpr (Epi::AFTER_DRAIN) { E.fused(acc, cur, wr, wc, fr, fq, lds, wid, lane); S.done(cur); }
#undef PG8_SA
#undef PG8_SB
#undef PG8_STAGE
#undef PG8_LDA
#undef PG8_LDB
#undef PG8_MMA
#undef PG8_WAIT_V
#undef PG8_WAIT_L
#undef PG8_BAR
#undef PG8_SCHED
}
}

namespace hp {
typedef unsigned short bf16_t;
typedef short bf16x8 __attribute__((ext_vector_type(8)));
typedef short s16x4 __attribute__((ext_vector_type(4)));
typedef float f32x4 __attribute__((ext_vector_type(4)));
typedef float f32x16 __attribute__((ext_vector_type(16)));
typedef unsigned u32x4 __attribute__((ext_vector_type(4)));
typedef unsigned u32x2 __attribute__((ext_vector_type(2)));

constexpr int NB = 4, SEQ = 4096, DM = 4096, NL = 4, MT = NB * SEQ;
constexpr int NIN = 11800, NINP = 12032, DFF = 11008, NGU = 2 * DFF;
constexpr int C_RQ = 0, C_RK = 1024, C_RV = 2048, C_RG = 3072, C_SQ = 4096, C_SK = 5120, C_SV = 6144, C_LG = 7168, C_LR = 8192,
              C_NQ = 9216, C_NKC = 10240, C_NVC = 10496, C_NKS = 10752, C_NVS = 11008, C_NKW = 11264, C_NVW = 11520, C_NG = 11776;
constexpr int MIX_RET = 0, MIX_SB = 1024, MIX_LRU = 2048, MIX_NSA = 3072;
constexpr int NTHR = 512, NWAVE = 8;
constexpr int LDS_STAGE = 131072, LDS_CTL = 256, RT_PANELS = 24, LDS_RT = RT_PANELS * 256 * 4, LDS_BYTES = LDS_STAGE + LDS_CTL + LDS_RT;

enum { I_X = 0, I_ANW, I_WIN, I_LCW, I_LCB, I_LWA, I_LBA, I_LWX, I_LBX, I_LLAM, I_NQW, I_NKW, I_CPOS, I_CW1, I_CW2, I_WOUT, I_MNW, I_WG, I_WU, I_MCW, I_MCB, I_WD, N_INPUTS };

constexpr size_t al256(size_t x) { return (x + 255) & ~(size_t)255; }
constexpr size_t WS_CTL   = 0;
constexpr size_t CTL_BYTES = 65536;
constexpr size_t WS_RSS   = WS_CTL + CTL_BYTES;
constexpr size_t WS_TAB_RC = WS_RSS + (size_t)2 * MT * 64 * 4;
constexpr size_t WS_TAB_RS = WS_TAB_RC + (size_t)SEQ * 64 * 4;
constexpr size_t WS_TAB_NC = WS_TAB_RS + (size_t)SEQ * 64 * 4;
constexpr size_t WS_TAB_NS = WS_TAB_NC + (size_t)SEQ * 16 * 4;
constexpr size_t WS_WIN   = WS_TAB_NS + (size_t)SEQ * 16 * 4;
constexpr size_t WS_WOUT  = WS_WIN  + (size_t)NINP * DM * 2;
constexpr size_t WS_WGU   = WS_WOUT + (size_t)DM * DM * 2;
constexpr size_t WS_WDN   = WS_WGU  + (size_t)NGU * DM * 2;
constexpr size_t WS_CW1   = WS_WDN  + (size_t)DM * DFF * 2;
constexpr size_t WS_CW2   = WS_CW1  + (size_t)2 * 4096 * 256 * 2;
constexpr size_t WS_LWA   = WS_CW2  + (size_t)2 * 256 * 128 * 2;
constexpr size_t WS_LWX   = WS_LWA  + (size_t)8 * 128 * 128 * 2;
constexpr size_t WS_HN    = WS_LWX  + (size_t)8 * 128 * 128 * 2;
constexpr size_t WS_MIX   = WS_HN   + (size_t)MT * DM * 2;
constexpr size_t WS_PROJ  = WS_MIX  + (size_t)MT * DM * 2;
constexpr size_t WS_GU    = WS_PROJ;
constexpr size_t WS_H     = WS_PROJ + (size_t)MT * NGU * 2;
constexpr size_t WS_QR    = WS_H    + (size_t)MT * DFF * 2;
constexpr size_t WS_KR    = WS_QR   + (size_t)MT * 1024 * 2;
constexpr size_t WS_QN    = WS_KR   + (size_t)MT * 1024 * 2;
constexpr size_t WS_KSN   = WS_QN   + (size_t)MT * 1024 * 2;
constexpr size_t WS_KWN   = WS_KSN  + (size_t)MT * 256 * 2;
constexpr size_t WS_KCMP  = WS_KWN  + (size_t)MT * 256 * 2;
constexpr size_t WS_VCMP  = WS_KCMP + (size_t)8 * 256 * 128 * 2;
constexpr size_t WS_ST    = WS_VCMP + (size_t)8 * 256 * 128 * 2;
constexpr size_t WS_HLOC  = WS_ST   + (size_t)32 * 32 * 128 * 128 * 2;
constexpr size_t WS_CUMA  = WS_HLOC + (size_t)MT * 1024 * 4;
constexpr size_t WS_YNSA  = WS_CUMA + (size_t)MT * 1024 * 4;
constexpr size_t WS_GT    = WS_YNSA + (size_t)MT * 1024 * 4;
constexpr size_t WS_GH    = WS_GT   + (size_t)256 * 2 * DFF * 2;
constexpr size_t WS_UH    = WS_GH   + (size_t)256 * 2 * DFF * 2;
constexpr size_t WS_CPOS  = WS_UH   + (size_t)256 * 2 * DFF * 2;
constexpr size_t WS_WDN2  = WS_CPOS + 2 * 256 * 4;
constexpr size_t WS_END   = WS_WDN2 + (size_t)DM * DFF * 2;
constexpr int CW_BAR = 0;
constexpr int CW_RSFLAG = 8192;
constexpr int CW_QUEUE = 4096;

struct Params {
    const float* in[N_INPUTS];
    float* out;
    unsigned char* ws;
    int l_lo, l_hi, ph_lo, ph_hi;
};
typedef const __attribute__((address_space(4))) Params* KP;

__device__ __forceinline__ float bf2f(unsigned short v) { return __uint_as_float(((unsigned)v) << 16); }
__device__ __forceinline__ float bflo(unsigned w) { return __uint_as_float(w << 16); }
__device__ __forceinline__ float bfhi(unsigned w) { return __uint_as_float(w & 0xffff0000u); }
__device__ __forceinline__ unsigned cvt_pk(float lo, float hi) { unsigned r; asm volatile("v_cvt_pk_bf16_f32 %0, %1, %2" : "=v"(r) : "v"(lo), "v"(hi)); return r; }
__device__ __forceinline__ unsigned short f2bf(float f) { return (unsigned short)(cvt_pk(f, 0.f) & 0xffffu); }
__device__ __forceinline__ float fexp2(float x) { return __builtin_amdgcn_exp2f(x); }
__device__ __forceinline__ float flog2(float x) { return __builtin_amdgcn_logf(x); }
__device__ __forceinline__ float frcp(float x) { return __builtin_amdgcn_rcpf(x); }
__device__ __forceinline__ float sigmoidf_(float x) { return frcp(1.f + fexp2(-x * 1.4426950408889634f)); }
__device__ __forceinline__ float gelu_tanh(float x) {
    const float u = 0.7978845608028654f * (x + 0.044715f * x * x * x);
    const float t = 1.f - 2.f * frcp(1.f + fexp2(2.f * 1.4426950408889634f * u));
    return 0.5f * x * (1.f + t);
}
__device__ __forceinline__ float half_max(float v) { auto r = __builtin_amdgcn_permlane32_swap(__float_as_uint(v), __float_as_uint(v), false, false); return fmaxf(__uint_as_float(r[0]), __uint_as_float(r[1])); }
__device__ __forceinline__ float half_sum(float v) { auto r = __builtin_amdgcn_permlane32_swap(__float_as_uint(v), __float_as_uint(v), false, false); return __uint_as_float(r[0]) + __uint_as_float(r[1]); }
__device__ __forceinline__ float wave_sum(float v) {
#pragma unroll
    for (int o = 32; o >= 1; o >>= 1) v += __shfl_xor(v, o);
    return v;
}

__device__ __forceinline__ unsigned off_b(unsigned row, unsigned ch) { return 256u * row + 16u * (ch ^ (((row & 3u) << 2) | ((row >> 2) & 3u))); }
__device__ __forceinline__ bf16x8 row_frag(const LAS unsigned char* tile, int r0, int s, int lane) {
    return *(const LAS bf16x8*)(tile + off_b((unsigned)(r0 + (lane & 31)), (unsigned)(2 * s + (lane >> 5))));
}
__device__ __forceinline__ unsigned lds_addr(const LAS unsigned char* p) { return (unsigned)(size_t)p; }
__device__ __forceinline__ unsigned tr_off_nat(int lane, int c, int ks, int t) {
    const unsigned h = lane >> 5, blk = (lane >> 4) & 1, q = (lane & 15) >> 2, p = lane & 3;
    return off_b(16u * ks + 8u * h + 4u * t + q, 4u * c + 2u * blk + (p >> 1)) + 8u * (p & 1);
}
__device__ __forceinline__ unsigned tr_off_acc(int lane, int c, int ks, int t) {
    const unsigned h = lane >> 5, blk = (lane >> 4) & 1, q = (lane & 15) >> 2, p = lane & 3;
    return off_b(16u * ks + 8u * t + 4u * h + q, 4u * c + 2u * blk + (p >> 1)) + 8u * (p & 1);
}
__device__ __forceinline__ bf16x8 tr_read2(unsigned a0, unsigned a1) {
    s16x4 lo, hi;
    asm volatile("ds_read_b64_tr_b16 %0, %2\n\tds_read_b64_tr_b16 %1, %3\n\ts_waitcnt lgkmcnt(0)" : "=&v"(lo), "=&v"(hi) : "v"(a0), "v"(a1) : "memory");
    return __builtin_shufflevector(lo, hi, 0, 1, 2, 3, 4, 5, 6, 7);
}
__device__ __forceinline__ void tr_frag_nat2(const LAS unsigned char* t0, const LAS unsigned char* t1, int c, int ks, int lane, bf16x8& f0, bf16x8& f1) {
    const unsigned o0 = tr_off_nat(lane, c, ks, 0), o1 = tr_off_nat(lane, c, ks, 1), b0 = lds_addr(t0), b1 = lds_addr(t1);
    s16x4 l0, h0, l1, h1;
    asm volatile("ds_read_b64_tr_b16 %0, %4\n\tds_read_b64_tr_b16 %1, %5\n\tds_read_b64_tr_b16 %2, %6\n\tds_read_b64_tr_b16 %3, %7\n\ts_waitcnt lgkmcnt(0)"
                 : "=&v"(l0), "=&v"(h0), "=&v"(l1), "=&v"(h1) : "v"(b0 + o0), "v"(b0 + o1), "v"(b1 + o0), "v"(b1 + o1) : "memory");
    f0 = __builtin_shufflevector(l0, h0, 0, 1, 2, 3, 4, 5, 6, 7); f1 = __builtin_shufflevector(l1, h1, 0, 1, 2, 3, 4, 5, 6, 7);
}
__device__ __forceinline__ bf16x8 tr_frag_nat(const LAS unsigned char* tile, int c, int ks, int lane) {
    const unsigned b = lds_addr(tile);
    return tr_read2(b + tr_off_nat(lane, c, ks, 0), b + tr_off_nat(lane, c, ks, 1));
}
struct TrAcc { unsigned a[4][2]; };
__device__ __forceinline__ void tr_acc_init(TrAcc& A, int lane) {
#pragma unroll
    for (int c = 0; c < 4; ++c)
#pragma unroll
        for (int t = 0; t < 2; ++t) A.a[c][t] = tr_off_acc(lane, c, 0, t);
}
__device__ __forceinline__ void pv_step(f32x16 (&o)[4], unsigned vb  , const TrAcc& A, bf16x8 pf) {
    s16x4 d0, d1, d2, d3, d4, d5, d6, d7;
    asm volatile("ds_read_b64_tr_b16 %0, %8\n\tds_read_b64_tr_b16 %1, %9\n\tds_read_b64_tr_b16 %2, %10\n\tds_read_b64_tr_b16 %3, %11\n\t"
                 "ds_read_b64_tr_b16 %4, %12\n\tds_read_b64_tr_b16 %5, %13\n\tds_read_b64_tr_b16 %6, %14\n\tds_read_b64_tr_b16 %7, %15\n\ts_waitcnt lgkmcnt(0)"
                 : "=&v"(d0), "=&v"(d1), "=&v"(d2), "=&v"(d3), "=&v"(d4), "=&v"(d5), "=&v"(d6), "=&v"(d7)
                 : "v"(vb + A.a[0][0]), "v"(vb + A.a[0][1]), "v"(vb + A.a[1][0]), "v"(vb + A.a[1][1]), "v"(vb + A.a[2][0]), "v"(vb + A.a[2][1]), "v"(vb + A.a[3][0]), "v"(vb + A.a[3][1]) : "memory");
    o[0] = __builtin_amdgcn_mfma_f32_32x32x16_bf16(__builtin_shufflevector(d0, d1, 0, 1, 2, 3, 4, 5, 6, 7), pf, o[0], 0, 0, 0);
    o[1] = __builtin_amdgcn_mfma_f32_32x32x16_bf16(__builtin_shufflevector(d2, d3, 0, 1, 2, 3, 4, 5, 6, 7), pf, o[1], 0, 0, 0);
    o[2] = __builtin_amdgcn_mfma_f32_32x32x16_bf16(__builtin_shufflevector(d4, d5, 0, 1, 2, 3, 4, 5, 6, 7), pf, o[2], 0, 0, 0);
    o[3] = __builtin_amdgcn_mfma_f32_32x32x16_bf16(__builtin_shufflevector(d6, d7, 0, 1, 2, 3, 4, 5, 6, 7), pf, o[3], 0, 0, 0);
}
__device__ __forceinline__ f32x16 qk_block(const LAS unsigned char* ktile, int kb, const bf16x8 (&qf)[8], int lane) {
    f32x16 acc;
#pragma unroll
    for (int i = 0; i < 16; ++i) acc[i] = 0.f;
#pragma unroll
    for (int s = 0; s < 8; ++s) acc = __builtin_amdgcn_mfma_f32_32x32x16_bf16(row_frag(ktile, 32 * kb, s, lane), qf[s], acc, 0, 0, 0);
    return acc;
}
__device__ __forceinline__ void qk_tile(const LAS unsigned char* ktile, const bf16x8 (&qf)[8], int lane, f32x16& s0, f32x16& s1) {
#pragma unroll
    for (int i = 0; i < 16; ++i) { s0[i] = 0.f; s1[i] = 0.f; }
#pragma unroll
    for (int s = 0; s < 8; ++s) {
        const bf16x8 a0 = row_frag(ktile, 0, s, lane), a1 = row_frag(ktile, 32, s, lane);
        s0 = __builtin_amdgcn_mfma_f32_32x32x16_bf16(a0, qf[s], s0, 0, 0, 0);
        s1 = __builtin_amdgcn_mfma_f32_32x32x16_bf16(a1, qf[s], s1, 0, 0, 0);
    }
}
struct KFrag4 { bf16x8 a, b, c, d; };
__device__ __forceinline__ void k_issue4(KFrag4& f, unsigned a0, unsigned a1, unsigned a2, unsigned a3) {
    asm volatile("ds_read_b128 %0, %4\n\tds_read_b128 %1, %5\n\tds_read_b128 %2, %6\n\tds_read_b128 %3, %7" : "=&v"(f.a), "=&v"(f.b), "=&v"(f.c), "=&v"(f.d) : "v"(a0), "v"(a1), "v"(a2), "v"(a3) : "memory");
}
__device__ __forceinline__ void k_wait4(KFrag4& f) { asm volatile("s_waitcnt lgkmcnt(4)" : "+v"(f.a), "+v"(f.b), "+v"(f.c), "+v"(f.d) :: "memory"); }
__device__ __forceinline__ void k_wait0(KFrag4& f) { asm volatile("s_waitcnt lgkmcnt(0)" : "+v"(f.a), "+v"(f.b), "+v"(f.c), "+v"(f.d) :: "memory"); }
__device__ __forceinline__ void qk_tile_pipe(const LAS unsigned char* ktile, const bf16x8 (&qf)[8], int lane, f32x16& s0, f32x16& s1) {
#pragma unroll
    for (int i = 0; i < 16; ++i) { s0[i] = 0.f; s1[i] = 0.f; }
    const unsigned kb = lds_addr(ktile), r0 = (unsigned)(lane & 31), h = (unsigned)(lane >> 5);
#define KA_(row_, s_) (kb + off_b((row_), 2u * (s_) + h))
    KFrag4 A, B;
    k_issue4(A, KA_(r0, 0), KA_(r0, 1), KA_(r0, 2), KA_(r0, 3));
    k_issue4(B, KA_(r0, 4), KA_(r0, 5), KA_(r0, 6), KA_(r0, 7));
    k_wait4(A);
    s0 = __builtin_amdgcn_mfma_f32_32x32x16_bf16(A.a, qf[0], s0, 0, 0, 0); s0 = __builtin_amdgcn_mfma_f32_32x32x16_bf16(A.b, qf[1], s0, 0, 0, 0);
    s0 = __builtin_amdgcn_mfma_f32_32x32x16_bf16(A.c, qf[2], s0, 0, 0, 0); s0 = __builtin_amdgcn_mfma_f32_32x32x16_bf16(A.d, qf[3], s0, 0, 0, 0);
    k_issue4(A, KA_(r0 + 32u, 0), KA_(r0 + 32u, 1), KA_(r0 + 32u, 2), KA_(r0 + 32u, 3));
    k_wait4(B);
    s0 = __builtin_amdgcn_mfma_f32_32x32x16_bf16(B.a, qf[4], s0, 0, 0, 0); s0 = __builtin_amdgcn_mfma_f32_32x32x16_bf16(B.b, qf[5], s0, 0, 0, 0);
    s0 = __builtin_amdgcn_mfma_f32_32x32x16_bf16(B.c, qf[6], s0, 0, 0, 0); s0 = __builtin_amdgcn_mfma_f32_32x32x16_bf16(B.d, qf[7], s0, 0, 0, 0);
    k_issue4(B, KA_(r0 + 32u, 4), KA_(r0 + 32u, 5), KA_(r0 + 32u, 6), KA_(r0 + 32u, 7));
    k_wait4(A);
    s1 = __builtin_amdgcn_mfma_f32_32x32x16_bf16(A.a, qf[0], s1, 0, 0, 0); s1 = __builtin_amdgcn_mfma_f32_32x32x16_bf16(A.b, qf[1], s1, 0, 0, 0);
    s1 = __builtin_amdgcn_mfma_f32_32x32x16_bf16(A.c, qf[2], s1, 0, 0, 0); s1 = __builtin_amdgcn_mfma_f32_32x32x16_bf16(A.d, qf[3], s1, 0, 0, 0);
    k_wait0(B);
    s1 = __builtin_amdgcn_mfma_f32_32x32x16_bf16(B.a, qf[4], s1, 0, 0, 0); s1 = __builtin_amdgcn_mfma_f32_32x32x16_bf16(B.b, qf[5], s1, 0, 0, 0);
    s1 = __builtin_amdgcn_mfma_f32_32x32x16_bf16(B.c, qf[6], s1, 0, 0, 0); s1 = __builtin_amdgcn_mfma_f32_32x32x16_bf16(B.d, qf[7], s1, 0, 0, 0);
#undef KA_
}
__device__ __forceinline__ f32x16 qk_block_pipe(const LAS unsigned char* ktile, int kb, const bf16x8 (&qf)[8], int lane) {
    f32x16 acc;
#pragma unroll
    for (int i = 0; i < 16; ++i) acc[i] = 0.f;
    const unsigned kbase = lds_addr(ktile), r0 = (unsigned)(32 * kb + (lane & 31)), h = (unsigned)(lane >> 5);
#define KA_(s_) (kbase + off_b(r0, 2u * (s_) + h))
    KFrag4 A, B;
    k_issue4(A, KA_(0), KA_(1), KA_(2), KA_(3));
    k_issue4(B, KA_(4), KA_(5), KA_(6), KA_(7));
    k_wait4(A);
    acc = __builtin_amdgcn_mfma_f32_32x32x16_bf16(A.a, qf[0], acc, 0, 0, 0); acc = __builtin_amdgcn_mfma_f32_32x32x16_bf16(A.b, qf[1], acc, 0, 0, 0);
    acc = __builtin_amdgcn_mfma_f32_32x32x16_bf16(A.c, qf[2], acc, 0, 0, 0); acc = __builtin_amdgcn_mfma_f32_32x32x16_bf16(A.d, qf[3], acc, 0, 0, 0);
    k_wait0(B);
    acc = __builtin_amdgcn_mfma_f32_32x32x16_bf16(B.a, qf[4], acc, 0, 0, 0); acc = __builtin_amdgcn_mfma_f32_32x32x16_bf16(B.b, qf[5], acc, 0, 0, 0);
    acc = __builtin_amdgcn_mfma_f32_32x32x16_bf16(B.c, qf[6], acc, 0, 0, 0); acc = __builtin_amdgcn_mfma_f32_32x32x16_bf16(B.d, qf[7], acc, 0, 0, 0);
#undef KA_
    return acc;
}
__device__ __forceinline__ bf16x8 pack8(const f32x16& p, int s2) {
    u32x4 w; w.x = cvt_pk(p[8 * s2 + 0], p[8 * s2 + 1]); w.y = cvt_pk(p[8 * s2 + 2], p[8 * s2 + 3]); w.z = cvt_pk(p[8 * s2 + 4], p[8 * s2 + 5]); w.w = cvt_pk(p[8 * s2 + 6], p[8 * s2 + 7]);
    return __builtin_bit_cast(bf16x8, w);
}
template <int ROWS> struct TileRegs { u32x4 r[ROWS * 16 / NTHR]; };
template <int ROWS> __device__ __forceinline__ void tile_load(TileRegs<ROWS>& R, const bf16_t* src, size_t ld, int tid) {
#pragma unroll
    for (int i = 0; i < ROWS * 16 / NTHR; ++i) { const int c = tid + NTHR * i; R.r[i] = *(const u32x4*)(src + (size_t)(c >> 4) * ld + (c & 15) * 8); }
}
template <int ROWS> __device__ __forceinline__ void tile_store(LAS unsigned char* tile, const TileRegs<ROWS>& R, int tid) {
#pragma unroll
    for (int i = 0; i < ROWS * 16 / NTHR; ++i) { const int c = tid + NTHR * i; *(LAS u32x4*)(tile + off_b((unsigned)(c >> 4), (unsigned)(c & 15))) = R.r[i]; }
}
template <int ROWS> __device__ __forceinline__ void tile_stage(LAS unsigned char* tile, const bf16_t* src, size_t ld, int tid) {
    TileRegs<ROWS> R; tile_load<ROWS>(R, src, ld, tid); tile_store<ROWS>(tile, R, tid);
}
__device__ __forceinline__ void unpack8(const u32x4 v, float (&x)[8]) {
    x[0] = bflo(v.x); x[1] = bfhi(v.x); x[2] = bflo(v.y); x[3] = bfhi(v.y); x[4] = bflo(v.z); x[5] = bfhi(v.z); x[6] = bflo(v.w); x[7] = bfhi(v.w);
}
__device__ __forceinline__ u32x4 pack8f(const float (&x)[8]) {
    u32x4 w; w.x = cvt_pk(x[0], x[1]); w.y = cvt_pk(x[2], x[3]); w.z = cvt_pk(x[4], x[5]); w.w = cvt_pk(x[6], x[7]); return w;
}
__device__ __forceinline__ void ld8f(const float* src, float (&x)[8]) {
    const f32x4 a = *(const f32x4*)src, b = *(const f32x4*)(src + 4);
    x[0] = a[0]; x[1] = a[1]; x[2] = a[2]; x[3] = a[3]; x[4] = b[0]; x[5] = b[1]; x[6] = b[2]; x[7] = b[3];
}
__device__ __forceinline__ void tile_dma64(LAS unsigned char* tile, const bf16_t* src, size_t ld, int tid, int wave) {
#pragma unroll
    for (int i = 0; i < 2; ++i) {
        const int c = tid + NTHR * i, row = c >> 4, pos = c & 15, ch = pos ^ (((row & 3) << 2) | ((row >> 2) & 3));
        __builtin_amdgcn_global_load_lds((const unsigned*)(src + (size_t)row * ld + ch * 8), (LAS unsigned*)(tile + (wave * 64 + NTHR * i) * 16), 16, 0, 0);
    }
}
__device__ __forceinline__ int lane_id_now() { int l; asm volatile("v_mbcnt_lo_u32_b32 %0, -1, 0\n\tv_mbcnt_hi_u32_b32 %0, -1, %0" : "=v"(l)); return l; }
__device__ __forceinline__ int next_task_n(unsigned* ctr, int n, volatile LAS int* slot, int tid) {
    __syncthreads();
    if (tid == 0) { int v = (int)__hip_atomic_load(ctr, __ATOMIC_RELAXED, __HIP_MEMORY_SCOPE_AGENT); if (v < n) v = (int)__hip_atomic_fetch_add(ctr, 1u, __ATOMIC_RELAXED, __HIP_MEMORY_SCOPE_AGENT); *slot = v < n ? v : n; }
    __syncthreads();
    return *slot;
}
__device__ __forceinline__ int next_task(unsigned* ctr, volatile LAS int* slot, int tid) {
    __syncthreads();
    if (tid == 0) *slot = (int)__hip_atomic_fetch_add(ctr, 1u, __ATOMIC_RELAXED, __HIP_MEMORY_SCOPE_AGENT);
    __syncthreads();
    return *slot;
}
#define QUEUE_LOOP(ctr_, n_, ...) do { int t = next_task((ctr_), slot, tid); while (t < (n_)) { \
        int nx_ = 0; if (tid == 0) nx_ = (int)__hip_atomic_fetch_add((ctr_), 1u, __ATOMIC_RELAXED, __HIP_MEMORY_SCOPE_AGENT); \
        { __VA_ARGS__; } \
        __syncthreads(); if (tid == 0) *slot = nx_; __syncthreads(); t = *slot; } } while (0)

struct CvTask { const float* W; const float* gain; bf16_t* Bt; int K, N, k0, n0, gu; };
__device__ __forceinline__ CvTask cv_task(KP p, int l, int t8) {
    CvTask c; int tt = t8, ntn;
    c.gu = 0;
    c.gain = nullptr;
    if (tt < 1504) { c.W = p->in[I_WIN] + (size_t)l * 4096 * NIN; c.K = 4096; c.N = NIN; c.Bt = (bf16_t*)(p->ws + WS_WIN); ntn = 47; c.gain = p->in[I_ANW] + (size_t)l * DM; }
    else if ((tt -= 1504) < 512) { c.W = p->in[I_WOUT] + (size_t)l * 4096 * 4096; c.K = 4096; c.N = 4096; c.Bt = (bf16_t*)(p->ws + WS_WOUT); ntn = 16; }
    else if ((tt -= 512) < 1376) { c.W = p->in[I_WG] + (size_t)l * 4096 * DFF; c.K = 4096; c.N = DFF; c.Bt = (bf16_t*)(p->ws + WS_WGU); ntn = 43; c.gain = p->in[I_MNW] + (size_t)l * DM; c.gu = 1; }
    else if ((tt -= 1376) < 1376) { c.W = p->in[I_WU] + (size_t)l * 4096 * DFF; c.K = 4096; c.N = DFF; c.Bt = (bf16_t*)(p->ws + WS_WGU); ntn = 43; c.gain = p->in[I_MNW] + (size_t)l * DM; c.gu = 2; }
    else { tt -= 1376; c.W = p->in[I_WD] + (size_t)l * DFF * 4096; c.K = DFF; c.N = 4096; c.Bt = (bf16_t*)(p->ws + ((l & 1) ? WS_WDN2 : WS_WDN)); ntn = 16; }
    const int kt = tt / ntn, nt = tt - kt * ntn; c.k0 = kt * 128; c.n0 = nt * 256;
    return c;
}
__device__ __forceinline__ void cv_load(const CvTask& c, f32x4 (&v)[2][4][2], int tid) {
    const int r = tid >> 4, c4 = (tid & 15) * 4;
#pragma unroll
    for (int kk = 0; kk < 2; ++kk)
#pragma unroll
        for (int sub = 0; sub < 4; ++sub)
#pragma unroll
            for (int i = 0; i < 2; ++i) {
                const int k = c.k0 + 64 * kk + 2 * r + i, n = c.n0 + 64 * sub + c4;
                v[kk][sub][i] = (f32x4){0.f, 0.f, 0.f, 0.f};
                if (n < c.N) v[kk][sub][i] = __builtin_nontemporal_load((const f32x4*)(c.W + (size_t)k * c.N + n));
            }
}
__device__ __forceinline__ void cv_store(const CvTask& c, const f32x4 (&v)[2][4][2], LAS unsigned* T, int tid) {
    const int r = tid >> 4, c4 = (tid & 15) * 4;
#pragma unroll
    for (int kk = 0; kk < 2; ++kk) {
        float g0 = 1.f, g1 = 1.f;
        if (c.gain) { g0 = c.gain[c.k0 + 64 * kk + 2 * r]; g1 = c.gain[c.k0 + 64 * kk + 2 * r + 1]; }
#pragma unroll
        for (int sub = 0; sub < 4; ++sub)
#pragma unroll
            for (int j = 0; j < 4; ++j) T[((kk * 4 + sub) * 64 + c4 + j) * 33 + r] = cvt_pk(v[kk][sub][0][j] * g0, v[kk][sub][1][j] * g1);
    }
    __syncthreads();
    {
        const int nl = tid >> 3, kq = (tid & 7) * 4;
#pragma unroll
        for (int kk = 0; kk < 2; ++kk)
#pragma unroll
            for (int sub = 0; sub < 4; ++sub) {
                const LAS unsigned* s = T + ((kk * 4 + sub) * 64 + nl) * 33 + kq;
                u32x4 w; w.x = s[0]; w.y = s[1]; w.z = s[2]; w.w = s[3];
                const int n = c.n0 + 64 * sub;
                const int drow = c.gu ? 256 * (n >> 7) + 128 * (c.gu - 1) + (n & 127) + nl : n + nl;
                *(u32x4*)(c.Bt + (size_t)drow * c.K + c.k0 + 64 * kk + 2 * kq) = w;
            }
    }
    __syncthreads();
}
__device__ __forceinline__ void convert_range(KP p, int l, int t, int tend, int step, LAS unsigned char* lds, int tid) {
    asm volatile("" : "+v"(tid), "+s"(p));
    if (t >= tend) return;
    LAS unsigned* T0 = (LAS unsigned*)lds;
    f32x4 va[2][4][2], vb[2][4][2];
    __syncthreads();
    CvTask A = cv_task(p, l, t), B = A; cv_load(A, va, tid);
    for (;;) {
        const int t1 = t + step; const bool h1 = t1 < tend;
        if (h1) { B = cv_task(p, l, t1); cv_load(B, vb, tid); }
        cv_store(A, va, T0, tid);
        if (!h1) break;
        t = t1 + step; const bool h0 = t < tend;
        if (h0) { A = cv_task(p, l, t); cv_load(A, va, tid); }
        cv_store(B, vb, T0, tid);
        if (!h0) break;
    }
}
__device__ __forceinline__ void convert_small(KP p, int l, int tid, int bid, int G) {
    asm volatile("" : "+v"(tid), "+s"(p));
    {
        const size_t gtid = (size_t)bid * NTHR + tid, gstride = (size_t)G * NTHR;
        const float* s1 = p->in[I_CW1] + (size_t)l * 2 * 4096 * 256; bf16_t* d1 = (bf16_t*)(p->ws + WS_CW1);
        for (size_t i = gtid; i < (size_t)2 * 4096 * 256 / 4; i += gstride) { const f32x4 v = *(const f32x4*)(s1 + i * 4); u32x2 w; w.x = cvt_pk(v[0], v[1]); w.y = cvt_pk(v[2], v[3]); *(u32x2*)(d1 + i * 4) = w; }
        const float* s2 = p->in[I_CW2] + (size_t)l * 2 * 256 * 128; bf16_t* d2 = (bf16_t*)(p->ws + WS_CW2);
        for (size_t i = gtid; i < (size_t)2 * 256 * 128 / 4; i += gstride) { const f32x4 v = *(const f32x4*)(s2 + i * 4); u32x2 w; w.x = cvt_pk(v[0], v[1]); w.y = cvt_pk(v[2], v[3]); *(u32x2*)(d2 + i * 4) = w; }
        const float* s3 = p->in[I_LWA] + (size_t)l * 8 * 128 * 128; bf16_t* d3 = (bf16_t*)(p->ws + WS_LWA);
        for (size_t i = gtid; i < (size_t)8 * 128 * 128 / 4; i += gstride) { const f32x4 v = *(const f32x4*)(s3 + i * 4); u32x2 w; w.x = cvt_pk(v[0], v[1]); w.y = cvt_pk(v[2], v[3]); *(u32x2*)(d3 + i * 4) = w; }
        {
            const int lane = tid & 63, wave = tid >> 6; float* cp = (float*)(p->ws + WS_CPOS);
            for (int o = bid * NWAVE + wave; o < 512; o += G * NWAVE) {
                const int kv = o >> 8, h = o & 255; const float* ps = p->in[I_CPOS] + ((size_t)l * 2 + kv) * 4096; const float* w = s1 + (size_t)kv * 4096 * 256 + h;
                float a = 0.f;
                for (int k = lane; k < 4096; k += 64) a += ps[k] * w[(size_t)k * 256];
                a = wave_sum(a);
                if (lane == 0) cp[o] = a;
            }
        }
        const float* s4 = p->in[I_LWX] + (size_t)l * 8 * 128 * 128; bf16_t* d4 = (bf16_t*)(p->ws + WS_LWX);
        for (size_t i = gtid; i < (size_t)8 * 128 * 128 / 4; i += gstride) { const f32x4 v = *(const f32x4*)(s4 + i * 4); u32x2 w; w.x = cvt_pk(v[0], v[1]); w.y = cvt_pk(v[2], v[3]); *(u32x2*)(d4 + i * 4) = w; }
    }
}

__device__ __forceinline__ void sincos_acc(double x, float& sn, float& cs) {
    const double kf = rint(x * 0.63661977236758134308);
    const double r = fma(-kf, 6.123233995736766036e-17, fma(-kf, 1.5707963267948965580, x));
    const double z = r * r;
    const double sr = r + r * z * (-0.166666666416265235595 + z * (0.0083333293858894631756 + z * (-0.000198393348360966317347 + z * 0.0000027183114939898219064)));
    const double cr = 1.0 + z * (-0.499999997251031003120 + z * (0.0416666233237390631894 + z * (-0.00138867637746099294692 + z * 0.0000243904487962774090654)));
    const int n = ((int)kf) & 3;
    const double s = (n == 0) ? sr : (n == 1) ? cr : (n == 2) ? -sr : -cr;
    const double c = (n == 0) ? cr : (n == 1) ? -sr : (n == 2) ? -cr : sr;
    sn = (float)s; cs = (float)c;
}
__device__ __forceinline__ void ph_tables(KP p, int tid, int bid, int G) {
    asm volatile("" : "+v"(tid), "+s"(p));
    float* rc = (float*)(p->ws + WS_TAB_RC); float* rs = (float*)(p->ws + WS_TAB_RS); float* nc = (float*)(p->ws + WS_TAB_NC); float* ns = (float*)(p->ws + WS_TAB_NS);
    const int gtid = bid * NTHR + tid, gstride = G * NTHR;
    for (int i = gtid; i < SEQ * 64; i += gstride) {
        const int pos = i >> 6, f = i & 63;
        const double inv = exp2(-((double)f / 63.0) * 13.287712379549449);
        float s, c; sincos_acc((double)pos * inv, s, c); rc[i] = c; rs[i] = s;
    }
    for (int i = gtid; i < SEQ * 16; i += gstride) {
        const int pos = i >> 4, f = i & 15;
        const double inv = exp2(-((double)f / 16.0) * 18.931568569324174);
        float s, c; sincos_acc((double)pos * inv, s, c); nc[i] = c; ns[i] = s;
    }
}

__device__ __forceinline__ void ph_rmsnorm(const float* x, const float* w, bf16_t* hn, int tid, int bid, int G) {
    asm volatile("" : "+v"(tid));
    const int lane = tid & 63, wave = tid >> 6;
    for (int row = bid * NWAVE + wave; row < MT; row += G * NWAVE) {
        const float* xr = x + (size_t)row * DM;
        f32x4 v[16]; float ss = 0.f;
#pragma unroll
        for (int i = 0; i < 16; ++i) { v[i] = *(const f32x4*)(xr + (i * 64 + lane) * 4); ss += v[i][0] * v[i][0] + v[i][1] * v[i][1] + v[i][2] * v[i][2] + v[i][3] * v[i][3]; }
        ss = wave_sum(ss);
        const float r = 1.0f / sqrtf(ss * (1.0f / DM) + 1e-6f);
#pragma unroll
        for (int i = 0; i < 16; ++i) {
            const f32x4 g = *(const f32x4*)(w + (i * 64 + lane) * 4);
            u32x2 o; o.x = cvt_pk(v[i][0] * r * g[0], v[i][1] * r * g[1]); o.y = cvt_pk(v[i][2] * r * g[2], v[i][3] * r * g[3]);
            *(u32x2*)(hn + (size_t)row * DM + (i * 64 + lane) * 4) = o;
        }
    }
}

__device__ __forceinline__ void ph_mlp_act(KP p, int l, int tid, int bid, int G) {
    asm volatile("" : "+v"(tid), "+s"(p));
    const bf16_t* GU = (const bf16_t*)(p->ws + WS_GU); bf16_t* H = (bf16_t*)(p->ws + WS_H);
    const float* cw = p->in[I_MCW] + (size_t)l * 3 * DFF; const float* cb = p->in[I_MCB] + (size_t)l * DFF;
    constexpr int NFG = DFF / 8, NTG = MT / 8;
    for (int it = bid * NTHR + tid; it < NFG * NTG; it += G * NTHR) {
        const int tg = it / NFG, fg = it - tg * NFG, f0 = fg * 8, t0 = tg * 8;
        float w0[8], w1[8], w2[8], bb[8];
#pragma unroll
        for (int j = 0; j < 8; j += 4) {
            const f32x4 a = *(const f32x4*)(cw + f0 + j), b = *(const f32x4*)(cw + DFF + f0 + j), c = *(const f32x4*)(cw + 2 * DFF + f0 + j), d = *(const f32x4*)(cb + f0 + j);
#pragma unroll
            for (int q = 0; q < 4; ++q) { w0[j + q] = a[q]; w1[j + q] = b[q]; w2[j + q] = c[q]; bb[j + q] = d[q]; }
        }
        float gm2[8], gm1[8];
        const bool first = (t0 & (SEQ - 1)) == 0;
        {
            u32x4 a = (u32x4){0u, 0u, 0u, 0u}, b = (u32x4){0u, 0u, 0u, 0u};
            if (!first) { a = *(const u32x4*)(GU + (size_t)(t0 - 2) * NGU + f0); b = *(const u32x4*)(GU + (size_t)(t0 - 1) * NGU + f0); }
#pragma unroll
            for (int q = 0; q < 4; ++q) { gm2[2 * q] = bflo(a[q]); gm2[2 * q + 1] = bfhi(a[q]); gm1[2 * q] = bflo(b[q]); gm1[2 * q + 1] = bfhi(b[q]); }
        }
#pragma unroll
        for (int i = 0; i < 8; ++i) {
            const u32x4 gv = *(const u32x4*)(GU + (size_t)(t0 + i) * NGU + f0), uv = *(const u32x4*)(GU + (size_t)(t0 + i) * NGU + DFF + f0);
            float g0[8], up[8], hv[8];
#pragma unroll
            for (int q = 0; q < 4; ++q) { g0[2 * q] = bflo(gv[q]); g0[2 * q + 1] = bfhi(gv[q]); up[2 * q] = bflo(uv[q]); up[2 * q + 1] = bfhi(uv[q]); }
#pragma unroll
            for (int j = 0; j < 8; ++j) { const float y = bb[j] + w0[j] * gm2[j] + w1[j] * gm1[j] + w2[j] * g0[j]; hv[j] = y * sigmoidf_(y) * up[j]; gm2[j] = gm1[j]; gm1[j] = g0[j]; }
            u32x4 o; o.x = cvt_pk(hv[0], hv[1]); o.y = cvt_pk(hv[2], hv[3]); o.z = cvt_pk(hv[4], hv[5]); o.w = cvt_pk(hv[6], hv[7]);
            *(u32x4*)(H + (size_t)(t0 + i) * DFF + f0) = o;
        }
    }
}

struct EpiResid {
    static constexpr bool PERM = false, AFTER_DRAIN = false;
    const float* base; float* out; int ldc;
    __device__ __forceinline__ void operator()(const pg8::f32x4 (&acc)[2][2][4][2], const pg8::Unit& u, int wr, int wc, int fr, int fq) const {
        const int row0 = u.pm * 256 + wr * 64 + fr, col0 = u.pn * 256 + wc * 32 + 4 * fq;
#pragma unroll
        for (int ai = 0; ai < 2; ++ai)
#pragma unroll
            for (int m = 0; m < 4; ++m) { const size_t off = (size_t)(row0 + ai * 128 + m * 16) * ldc + col0;
#pragma unroll
                for (int bj = 0; bj < 2; ++bj)
#pragma unroll
                    for (int n = 0; n < 2; ++n) { const pg8::f32x4 bs = *(const pg8::f32x4*)(base + off + bj * 128 + n * 16); *(pg8::f32x4*)(out + off + bj * 128 + n * 16) = bs + acc[ai][bj][m][n]; }
                asm volatile("" ::: "memory"); }
    }
};

__device__ __forceinline__ void ph_xcvt(const float* x, bf16_t* xb, float* rowss, int tid, int bid, int G) {
    asm volatile("" : "+v"(tid));
    const int lane = tid & 63, wave = tid >> 6;
    for (int row = bid * NWAVE + wave; row < MT; row += G * NWAVE) {
        const float* xr = x + (size_t)row * DM;
        float ss = 0.f;
#pragma unroll
        for (int i = 0; i < 16; ++i) { const f32x4 v = *(const f32x4*)(xr + (i * 64 + lane) * 4); ss += v[0] * v[0] + v[1] * v[1] + v[2] * v[2] + v[3] * v[3];
            u32x2 o; o.x = cvt_pk(v[0], v[1]); o.y = cvt_pk(v[2], v[3]); *(u32x2*)(xb + (size_t)row * DM + (i * 64 + lane) * 4) = o; }
        ss = wave_sum(ss);
        rowss[(size_t)lane * MT + row] = (lane == 0) ? ss : 0.f;
    }
}
#ifdef EPI_NT
#define EPI_STORE16(ptr_, v_) __builtin_nontemporal_store((v_), (u32x4*)(ptr_))
#else
#define EPI_STORE16(ptr_, v_) (*(u32x4*)(ptr_) = (v_))
#endif
struct EpiBf16RS {
    static constexpr bool PERM = true, AFTER_DRAIN = false;
    bf16_t* O; int ldc; const LAS float* rt; int rbase;
    __device__ __forceinline__ void operator()(const pg8::f32x4 (&acc)[2][2][4][2], const pg8::Unit& u, int wr, int wc, int fr, int fq) const {
        const int row0 = u.pm * 256 + wr * 64 + fr, col0 = u.pn * 256 + wc * 32 + 8 * fq;
#pragma unroll
        for (int ai = 0; ai < 2; ++ai)
#pragma unroll
            for (int m = 0; m < 4; ++m) { const int row = row0 + ai * 128 + m * 16; const float rs = rt[row - rbase]; bf16_t* rowp = O + (size_t)row * ldc + col0;
#pragma unroll
                for (int bj = 0; bj < 2; ++bj) { const pg8::f32x4 v0 = acc[ai][bj][m][0] * rs, v1 = acc[ai][bj][m][1] * rs;
                    u32x4 w; w.x = cvt_pk(v0[0], v0[1]); w.y = cvt_pk(v0[2], v0[3]); w.z = cvt_pk(v1[0], v1[1]); w.w = cvt_pk(v1[2], v1[3]);
                    EPI_STORE16(rowp + bj * 128, w); } }
    }
};
__device__ __forceinline__ void in_gate_cols(KP p, int row0, const float* rowss, LAS unsigned char* lds, int tid) {
    asm volatile("" : "+v"(tid), "+s"(p));
    const int lane = tid & 63, wave = __builtin_amdgcn_readfirstlane(tid >> 6), hh = lane >> 5, rb = wave & 3, kh = wave >> 2;
    const bf16_t* arow = (const bf16_t*)(p->ws + WS_HN) + (size_t)(row0 + 32 * rb + (lane & 31)) * DM + kh * 2048 + 8 * hh;
    const bf16_t* brow = (const bf16_t*)(p->ws + WS_WIN) + (size_t)(C_NG + (lane & 31)) * DM + kh * 2048 + 8 * hh;
    f32x16 acc;
#pragma unroll
    for (int i = 0; i < 16; ++i) acc[i] = 0.f;
    bf16x8 a0[4], b0[4], a1[4], b1[4];
#pragma unroll
    for (int s8 = 0; s8 < 4; ++s8) { a0[s8] = *(const bf16x8*)(arow + 16 * s8); b0[s8] = *(const bf16x8*)(brow + 16 * s8); }
#pragma unroll 1
    for (int k0 = 0; k0 < 2048; k0 += 128) {
#pragma unroll
        for (int s8 = 0; s8 < 4; ++s8) { a1[s8] = *(const bf16x8*)(arow + k0 + 64 + 16 * s8); b1[s8] = *(const bf16x8*)(brow + k0 + 64 + 16 * s8); }
#pragma unroll
        for (int s8 = 0; s8 < 4; ++s8) acc = __builtin_amdgcn_mfma_f32_32x32x16_bf16(a0[s8], b0[s8], acc, 0, 0, 0);
        if (k0 + 128 < 2048) {
#pragma unroll
            for (int s8 = 0; s8 < 4; ++s8) { a0[s8] = *(const bf16x8*)(arow + k0 + 128 + 16 * s8); b0[s8] = *(const bf16x8*)(brow + k0 + 128 + 16 * s8); }
        }
#pragma unroll
        for (int s8 = 0; s8 < 4; ++s8) acc = __builtin_amdgcn_mfma_f32_32x32x16_bf16(a1[s8], b1[s8], acc, 0, 0, 0);
    }
    __syncthreads();
    LAS float* RED = (LAS float*)lds;
    LAS float* RS = RED + 4 * 16 * 64;
    if (tid < 128) { float t = 0.f;
#pragma unroll 16
        for (int i = 0; i < 64; ++i) t += rowss[(size_t)i * MT + row0 + tid];
        RS[tid] = 1.0f / sqrtf(t * (1.0f / DM) + 1e-6f); }
    if (kh == 1) {
#pragma unroll
        for (int r = 0; r < 16; ++r) RED[(rb * 16 + r) * 64 + lane] = acc[r];
    }
    __syncthreads();
    if (kh == 0) {
        bf16_t* PROJ = (bf16_t*)(p->ws + WS_PROJ);
        const int n = lane & 31;
#pragma unroll
        for (int r = 0; r < 16; ++r) {
            const int rl = 32 * rb + (r & 3) + 8 * (r >> 2) + 4 * hh;
            const float v = (acc[r] + RED[(rb * 16 + r) * 64 + lane]) * RS[rl];
            if (n < 24) PROJ[(size_t)(row0 + rl) * NINP + C_NG + n] = f2bf(v);
        }
    }
    __syncthreads();
}
struct EpiResid2 {
    static constexpr bool PERM = false, AFTER_DRAIN = false;
    const float* base; float* out; bf16_t* xb; float* rowss; int ldc; int wx;
    __device__ __forceinline__ void operator()(const pg8::f32x4 (&acc)[2][2][4][2], const pg8::Unit& u, int wr, int wc, int fr, int fq) const {
        const int row0 = u.pm * 256 + wr * 64 + fr, col0 = u.pn * 256 + wc * 32 + 4 * fq;
#pragma unroll
        for (int ai = 0; ai < 2; ++ai)
#pragma unroll
            for (int m = 0; m < 4; ++m) { const int row = row0 + ai * 128 + m * 16; const size_t off = (size_t)row * ldc + col0; float ss = 0.f;
#pragma unroll
                for (int bj = 0; bj < 2; ++bj)
#pragma unroll
                    for (int n = 0; n < 2; ++n) { const pg8::f32x4 bs = *(const pg8::f32x4*)(base + off + bj * 128 + n * 16); const pg8::f32x4 o = bs + acc[ai][bj][m][n];
                        *(pg8::f32x4*)(out + off + bj * 128 + n * 16) = o;
                        if (wx) { u32x2 w; w.x = cvt_pk(o[0], o[1]); w.y = cvt_pk(o[2], o[3]); *(u32x2*)(xb + off + bj * 128 + n * 16) = w; ss += (o[0] * o[0] + o[1] * o[1]) + (o[2] * o[2] + o[3] * o[3]); } }
                if (wx) { ss += __shfl_xor(ss, 16); ss += __shfl_xor(ss, 32); if (fq == 0) rowss[(size_t)(u.pn * 4 + wc) * MT + row] = ss; }
                asm volatile("" ::: "memory"); }
    }
};

template <class Sched> __device__ __forceinline__ int fill_rstd_table(const Sched& S, const float* rowss, LAS float* rt, int tid) {
    int lo = 1 << 30, hi = -1; pg8::Unit u;
    for (int i = 0; S.next(i, u); ++i) { lo = u.pm < lo ? u.pm : lo; hi = u.pm > hi ? u.pm : hi; }
    if (hi < 0) return 0;
    int n = (hi - lo + 1) * 256; if (n > RT_PANELS * 256) n = RT_PANELS * 256;
    for (int r4 = tid * 4; r4 < n; r4 += NTHR * 4) {
        const float* s = rowss + (size_t)lo * 256 + r4; f32x4 t = (f32x4){0.f, 0.f, 0.f, 0.f};
#pragma unroll 16
        for (int i = 0; i < 64; ++i) t += *(const f32x4*)(s + (size_t)i * MT);
#pragma unroll
        for (int q = 0; q < 4; ++q) rt[r4 + q] = 1.0f / sqrtf(t[q] * (1.0f / DM) + 1e-6f);
    }
    __syncthreads();
    return lo * 256;
}

__device__ __forceinline__ float dpp_ror1(float v) { return __int_as_float(__builtin_amdgcn_update_dpp(0, __float_as_int(v), 0x121, 0xf, 0xf, false)); }
__device__ __forceinline__ float dpp_ror2(float v) { return __int_as_float(__builtin_amdgcn_update_dpp(0, __float_as_int(v), 0x122, 0xf, 0xf, false)); }
struct EpiGateUp {
    static constexpr bool PERM = true, AFTER_DRAIN = false;
    bf16_t* H; const LAS float* rt; int rbase; const float* cw; const float* cb; bf16_t* GT; bf16_t* GH; bf16_t* UH;
    __device__ __forceinline__ void operator()(const pg8::f32x4 (&acc)[2][2][4][2], const pg8::Unit& u, int wr, int wc, int fr, int fq) const {
        const int f0 = u.pn * 128 + wc * 32 + 8 * fq;
        float w0[8], w1[8], w2[8], bb[8];
#pragma unroll
        for (int j = 0; j < 8; j += 4) {
            const f32x4 a = *(const f32x4*)(cw + f0 + j), b = *(const f32x4*)(cw + DFF + f0 + j), c = *(const f32x4*)(cw + 2 * DFF + f0 + j), d = *(const f32x4*)(cb + f0 + j);
#pragma unroll
            for (int q = 0; q < 4; ++q) { w0[j + q] = a[q]; w1[j + q] = b[q]; w2[j + q] = c[q]; bb[j + q] = d[q]; }
        }
#pragma unroll
        for (int ai = 0; ai < 2; ++ai) {
            const int c64 = u.pm * 4 + ai * 2 + wr;
            float gp[8];
#pragma unroll
            for (int j = 0; j < 8; ++j) gp[j] = 0.f;
#pragma unroll
            for (int m = 0; m < 4; ++m) {
                const int row = u.pm * 256 + ai * 128 + wr * 64 + m * 16 + fr;
                const float rs = rt[row - rbase];
                float g[8], uu[8], hv[8];
#pragma unroll
                for (int j = 0; j < 8; ++j) { g[j] = acc[ai][0][m][j >> 2][j & 3] * rs; uu[j] = acc[ai][1][m][j >> 2][j & 3] * rs; }
#pragma unroll
                for (int j = 0; j < 8; ++j) {
                    const float a1 = dpp_ror1(g[j]), a2 = dpp_ror2(g[j]), b1 = dpp_ror1(gp[j]), b2 = dpp_ror2(gp[j]);
                    const float g1 = (fr >= 1) ? a1 : b1, g2 = (fr >= 2) ? a2 : b2;
                    const float y = bb[j] + w0[j] * g2 + w1[j] * g1 + w2[j] * g[j];
                    hv[j] = y * sigmoidf_(y) * uu[j];
                }
                u32x4 hw; hw.x = cvt_pk(hv[0], hv[1]); hw.y = cvt_pk(hv[2], hv[3]); hw.z = cvt_pk(hv[4], hv[5]); hw.w = cvt_pk(hv[6], hv[7]);
                if (m > 0 || fr >= 2) EPI_STORE16(H + (size_t)row * DFF + f0, hw);
                if ((m == 0 && fr < 2) || (m == 3 && fr >= 14)) {
                    u32x4 gw; gw.x = cvt_pk(g[0], g[1]); gw.y = cvt_pk(g[2], g[3]); gw.z = cvt_pk(g[4], g[5]); gw.w = cvt_pk(g[6], g[7]);
                    if (m == 0) { u32x4 uw; uw.x = cvt_pk(uu[0], uu[1]); uw.y = cvt_pk(uu[2], uu[3]); uw.z = cvt_pk(uu[4], uu[5]); uw.w = cvt_pk(uu[6], uu[7]);
                        *(u32x4*)(GH + ((size_t)c64 * 2 + fr) * DFF + f0) = gw; *(u32x4*)(UH + ((size_t)c64 * 2 + fr) * DFF + f0) = uw; }
                    else *(u32x4*)(GT + ((size_t)c64 * 2 + (fr - 14)) * DFF + f0) = gw;
                }
#pragma unroll
                for (int j = 0; j < 8; ++j) gp[j] = g[j];
            }
        }
    }
};
__device__ __forceinline__ void ph_mlp_fix(KP p, int l, int tid, int bid, int G) {
    asm volatile("" : "+v"(tid), "+s"(p));
    const bf16_t* GT = (const bf16_t*)(p->ws + WS_GT); const bf16_t* GH = (const bf16_t*)(p->ws + WS_GH); const bf16_t* UH = (const bf16_t*)(p->ws + WS_UH); bf16_t* H = (bf16_t*)(p->ws + WS_H);
    const float* cw = p->in[I_MCW] + (size_t)l * 3 * DFF; const float* cb = p->in[I_MCB] + (size_t)l * DFF;
    constexpr int NFG = DFF / 8;
    for (int it = bid * NTHR + tid; it < NFG * 256; it += G * NTHR) {
        const int c64 = it / NFG, fg = it - c64 * NFG, f0 = fg * 8;
        float w0[8], w1[8], w2[8], bb[8], gm2[8], gm1[8], g0[8], g1[8], u0[8], u1[8], h0[8], h1[8];
        ld8f(cw + f0, w0); ld8f(cw + DFF + f0, w1); ld8f(cw + 2 * DFF + f0, w2); ld8f(cb + f0, bb);
        if ((c64 & 63) == 0) {
#pragma unroll
            for (int j = 0; j < 8; ++j) { gm2[j] = 0.f; gm1[j] = 0.f; }
        } else { unpack8(*(const u32x4*)(GT + ((size_t)(c64 - 1) * 2 + 0) * DFF + f0), gm2); unpack8(*(const u32x4*)(GT + ((size_t)(c64 - 1) * 2 + 1) * DFF + f0), gm1); }
        unpack8(*(const u32x4*)(GH + ((size_t)c64 * 2 + 0) * DFF + f0), g0); unpack8(*(const u32x4*)(GH + ((size_t)c64 * 2 + 1) * DFF + f0), g1);
        unpack8(*(const u32x4*)(UH + ((size_t)c64 * 2 + 0) * DFF + f0), u0); unpack8(*(const u32x4*)(UH + ((size_t)c64 * 2 + 1) * DFF + f0), u1);
#pragma unroll
        for (int j = 0; j < 8; ++j) {
            const float y0 = bb[j] + w0[j] * gm2[j] + w1[j] * gm1[j] + w2[j] * g0[j], y1 = bb[j] + w0[j] * gm1[j] + w1[j] * g0[j] + w2[j] * g1[j];
            h0[j] = y0 * sigmoidf_(y0) * u0[j]; h1[j] = y1 * sigmoidf_(y1) * u1[j];
        }
        *(u32x4*)(H + (size_t)(c64 * 64) * DFF + f0) = pack8f(h0); *(u32x4*)(H + (size_t)(c64 * 64 + 1) * DFF + f0) = pack8f(h1);
    }
}

struct EpiResid3 {
    static constexpr bool PERM = true, AFTER_DRAIN = false;
    const float* basef; bf16_t* xb; float* outf; float* rowss; int dry = 0;
    __device__ __forceinline__ void operator()(const pg8::f32x4 (&acc)[2][2][4][2], const pg8::Unit& u, int wr, int wc, int fr, int fq) const {
        const int row0 = u.pm * 256 + wr * 64 + fr, col0 = u.pn * 256 + wc * 32 + 8 * fq;
#pragma unroll
        for (int ai = 0; ai < 2; ++ai) {
            u32x4 bw[4][2];
            if (!basef) {
#pragma unroll
                for (int m = 0; m < 4; ++m) { const size_t off = (size_t)(row0 + ai * 128 + m * 16) * DM + col0;
#pragma unroll
                    for (int bj = 0; bj < 2; ++bj) bw[m][bj] = *(const u32x4*)(xb + off + bj * 128); }
            }
#pragma unroll
            for (int m = 0; m < 4; ++m) { const int row = row0 + ai * 128 + m * 16; const size_t off = (size_t)row * DM + col0; float ss = 0.f;
#pragma unroll
                for (int bj = 0; bj < 2; ++bj) {
                    float x[8];
                    if (basef) ld8f(basef + off + bj * 128, x); else unpack8(bw[m][bj], x);
#pragma unroll
                    for (int j = 0; j < 8; ++j) { x[j] += acc[ai][bj][m][j >> 2][j & 3]; ss += x[j] * x[j]; }
                    if (outf) { *(f32x4*)(outf + off + bj * 128) = (f32x4){x[0], x[1], x[2], x[3]}; *(f32x4*)(outf + off + bj * 128 + 4) = (f32x4){x[4], x[5], x[6], x[7]}; }
                    if (!outf) *(u32x4*)(xb + off + bj * 128) = pack8f(x);
                }
                if (!outf) { ss += __shfl_xor(ss, 16); ss += __shfl_xor(ss, 32); if (fq == 0) rowss[(size_t)(u.pn * 4 + wc) * MT + row] = ss; }
            }
        }
    }
};

__device__ __forceinline__ void ph_prep_elem(KP p, int l, int tid, int bid, int G) {
    asm volatile("" : "+v"(tid), "+s"(p));
    const int lane = tid & 63, wave = tid >> 6, hi = lane >> 3, j = lane & 7;
    const bf16_t* PROJ = (const bf16_t*)(p->ws + WS_PROJ);
    const float* rc = (const float*)(p->ws + WS_TAB_RC); const float* rs = (const float*)(p->ws + WS_TAB_RS); const float* nc = (const float*)(p->ws + WS_TAB_NC); const float* ns = (const float*)(p->ws + WS_TAB_NS);
    for (int it = bid * NWAVE + wave; it < MT * 2; it += G * NWAVE) {
        const int tok = it >> 1, grp = (it & 1) ? 3 : 1, b = tok >> 12, s = tok & (SEQ - 1);
        const bf16_t* prow = PROJ + (size_t)tok * NINP;
        if (grp < 2) {
            const int h = hi;
            const bf16_t* src = prow + (grp ? C_RK : C_RQ) + h * 128 + 8 * j;
            float x1[8], x2[8], c[8], sn[8];
            unpack8(*(const u32x4*)src, x1); unpack8(*(const u32x4*)(src + 64), x2);
            ld8f(rc + s * 64 + 8 * j, c); ld8f(rs + s * 64 + 8 * j, sn);
            const float lg2 = log2f(1.0f - exp2f(-5.0f - (float)h));
            const float e = (float)((s & 127) + 1) * lg2;
            const float d = grp ? fexp2(-e) * 0.08838834764831845f : fexp2(e);
            float o1[8], o2[8];
#pragma unroll
            for (int i = 0; i < 8; ++i) { o1[i] = (x1[i] * c[i] - x2[i] * sn[i]) * d; o2[i] = (x2[i] * c[i] + x1[i] * sn[i]) * d; }
            bf16_t* dst = (bf16_t*)(p->ws + (grp ? WS_KR : WS_QR)) + ((size_t)(b * 8 + h) * SEQ + s) * 128 + 8 * j;
            *(u32x4*)dst = pack8f(o1); *(u32x4*)(dst + 64) = pack8f(o2);
        } else {
            int col; const float* w; bf16_t* dst; bool act = true;
            if (grp == 2) { col = C_NQ + hi * 128; w = p->in[I_NQW] + (size_t)l * 128; dst = (bf16_t*)(p->ws + WS_QN) + ((size_t)(b * 8 + hi) * SEQ + s) * 128; }
            else if (hi < 2) { col = C_NKS + hi * 128; w = p->in[I_NKW] + (size_t)l * 3 * 128 + 128; dst = (bf16_t*)(p->ws + WS_KSN) + ((size_t)(b * 2 + hi) * SEQ + s) * 128; }
            else if (hi < 4) { col = C_NKW + (hi - 2) * 128; w = p->in[I_NKW] + (size_t)l * 3 * 128 + 256; dst = (bf16_t*)(p->ws + WS_KWN) + ((size_t)(b * 2 + hi - 2) * SEQ + s) * 128; }
            else { act = false; col = C_NQ; w = p->in[I_NQW]; dst = (bf16_t*)(p->ws + WS_QN); }
            float x1[8], x2[8], w1[8], w2[8];
            unpack8(*(const u32x4*)(prow + col + 8 * j), x1); unpack8(*(const u32x4*)(prow + col + 64 + 8 * j), x2);
            ld8f(w + 8 * j, w1); ld8f(w + 64 + 8 * j, w2);
            float ss = 0.f;
#pragma unroll
            for (int i = 0; i < 8; ++i) ss += x1[i] * x1[i] + x2[i] * x2[i];
            ss += __shfl_xor(ss, 1); ss += __shfl_xor(ss, 2); ss += __shfl_xor(ss, 4);
            const float r = 1.0f / sqrtf(ss * (1.0f / 128.0f) + 1e-6f);
            const float qs = (grp == 2) ? 0.08838834764831845f * 1.4426950408889634f : 1.0f;
            float c[8], sn[8], y1[8], y2[8], pr[8];
            ld8f(nc + s * 16 + 8 * (j & 1), c); ld8f(ns + s * 16 + 8 * (j & 1), sn);
#pragma unroll
            for (int i = 0; i < 8; ++i) { y1[i] = x1[i] * (r * qs) * w1[i]; y2[i] = x2[i] * (r * qs) * w2[i]; }
#pragma unroll
            for (int i = 0; i < 8; ++i) pr[i] = __shfl_xor(y1[i], 2);
            if (j < 4) {
#pragma unroll
                for (int i = 0; i < 8; ++i) y1[i] = (j < 2) ? (y1[i] * c[i] - pr[i] * sn[i]) : (y1[i] * c[i] + pr[i] * sn[i]);
            }
            if (act) { *(u32x4*)(dst + 8 * j) = pack8f(y1); *(u32x4*)(dst + 64 + 8 * j) = pack8f(y2); }
        }
    }
}

__device__ __forceinline__ void lru_c1_task(KP p, int l, int task, LAS unsigned char* lds, int tid) {
    asm volatile("" : "+v"(tid), "+s"(p));
    const int lane = tid & 63, wave = __builtin_amdgcn_readfirstlane(tid >> 6), hh = lane >> 5;
    const int grp = task & 15, n = (task >> 4) & 7, b = task >> 7;
    const bf16_t* PROJ = (const bf16_t*)(p->ws + WS_PROJ);
    LAS unsigned char* XB = lds;
    LAS float* AA = (LAS float*)lds;
    LAS float* X32 = (LAS float*)(lds + 32768);
    LAS unsigned char* WA = lds + 65536;
    LAS unsigned char* WX = lds + 98304;
    LAS float* SM = (LAS float*)(lds + LDS_STAGE + LDS_CTL);
    LAS float* CH = SM; LAS float* CP = SM + 128; LAS float* SH = SM + 256; LAS float* SP = SM + 768;
    tile_stage<128>(WA, (const bf16_t*)(p->ws + WS_LWA) + (size_t)n * 128 * 128, 128, tid);
    tile_stage<128>(WX, (const bf16_t*)(p->ws + WS_LWX) + (size_t)n * 128 * 128, 128, tid);
    if (tid < 128) { CH[tid] = 0.f; CP[tid] = 1.f; }
    const int tb = wave >> 2, db = wave & 3, dd = 32 * db + (lane & 31), chd = n * 128 + dd;
    const float ba = p->in[I_LBA][(size_t)l * 1024 + chd], bx = p->in[I_LBX][(size_t)l * 1024 + chd], lam = p->in[I_LLAM][(size_t)l * 1024 + chd];
    const float lsl = fminf(lam, 0.f) - log1pf(expf(-fabsf(lam)));
    const int ctt = tid >> 3, cc0 = (tid & 7) * 16, cch0 = n * 128 + cc0;
    float cwr[4][16], cbr[16];
    {
        const float* cw = p->in[I_LCW] + (size_t)l * 4 * 1024; const float* cb = p->in[I_LCB] + (size_t)l * 1024;
#pragma unroll
        for (int j = 0; j < 16; j += 4) { const f32x4 v = *(const f32x4*)(cb + cch0 + j); cbr[j] = v[0]; cbr[j + 1] = v[1]; cbr[j + 2] = v[2]; cbr[j + 3] = v[3]; }
#pragma unroll
        for (int k = 0; k < 4; ++k)
#pragma unroll
            for (int j = 0; j < 16; j += 4) { const f32x4 v = *(const f32x4*)(cw + k * 1024 + cch0 + j); cwr[k][j] = v[0]; cwr[k][j + 1] = v[1]; cwr[k][j + 2] = v[2]; cwr[k][j + 3] = v[3]; }
    }
    u32x4 rw[4][2];
#define C1_LOADROWS(s0_) do { _Pragma("unroll") for (int k = 0; k < 4; ++k) { const int s_ = (s0_) + ctt - 3 + k; rw[k][0] = (u32x4){0u, 0u, 0u, 0u}; rw[k][1] = (u32x4){0u, 0u, 0u, 0u}; \
        if (s_ >= 0) { const bf16_t* src = PROJ + (size_t)(b * SEQ + s_) * NINP + C_LR + cch0; rw[k][0] = *(const u32x4*)src; rw[k][1] = *(const u32x4*)(src + 8); } } } while (0)
    C1_LOADROWS(grp * 4 * 64);
    for (int ck = 0; ck < 4; ++ck) {
        const int s0 = (grp * 4 + ck) * 64;
        __syncthreads();
        {
            float acc[16];
#pragma unroll
            for (int j = 0; j < 16; ++j) acc[j] = cbr[j];
#pragma unroll
            for (int k = 0; k < 4; ++k)
#pragma unroll
                for (int j = 0; j < 16; j += 2) { const unsigned w = rw[k][j >> 3][(j >> 1) & 3]; acc[j] += cwr[k][j] * bflo(w); acc[j + 1] += cwr[k][j + 1] * bfhi(w); }
            if (ck + 1 < 4) C1_LOADROWS(s0 + 64);
#pragma unroll
            for (int j = 0; j < 16; j += 4) *(LAS f32x4*)(X32 + ctt * 128 + cc0 + j) = (f32x4){acc[j], acc[j + 1], acc[j + 2], acc[j + 3]};
            u32x4 o0, o1;
            o0.x = cvt_pk(acc[0], acc[1]); o0.y = cvt_pk(acc[2], acc[3]); o0.z = cvt_pk(acc[4], acc[5]); o0.w = cvt_pk(acc[6], acc[7]);
            o1.x = cvt_pk(acc[8], acc[9]); o1.y = cvt_pk(acc[10], acc[11]); o1.z = cvt_pk(acc[12], acc[13]); o1.w = cvt_pk(acc[14], acc[15]);
            *(LAS u32x4*)(XB + off_b((unsigned)ctt, (unsigned)(cc0 >> 3))) = o0; *(LAS u32x4*)(XB + off_b((unsigned)ctt, (unsigned)(cc0 >> 3) + 1u)) = o1;
        }
        __syncthreads();
        f32x16 ca, cx;
#pragma unroll
        for (int i = 0; i < 16; ++i) { ca[i] = 0.f; cx[i] = 0.f; }
#pragma unroll
        for (int s = 0; s < 8; ++s) {
            const bf16x8 a = row_frag(XB, 32 * tb, s, lane);
            bf16x8 bfa, bfx; tr_frag_nat2(WA, WX, db, s, lane, bfa, bfx);
            ca = __builtin_amdgcn_mfma_f32_32x32x16_bf16(a, bfa, ca, 0, 0, 0);
            cx = __builtin_amdgcn_mfma_f32_32x32x16_bf16(a, bfx, cx, 0, 0, 0);
        }
        __syncthreads();
#pragma unroll
        for (int r = 0; r < 16; ++r) {
            const int tok = 32 * tb + (r & 3) + 8 * (r >> 2) + 4 * hh;
            const float rg = sigmoidf_(ca[r] + ba), ig = sigmoidf_(cx[r] + bx);
            const float la = 8.0f * rg * lsl;
            const float a = expf(la);
            const float x2 = 2.0f * la;
            const float em1 = (x2 > -0.1f) ? x2 * (1.f + x2 * 0.5f * (1.f + x2 * (1.f / 3.f) * (1.f + x2 * 0.25f * (1.f + x2 * 0.2f)))) : (expf(x2) - 1.0f);
            float mult = sqrtf(fmaxf(-em1, 0.f));
            if (s0 + tok == 0) mult = 1.0f;
            AA[tok * 128 + dd] = a; X32[tok * 128 + dd] = mult * ig * X32[tok * 128 + dd];
        }
        __syncthreads();
        {
            const int ch = tid & 127, seg = tid >> 7;
            float hl[16], pl[16]; float h = 0.f, P = 1.f;
#pragma unroll
            for (int t = 0; t < 16; ++t) { const float a = AA[(16 * seg + t) * 128 + ch], u = X32[(16 * seg + t) * 128 + ch]; h = a * h + u; P *= a; hl[t] = h; pl[t] = P; }
            SH[seg * 128 + ch] = h; SP[seg * 128 + ch] = P;
            __syncthreads();
            float Hin = CH[ch], Pin = CP[ch];
#pragma unroll
            for (int s2 = 0; s2 < 3; ++s2) if (s2 < seg) { const float sp = SP[s2 * 128 + ch]; Hin = sp * Hin + SH[s2 * 128 + ch]; Pin *= sp; }
            bf16_t* hlg = (bf16_t*)(p->ws + WS_HLOC) + (size_t)(b * SEQ + s0 + 16 * seg) * 1024 + n * 128 + ch;
            bf16_t* cug = (bf16_t*)(p->ws + WS_CUMA) + (size_t)(b * SEQ + s0 + 16 * seg) * 1024 + n * 128 + ch;
            float hlast = 0.f, plast = 0.f;
#pragma unroll
            for (int t = 0; t < 16; ++t) { hlast = hl[t] + pl[t] * Hin; plast = pl[t] * Pin; hlg[(size_t)t * 1024] = f2bf(hlast); cug[(size_t)t * 1024] = f2bf(plast); }
            __syncthreads();
            if (seg == 3) { CH[ch] = hlast; CP[ch] = plast; }
        }
    }
#undef C1_LOADROWS
}

__device__ __forceinline__ void lru_c3_task(KP p, int task, LAS unsigned char* lds, int tid) {
    asm volatile("" : "+v"(tid), "+s"(p));
    const int grp = task & 15, n = (task >> 4) & 7, b = task >> 7, s0 = grp * 256;
    const bf16_t* HL = (const bf16_t*)(p->ws + WS_HLOC); const bf16_t* CU = (const bf16_t*)(p->ws + WS_CUMA);
    const bf16_t* PROJ = (const bf16_t*)(p->ws + WS_PROJ); bf16_t* MIX = (bf16_t*)(p->ws + WS_MIX);
    LAS float* Hin = (LAS float*)lds;
    if (tid < 128) {
        float H = 0.f;
        const size_t base = (size_t)(b * SEQ + 255) * 1024 + n * 128 + tid;
        for (int c = 0; c < grp; ++c) { const float a = bf2f(CU[base + (size_t)c * 256 * 1024]), hv = bf2f(HL[base + (size_t)c * 256 * 1024]); H = a * H + hv; }
        Hin[tid] = H;
    }
    __syncthreads();
    const int c4 = (tid & 31) * 4;
    const f32x4 hin = *(const LAS f32x4*)(Hin + c4);
#pragma unroll 4
    for (int i = 0; i < 16; ++i) {
        const int tok = (tid >> 5) + 16 * i;
        const size_t row = (size_t)(b * SEQ + s0 + tok);
        const u32x2 hlw = *(const u32x2*)(HL + row * 1024 + n * 128 + c4), cuw = *(const u32x2*)(CU + row * 1024 + n * 128 + c4);
        const f32x4 hl = (f32x4){bflo(hlw.x), bfhi(hlw.x), bflo(hlw.y), bfhi(hlw.y)}, cu = (f32x4){bflo(cuw.x), bfhi(cuw.x), bflo(cuw.y), bfhi(cuw.y)};
        const u32x2 gv = *(const u32x2*)(PROJ + row * NINP + C_LG + n * 128 + c4);
        const float g0 = bflo(gv.x), g1 = bfhi(gv.x), g2 = bflo(gv.y), g3 = bfhi(gv.y);
        u32x2 o; o.x = cvt_pk((hl[0] + cu[0] * hin[0]) * gelu_tanh(g0), (hl[1] + cu[1] * hin[1]) * gelu_tanh(g1));
        o.y = cvt_pk((hl[2] + cu[2] * hin[2]) * gelu_tanh(g2), (hl[3] + cu[3] * hin[3]) * gelu_tanh(g3));
        *(u32x2*)(MIX + row * DM + MIX_LRU + n * 128 + c4) = o;
    }
}

__device__ __forceinline__ void tr_nat4(const LAS unsigned char* tile, int ks, int lane, bf16x8 (&f)[4]) {
    const unsigned b = lds_addr(tile);
    s16x4 d0, d1, d2, d3, d4, d5, d6, d7;
    asm volatile("ds_read_b64_tr_b16 %0, %8\n\tds_read_b64_tr_b16 %1, %9\n\tds_read_b64_tr_b16 %2, %10\n\tds_read_b64_tr_b16 %3, %11\n\t"
                 "ds_read_b64_tr_b16 %4, %12\n\tds_read_b64_tr_b16 %5, %13\n\tds_read_b64_tr_b16 %6, %14\n\tds_read_b64_tr_b16 %7, %15\n\ts_waitcnt lgkmcnt(0)"
                 : "=&v"(d0), "=&v"(d1), "=&v"(d2), "=&v"(d3), "=&v"(d4), "=&v"(d5), "=&v"(d6), "=&v"(d7)
                 : "v"(b + tr_off_nat(lane, 0, ks, 0)), "v"(b + tr_off_nat(lane, 0, ks, 1)), "v"(b + tr_off_nat(lane, 1, ks, 0)), "v"(b + tr_off_nat(lane, 1, ks, 1)),
                   "v"(b + tr_off_nat(lane, 2, ks, 0)), "v"(b + tr_off_nat(lane, 2, ks, 1)), "v"(b + tr_off_nat(lane, 3, ks, 0)), "v"(b + tr_off_nat(lane, 3, ks, 1)) : "memory");
    f[0] = __builtin_shufflevector(d0, d1, 0, 1, 2, 3, 4, 5, 6, 7); f[1] = __builtin_shufflevector(d2, d3, 0, 1, 2, 3, 4, 5, 6, 7);
    f[2] = __builtin_shufflevector(d4, d5, 0, 1, 2, 3, 4, 5, 6, 7); f[3] = __builtin_shufflevector(d6, d7, 0, 1, 2, 3, 4, 5, 6, 7);
}
__device__ __forceinline__ void cmp_task(KP p, int l, int task, LAS unsigned char* lds, int tid) {
    asm volatile("" : "+v"(tid), "+s"(p));
    const int lane = tid & 63, wave = __builtin_amdgcn_readfirstlane(tid >> 6), hh = lane >> 5;
    const int rh = task & 1, bg = (task >> 1) & 7, kv = task >> 4, b = bg >> 1, g = bg & 1, n0 = rh * 128;
    const bf16_t* PROJ = (const bf16_t*)(p->ws + WS_PROJ);
    const bf16_t* W1 = (const bf16_t*)(p->ws + WS_CW1) + (size_t)kv * 4096 * 256;
    const bf16_t* W2 = (const bf16_t*)(p->ws + WS_CW2) + (size_t)kv * 256 * 128;
    const int col = (kv ? C_NVC : C_NKC) + g * 128;
    const int rb = wave & 3, kh = wave >> 2, hc = kh, nrow = n0 + 32 * rb + (lane & 31);
    const bool rowok = nrow < 255;
    const bf16_t* arow = PROJ + (size_t)(b * SEQ + 16 * (rowok ? nrow : 0)) * NINP + col + 64 * kh + 8 * hh;
    f32x16 ac8[8];
#pragma unroll
    for (int c = 0; c < 8; ++c)
#pragma unroll
        for (int i = 0; i < 16; ++i) ac8[c][i] = 0.f;
#define CMP_ISSUE(li_, buf_) do { _Pragma("unroll") for (int hf = 0; hf < 2; ++hf) _Pragma("unroll") for (int rr = 0; rr < 2; ++rr) \
        tile_dma64(lds + (buf_) * 65536 + hf * 32768 + rr * 16384, W1 + (size_t)((li_) * 128 + rr * 64) * 256 + hf * 128, 256, tid, wave); } while (0)
    bf16x8 af[4], an[4];
    CMP_ISSUE(0, 0);
#pragma unroll
    for (int s = 0; s < 4; ++s) af[s] = *(const bf16x8*)(arow + 16 * s);
    asm volatile("s_waitcnt vmcnt(0)" ::: "memory");
    __syncthreads();
    for (int li = 0; li < 32; ++li) {
        const int buf = li & 1;
        if (li + 1 < 32) {
            CMP_ISSUE(li + 1, buf ^ 1);
#pragma unroll
            for (int s = 0; s < 4; ++s) an[s] = *(const bf16x8*)(arow + (size_t)(li + 1) * NINP + 16 * s);
        }
        int lane_o = lane; asm volatile("" : "+v"(lane_o));
#pragma unroll
        for (int hf = 0; hf < 2; ++hf) {
            const LAS unsigned char* Bt = lds + buf * 65536 + hf * 32768;
#pragma unroll
            for (int s = 0; s < 4; ++s) {
                bf16x8 bf[4]; tr_nat4(Bt, 4 * kh + s, lane_o, bf);
#pragma unroll
                for (int c = 0; c < 4; ++c) ac8[4 * hf + c] = __builtin_amdgcn_mfma_f32_32x32x16_bf16(af[s], bf[c], ac8[4 * hf + c], 0, 0, 0);
            }
        }
        if (li + 1 < 32) {
            asm volatile("s_waitcnt vmcnt(0)" ::: "memory");
#pragma unroll
            for (int s = 0; s < 4; ++s) af[s] = an[s];
            __syncthreads();
        }
    }
#undef CMP_ISSUE
    __syncthreads();
    f32x16 acc[4];
    {
        LAS float* EX = (LAS float*)lds;
        if (kh == 0) {
#pragma unroll
            for (int c = 0; c < 4; ++c)
#pragma unroll
                for (int r = 0; r < 16; ++r) EX[((wave * 4 + c) * 16 + r) * 64 + lane] = ac8[4 + c][r];
        } else {
#pragma unroll
            for (int c = 0; c < 4; ++c)
#pragma unroll
                for (int r = 0; r < 16; ++r) EX[((wave * 4 + c) * 16 + r) * 64 + lane] = ac8[c][r];
        }
        __syncthreads();
        const int pw = wave ^ 4;
        if (kh == 0) {
#pragma unroll
            for (int c = 0; c < 4; ++c)
#pragma unroll
                for (int r = 0; r < 16; ++r) acc[c][r] = ac8[c][r] + EX[((pw * 4 + c) * 16 + r) * 64 + lane];
        } else {
#pragma unroll
            for (int c = 0; c < 4; ++c)
#pragma unroll
                for (int r = 0; r < 16; ++r) acc[c][r] = ac8[4 + c][r] + EX[((pw * 4 + c) * 16 + r) * 64 + lane];
        }
        __syncthreads();
    }
    LAS unsigned char* HI = lds;
    LAS unsigned char* W2I = lds + 65536;
#pragma unroll
    for (int hf = 0; hf < 2; ++hf)
#pragma unroll
        for (int rr = 0; rr < 2; ++rr) tile_dma64(W2I + hf * 32768 + rr * 16384, W2 + (size_t)(hf * 128 + rr * 64) * 128, 128, tid, wave);
    {
        const float* cp = (const float*)(p->ws + WS_CPOS) + kv * 256 + hc * 128;
        LAS unsigned char* Ht = HI + hc * 32768;
#pragma unroll
        for (int c = 0; c < 4; ++c) {
            const int cc = 32 * c + (lane & 31); const float cpv = cp[cc];
#pragma unroll
            for (int r = 0; r < 16; ++r) {
                const int n = 32 * rb + (r & 3) + 8 * (r >> 2) + 4 * hh;
                const bool ok = n0 + n < 255;
                *(LAS unsigned short*)(Ht + off_b((unsigned)n, (unsigned)(cc >> 3)) + 2 * (cc & 7)) = ok ? f2bf(gelu_tanh(acc[c][r] + cpv)) : (unsigned short)0;
            }
        }
    }
    asm volatile("s_waitcnt vmcnt(0)" ::: "memory");
    __syncthreads();
    {
        const int nb = wave & 3, dh = wave >> 2;
        f32x16 o[2];
#pragma unroll
        for (int q = 0; q < 2; ++q) {
#pragma unroll
            for (int i = 0; i < 16; ++i) o[q][i] = 0.f;
#pragma unroll
            for (int ks = 0; ks < 16; ++ks)
                o[q] = __builtin_amdgcn_mfma_f32_32x32x16_bf16(tr_frag_nat(W2I + (ks >> 3) * 32768, 2 * dh + q, ks & 7, lane), row_frag(HI + (ks >> 3) * 32768, 32 * nb, ks & 7, lane), o[q], 0, 0, 0);
        }
        const int n = n0 + 32 * nb + (lane & 31);
        bf16_t* dst = (bf16_t*)(p->ws + (kv ? WS_VCMP : WS_KCMP)) + ((size_t)bg * 256 + n) * 128;
        if (kv == 0) {
            LAS float* SS = (LAS float*)(lds + LDS_STAGE + LDS_CTL);
            float ss = 0.f;
#pragma unroll
            for (int q = 0; q < 2; ++q)
#pragma unroll
                for (int r = 0; r < 16; ++r) ss += o[q][r] * o[q][r];
            ss = half_sum(ss);
            if (hh == 0) SS[dh * 128 + 32 * nb + (lane & 31)] = ss;
            __syncthreads();
            const float tot = SS[32 * nb + (lane & 31)] + SS[128 + 32 * nb + (lane & 31)];
            const float rn = 1.0f / sqrtf(tot * (1.0f / 128.0f) + 1e-6f);
            const float* kw = p->in[I_NKW] + (size_t)l * 3 * 128;
#pragma unroll
            for (int q = 0; q < 2; ++q)
#pragma unroll
                for (int r = 0; r < 16; ++r) o[q][r] *= rn * kw[32 * (2 * dh + q) + (r & 3) + 8 * (r >> 2) + 4 * hh];
            if (dh == 0 && n < 255) {
                const int cpz = 16 * n + 31;
                const float* nc = (const float*)(p->ws + WS_TAB_NC) + cpz * 16; const float* ns = (const float*)(p->ws + WS_TAB_NS) + cpz * 16;
#pragma unroll
                for (int a = 0; a < 2; ++a)
#pragma unroll
                    for (int q = 0; q < 4; ++q) {
                        const int i = 8 * a + 4 * hh + q;
                        const float c = nc[i], sn = ns[i], x1 = o[0][4 * a + q], x2 = o[0][4 * (a + 2) + q];
                        o[0][4 * a + q] = x1 * c - x2 * sn; o[0][4 * (a + 2) + q] = x2 * c + x1 * sn;
                    }
            }
        }
#pragma unroll
        for (int q = 0; q < 2; ++q)
#pragma unroll
            for (int a = 0; a < 4; ++a) {
                u32x2 w; w.x = cvt_pk(o[q][4 * a], o[q][4 * a + 1]); w.y = cvt_pk(o[q][4 * a + 2], o[q][4 * a + 3]);
                if (n >= 255) { w.x = 0u; w.y = 0u; }
                *(u32x2*)(dst + 32 * (2 * dh + q) + 8 * a + 4 * hh) = w;
            }
    }
}

__device__ __forceinline__ float softmax_block(f32x16& sa, float& m, float& l) {
    float mx = m;
#pragma unroll
    for (int r = 0; r < 16; ++r) mx = fmaxf(mx, sa[r]);
    mx = half_max(mx);
    const float alpha = fexp2(m - mx);
    float ps = 0.f;
#pragma unroll
    for (int r = 0; r < 16; ++r) { const float pv = fexp2(sa[r] - mx); sa[r] = pv; ps += pv; }
    l = l * alpha + ps; m = mx;
    return alpha;
}
__device__ __forceinline__ void scale_o(f32x16 (&o)[4], float a) {
#pragma unroll
    for (int c = 0; c < 4; ++c)
#pragma unroll
        for (int r = 0; r < 16; ++r) o[c][r] *= a;
}
__device__ __forceinline__ void zero_o(f32x16 (&o)[4]) {
#pragma unroll
    for (int c = 0; c < 4; ++c)
#pragma unroll
        for (int r = 0; r < 16; ++r) o[c][r] = 0.f;
}
__device__ __forceinline__ void pv_block(f32x16 (&o)[4], const LAS unsigned char* vt, const TrAcc& TA, const f32x16& pp, int kb) {
    const unsigned vb = lds_addr(vt);
    pv_step(o, vb + 4096u * (unsigned)(2 * kb), TA, pack8(pp, 0));
    pv_step(o, vb + 4096u * (unsigned)(2 * kb + 1), TA, pack8(pp, 1));
}

struct VFrag { s16x4 d0, d1, d2, d3, d4, d5, d6, d7; };
__device__ __forceinline__ void v_issue(VFrag& f, unsigned vb, const TrAcc& A) {
    asm volatile("ds_read_b64_tr_b16 %0, %8\n\tds_read_b64_tr_b16 %1, %9\n\tds_read_b64_tr_b16 %2, %10\n\tds_read_b64_tr_b16 %3, %11\n\t"
                 "ds_read_b64_tr_b16 %4, %12\n\tds_read_b64_tr_b16 %5, %13\n\tds_read_b64_tr_b16 %6, %14\n\tds_read_b64_tr_b16 %7, %15"
                 : "=&v"(f.d0), "=&v"(f.d1), "=&v"(f.d2), "=&v"(f.d3), "=&v"(f.d4), "=&v"(f.d5), "=&v"(f.d6), "=&v"(f.d7)
                 : "v"(vb + A.a[0][0]), "v"(vb + A.a[0][1]), "v"(vb + A.a[1][0]), "v"(vb + A.a[1][1]), "v"(vb + A.a[2][0]), "v"(vb + A.a[2][1]), "v"(vb + A.a[3][0]), "v"(vb + A.a[3][1]) : "memory");
}
__device__ __forceinline__ void v_wait(VFrag& f) {
    asm volatile("s_waitcnt lgkmcnt(0)" : "+v"(f.d0), "+v"(f.d1), "+v"(f.d2), "+v"(f.d3), "+v"(f.d4), "+v"(f.d5), "+v"(f.d6), "+v"(f.d7) :: "memory");
}
__device__ __forceinline__ void v_mma(f32x16 (&o)[4], const VFrag& f, bf16x8 pf) {
    o[0] = __builtin_amdgcn_mfma_f32_32x32x16_bf16(__builtin_shufflevector(f.d0, f.d1, 0, 1, 2, 3, 4, 5, 6, 7), pf, o[0], 0, 0, 0);
    o[1] = __builtin_amdgcn_mfma_f32_32x32x16_bf16(__builtin_shufflevector(f.d2, f.d3, 0, 1, 2, 3, 4, 5, 6, 7), pf, o[1], 0, 0, 0);
    o[2] = __builtin_amdgcn_mfma_f32_32x32x16_bf16(__builtin_shufflevector(f.d4, f.d5, 0, 1, 2, 3, 4, 5, 6, 7), pf, o[2], 0, 0, 0);
    o[3] = __builtin_amdgcn_mfma_f32_32x32x16_bf16(__builtin_shufflevector(f.d6, f.d7, 0, 1, 2, 3, 4, 5, 6, 7), pf, o[3], 0, 0, 0);
}

constexpr float NSA_DEFER = 8.0f;
template <int MODE>
__device__ __forceinline__ void nsa_branch(unsigned long long tmask, const bf16_t* ksrc, size_t kld, const bf16_t* vsrc, size_t vld, const bf16_t* nk, size_t nkld, const bf16_t* nv, size_t nvld, int& buf,
                                           LAS unsigned char* lds, const bf16x8 (&qf)[8], const TrAcc& TA,
                                           f32x16 (&o)[4], float& m, float& lsum, float inv, int tq, unsigned long long mysel, LAS unsigned* PS, int ql, int tid, int lane, int wave) {
    constexpr bool HASV = MODE != 0;
    const int hh = lane >> 5;
    const int qb = tq >> 6, tqmin = tq & ~31;
    int j = __builtin_ctzll(tmask); tmask &= tmask - 1;
    asm volatile("s_waitcnt vmcnt(0)" ::: "memory");
    __syncthreads();
    for (;;) {
        const bool more = tmask != 0ull;
        const int jn = more ? __builtin_ctzll(tmask) : 0; tmask &= tmask - 1;
        {
            LAS unsigned char* nb = lds + (buf ^ 1) * 32768;
            if (more) { tile_dma64(nb, ksrc + (size_t)jn * 64 * kld, kld, tid, wave); if (HASV) tile_dma64(nb + 16384, vsrc + (size_t)jn * 64 * vld, vld, tid, wave); }
            else if (nk) { tile_dma64(nb, nk, nkld, tid, wave); if (nv) tile_dma64(nb + 16384, nv, nvld, tid, wave); }
        }
        const LAS unsigned char* KT = lds + buf * 32768; const LAS unsigned char* VT = KT + 16384;
        const bool sel = MODE == 3 ? (bool)((mysel >> j) & 1ull) : true;
        f32x16 sa[2];
        qk_tile_pipe(KT, qf, lane, sa[0], sa[1]);
        VFrag fa;
        if (HASV) v_issue(fa, lds_addr(VT), TA);
#pragma unroll
        for (int kb = 0; kb < 2; ++kb) {
            bool need_mask;
            if (MODE < 2) need_mask = 16 * (64 * j + 32 * kb + 31) + 31 > tqmin; else if (MODE == 2) need_mask = (j == qb) || (j + 8 == qb); else need_mask = (j == qb);
            if (need_mask) {
#pragma unroll
                for (int r = 0; r < 16; ++r) {
                    const int kp = 64 * j + 32 * kb + (r & 3) + 8 * (r >> 2) + 4 * hh;
                    bool ok;
                    if (MODE < 2) ok = 16 * kp + 31 <= tq; else if (MODE == 2) ok = (tq - kp >= 0) && (tq - kp < 512); else ok = kp <= tq;
                    sa[kb][r] = ok ? sa[kb][r] : -__builtin_inff();
                }
            }
        }
        if (MODE == 3 && !__all(sel)) {
#pragma unroll
            for (int kb = 0; kb < 2; ++kb)
#pragma unroll
                for (int r = 0; r < 16; ++r) sa[kb][r] = sel ? sa[kb][r] : -__builtin_inff();
        }
        if (MODE == 1) {
#pragma unroll
            for (int kb = 0; kb < 2; ++kb) {
#pragma unroll
                for (int r = 0; r < 16; ++r) sa[kb][r] = fexp2(sa[kb][r] - m) * inv;
#pragma unroll
                for (int a = 0; a < 4; ++a) {
                    const int jj = 16 * j + 8 * kb + 2 * a + hh;
                    const float p3 = sa[kb][4 * a + 3], mainv = 2.0f * (sa[kb][4 * a] + sa[kb][4 * a + 1] + sa[kb][4 * a + 2]) + p3;
                    __hip_atomic_fetch_add(PS + ql * 66 + jj, (unsigned)(mainv * 268435456.0f + 0.5f), __ATOMIC_RELAXED, __HIP_MEMORY_SCOPE_WORKGROUP);
                    __hip_atomic_fetch_add(PS + ql * 66 + jj + 1, (unsigned)(p3 * 268435456.0f + 0.5f), __ATOMIC_RELAXED, __HIP_MEMORY_SCOPE_WORKGROUP);
                }
            }
        } else {
            float mx = m;
#pragma unroll
            for (int r = 0; r < 16; ++r) mx = fmaxf(mx, fmaxf(sa[0][r], sa[1][r]));
            mx = half_max(mx);
            float alpha = 1.0f;
            if (!__all(mx - m <= NSA_DEFER)) { alpha = fexp2(m - mx); m = mx; if (HASV) scale_o(o, alpha); }
            float ps = 0.f;
#pragma unroll
            for (int kb = 0; kb < 2; ++kb)
#pragma unroll
                for (int r = 0; r < 16; ++r) { const float pv = fexp2(sa[kb][r] - m); sa[kb][r] = pv; ps += pv; }
            lsum = lsum * alpha + ps;
        }
        if (HASV) {
            const unsigned vb = lds_addr(VT);
            VFrag fb;
            v_wait(fa); v_issue(fb, vb + 4096u, TA); v_mma(o, fa, pack8(sa[0], 0));
            v_wait(fb); v_issue(fa, vb + 8192u, TA); v_mma(o, fb, pack8(sa[0], 1));
            v_wait(fa); v_issue(fb, vb + 12288u, TA); v_mma(o, fa, pack8(sa[1], 0));
            v_wait(fb); v_mma(o, fb, pack8(sa[1], 1));
        }
        buf ^= 1;
        if (!more) break;
        asm volatile("s_waitcnt vmcnt(0)" ::: "memory");
        __syncthreads();
        j = jn;
    }
}

__device__ __forceinline__ void nsa_task(KP p, int nsa_layer, int task, LAS unsigned char* lds, int tid) {
    asm volatile("" : "+v"(tid), "+s"(p));
    const int lane = tid & 63, wave = __builtin_amdgcn_readfirstlane(tid >> 6), hh = lane >> 5;
    const int qb = 63 - (task >> 3), bg = task & 7, b = bg >> 1, g = bg & 1, t0 = qb * 64;
    const int hd = g * 4 + (wave >> 1), ql = 32 * (wave & 1) + (lane & 31), tq = t0 + ql;
    const bf16_t* PROJ = (const bf16_t*)(p->ws + WS_PROJ);
    LAS unsigned* PS = (LAS unsigned*)(lds + 65536);
    LAS unsigned* SM = (LAS unsigned*)(lds + LDS_STAGE + LDS_CTL);
    LAS u32x2* YL = (LAS u32x2*)(lds + 65536) + wave * 1024 + lane;
    LAS unsigned* UN = SM + 128;
    const bf16_t* kc = (const bf16_t*)(p->ws + WS_KCMP) + (size_t)bg * 256 * 128; const bf16_t* vc = (const bf16_t*)(p->ws + WS_VCMP) + (size_t)bg * 256 * 128;
    const bf16_t* kw = (const bf16_t*)(p->ws + WS_KWN) + (size_t)bg * SEQ * 128; const bf16_t* vw = PROJ + (size_t)b * SEQ * NINP + C_NVW + g * 128;
    const bf16_t* ks = (const bf16_t*)(p->ws + WS_KSN) + (size_t)bg * SEQ * 128; const bf16_t* vs = PROJ + (size_t)b * SEQ * NINP + C_NVS + g * 128;
    int buf = 0;
    tile_dma64(lds, kc, 128, tid, wave);
    bf16x8 qf[8];
    {
        const bf16_t* qsrc = PROJ + (size_t)(b * SEQ + tq) * NINP + C_NQ + hd * 128 + 8 * hh;
        const float* qw = p->in[I_NQW] + (size_t)nsa_layer * 128 + 8 * hh;
        float x[8][8]; float ss = 0.f;
#pragma unroll
        for (int s8 = 0; s8 < 8; ++s8) { unpack8(*(const u32x4*)(qsrc + 16 * s8), x[s8]);
#pragma unroll
            for (int j = 0; j < 8; ++j) ss += x[s8][j] * x[s8][j]; }
        ss = half_sum(ss);
        const float r = (1.0f / sqrtf(ss * (1.0f / 128.0f) + 1e-6f)) * (0.08838834764831845f * 1.4426950408889634f);
#pragma unroll
        for (int s8 = 0; s8 < 8; ++s8) { float w[8]; ld8f(qw + 16 * s8, w);
#pragma unroll
            for (int j = 0; j < 8; ++j) x[s8][j] *= r * w[j]; }
        {
            float c[8], sn[8]; ld8f((const float*)(p->ws + WS_TAB_NC) + tq * 16 + 8 * hh, c); ld8f((const float*)(p->ws + WS_TAB_NS) + tq * 16 + 8 * hh, sn);
#pragma unroll
            for (int j = 0; j < 8; ++j) { const float x1 = x[0][j], x2 = x[1][j]; x[0][j] = x1 * c[j] - x2 * sn[j]; x[1][j] = x2 * c[j] + x1 * sn[j]; }
        }
#pragma unroll
        for (int s8 = 0; s8 < 8; ++s8) qf[s8] = __builtin_bit_cast(bf16x8, pack8f(x[s8]));
    }
    const size_t tokrow = (size_t)(b * SEQ + tq);
    const unsigned short graw0 = PROJ[tokrow * NINP + C_NG + hd * 3 + 0], graw1 = PROJ[tokrow * NINP + C_NG + hd * 3 + 1], graw2 = PROJ[tokrow * NINP + C_NG + hd * 3 + 2];
    TrAcc TA; tr_acc_init(TA, lane);
    if (wave >= 4) __builtin_amdgcn_s_setprio(1);
    for (int i = tid; i < 64 * 66; i += NTHR) PS[i] = 0u;
    if (tid < 2) UN[tid] = 0u;
    f32x16 o[4];
    const int jw0 = (qb >= 8 ? qb - 8 : 0);
    {
        const int nv = ((t0 + 32) >> 4) + 1, ntile = (nv + 63) >> 6;
        const unsigned long long tm = (1ull << ntile) - 1ull;
        float m = -1e30f, lsum = 0.f;
        nsa_branch<0>(tm, kc, 128, vc, 128, kc, 128, vc, 128, buf, lds, qf, TA, o, m, lsum, 0.f, tq, 0ull, PS, ql, tid, lane, wave);
        lsum = half_sum(lsum);
        const float inv = lsum > 0.f ? 1.0f / lsum : 0.f;
        zero_o(o);
        nsa_branch<1>(tm, kc, 128, vc, 128, kw + (size_t)jw0 * 64 * 128, 128, vw + (size_t)jw0 * 64 * NINP, NINP, buf, lds, qf, TA, o, m, lsum, inv, tq, 0ull, PS, ql, tid, lane, wave);
    }
    __syncthreads();
    for (int qi = 0; qi < 8; ++qi) {
        const int q = 8 * wave + qi, cur = qb;
        const unsigned v = PS[q * 66 + lane];
        const bool forced = (lane == 0) || (lane == cur) || (lane == cur - 1);
        const unsigned key = forced ? 0xffffffffu : ((lane <= cur) ? v + 1u : 0u);
        int rank = 0;
#pragma unroll
        for (int i = 0; i < 64; ++i) { const unsigned ki = (unsigned)__builtin_amdgcn_readlane((int)key, i); rank += ((ki > key) || (ki == key && i < lane)) ? 1 : 0; }
        const unsigned long long msk = __ballot(rank < 16);
        if (lane == 0) { SM[2 * q] = (unsigned)msk; SM[2 * q + 1] = (unsigned)(msk >> 32); __hip_atomic_fetch_or(UN, (unsigned)msk, __ATOMIC_RELAXED, __HIP_MEMORY_SCOPE_WORKGROUP); __hip_atomic_fetch_or(UN + 1, (unsigned)(msk >> 32), __ATOMIC_RELAXED, __HIP_MEMORY_SCOPE_WORKGROUP); }
    }
    const unsigned long long upto = (qb == 63) ? ~0ull : ((2ull << qb) - 1ull);
    __syncthreads();
    {
        const float gt0 = sigmoidf_(bf2f(graw0));
#pragma unroll
        for (int c = 0; c < 4; ++c)
#pragma unroll
            for (int a = 0; a < 4; ++a) { u32x2 w; w.x = cvt_pk(o[c][4 * a] * gt0, o[c][4 * a + 1] * gt0); w.y = cvt_pk(o[c][4 * a + 2] * gt0, o[c][4 * a + 3] * gt0); YL[(c * 4 + a) * 64] = w; }
    }
    const unsigned long long mysel = (unsigned long long)SM[2 * ql] | ((unsigned long long)SM[2 * ql + 1] << 32);
    const unsigned long long un = ((unsigned long long)UN[0] | ((unsigned long long)UN[1] << 32)) & upto;
    const int js0 = __builtin_ctzll(un);
    {
        float m = -1e30f, lsum = 0.f; zero_o(o);
        const unsigned long long tm = upto & ~((qb >= 8) ? ((1ull << (qb - 8)) - 1ull) : 0ull);
        nsa_branch<2>(tm, kw, 128, vw, NINP, ks + (size_t)js0 * 64 * 128, 128, vs + (size_t)js0 * 64 * NINP, NINP, buf, lds, qf, TA, o, m, lsum, 0.f, tq, 0ull, PS, ql, tid, lane, wave);
        lsum = half_sum(lsum);
        const float sc = sigmoidf_(bf2f(graw2)) / lsum;
#pragma unroll
        for (int c = 0; c < 4; ++c)
#pragma unroll
            for (int a = 0; a < 4; ++a) { const u32x2 y = YL[(c * 4 + a) * 64];
                u32x2 w; w.x = cvt_pk(bflo(y.x) + o[c][4 * a] * sc, bfhi(y.x) + o[c][4 * a + 1] * sc); w.y = cvt_pk(bflo(y.y) + o[c][4 * a + 2] * sc, bfhi(y.y) + o[c][4 * a + 3] * sc); YL[(c * 4 + a) * 64] = w; }
    }
    {
        float m = -1e30f, lsum = 0.f; zero_o(o);
        nsa_branch<3>(un, ks, 128, vs, NINP, nullptr, 0, nullptr, 0, buf, lds, qf, TA, o, m, lsum, 0.f, tq, mysel, PS, ql, tid, lane, wave);
        lsum = half_sum(lsum);
        const float sc = sigmoidf_(bf2f(graw1)) / lsum;
        bf16_t* mrow = (bf16_t*)(p->ws + WS_MIX) + tokrow * DM + MIX_NSA + hd * 128;
#pragma unroll
        for (int c = 0; c < 4; ++c)
#pragma unroll
            for (int a = 0; a < 4; ++a) {
                const u32x2 y = YL[(c * 4 + a) * 64];
                u32x2 w; w.x = cvt_pk(bflo(y.x) + o[c][4 * a] * sc, bfhi(y.x) + o[c][4 * a + 1] * sc); w.y = cvt_pk(bflo(y.y) + o[c][4 * a + 2] * sc, bfhi(y.y) + o[c][4 * a + 3] * sc);
                *(u32x2*)(mrow + 32 * c + 8 * a + 4 * hh) = w;
            }
    }
    __builtin_amdgcn_s_setprio(0);
}

constexpr float SB_THR = 40.0f;
__device__ __forceinline__ void sb_task(KP p, int task, LAS unsigned char* lds, int tid) {
    asm volatile("" : "+v"(tid), "+s"(p));
    const int lane = tid & 63, wave = __builtin_amdgcn_readfirstlane(tid >> 6), hh = lane >> 5;
    const int bh = task >> 4, b = bh >> 3, h = bh & 7, Q0 = (task & 15) * 256;
    const bf16_t* PROJ = (const bf16_t*)(p->ws + WS_PROJ);
    const bf16_t* base = PROJ + (size_t)b * SEQ * NINP + h * 128;
    volatile LAS int* FL = (volatile LAS int*)(lds + 65536);
    const int tq = Q0 + 32 * wave + (lane & 31);
    int jt = (Q0 >> 6) + 3, buf = 0;
    tile_dma64(lds, base + (size_t)jt * 64 * NINP + C_SK, NINP, tid, wave); tile_dma64(lds + 16384, base + (size_t)jt * 64 * NINP + C_SV, NINP, tid, wave);
    bf16x8 qf[8];
#ifndef REPS_SBQ
#define REPS_SBQ 1
#endif
    for (int rr = 0; rr < REPS_SBQ; ++rr) {
#pragma unroll
        for (int s = 0; s < 8; ++s) qf[s] = *(const bf16x8*)(base + (size_t)tq * NINP + C_SQ + 16 * s + 8 * hh);
        if (REPS_SBQ > 1) {
#pragma unroll
            for (int s = 0; s < 8; ++s) asm volatile("" : "+v"(qf[s]));
        }
    }
    TrAcc TA; tr_acc_init(TA, lane);
    f32x16 o[4]; zero_o(o);
    float Lc = 0.f; bool wdone = false;
    if (tid < 8) FL[tid] = 0;
    const float SC = 0.08838834764831845f, L2E = 1.4426950408889634f, LN2 = 0.6931471805599453f;
    asm volatile("s_waitcnt vmcnt(0)" ::: "memory");
    __syncthreads();
    for (;;) {
        if (FL[0] & FL[1] & FL[2] & FL[3] & FL[4] & FL[5] & FL[6] & FL[7]) break;
        if (jt > 0) { LAS unsigned char* nb = lds + (buf ^ 1) * 32768; tile_dma64(nb, base + (size_t)(jt - 1) * 64 * NINP + C_SK, NINP, tid, wave); tile_dma64(nb + 16384, base + (size_t)(jt - 1) * 64 * NINP + C_SV, NINP, tid, wave); }
        const LAS unsigned char* KT = lds + buf * 32768; const LAS unsigned char* VT = KT + 16384;
        const int k0 = jt * 64;
        if (!wdone && k0 < Q0 + 32 * wave + 31) {
            const unsigned vb = lds_addr(VT);
#pragma unroll 1
            for (int kbi = 0; kbi < 2; ++kbi) {
                const int kb = 1 - kbi;
                f32x16 sa = qk_block(KT, kb, qf, lane), ls;
#pragma unroll
                for (int r = 0; r < 16; ++r) {
                    const int key = k0 + 32 * kb + (r & 3) + 8 * (r >> 2) + 4 * hh;
                    const float z = sa[r] * SC;
                    const float lp = flog2(1.0f + fexp2(-fabsf(z) * L2E)) * LN2;
                    const float lb = fminf(z, 0.f) - lp;
                    sa[r] = lb; ls[r] = (key < tq) ? (lb - z) : 0.f;
                }
                float gsum[4], ghi[4], after[4];
#pragma unroll
                for (int a = 0; a < 4; ++a) { const float gsv = (ls[4 * a] + ls[4 * a + 1]) + (ls[4 * a + 2] + ls[4 * a + 3]);
                    auto rr = __builtin_amdgcn_permlane32_swap(__float_as_uint(gsv), __float_as_uint(gsv), false, false);
                    ghi[a] = __uint_as_float(rr[1]); gsum[a] = __uint_as_float(rr[0]) + ghi[a]; }
                float run = 0.f;
#pragma unroll
                for (int a = 3; a >= 0; --a) { after[a] = run; run += gsum[a]; }
#pragma unroll
                for (int a = 0; a < 4; ++a) {
                    float suf = Lc + after[a] + (hh == 0 ? ghi[a] : 0.f);
#pragma unroll
                    for (int q = 3; q >= 0; --q) {
                        const int r = 4 * a + q, key = k0 + 32 * kb + q + 8 * a + 4 * hh;
                        const float w = (key < tq) ? fexp2((sa[r] + suf) * L2E) : 0.f;
                        suf += ls[r];
                        sa[r] = w;
                    }
                }
                Lc += run;
                pv_step(o, vb + 4096u * (unsigned)(2 * kb), TA, pack8(sa, 0));
                pv_step(o, vb + 4096u * (unsigned)(2 * kb + 1), TA, pack8(sa, 1));
            }
            wdone = __all(Lc < -SB_THR);
            if (lane == 0) FL[wave] = wdone ? 1 : 0;
        }
        if (jt == 0) break;
        asm volatile("s_waitcnt vmcnt(0)" ::: "memory");
        __syncthreads();
        --jt; buf ^= 1;
    }
    bf16_t* mrow = (bf16_t*)(p->ws + WS_MIX) + (size_t)(b * SEQ + tq) * DM + MIX_SB + h * 128;
#pragma unroll
    for (int c = 0; c < 4; ++c)
#pragma unroll
        for (int a = 0; a < 4; ++a) { u32x2 w; w.x = cvt_pk(o[c][4 * a], o[c][4 * a + 1]); w.y = cvt_pk(o[c][4 * a + 2], o[c][4 * a + 3]); *(u32x2*)(mrow + 32 * c + 8 * a + 4 * hh) = w; }
}

__device__ __forceinline__ void ret_state_task(KP p, int task, LAS unsigned char* lds, int tid, unsigned* rsflag) {
    asm volatile("" : "+v"(tid), "+s"(p));
    const int lane = tid & 63, wave = __builtin_amdgcn_readfirstlane(tid >> 6), hh = lane >> 5;
    const int eh = task & 1, bh = task >> 1, b = bh >> 3, h = bh & 7;
    const bf16_t* KR = (const bf16_t*)(p->ws + WS_KR) + (size_t)bh * SEQ * 128;
    const bf16_t* V = (const bf16_t*)(p->ws + WS_PROJ) + (size_t)b * SEQ * NINP + C_RV + h * 128;
    bf16_t* ST = (bf16_t*)(p->ws + WS_ST) + (size_t)bh * 32 * 128 * 128;
    const int eb = wave >> 2, db = wave & 3;
    const float gC = exp2f(128.0f * log2f(1.0f - exp2f(-5.0f - (float)h)));
    f32x16 acc;
#pragma unroll
    for (int i = 0; i < 16; ++i) acc[i] = 0.f;
#define RS_ISSUE(c_, nb_) do { _Pragma("unroll") for (int rr = 0; rr < 2; ++rr) { tile_dma64((nb_) + rr * 16384, KR + ((size_t)(c_) * 128 + rr * 64) * 128, 128, tid, wave); \
        tile_dma64((nb_) + 32768 + rr * 16384, V + ((size_t)(c_) * 128 + rr * 64) * NINP, NINP, tid, wave); } } while (0)
    __syncthreads();
    RS_ISSUE(0, lds);
    for (int c = 0; c < 32; ++c) {
        {
            bf16_t* dst = ST + (size_t)c * 128 * 128 + 32 * db + (lane & 31);
#pragma unroll
            for (int r = 0; r < 16; ++r) { const int e = 64 * eh + 32 * eb + (r & 3) + 8 * (r >> 2) + 4 * hh; dst[(size_t)e * 128] = f2bf(acc[r]); }
        }
        if (c == 31) break;
        asm volatile("s_waitcnt vmcnt(0)" ::: "memory");
        __syncthreads();
        if (c + 1 < 31) { LAS unsigned char* nb = lds + ((c + 1) & 1) * 65536; RS_ISSUE(c + 1, nb); }
        const LAS unsigned char* KT = lds + (c & 1) * 65536; const LAS unsigned char* VT = KT + 32768;
#pragma unroll
        for (int ks = 0; ks < 8; ++ks) {
            const unsigned ov0 = tr_off_nat(lane, 2 * eh + eb, ks, 0), ov1 = tr_off_nat(lane, 2 * eh + eb, ks, 1), ok0 = tr_off_nat(lane, db, ks, 0), ok1 = tr_off_nat(lane, db, ks, 1);
            s16x4 v0, v1, k0, k1;
            asm volatile("ds_read_b64_tr_b16 %0, %4\n\tds_read_b64_tr_b16 %1, %5\n\tds_read_b64_tr_b16 %2, %6\n\tds_read_b64_tr_b16 %3, %7\n\ts_waitcnt lgkmcnt(0)"
                         : "=&v"(v0), "=&v"(v1), "=&v"(k0), "=&v"(k1) : "v"(lds_addr(VT) + ov0), "v"(lds_addr(VT) + ov1), "v"(lds_addr(KT) + ok0), "v"(lds_addr(KT) + ok1) : "memory");
            acc = __builtin_amdgcn_mfma_f32_32x32x16_bf16(__builtin_shufflevector(v0, v1, 0, 1, 2, 3, 4, 5, 6, 7), __builtin_shufflevector(k0, k1, 0, 1, 2, 3, 4, 5, 6, 7), acc, 0, 0, 0);
        }
#pragma unroll
        for (int i = 0; i < 16; ++i) acc[i] *= gC;
    }
#undef RS_ISSUE
    asm volatile("s_waitcnt vmcnt(0)" ::: "memory");
    __syncthreads();
    if (tid == 0) { __builtin_amdgcn_fence(__ATOMIC_RELEASE, "agent"); asm volatile("s_waitcnt vmcnt(0)" ::: "memory"); __hip_atomic_fetch_add(rsflag + 64 * bh, 1u, __ATOMIC_RELAXED, __HIP_MEMORY_SCOPE_AGENT); }
}

__device__ __forceinline__ void ret_out_task(KP p, int task, LAS unsigned char* lds, int tid, unsigned* rsflag) {
    asm volatile("" : "+v"(tid), "+s"(p));
    const int lane = tid & 63, wave = __builtin_amdgcn_readfirstlane(tid >> 6), hh = lane >> 5;
    const int bh = task >> 4, cp = task & 15, b = bh >> 3, h = bh & 7;
    const int cw = wave >> 2, ib = wave & 3, c = 2 * cp + cw, s = 128 * c + 32 * ib + (lane & 31);
    const bf16_t* PROJ = (const bf16_t*)(p->ws + WS_PROJ);
    const bf16_t* KR = (const bf16_t*)(p->ws + WS_KR) + (size_t)bh * SEQ * 128;
    const bf16_t* V = PROJ + (size_t)b * SEQ * NINP + C_RV + h * 128;
    const bf16_t* ST = (const bf16_t*)(p->ws + WS_ST) + (size_t)bh * 32 * 128 * 128;
#define RET_ISSUE(st_, nb_) do { _Pragma("unroll") for (int cwi = 0; cwi < 2; ++cwi) { const size_t cc_ = (size_t)(2 * cp + cwi); \
        if ((st_) < 2) { const size_t krow = cc_ * 128 + (st_) * 64; tile_dma64((nb_) + cwi * 32768, KR + krow * 128, 128, tid, wave); tile_dma64((nb_) + cwi * 32768 + 16384, V + krow * NINP, NINP, tid, wave); } \
        else tile_dma64((nb_) + cwi * 32768, ST + (cc_ * 128 + ((st_) - 2) * 64) * 128, 128, tid, wave); } } while (0)
    RET_ISSUE(0, lds);
    bf16x8 qf[8];
    {
        const bf16_t* qsrc = PROJ + (size_t)(b * SEQ + s) * NINP + C_RQ + h * 128 + 8 * hh;
        const float* rc = (const float*)(p->ws + WS_TAB_RC) + s * 64 + 8 * hh; const float* rs = (const float*)(p->ws + WS_TAB_RS) + s * 64 + 8 * hh;
        const float dq = fexp2((float)((s & 127) + 1) * log2f(1.0f - exp2f(-5.0f - (float)h)));
#pragma unroll
        for (int s8 = 0; s8 < 4; ++s8) {
            float x1[8], x2[8], c[8], sn[8], o1[8], o2[8];
            unpack8(*(const u32x4*)(qsrc + 16 * s8), x1); unpack8(*(const u32x4*)(qsrc + 64 + 16 * s8), x2);
            ld8f(rc + 16 * s8, c); ld8f(rs + 16 * s8, sn);
#pragma unroll
            for (int j = 0; j < 8; ++j) { o1[j] = (x1[j] * c[j] - x2[j] * sn[j]) * dq; o2[j] = (x2[j] * c[j] + x1[j] * sn[j]) * dq; }
            qf[s8] = __builtin_bit_cast(bf16x8, pack8f(o1)); qf[s8 + 4] = __builtin_bit_cast(bf16x8, pack8f(o2));
        }
    }
    TrAcc TA; tr_acc_init(TA, lane);
    f32x16 o[4]; zero_o(o);
    if (tid == 0) {
        unsigned spins = 0;
        while (__hip_atomic_load(rsflag + 64 * bh, __ATOMIC_RELAXED, __HIP_MEMORY_SCOPE_AGENT) < 2u && ++spins < (1u << 24)) __builtin_amdgcn_s_sleep(8);
        __builtin_amdgcn_fence(__ATOMIC_ACQUIRE, "agent");
        asm volatile("s_waitcnt vmcnt(0)" ::: "memory");
    }
    const size_t tok = (size_t)(b * SEQ + s);
    u32x2 gvr[4][4];
    {
        const bf16_t* grow = PROJ + tok * NINP + C_RG + h * 128;
#pragma unroll
        for (int cc = 0; cc < 4; ++cc)
#pragma unroll
            for (int a = 0; a < 4; ++a) gvr[cc][a] = *(const u32x2*)(grow + 32 * cc + 8 * a + 4 * hh);
    }
    asm volatile("s_waitcnt vmcnt(0)" ::: "memory");
    __syncthreads();
#pragma unroll
    for (int st = 0; st < 4; ++st) {
        if (st + 1 < 4) { LAS unsigned char* nb = lds + ((st + 1) & 1) * 65536; RET_ISSUE(st + 1, nb); }
        const LAS unsigned char* KT = lds + (st & 1) * 65536 + cw * 32768; const LAS unsigned char* VT = KT + 16384;
        if (st < 2) {
#pragma unroll
            for (int kb = 0; kb < 2; ++kb) {
                const int jb = 2 * st + kb;
                if (jb <= ib) {
                    f32x16 sa = qk_block(KT, kb, qf, lane);
                    if (jb == ib) {
#pragma unroll
                        for (int r = 0; r < 16; ++r) { const int kl = (r & 3) + 8 * (r >> 2) + 4 * hh; if (kl > (lane & 31)) sa[r] = 0.f; }
                    }
                    const unsigned vb = lds_addr(VT);
                    pv_step(o, vb + 4096u * (unsigned)(2 * kb), TA, pack8(sa, 0));
                    pv_step(o, vb + 4096u * (unsigned)(2 * kb + 1), TA, pack8(sa, 1));
                }
            }
        } else {
#pragma unroll
            for (int eb = 0; eb < 2; ++eb)
#pragma unroll
                for (int k = 0; k < 8; ++k) o[2 * (st - 2) + eb] = __builtin_amdgcn_mfma_f32_32x32x16_bf16(row_frag(KT, 32 * eb, k, lane), qf[k], o[2 * (st - 2) + eb], 0, 0, 0);
        }
        if (st + 1 < 4) { asm volatile("s_waitcnt vmcnt(0)" ::: "memory"); __syncthreads(); }
    }
#undef RET_ISSUE
    float ss = 0.f;
#pragma unroll
    for (int cc = 0; cc < 4; ++cc)
#pragma unroll
        for (int r = 0; r < 16; ++r) ss += o[cc][r] * o[cc][r];
    ss = half_sum(ss);
    const float rn = 1.0f / sqrtf(ss * (1.0f / 128.0f) + 1e-6f);
    bf16_t* mrow = (bf16_t*)(p->ws + WS_MIX) + tok * DM + MIX_RET + h * 128;
#ifndef REPS_RETEPI
#define REPS_RETEPI 1
#endif
    for (int rr = 0; rr < REPS_RETEPI; ++rr)
#pragma unroll
    for (int cc = 0; cc < 4; ++cc)
#pragma unroll
        for (int a = 0; a < 4; ++a) {
            const u32x2 gv = gvr[cc][a];
            const float g0 = bflo(gv.x), g1 = bfhi(gv.x), g2 = bflo(gv.y), g3 = bfhi(gv.y);
            u32x2 w; w.x = cvt_pk(o[cc][4 * a] * rn * g0 * sigmoidf_(g0), o[cc][4 * a + 1] * rn * g1 * sigmoidf_(g1));
            w.y = cvt_pk(o[cc][4 * a + 2] * rn * g2 * sigmoidf_(g2), o[cc][4 * a + 3] * rn * g3 * sigmoidf_(g3));
            *(u32x2*)(mrow + 32 * cc + 8 * a + 4 * hh) = w;
        }
}

#ifndef HP_SP2
#define HP_SP2 true
#endif
#ifndef HP_ALIGN
#define HP_ALIGN true
#endif
#ifndef REPS_CMP
#define REPS_CMP 1
#endif
#ifndef REPS_C1
#define REPS_C1 1
#endif
#ifndef REPS_RS
#define REPS_RS 1
#endif
#ifndef REPS_NSA
#define REPS_NSA 1
#endif
#ifndef REPS_SB
#define REPS_SB 1
#endif
#ifndef REPS_C3
#define REPS_C3 1
#endif
#ifndef REPS_PE
#define REPS_PE 1
#endif
#ifndef REP_CONV
#define REP_CONV 1
#endif
#ifndef REP_GIN
#define REP_GIN 1
#endif
#ifndef REPS_RO
#define REPS_RO 1
#endif
#ifndef REP_PREP
#define REP_PREP 1
#endif
#ifndef REP_MIX1
#define REP_MIX1 1
#endif
#ifndef REP_MIX2
#define REP_MIX2 1
#endif
#ifndef REP_NORM2
#define REP_NORM2 1
#endif
#ifndef REP_GGU
#define REP_GGU 1
#endif
#ifndef REP_ACT
#define REP_ACT 1
#endif
#ifndef IN_MIDCONV
#define IN_MIDCONV 0
#endif
struct SegOrder {
    pg8::StaticOrder S; int i0, n;
    __device__ __forceinline__ bool next(int i, pg8::Unit& u) const { return i < n && S.next(i0 + i, u); }
    __device__ __forceinline__ void a_ready(const pg8::Unit&) const {}
    __device__ __forceinline__ void done(const pg8::Unit&) const {}
};
#ifndef IN_SKINNY
#define IN_SKINNY 0
#endif
#ifndef GU_TAIL_N
#define GU_TAIL_N 2016
#endif
#ifndef IN_TAIL_N
#define IN_TAIL_N 1024
#endif
#ifndef IN_TAIL_N0
#define IN_TAIL_N0 1024
#endif
static_assert(GU_TAIL_N <= 2016 && IN_TAIL_N0 >= 512 && (GU_TAIL_N > 1504 ? GU_TAIL_N : 1504) + IN_TAIL_N >= 2016, "conversion task placement");
enum { PH_CONV = 0, PH_GEMM_IN, PH_PREP, PH_MIX1, PH_MIX2, PH_GEMM_OUT, PH_GEMM_GU, PH_ACT, PH_GEMM_DN, N_PHASES };

__global__ void __launch_bounds__(NTHR, 2) hybrid_fwd(Params p_arg) {
    extern __shared__ __attribute__((aligned(16))) unsigned char lds_raw[];
    LAS unsigned char* lds = (LAS unsigned char*)lds_raw;
    const int wave0 = __builtin_amdgcn_readfirstlane(threadIdx.x >> 6), bid = blockIdx.x, G = gridDim.x;
#define TID0() (wave0 * 64 + lane_id_now())
    volatile LAS unsigned* CT = (volatile LAS unsigned*)(lds + LDS_STAGE);
    { const int t0_ = TID0(); if (t0_ < 8) CT[t0_] = 0u; }
    __syncthreads();
    const KP kp = (KP)__builtin_amdgcn_kernarg_segment_ptr();
    unsigned* ctl = (unsigned*)(kp->ws + WS_CTL);
    const int l_lo = kp->l_lo, l_hi = kp->l_hi, ph_lo = kp->ph_lo, ph_hi = kp->ph_hi;
    const bool multi = (l_hi - l_lo) > 1 || (ph_hi - ph_lo) > 1;
    XcdBarrier bar; bar.bar = ctl + CW_BAR; bar.x = 0; bar.st = CT;
    if (multi) bar = xcd_barrier_post(ctl + CW_BAR, CT);
    volatile LAS int* slot = (volatile LAS int*)(CT + 4);

#define PH_ON(k) (ph_lo <= (k) && (k) < ph_hi)
#define WSP(T, off) ((T*)(p->ws + (off)))
#ifndef REP_SEAM
#define REP_SEAM 1
#endif
#define SEAM() do { if (multi) for (int sr_ = 0; sr_ < REP_SEAM; ++sr_) xcd_barrier(bar); } while (0)
#define ARRIVE_ALL(ctr_, tid_) do { asm volatile("s_waitcnt vmcnt(0)" ::: "memory"); __syncthreads(); \
        if ((tid_) == 0) { __builtin_amdgcn_fence(__ATOMIC_RELEASE, "agent"); asm volatile("s_waitcnt vmcnt(0)" ::: "memory"); __hip_atomic_fetch_add((ctr_), 1u, __ATOMIC_RELAXED, __HIP_MEMORY_SCOPE_AGENT); } } while (0)
#define WAIT_ALL(ctr_, tid_) do { if ((tid_) == 0) { unsigned spins_ = 0; \
            while (__hip_atomic_load((ctr_), __ATOMIC_RELAXED, __HIP_MEMORY_SCOPE_AGENT) < (unsigned)G && ++spins_ < (1u << 24)) __builtin_amdgcn_s_sleep(8); \
            __builtin_amdgcn_fence(__ATOMIC_ACQUIRE, "agent"); asm volatile("s_waitcnt vmcnt(0)" ::: "memory"); } \
        __syncthreads(); } while (0)
#ifndef SPLIT_SEAMS
#define SPLIT_SEAMS 1
#endif
#define SEAM_FILL(i_, lo_, hi_, last_rep_) do { const int tid_s = TID0(); \
        if (multi && SPLIT_SEAMS && (last_rep_)) { ARRIVE_ALL(qctr + 448 + 16 * (i_), tid_s); convert_range(p, l, (lo_) + bid, (hi_), G, lds, tid_s); WAIT_ALL(qctr + 448 + 16 * (i_), tid_s); } \
        else { convert_range(p, l, (lo_) + bid, (hi_), G, lds, tid_s); SEAM(); } } while (0)
#ifndef DIS_TAB
    if (l_lo == 0 && PH_ON(PH_CONV)) ph_tables(kp, TID0(), bid, G);
#endif
    for (int l = l_lo; l < l_hi; ++l) {
        KP p = kp; asm volatile("" : "+s"(p));
        const int vis_lo = (l == 0) ? 1504 + IN_TAIL_N0 : (GU_TAIL_N > 1504 ? GU_TAIL_N : 1504) + IN_TAIL_N, vis_mid = (vis_lo + 4768) / 2;
        unsigned* qctr = ctl + CW_QUEUE + 1024 * l;
        if (PH_ON(PH_CONV)) for (int rep = 0; rep < REP_CONV; ++rep) {
            const int tid = TID0();
#ifndef DIS_CONV
            convert_range(p, l, ((l == 0) ? 0 : (GU_TAIL_N < 1504 ? GU_TAIL_N : 1504)) + bid, 1504, G, lds, tid);
            convert_small(p, l, tid, bid, G);
#endif
            if (l == 0) ph_xcvt(p->in[I_X], WSP(bf16_t, WS_HN), WSP(float, WS_RSS), tid, bid, G);
            SEAM();
        }
        if (PH_ON(PH_GEMM_IN)) for (int rep = 0; rep < REP_GIN; ++rep) {
            const int tid = TID0();
            constexpr int nin_g = IN_SKINNY ? C_NG : NINP;
            pg8::Gemm g{WSP(bf16_t, WS_HN), WSP(bf16_t, WS_WIN), MT, nin_g, DM}; pg8::StaticOrder S; S.init(MT, nin_g, G, bid);
            LAS float* rt = (LAS float*)(lds + LDS_STAGE + LDS_CTL);
            const int rbase = fill_rstd_table(S, WSP(float, WS_RSS), rt, tid);
            EpiBf16RS E{WSP(bf16_t, WS_PROJ), NINP, rt, rbase};
#if !defined(DIS_GEMM) && !defined(DIS_G1)
#if IN_MIDCONV
            {
                const int cut = 1 + (bid & 7);
                SegOrder Sa{S, 0, cut}, Sb{S, cut, 1 << 20};
                pg8::gemm_phase<EpiBf16RS, SegOrder, HP_ALIGN, HP_SP2>(lds, g, Sa, E, tid);
                convert_range(p, l, vis_lo + bid, 4768, G, lds, tid);
                __syncthreads();
                pg8::gemm_phase<EpiBf16RS, SegOrder, HP_ALIGN, HP_SP2>(lds, g, Sb, E, tid);
            }
#else
            pg8::gemm_phase<EpiBf16RS, pg8::StaticOrder, HP_ALIGN, HP_SP2>(lds, g, S, E, tid);
#endif
#endif
#ifndef DIS_CONV
            {
                const int nwg = (MT / 256) * (nin_g / 256), first_short = nwg - ((nwg + G - 1) / G - 1) * G;
                if (IN_SKINNY) {
                    int rp0, rstep;
                    if (G == 256) { const int j = bid >> 3, x = bid & 7; rp0 = bid >= 128 ? 2 * (8 * x + (j & 7)) + ((j >> 3) & 1) : 128; rstep = 128; }
                    else if (first_short < G) { rp0 = bid >= first_short ? bid - first_short : 128; rstep = G - first_short; }
                    else { rp0 = bid; rstep = G; }
                    for (int rp = rp0; rp < 128; rp += rstep) in_gate_cols(p, rp * 128, WSP(float, WS_RSS), lds, tid);
                }
                const int in_lo = (l == 0) ? 1504 : (GU_TAIL_N > 1504 ? GU_TAIL_N : 1504), in_hi = in_lo + ((l == 0) ? IN_TAIL_N0 : IN_TAIL_N);
                if (first_short < G && bid >= first_short) convert_range(p, l, in_lo + (bid - first_short), in_hi, G - first_short, lds, tid);
                else if (first_short >= G) convert_range(p, l, in_lo + bid, in_hi, G, lds, tid);
            }
#endif
#if IN_MIDCONV
            SEAM();
#else
            SEAM_FILL(1, vis_lo, vis_mid, rep + 1 == REP_GIN);
#endif
        }
        if (PH_ON(PH_PREP)) for (int rep = 0; rep < REP_PREP; ++rep) {
            unsigned* qc = qctr + 512 * rep;
            for (int r2 = 0; r2 < REPS_PE; ++r2) ph_prep_elem(p, l, TID0(), bid, G);
#ifndef DIS_CMP
            { const int tid = TID0();
            for (int r2 = 0; r2 < REPS_CMP; ++r2) for (;;) { const int t = next_task(qc + 512 * r2, slot, tid); if (t >= 32) break; cmp_task(p, l, t, lds, tid); }
            }
#endif
#ifndef DIS_C1
            { const int tid = TID0();
            for (int r2 = 0; r2 < REPS_C1; ++r2) for (;;) { const int t = next_task(qc + 64 + 512 * r2, slot, tid); if (t >= 512) break; lru_c1_task(p, l, t, lds, tid); }
            }
#endif
            const bool split_pm = multi && PH_ON(PH_MIX1) && rep + 1 == REP_PREP;
            if (split_pm) { const int tid = TID0(); ARRIVE_ALL(qctr + 448, tid); }
#ifndef DIS_SB
            { const int tid = TID0();
            for (int r2 = 0; r2 < REPS_SB; ++r2) for (;;) { const int t = next_task(qc + 256 + 512 * r2, slot, tid); if (t >= 512) break; sb_task(p, t, lds, tid); }
            }
#endif
            if (split_pm) { const int tid = TID0(); WAIT_ALL(qctr + 448, tid);
            } else SEAM();
        }
        if (PH_ON(PH_MIX1)) for (int rep = 0; rep < REP_MIX1; ++rep) {
            unsigned* qc = qctr + 512 * rep;
#ifndef DIS_RS
            { const int tid = TID0();
            for (int r2 = 0; r2 < REPS_RS; ++r2) for (;;) { const int t = next_task(qc + 128 + 512 * r2, slot, tid); if (t >= 64) break; ret_state_task(p, t, lds, tid, ctl + CW_RSFLAG + 2048 * l); }
            }
#endif
#ifndef DIS_NSA
            { const int tid = TID0();
            for (int r2 = 0; r2 < REPS_NSA; ++r2) for (;;) { const int t = next_task(qc + 192 + 512 * r2, slot, tid); if (t >= 512) break; nsa_task(p, l, t, lds, tid); }
            }
#endif
#ifndef DIS_RO
            { const int tid = TID0();
            for (int r2 = 0; r2 < REPS_RO; ++r2) for (;;) { const int t = next_task(qc + 384 + 512 * r2, slot, tid); if (t >= 512) break; ret_out_task(p, t, lds, tid, ctl + CW_RSFLAG + 2048 * l); }
            }
#endif
#ifndef DIS_C3
            { const int tid = TID0();
            for (int r2 = 0; r2 < REPS_C3; ++r2) for (;;) { const int t = next_task(qc + 320 + 512 * r2, slot, tid); if (t >= 512) break; lru_c3_task(p, t, lds, tid); }
            }
#endif
#if IN_MIDCONV
            SEAM();
#else
            SEAM_FILL(2, vis_mid, 4768, rep + 1 == REP_MIX1);
#endif
        }
        if (PH_ON(PH_GEMM_OUT)) {
            const int tid = TID0();
            pg8::Gemm g{WSP(bf16_t, WS_MIX), WSP(bf16_t, WS_WOUT), MT, DM, DM}; pg8::StaticOrder S; S.init(MT, DM, G, bid);
            EpiResid3 E{(l == 0) ? p->in[I_X] : nullptr, WSP(bf16_t, WS_HN), nullptr, WSP(float, WS_RSS) + (size_t)MT * 64};
#if !defined(DIS_GEMM) && !defined(DIS_G2)
#ifdef REP_GOUT
            for (int rp = 1; rp < REP_GOUT; ++rp) { EpiResid3 E2{(l == 0) ? p->in[I_X] : nullptr, WSP(bf16_t, WS_HN), WSP(float, WS_PROJ), WSP(float, WS_RSS) + (size_t)MT * 64, 1};
                pg8::gemm_phase<EpiResid3, pg8::StaticOrder, HP_ALIGN, HP_SP2>(lds, g, S, E2, tid); SEAM(); }
#endif
            pg8::gemm_phase<EpiResid3, pg8::StaticOrder, HP_ALIGN, HP_SP2>(lds, g, S, E, tid);
#endif
            SEAM_FILL(3, 4768, (l + 1 == NL) ? 4768 : 6144, true);
        }
        if (PH_ON(PH_GEMM_GU)) for (int rep = 0; rep < REP_GGU; ++rep) {
            const int tid = TID0();
            pg8::Gemm g{WSP(bf16_t, WS_HN), WSP(bf16_t, WS_WGU), MT, NGU, DM}; pg8::StaticOrder S; S.init(MT, NGU, G, bid);
            LAS float* rt = (LAS float*)(lds + LDS_STAGE + LDS_CTL);
            const int rbase = fill_rstd_table(S, WSP(float, WS_RSS) + (size_t)MT * 64, rt, tid);
            EpiGateUp E{WSP(bf16_t, WS_H), rt, rbase, p->in[I_MCW] + (size_t)l * 3 * DFF, p->in[I_MCB] + (size_t)l * DFF, WSP(bf16_t, WS_GT), WSP(bf16_t, WS_GH), WSP(bf16_t, WS_UH)};
#if !defined(DIS_GEMM) && !defined(DIS_G3)
            pg8::gemm_phase<EpiGateUp, pg8::StaticOrder, HP_ALIGN, HP_SP2>(lds, g, S, E, tid);
#endif
#ifndef DIS_CONV
            if (rep == 0) {
                const int nwg = (MT / 256) * (NGU / 256), first_short = nwg - ((nwg + G - 1) / G - 1) * G;
                const int ll = (l + 1 < NL) ? l + 1 : l, t_lo = (l + 1 < NL) ? 0 : 4768, t_hi = (l + 1 < NL) ? GU_TAIL_N : 6144;
                if (first_short < G && bid >= first_short) convert_range(p, ll, t_lo + bid - first_short, t_hi, G - first_short, lds, tid);
                else if (first_short >= G) convert_range(p, ll, t_lo + bid, t_hi, G, lds, tid);
            }
#endif
            SEAM();
        }
        if (PH_ON(PH_ACT)) for (int rep = 0; rep < REP_ACT; ++rep) {
            const int tid = TID0();
            ph_mlp_fix(p, l, tid, bid, G);
            SEAM();
        }
        if (PH_ON(PH_GEMM_DN)) {
            const int tid = TID0();
            pg8::Gemm g{WSP(bf16_t, WS_H), WSP(bf16_t, (l & 1) ? WS_WDN2 : WS_WDN), MT, DM, DFF}; pg8::StaticOrder S; S.init(MT, DM, G, bid);
            EpiResid3 E{nullptr, WSP(bf16_t, WS_HN), (l + 1 < NL) ? nullptr : p->out, WSP(float, WS_RSS)};
#if !defined(DIS_GEMM) && !defined(DIS_G4)
#ifdef REP_GDN
            for (int rp = 1; rp < REP_GDN; ++rp) { EpiResid3 E2{nullptr, WSP(bf16_t, WS_HN), WSP(float, WS_PROJ), WSP(float, WS_RSS), 1};
                pg8::gemm_phase<EpiResid3, pg8::StaticOrder, HP_ALIGN, HP_SP2>(lds, g, S, E2, tid); SEAM(); }
#endif
            pg8::gemm_phase<EpiResid3, pg8::StaticOrder, HP_ALIGN, HP_SP2>(lds, g, S, E, tid);
#endif
            if (l + 1 < l_hi && !(multi && PH_ON(PH_CONV) && REP_CONV == 1)) SEAM();
        }
    }
#undef PH_ON
#undef SEAM
#undef WSP
#undef TID0
}
}

#ifndef HP_N_LAUNCH_MODE
#define HP_N_LAUNCH_MODE 0
#endif
extern "C" void kernel_launch(void* const* d_in, const int* in_sizes, int n_in, void* d_out, int out_size, void* d_ws, size_t ws_size, hipStream_t stream) {
    using namespace hp;
    static int grid = 0;
    if (grid == 0) {
        if (n_in != N_INPUTS || out_size != MT * DM || ws_size < WS_END) { fprintf(stderr, "kernel_launch: unexpected problem (n_in %d, out %d, ws %zu, need %zu)\n", n_in, out_size, ws_size, (size_t)WS_END); grid = -1; return; }
        int dev = 0, cus = 0, per_cu = 0;
        if (hipGetDevice(&dev) != hipSuccess || hipDeviceGetAttribute(&cus, hipDeviceAttributeMultiprocessorCount, dev) != hipSuccess) { grid = -1; return; }
        if (hipFuncSetAttribute((const void*)hybrid_fwd, hipFuncAttributeMaxDynamicSharedMemorySize, LDS_BYTES) != hipSuccess) { fprintf(stderr, "kernel_launch: hipFuncSetAttribute failed\n"); grid = -1; return; }
        if (hipOccupancyMaxActiveBlocksPerMultiprocessor(&per_cu, (const void*)hybrid_fwd, NTHR, LDS_BYTES) != hipSuccess || per_cu < 1) { fprintf(stderr, "kernel_launch: occupancy query says %d\n", per_cu); (void)hipGetLastError(); per_cu = 1; }
        grid = cus;
    }
    if (grid < 0) return;
    (void)hipMemsetAsync((char*)d_ws + WS_CTL, 0, CTL_BYTES, stream);
    Params p{};
    for (int i = 0; i < N_INPUTS; ++i) p.in[i] = (const float*)d_in[i];
    p.out = (float*)d_out; p.ws = (unsigned char*)d_ws;
#if HP_N_LAUNCH_MODE == 0
    p.l_lo = 0; p.l_hi = NL; p.ph_lo = 0; p.ph_hi = N_PHASES;
    hipLaunchKernelGGL(hybrid_fwd, dim3(grid), dim3(NTHR), LDS_BYTES, stream, p);
#else
    for (int l = 0; l < NL; ++l)
        for (int ph = 0; ph < N_PHASES; ++ph) { p.l_lo = l; p.l_hi = l + 1; p.ph_lo = ph; p.ph_hi = ph + 1; hipLaunchKernelGGL(hybrid_fwd, dim3(grid), dim3(NTHR), LDS_BYTES, stream, p); }
#endif
}
```

```cpp
#include <hip/hip_runtime.h>
#include <stdint.h>
#include <stdio.h>
#define XB_TMO      128
#define XB_XCNT(j)  (256  + 64 * (j))
#define XB_XSUB(j)  (1280 + 64 * (j))
#define XB_XGEN(j)  (2304 + 64 * (j))
#define XB_TOP      3328
#define XB_TOPGEN   3392
#define XCD_BAR_WORDS 3456
#define XB_SPIN_CAP (1u << 22)
#define LAS __attribute__((address_space(3)))

__device__ __forceinline__ unsigned xb_ld(unsigned* p)              { return __hip_atomic_load(p, __ATOMIC_RELAXED, __HIP_MEMORY_SCOPE_AGENT); }
__device__ __forceinline__ unsigned xb_add(unsigned* p, unsigned v) { return __hip_atomic_fetch_add(p, v, __ATOMIC_RELAXED, __HIP_MEMORY_SCOPE_AGENT); }
__device__ __forceinline__ unsigned xb_xcc_id() { return (unsigned)__builtin_amdgcn_s_getreg((3 << 11) | 20) & 0xFu; }
#define XB_SPIN(cond, bar) do { unsigned _sp = 0; while (cond) { __builtin_amdgcn_s_sleep(1); \
    if ((++_sp & 255u) == 0u) { if (xb_ld(&(bar)[XB_TMO])) break; if (_sp > XB_SPIN_CAP) { atomicAdd(&(bar)[XB_TMO], 1u); break; } } } } while (0)

struct XcdBarrier {
    unsigned* bar; unsigned x;
    volatile LAS unsigned* st;
};

__device__ __forceinline__ XcdBarrier xcd_barrier_post(unsigned* bar, volatile LAS unsigned* st) {
    XcdBarrier b; b.bar = bar; b.x = xb_xcc_id(); b.st = st;
    if (threadIdx.x == 0) (void)xb_add(&bar[XB_XCNT(b.x)], 1u);
    return b;
}
__device__ __forceinline__ void xcd_barrier_complete(unsigned* bar, unsigned x, unsigned& nloc, unsigned& nx) {
    const unsigned G = gridDim.x * gridDim.y * gridDim.z;
    unsigned sum, cnt, mine, sp = 0u;
    for (;;) {
        sum = 0u; cnt = 0u; mine = 0u;
#pragma unroll
        for (unsigned j = 0; j < 16; ++j) { const unsigned c = xb_ld(&bar[XB_XCNT(j)]); sum += c; cnt += (c > 0u) ? 1u : 0u; mine = (j == x) ? c : mine; }
        if (sum == G) break;
        __builtin_amdgcn_s_sleep(1);
        if ((++sp & 255u) == 0u) { if (xb_ld(&bar[XB_TMO])) break; if (sp > XB_SPIN_CAP) { atomicAdd(&bar[XB_TMO], 1u); break; } }
    }
    nloc = mine > 0u ? mine : 1u; nx = cnt > 0u ? cnt : 1u;
}

__device__ __forceinline__ void xcd_barrier(const XcdBarrier& b) {
    asm volatile("s_waitcnt vmcnt(0)" ::: "memory");
    __syncthreads();
    if (threadIdx.x == 0) {
        unsigned* bar = b.bar;
        __builtin_amdgcn_s_waitcnt(0);
        unsigned nloc = b.st[0], nx = b.st[1];
        if (nloc == 0u) { xcd_barrier_complete(bar, b.x, nloc, nx); b.st[0] = nloc; b.st[1] = nx; }
        const unsigned old = xb_add(&bar[XB_XSUB(b.x)], 1u);
        const unsigned gen = old / nloc;
        if (old + 1u == (gen + 1u) * nloc) {
            __builtin_amdgcn_fence(__ATOMIC_RELEASE, "agent");
            asm volatile("s_waitcnt vmcnt(0)" ::: "memory");
            const unsigned og = xb_add(&bar[XB_TOP], 1u);
            const unsigned tg = og / nx;
            if (og + 1u == (tg + 1u) * nx) xb_add(&bar[XB_TOPGEN], 1u);
            else XB_SPIN(xb_ld(&bar[XB_TOPGEN]) == tg, bar);
            __builtin_amdgcn_fence(__ATOMIC_ACQUIRE, "agent");
            xb_add(&bar[XB_XGEN(b.x)], 1u);
            asm volatile("s_waitcnt vmcnt(0)" ::: "memory");
        } else {
            XB_SPIN(xb_ld(&bar[XB_XGEN(b.x)]) == gen, bar);
            __builtin_amdgcn_fence(__ATOMIC_ACQUIRE, "agent");
            asm volatile("s_waitcnt vmcnt(0)" ::: "memory");
        }
    }
    __syncthreads();
}
#ifndef PG8_WGM
#define PG8_WGM 8
#endif
namespace pg8 {
#define PG8_LAS __attribute__((address_space(3)))
typedef unsigned short bf16_t;
typedef short bf16x8 __attribute__((ext_vector_type(8)));
typedef float f32x4 __attribute__((ext_vector_type(4)));
typedef unsigned u32x4 __attribute__((ext_vector_type(4)));
constexpr int BM = 256, BK = 64, HALF = 128, HTB = HALF * BK * 2  , STAGE_BYTES = 8 * HTB, NXCD = 8, WGM = PG8_WGM;

__host__ __device__ __forceinline__ int lds_byte(int r, int c) { const int st = (r >> 4) * 2 + (c >> 5), rr = r & 15, cc = c & 31, ob = rr * 64 + cc * 2; return st * 1024 + (ob ^ (((ob >> 9) & 1) << 5)); }
__host__ __device__ __forceinline__ void stage_rc(int b, int& R, int& C) { const int st = b / 1024, sb = b % 1024, swz = sb ^ (((sb >> 9) & 1) << 5); R = (st >> 1) * 16 + swz / 64; C = (st & 1) * 32 + (swz % 64) / 2; }
__host__ __device__ __forceinline__ int perm32(int rho) { const int n = rho >> 4, i = rho & 15; return 8 * (i >> 2) + 4 * n + (i & 3); }

struct Unit { int pm, pn; };
struct Gemm { const bf16_t* A; const bf16_t* Bt; int M, N, K; };

struct StaticOrder {
    int nM, nN, nwg, G, c;
    __host__ __device__ void init(int M, int N, int G_, int c_) { nM = M / BM; nN = N / BM; nwg = nM * nN; G = G_; c = c_; }
    __host__ __device__ bool next(int i, Unit& u) const {
        const long L = (long)i * G + c; if (L >= nwg) return false;
        int wgid = (int)L; { const int q = nwg / NXCD, r = nwg % NXCD, xcd = wgid % NXCD, off = wgid / NXCD; wgid = (xcd < r ? xcd * (q + 1) : r * (q + 1) + (xcd - r) * q) + off; }
        const int nig = WGM * nN, gid = wgid / nig, fm = gid * WGM, gsz = (nM - fm) < WGM ? (nM - fm) : WGM;
        u.pm = fm + ((wgid % nig) % gsz); u.pn = (wgid % nig) / gsz; return true;
    }
    __device__ __forceinline__ void a_ready(const Unit&) const {}
    __device__ __forceinline__ void done(const Unit&) const {}
};

__device__ __forceinline__ unsigned cvt_pk_bf16(float lo, float hi) { unsigned r; asm volatile("v_cvt_pk_bf16_f32 %0, %1, %2" : "=v"(r) : "v"(lo), "v"(hi)); return r; }
typedef float f32x2 __attribute__((ext_vector_type(2)));
__device__ __forceinline__ f32x2 gelu_pk(f32x2 v) {
    const f32x2 av = __builtin_elementwise_abs(v), d = av * 0.2316418882f + 1.0f;
    f32x2 t; t.x = __builtin_amdgcn_rcpf(d.x); t.y = __builtin_amdgcn_rcpf(d.y);
    f32x2 q = t * 0.5307027145f + (-0.7265760135f); q = q * t + 0.7107068705f; q = q * t + (-0.142248368f); q = q * t + 0.127414796f; q = q * t;
    const f32x2 s = (v * v) * (-0.72134752044f);
    f32x2 e; e.x = __builtin_amdgcn_exp2f(s.x); e.y = __builtin_amdgcn_exp2f(s.y);
    const f32x2 m = v * (q * e), r = v - m;
    f32x2 o; o.x = v.x < 0.f ? m.x : r.x; o.y = v.y < 0.f ? m.y : r.y; return o;
}

template <int ACT  > struct EpiBf16 {
    static constexpr bool PERM = true, AFTER_DRAIN = false; static_assert(ACT == 0 || ACT == 1, "EpiBf16: ACT is 0 (none) or 1 (gelu_pk)");
    bf16_t* O; int ldc; const float* bias; int split_cols; size_t split_stride; float scale0;
    __device__ __forceinline__ void operator()(const f32x4 (&acc)[2][2][4][2], const Unit& u, int wr, int wc, int fr, int fq) const {
        const int row0 = u.pm * BM + wr * 64 + fr; int colt = u.pn * BM; bf16_t* base = O;
        float sc = 1.f; if (split_cols) { const int t = colt / split_cols; base += (size_t)t * split_stride; colt -= t * split_cols; if (t == 0) sc = scale0; }
        const int col0 = colt + wc * 32 + 8 * fq, bcol0 = u.pn * BM + wc * 32 + 8 * fq;
        f32x4 bv[2][2];
#pragma unroll
        for (int bj = 0; bj < 2; ++bj)
#pragma unroll
            for (int n = 0; n < 2; ++n) bv[bj][n] = bias ? *(const f32x4*)(bias + bcol0 + bj * HALF + 4 * n) : (f32x4){0.f, 0.f, 0.f, 0.f};
#pragma unroll
        for (int ai = 0; ai < 2; ++ai)
#pragma unroll
            for (int m = 0; m < 4; ++m) { bf16_t* rowp = base + (size_t)(row0 + ai * HALF + m * 16) * ldc + col0;
#pragma unroll
                for (int bj = 0; bj < 2; ++bj) { f32x4 v0 = acc[ai][bj][m][0] + bv[bj][0], v1 = acc[ai][bj][m][1] + bv[bj][1];
                    if (ACT == 1) { f32x2 a = gelu_pk((f32x2){v0[0], v0[1]}), b = gelu_pk((f32x2){v0[2], v0[3]}), c = gelu_pk((f32x2){v1[0], v1[1]}), d = gelu_pk((f32x2){v1[2], v1[3]});
                        v0 = (f32x4){a.x, a.y, b.x, b.y}; v1 = (f32x4){c.x, c.y, d.x, d.y}; }
                    v0 = v0 * sc; v1 = v1 * sc; u32x4 w; w.x = cvt_pk_bf16(v0[0], v0[1]); w.y = cvt_pk_bf16(v0[2], v0[3]); w.z = cvt_pk_bf16(v1[0], v1[1]); w.w = cvt_pk_bf16(v1[2], v1[3]);
                    *(u32x4*)(rowp + bj * HALF) = w; } }
    }
};

struct PanelStats {
    unsigned* xbuf;
    unsigned* cnt;
    unsigned* tmo;
    int ntn; float eps;
    unsigned code;
    __device__ __forceinline__ bool run(const f32x4 (&v)[2][2][4][2], const Unit& u, int wr, int wc, int fr, int fq, PG8_LAS unsigned char* lds, int wid, int lane) const {
        typedef float f32x2v __attribute__((ext_vector_type(2)));
        PG8_LAS f32x2v* P = (PG8_LAS f32x2v*)lds;
        PG8_LAS f32x2v* S = (PG8_LAS f32x2v*)(lds + 8192);
        PG8_LAS unsigned* flag = (PG8_LAS unsigned*)(lds + 8192 + 2048);
#pragma unroll
        for (int ai = 0; ai < 2; ++ai)
#pragma unroll
            for (int m = 0; m < 4; ++m) {
                float s = 0.f;
#pragma unroll
                for (int bj = 0; bj < 2; ++bj)
#pragma unroll
                    for (int n = 0; n < 2; ++n) { const f32x4 x = v[ai][bj][m][n]; s += (x[0] + x[1]) + (x[2] + x[3]); }
                s += __shfl_xor(s, 16); s += __shfl_xor(s, 32);
                const float mw = s * (1.0f / 64.0f); float q = 0.f;
#pragma unroll
                for (int bj = 0; bj < 2; ++bj)
#pragma unroll
                    for (int n = 0; n < 2; ++n) { const f32x4 d = v[ai][bj][m][n] - mw; q += (d[0] * d[0] + d[1] * d[1]) + (d[2] * d[2] + d[3] * d[3]); }
                q += __shfl_xor(q, 16); q += __shfl_xor(q, 32);
                if (fq == 0) P[(ai * HALF + wr * 64 + m * 16 + fr) * 4 + wc] = (f32x2v){mw, q};
            }
        asm volatile("s_waitcnt lgkmcnt(0)" ::: "memory"); __builtin_amdgcn_s_barrier(); asm volatile("" ::: "memory");
#if defined(BROKEN_EXCHANGE_NO_WAIT)
#warning BROKEN CONTROL BUILD: the row-statistics exchange does not wait; results are wrong by design
        if (blockIdx.x >= 64) { const long long t0_ = clock64(); while (clock64() - t0_ < 60000) __builtin_amdgcn_s_sleep(8); }
#endif
        const int row = wid * 32 + (lane & 31);
        if (lane < 32) {
            const f32x2v a = P[row * 4 + 0], b = P[row * 4 + 1], c = P[row * 4 + 2], d = P[row * 4 + 3];
            const float mt = (a.x + b.x + c.x + d.x) * 0.25f;
            const float da = a.x - mt, db = b.x - mt, dc = c.x - mt, dd = d.x - mt;
            const float m2 = (a.y + b.y) + (c.y + d.y) + 64.0f * ((da * da + db * db) + (dc * dc + dd * dd));
            unsigned long long* slot = (unsigned long long*)xbuf + ((size_t)(u.pm * BM + row) * 4 + u.pn);
            __hip_atomic_store(slot, ((unsigned long long)__float_as_uint(m2) << 32) | __float_as_uint(mt), __ATOMIC_RELAXED, __HIP_MEMORY_SCOPE_AGENT);
        }
        asm volatile("s_waitcnt vmcnt(0)" ::: "memory");
        if (lane == 0) __hip_atomic_fetch_add(cnt + 64 * u.pm, 1u, __ATOMIC_RELAXED, __HIP_MEMORY_SCOPE_AGENT);
        if (wid == 0) {
            bool dead = false; const unsigned long long t0 = __builtin_amdgcn_s_memrealtime(); const unsigned want = 8u * (unsigned)ntn;
            for (;;) {
#if defined(BROKEN_EXCHANGE_NO_WAIT)
                break;
#endif
                if ((unsigned)__builtin_amdgcn_readfirstlane(__hip_atomic_load(cnt + 64 * u.pm, __ATOMIC_RELAXED, __HIP_MEMORY_SCOPE_AGENT)) >= want) break;
                if (__builtin_amdgcn_s_memrealtime() - t0 > 2000000ull) {
                    if (lane == 0) { unsigned expect = 0u; __hip_atomic_compare_exchange_strong(tmo + 1, &expect, code | (unsigned)(u.pm & 0xff), __ATOMIC_RELAXED, __ATOMIC_RELAXED, __HIP_MEMORY_SCOPE_AGENT);
                                     __hip_atomic_store(tmo, 1u, __ATOMIC_RELAXED, __HIP_MEMORY_SCOPE_AGENT); }
                    dead = true; break; }
                __builtin_amdgcn_s_sleep(2);
            }
            __builtin_amdgcn_fence(__ATOMIC_ACQUIRE, "agent");
            if (lane == 0) flag[0] = dead ? 1u : 0u;
        }
        asm volatile("s_waitcnt vmcnt(0) lgkmcnt(0)" ::: "memory"); __builtin_amdgcn_s_barrier(); asm volatile("" ::: "memory");
        const bool bad = flag[0] != 0u;
        if (lane < 32) {
            const unsigned long long* slot = (const unsigned long long*)xbuf + (size_t)(u.pm * BM + row) * 4; float mt[4], m2[4]; float ms = 0.f;
#pragma unroll
            for (int t = 0; t < 4; ++t) { if (t < ntn) { const unsigned long long w = __hip_atomic_load(slot + t, __ATOMIC_RELAXED, __HIP_MEMORY_SCOPE_AGENT); mt[t] = __uint_as_float((unsigned)w); m2[t] = __uint_as_float((unsigned)(w >> 32)); } else { mt[t] = 0.f; m2[t] = 0.f; } ms += mt[t]; }
            const float mean = ms / (float)ntn; float q = 0.f;
#pragma unroll
            for (int t = 0; t < 4; ++t) if (t < ntn) { const float dm = mt[t] - mean; q += m2[t] + 256.0f * dm * dm; }
            S[row] = (f32x2v){mean, 1.0f / sqrtf(q / (256.0f * (float)ntn) + eps)};
        }
        asm volatile("s_waitcnt lgkmcnt(0)" ::: "memory"); __builtin_amdgcn_s_barrier(); asm volatile("" ::: "memory");
        return bad;
    }
};
struct EpiLnRes {
    static constexpr bool PERM = false, AFTER_DRAIN = true;
    const float* base; float* out; int ldc; const float* bias; PanelStats st; unsigned poison;
    __device__ __forceinline__ void fused(f32x4 (&acc)[2][2][4][2], const Unit& u, int wr, int wc, int fr, int fq, PG8_LAS unsigned char* lds, int wid, int lane) const {
        typedef float f32x2v __attribute__((ext_vector_type(2)));
        const PG8_LAS f32x2v* S = (const PG8_LAS f32x2v*)(lds + 8192);
        const int col0 = u.pn * BM + wc * 32 + 4 * fq;
#pragma unroll
        for (int bj = 0; bj < 2; ++bj)
#pragma unroll
            for (int n = 0; n < 2; ++n) { const f32x4 bv = bias ? *(const f32x4*)(bias + col0 + bj * HALF + n * 16) : (f32x4){0.f, 0.f, 0.f, 0.f};
#pragma unroll
                for (int ai = 0; ai < 2; ++ai)
#pragma unroll
                    for (int m = 0; m < 4; ++m) acc[ai][bj][m][n] += bv; }
        f32x4 pre[4][2][2];
#pragma unroll
        for (int m = 0; m < 4; ++m) { const size_t off = (size_t)(u.pm * BM + wr * 64 + m * 16 + fr) * ldc + col0;
#pragma unroll
            for (int bj = 0; bj < 2; ++bj)
#pragma unroll
                for (int n = 0; n < 2; ++n) pre[m][bj][n] = *(const f32x4*)(base + off + bj * HALF + n * 16); }
        const bool bad = st.run(acc, u, wr, wc, fr, fq, lds, wid, lane) || poison != 0u;
        const float qnan = __builtin_nanf("");
#pragma unroll
        for (int ai = 0; ai < 2; ++ai)
#pragma unroll
            for (int m = 0; m < 4; ++m) { const int r = ai * HALF + wr * 64 + m * 16 + fr; const f32x2v sr = S[r]; const size_t off = (size_t)(u.pm * BM + r) * ldc + col0;
#pragma unroll
                for (int bj = 0; bj < 2; ++bj)
#pragma unroll
                    for (int n = 0; n < 2; ++n) { const f32x4 bs = ai == 0 ? pre[m][bj][n] : *(const f32x4*)(base + off + bj * HALF + n * 16); f32x4 o = bs + (acc[ai][bj][m][n] - sr.x) * sr.y;
                        if (bad) o = (f32x4){qnan, qnan, qnan, qnan}; *(f32x4*)(out + off + bj * HALF + n * 16) = o; }
                if (m & 1) asm volatile("" ::: "memory"); }
    }
};
struct EpiLnResLn {
    static constexpr bool PERM = false, AFTER_DRAIN = true;
    const float* base; float* out; bf16_t* xn; int ldc; const float* bias; PanelStats st1, st2; unsigned poison;
    __device__ __forceinline__ void fused(f32x4 (&acc)[2][2][4][2], const Unit& u, int wr, int wc, int fr, int fq, PG8_LAS unsigned char* lds, int wid, int lane) const {
        typedef float f32x2v __attribute__((ext_vector_type(2))); typedef unsigned u32x2v __attribute__((ext_vector_type(2)));
        const PG8_LAS f32x2v* S = (const PG8_LAS f32x2v*)(lds + 8192);
        const int col0 = u.pn * BM + wc * 32 + 4 * fq;
#pragma unroll
        for (int bj = 0; bj < 2; ++bj)
#pragma unroll
            for (int n = 0; n < 2; ++n) { const f32x4 bv = bias ? *(const f32x4*)(bias + col0 + bj * HALF + n * 16) : (f32x4){0.f, 0.f, 0.f, 0.f};
#pragma unroll
                for (int ai = 0; ai < 2; ++ai)
#pragma unroll
                    for (int m = 0; m < 4; ++m) acc[ai][bj][m][n] += bv; }
        bool bad = st1.run(acc, u, wr, wc, fr, fq, lds, wid, lane) || poison != 0u;
        const float qnan = __builtin_nanf("");
#pragma unroll
        for (int ai = 0; ai < 2; ++ai)
#pragma unroll
            for (int m = 0; m < 4; ++m) { const int r = ai * HALF + wr * 64 + m * 16 + fr; const f32x2v sr = S[r]; const size_t off = (size_t)(u.pm * BM + r) * ldc + col0;
#pragma unroll
                for (int bj = 0; bj < 2; ++bj)
#pragma unroll
                    for (int n = 0; n < 2; ++n) { const f32x4 bs = *(const f32x4*)(base + off + bj * HALF + n * 16); acc[ai][bj][m][n] = bs + (acc[ai][bj][m][n] - sr.x) * sr.y; }
                asm volatile("" : "+v"(acc[ai][0][m][0]), "+v"(acc[ai][0][m][1]), "+v"(acc[ai][1][m][0]), "+v"(acc[ai][1][m][1]));
                if (m & 1) asm volatile("" ::: "memory"); }
        const bool bad1 = bad;
        bad = st2.run(acc, u, wr, wc, fr, fq, lds, wid, lane) || bad;
#pragma unroll
        for (int ai = 0; ai < 2; ++ai)
#pragma unroll
            for (int m = 0; m < 4; ++m) { const int r = ai * HALF + wr * 64 + m * 16 + fr; const f32x2v sr = S[r]; const size_t off = (size_t)(u.pm * BM + r) * ldc + col0;
#pragma unroll
                for (int bj = 0; bj < 2; ++bj)
#pragma unroll
                    for (int n = 0; n < 2; ++n) { const f32x4 x1 = acc[ai][bj][m][n]; *(f32x4*)(out + off + bj * HALF + n * 16) = bad1 ? (f32x4){qnan, qnan, qnan, qnan} : x1;
                        const f32x4 o = (x1 - sr.x) * sr.y; u32x2v w; w.x = cvt_pk_bf16(o[0], o[1]); w.y = cvt_pk_bf16(o[2], o[3]);
                        if (bad) { w.x = 0x7fc07fc0u; w.y = 0x7fc07fc0u; } *(u32x2v*)(xn + off + bj * HALF + n * 16) = w; }
                asm volatile("" ::: "memory"); }
    }
};

template <class Epi, class Sched, bool ALIGN_EPI = false, bool SP2 = false>
__device__ __forceinline__ void gemm_phase(PG8_LAS unsigned char* lds, const Gemm g, const Sched& S, const Epi& E, int tid_) {
    asm volatile("" : "+v"(tid_));
    const int tid = tid_, wid = __builtin_amdgcn_readfirstlane(tid >> 6), lane = tid & 63, wr = wid >> 2, wc = wid & 3, fr = lane & 15, fq = lane >> 4;
    const int K = g.K, nt = K / BK;
    unsigned voffA[2], voffB[2];
#pragma unroll
    for (int i = 0; i < 2; ++i) { int R, C; stage_rc(tid * 16 + i * 8192, R, C); const int Rb = Epi::PERM ? ((R & ~31) + perm32(R & 31)) : R;
        voffA[i] = (unsigned)(R * K + C) * 2u; voffB[i] = (unsigned)(Rb * K + C) * 2u; }
    const size_t kstep = (size_t)(BK * 2);
    const size_t hstep = (size_t)HALF * K * 2;
    const size_t tstep = 2 * hstep;
    const unsigned ldsw = (unsigned)wid * 1024u;
    const int aoff = lds_byte(wr * 64 + fr, fq * 8), boff = lds_byte(wc * 32 + fr, fq * 8);
#define PG8_SA(b, h) (((b) * 2 + (h)) * HTB)
#define PG8_SB(b, h) ((4 + (b) * 2 + (h)) * HTB)
#define PG8_STAGE(bufoff, gbase, voff) do { _Pragma("unroll") for (int _i = 0; _i < 2; ++_i) \
        __builtin_amdgcn_global_load_lds((const unsigned*)((const char*)(gbase) + (voff)[_i]), (PG8_LAS unsigned*)(lds + (bufoff) + ldsw + _i * 8192), 16, 0, 0); } while (0)
#define PG8_LDA(dst, b, h) do { _Pragma("unroll") for (int m = 0; m < 4; ++m) _Pragma("unroll") for (int k = 0; k < 2; ++k) dst[m][k] = *(const PG8_LAS bf16x8*)(lds + PG8_SA(b, h) + aoff + m * 2048 + k * 1024); } while (0)
#define PG8_LDB(dst, b, h) do { _Pragma("unroll") for (int n = 0; n < 2; ++n) _Pragma("unroll") for (int k = 0; k < 2; ++k) dst[n][k] = *(const PG8_LAS bf16x8*)(lds + PG8_SB(b, h) + boff + n * 2048 + k * 1024); } while (0)
#define PG8_MMA(ai, bj, At, Bt) do { __builtin_amdgcn_s_setprio(1); _Pragma("unroll") for (int m = 0; m < 4; ++m) _Pragma("unroll") for (int n = 0; n < 2; ++n) _Pragma("unroll") for (int k = 0; k < 2; ++k) \
        acc[ai][bj][m][n] = __builtin_amdgcn_mfma_f32_16x16x32_bf16(Bt[n][k], At[m][k], acc[ai][bj][m][n], 0, 0, 0); __builtin_amdgcn_s_setprio(0); } while (0)
#define PG8_WAIT_V(n) asm volatile("s_waitcnt vmcnt(" #n ")" ::: "memory")
#define PG8_WAIT_L(n) asm volatile("s_waitcnt lgkmcnt(" #n ")" ::: "memory")
#define PG8_BAR __builtin_amdgcn_s_barrier()
#define PG8_SCHED __builtin_amdgcn_sched_barrier(0)
    Unit cur, nxt; int ui = 0;
    if (!S.next(0, cur)) return;
    f32x4 acc[2][2][4][2];
#pragma unroll
    for (int a = 0; a < 2; ++a)
#pragma unroll
        for (int b = 0; b < 2; ++b)
#pragma unroll
            for (int m = 0; m < 4; ++m)
#pragma unroll
                for (int n = 0; n < 2; ++n) acc[a][b][m][n] = (f32x4){0.f, 0.f, 0.f, 0.f};
    bf16x8 At[4][2], B0[2][2], B1[2][2];
    const char* cA = (const char*)g.A + (size_t)cur.pm * tstep; const char* cB = (const char*)g.Bt + (size_t)cur.pn * tstep;
    S.a_ready(cur);
    if constexpr (SP2) {
        PG8_STAGE(PG8_SB(0, 0), cB, voffB); PG8_STAGE(PG8_SB(0, 1), cB + hstep, voffB); PG8_STAGE(PG8_SA(0, 0), cA, voffA); PG8_STAGE(PG8_SA(0, 1), cA + hstep, voffA);
        if (wr == 1) PG8_BAR;
        PG8_WAIT_V(2); PG8_BAR;
        PG8_STAGE(PG8_SB(1, 0), cB + kstep, voffB); PG8_STAGE(PG8_SA(1, 0), cA + kstep, voffA); PG8_STAGE(PG8_SB(1, 1), cB + hstep + kstep, voffB);
        PG8_WAIT_V(6); PG8_BAR;
    } else {
        PG8_STAGE(PG8_SB(0, 0), cB, voffB); PG8_STAGE(PG8_SA(0, 0), cA, voffA); PG8_STAGE(PG8_SB(0, 1), cB + hstep, voffB); PG8_STAGE(PG8_SA(0, 1), cA + hstep, voffA);
        if (wr == 1) PG8_BAR;
        PG8_WAIT_V(4); PG8_BAR;
        PG8_STAGE(PG8_SB(1, 0), cB + kstep, voffB); PG8_STAGE(PG8_SA(1, 0), cA + kstep, voffA); PG8_STAGE(PG8_SB(1, 1), cB + hstep + kstep, voffB);
        PG8_WAIT_V(6); PG8_BAR;
    }
    for (;;) {
        const bool has_next = S.next(ui + 1, nxt);
        const char* nA = has_next ? (const char*)g.A + (size_t)nxt.pm * tstep : cA; const char* nB = has_next ? (const char*)g.Bt + (size_t)nxt.pn * tstep : cB;
        for (int t = 0; t < nt; t += 2) {
            const bool last = (t == nt - 2);
            const char* a1 = cA + (size_t)(t + 1) * kstep;
            const char* a2 = last ? nA : cA + (size_t)(t + 2) * kstep; const char* b2 = last ? nB : cB + (size_t)(t + 2) * kstep;
            const char* a3 = a2 + kstep; const char* b3 = b2 + kstep;
            if (last && has_next) S.a_ready(nxt);
            if constexpr (SP2) {
            PG8_LDB(B0, 0, 0); PG8_LDB(B1, 0, 1); PG8_SCHED; PG8_LDA(At, 0, 0); PG8_STAGE(PG8_SA(1, 1), a1 + hstep, voffA);
            PG8_WAIT_V(8); PG8_WAIT_L(0); PG8_BAR; PG8_MMA(0, 0, At, B0); PG8_MMA(0, 1, At, B1); PG8_BAR; PG8_SCHED;
            PG8_LDA(At, 0, 1); PG8_STAGE(PG8_SB(0, 0), b2, voffB); PG8_STAGE(PG8_SB(0, 1), b2 + hstep, voffB); PG8_STAGE(PG8_SA(0, 0), a2, voffA);
            PG8_WAIT_V(8); PG8_WAIT_L(0); PG8_BAR; PG8_MMA(1, 0, At, B0); PG8_MMA(1, 1, At, B1); PG8_BAR; PG8_SCHED;
            PG8_LDB(B0, 1, 0); PG8_LDB(B1, 1, 1); PG8_SCHED; PG8_LDA(At, 1, 0); PG8_STAGE(PG8_SA(0, 1), a2 + hstep, voffA);
            PG8_WAIT_V(8); PG8_WAIT_L(0); PG8_BAR; PG8_MMA(0, 0, At, B0); PG8_MMA(0, 1, At, B1); PG8_BAR; PG8_SCHED;
            PG8_LDA(At, 1, 1); PG8_STAGE(PG8_SB(1, 0), b3, voffB); PG8_STAGE(PG8_SB(1, 1), b3 + hstep, voffB); PG8_STAGE(PG8_SA(1, 0), a3, voffA);
            PG8_WAIT_V(8); PG8_WAIT_L(0); PG8_BAR; PG8_MMA(1, 0, At, B0); PG8_MMA(1, 1, At, B1); PG8_BAR; PG8_SCHED;
            } else {
            PG8_LDB(B0, 0, 0); PG8_SCHED; PG8_LDA(At, 0, 0); PG8_STAGE(PG8_SA(1, 1), a1 + hstep, voffA);
            PG8_WAIT_L(8); PG8_BAR; PG8_WAIT_L(0); PG8_MMA(0, 0, At, B0); PG8_BAR; PG8_SCHED;
            PG8_LDB(B1, 0, 1); PG8_STAGE(PG8_SB(0, 0), b2, voffB);
            PG8_BAR; PG8_WAIT_L(0); PG8_MMA(0, 1, At, B1); PG8_BAR;
            PG8_LDA(At, 0, 1); PG8_STAGE(PG8_SA(0, 0), a2, voffA);
            PG8_BAR; PG8_WAIT_L(0); PG8_MMA(1, 0, At, B0); PG8_BAR; PG8_SCHED;
            PG8_STAGE(PG8_SB(0, 1), b2 + hstep, voffB);
            PG8_WAIT_V(6); PG8_BAR; PG8_MMA(1, 1, At, B1); PG8_BAR;
            PG8_LDB(B0, 1, 0); PG8_SCHED; PG8_LDA(At, 1, 0); PG8_STAGE(PG8_SA(0, 1), a2 + hstep, voffA);
            PG8_WAIT_L(8); PG8_BAR; PG8_WAIT_L(0); PG8_MMA(0, 0, At, B0); PG8_BAR; PG8_SCHED;
            PG8_LDB(B1, 1, 1); PG8_STAGE(PG8_SB(1, 0), b3, voffB);
            PG8_BAR; PG8_WAIT_L(0); PG8_MMA(0, 1, At, B1); PG8_BAR;
            PG8_LDA(At, 1, 1); PG8_STAGE(PG8_SA(1, 0), a3, voffA);
            PG8_BAR; PG8_WAIT_L(0); PG8_MMA(1, 0, At, B0); PG8_BAR; PG8_SCHED;
            PG8_STAGE(PG8_SB(1, 1), b3 + hstep, voffB);
            PG8_WAIT_V(6); PG8_BAR; PG8_MMA(1, 1, At, B1); PG8_BAR;
            }
        }
        if constexpr (ALIGN_EPI) { if (wr == 0) PG8_BAR; }
        if constexpr (!Epi::AFTER_DRAIN) { E(acc, cur, wr, wc, fr, fq); S.done(cur); }
        if (!has_next) break;
#pragma unroll
        for (int a = 0; a < 2; ++a)
#pragma unroll
            for (int b = 0; b < 2; ++b)
#pragma unroll
                for (int m = 0; m < 4; ++m)
#pragma unroll
                    for (int n = 0; n < 2; ++n) acc[a][b][m][n] = (f32x4){0.f, 0.f, 0.f, 0.f};
        cur = nxt; cA = nA; cB = nB; ++ui;
        if constexpr (ALIGN_EPI) { if (wr == 1) PG8_BAR; }
    }
    PG8_WAIT_V(0);
    if constexpr (!ALIGN_EPI) { if (wr == 0) PG8_BAR; }
    PG8_BAR;
    if constexpr (Epi::AFTER_DRAIN) { E.fused(acc, cur, wr, wc, fr, fq, lds, wid, lane); S.done(cur); }
#undef PG8_SA
#undef PG8_SB
#undef PG8_STAGE
#undef PG8_LDA
#undef PG8_LDB
#undef PG8_MMA
#undef PG8_WAIT_V
#undef PG8_WAIT_L
#undef PG8_BAR
#undef PG8_SCHED
}
}

namespace hp {
typedef unsigned short bf16_t;
typedef short bf16x8 __attribute__((ext_vector_type(8)));
typedef short s16x4 __attribute__((ext_vector_type(4)));
typedef float f32x4 __attribute__((ext_vector_type(4)));
typedef float f32x16 __attribute__((ext_vector_type(16)));
typedef unsigned u32x4 __attribute__((ext_vector_type(4)));
typedef unsigned u32x2 __attribute__((ext_vector_type(2)));

constexpr int NB = 4, SEQ = 4096, DM = 4096, NL = 4, MT = NB * SEQ;
constexpr int NIN = 11800, NINP = 12032, DFF = 11008, NGU = 2 * DFF;
constexpr int C_RQ = 0, C_RK = 1024, C_RV = 2048, C_RG = 3072, C_SQ = 4096, C_SK = 5120, C_SV = 6144, C_LG = 7168, C_LR = 8192,
              C_NQ = 9216, C_NKC = 10240, C_NVC = 10496, C_NKS = 10752, C_NVS = 11008, C_NKW = 11264, C_NVW = 11520, C_NG = 11776;
constexpr int MIX_RET = 0, MIX_SB = 1024, MIX_LRU = 2048, MIX_NSA = 3072;
constexpr int NTHR = 512, NWAVE = 8;
constexpr int LDS_STAGE = 131072, LDS_CTL = 256, RT_PANELS = 24, LDS_RT = RT_PANELS * 256 * 4, LDS_BYTES = LDS_STAGE + LDS_CTL + LDS_RT;

enum { I_X = 0, I_ANW, I_WIN, I_LCW, I_LCB, I_LWA, I_LBA, I_LWX, I_LBX, I_LLAM, I_NQW, I_NKW, I_CPOS, I_CW1, I_CW2, I_WOUT, I_MNW, I_WG, I_WU, I_MCW, I_MCB, I_WD, N_INPUTS };

constexpr size_t al256(size_t x) { return (x + 255) & ~(size_t)255; }
constexpr size_t WS_CTL   = 0;
constexpr size_t CTL_BYTES = 65536;
constexpr size_t WS_RSS   = WS_CTL + CTL_BYTES;
constexpr size_t WS_TAB_RC = WS_RSS + (size_t)2 * MT * 64 * 4;
constexpr size_t WS_TAB_RS = WS_TAB_RC + (size_t)SEQ * 64 * 4;
constexpr size_t WS_TAB_NC = WS_TAB_RS + (size_t)SEQ * 64 * 4;
constexpr size_t WS_TAB_NS = WS_TAB_NC + (size_t)SEQ * 16 * 4;
constexpr size_t WS_WIN   = WS_TAB_NS + (size_t)SEQ * 16 * 4;
constexpr size_t WS_WOUT  = WS_WIN  + (size_t)NINP * DM * 2;
constexpr size_t WS_WGU   = WS_WOUT + (size_t)DM * DM * 2;
constexpr size_t WS_WDN   = WS_WGU  + (size_t)NGU * DM * 2;
constexpr size_t WS_CW1   = WS_WDN  + (size_t)DM * DFF * 2;
constexpr size_t WS_CW2   = WS_CW1  + (size_t)2 * 4096 * 256 * 2;
constexpr size_t WS_LWA   = WS_CW2  + (size_t)2 * 256 * 128 * 2;
constexpr size_t WS_LWX   = WS_LWA  + (size_t)8 * 128 * 128 * 2;
constexpr size_t WS_HN    = WS_LWX  + (size_t)8 * 128 * 128 * 2;
constexpr size_t WS_MIX   = WS_HN   + (size_t)MT * DM * 2;
constexpr size_t WS_PROJ  = WS_MIX  + (size_t)MT * DM * 2;
constexpr size_t WS_GU    = WS_PROJ;
constexpr size_t WS_H     = WS_PROJ + (size_t)MT * NGU * 2;
constexpr size_t WS_QR    = WS_H    + (size_t)MT * DFF * 2;
constexpr size_t WS_KR    = WS_QR   + (size_t)MT * 1024 * 2;
constexpr size_t WS_QN    = WS_KR   + (size_t)MT * 1024 * 2;
constexpr size_t WS_KSN   = WS_QN   + (size_t)MT * 1024 * 2;
constexpr size_t WS_KWN   = WS_KSN  + (size_t)MT * 256 * 2;
constexpr size_t WS_KCMP  = WS_KWN  + (size_t)MT * 256 * 2;
constexpr size_t WS_VCMP  = WS_KCMP + (size_t)8 * 256 * 128 * 2;
constexpr size_t WS_ST    = WS_VCMP + (size_t)8 * 256 * 128 * 2;
constexpr size_t WS_HLOC  = WS_ST   + (size_t)32 * 32 * 128 * 128 * 2;
constexpr size_t WS_CUMA  = WS_HLOC + (size_t)MT * 1024 * 4;
constexpr size_t WS_YNSA  = WS_CUMA + (size_t)MT * 1024 * 4;
constexpr size_t WS_GT    = WS_YNSA + (size_t)MT * 1024 * 4;
constexpr size_t WS_GH    = WS_GT   + (size_t)256 * 2 * DFF * 2;
constexpr size_t WS_UH    = WS_GH   + (size_t)256 * 2 * DFF * 2;
constexpr size_t WS_CPOS  = WS_UH   + (size_t)256 * 2 * DFF * 2;
constexpr size_t WS_WDN2  = WS_CPOS + 2 * 256 * 4;
constexpr size_t WS_END   = WS_WDN2 + (size_t)DM * DFF * 2;
constexpr int CW_BAR = 0;
constexpr int CW_RSFLAG = 8192;
constexpr int CW_QUEUE = 4096;

struct Params {
    const float* in[N_INPUTS];
    float* out;
    unsigned char* ws;
    int l_lo, l_hi, ph_lo, ph_hi;
};
typedef const __attribute__((address_space(4))) Params* KP;

__device__ __forceinline__ float bf2f(unsigned short v) { return __uint_as_float(((unsigned)v) << 16); }
__device__ __forceinline__ float bflo(unsigned w) { return __uint_as_float(w << 16); }
__device__ __forceinline__ float bfhi(unsigned w) { return __uint_as_float(w & 0xffff0000u); }
__device__ __forceinline__ unsigned cvt_pk(float lo, float hi) { unsigned r; asm volatile("v_cvt_pk_bf16_f32 %0, %1, %2" : "=v"(r) : "v"(lo), "v"(hi)); return r; }
__device__ __forceinline__ unsigned short f2bf(float f) { return (unsigned short)(cvt_pk(f, 0.f) & 0xffffu); }
__device__ __forceinline__ float fexp2(float x) { return __builtin_amdgcn_exp2f(x); }
__device__ __forceinline__ float flog2(float x) { return __builtin_amdgcn_logf(x); }
__device__ __forceinline__ float frcp(float x) { return __builtin_amdgcn_rcpf(x); }
__device__ __forceinline__ float sigmoidf_(float x) { return frcp(1.f + fexp2(-x * 1.4426950408889634f)); }
__device__ __forceinline__ float gelu_tanh(float x) {
    const float u = 0.7978845608028654f * (x + 0.044715f * x * x * x);
    const float t = 1.f - 2.f * frcp(1.f + fexp2(2.f * 1.4426950408889634f * u));
    return 0.5f * x * (1.f + t);
}
__device__ __forceinline__ float half_max(float v) { auto r = __builtin_amdgcn_permlane32_swap(__float_as_uint(v), __float_as_uint(v), false, false); return fmaxf(__uint_as_float(r[0]), __uint_as_float(r[1])); }
__device__ __forceinline__ float half_sum(float v) { auto r = __builtin_amdgcn_permlane32_swap(__float_as_uint(v), __float_as_uint(v), false, false); return __uint_as_float(r[0]) + __uint_as_float(r[1]); }
__device__ __forceinline__ float wave_sum(float v) {
#pragma unroll
    for (int o = 32; o >= 1; o >>= 1) v += __shfl_xor(v, o);
    return v;
}

__device__ __forceinline__ unsigned off_b(unsigned row, unsigned ch) { return 256u * row + 16u * (ch ^ (((row & 3u) << 2) | ((row >> 2) & 3u))); }
__device__ __forceinline__ bf16x8 row_frag(const LAS unsigned char* tile, int r0, int s, int lane) {
    return *(const LAS bf16x8*)(tile + off_b((unsigned)(r0 + (lane & 31)), (unsigned)(2 * s + (lane >> 5))));
}
__device__ __forceinline__ unsigned lds_addr(const LAS unsigned char* p) { return (unsigned)(size_t)p; }
__device__ __forceinline__ unsigned tr_off_nat(int lane, int c, int ks, int t) {
    const unsigned h = lane >> 5, blk = (lane >> 4) & 1, q = (lane & 15) >> 2, p = lane & 3;
    return off_b(16u * ks + 8u * h + 4u * t + q, 4u * c + 2u * blk + (p >> 1)) + 8u * (p & 1);
}
__device__ __forceinline__ unsigned tr_off_acc(int lane, int c, int ks, int t) {
    const unsigned h = lane >> 5, blk = (lane >> 4) & 1, q = (lane & 15) >> 2, p = lane & 3;
    return off_b(16u * ks + 8u * t + 4u * h + q, 4u * c + 2u * blk + (p >> 1)) + 8u * (p & 1);
}
__device__ __forceinline__ bf16x8 tr_read2(unsigned a0, unsigned a1) {
    s16x4 lo, hi;
    asm volatile("ds_read_b64_tr_b16 %0, %2\n\tds_read_b64_tr_b16 %1, %3\n\ts_waitcnt lgkmcnt(0)" : "=&v"(lo), "=&v"(hi) : "v"(a0), "v"(a1) : "memory");
    return __builtin_shufflevector(lo, hi, 0, 1, 2, 3, 4, 5, 6, 7);
}
__device__ __forceinline__ void tr_frag_nat2(const LAS unsigned char* t0, const LAS unsigned char* t1, int c, int ks, int lane, bf16x8& f0, bf16x8& f1) {
    const unsigned o0 = tr_off_nat(lane, c, ks, 0), o1 = tr_off_nat(lane, c, ks, 1), b0 = lds_addr(t0), b1 = lds_addr(t1);
    s16x4 l0, h0, l1, h1;
    asm volatile("ds_read_b64_tr_b16 %0, %4\n\tds_read_b64_tr_b16 %1, %5\n\tds_read_b64_tr_b16 %2, %6\n\tds_read_b64_tr_b16 %3, %7\n\ts_waitcnt lgkmcnt(0)"
                 : "=&v"(l0), "=&v"(h0), "=&v"(l1), "=&v"(h1) : "v"(b0 + o0), "v"(b0 + o1), "v"(b1 + o0), "v"(b1 + o1) : "memory");
    f0 = __builtin_shufflevector(l0, h0, 0, 1, 2, 3, 4, 5, 6, 7); f1 = __builtin_shufflevector(l1, h1, 0, 1, 2, 3, 4, 5, 6, 7);
}
__device__ __forceinline__ bf16x8 tr_frag_nat(const LAS unsigned char* tile, int c, int ks, int lane) {
    const unsigned b = lds_addr(tile);
    return tr_read2(b + tr_off_nat(lane, c, ks, 0), b + tr_off_nat(lane, c, ks, 1));
}
struct TrAcc { unsigned a[4][2]; };
__device__ __forceinline__ void tr_acc_init(TrAcc& A, int lane) {
#pragma unroll
    for (int c = 0; c < 4; ++c)
#pragma unroll
        for (int t = 0; t < 2; ++t) A.a[c][t] = tr_off_acc(lane, c, 0, t);
}
__device__ __forceinline__ void pv_step(f32x16 (&o)[4], unsigned vb  , const TrAcc& A, bf16x8 pf) {
    s16x4 d0, d1, d2, d3, d4, d5, d6, d7;
    asm volatile("ds_read_b64_tr_b16 %0, %8\n\tds_read_b64_tr_b16 %1, %9\n\tds_read_b64_tr_b16 %2, %10\n\tds_read_b64_tr_b16 %3, %11\n\t"
                 "ds_read_b64_tr_b16 %4, %12\n\tds_read_b64_tr_b16 %5, %13\n\tds_read_b64_tr_b16 %6, %14\n\tds_read_b64_tr_b16 %7, %15\n\ts_waitcnt lgkmcnt(0)"
                 : "=&v"(d0), "=&v"(d1), "=&v"(d2), "=&v"(d3), "=&v"(d4), "=&v"(d5), "=&v"(d6), "=&v"(d7)
                 : "v"(vb + A.a[0][0]), "v"(vb + A.a[0][1]), "v"(vb + A.a[1][0]), "v"(vb + A.a[1][1]), "v"(vb + A.a[2][0]), "v"(vb + A.a[2][1]), "v"(vb + A.a[3][0]), "v"(vb + A.a[3][1]) : "memory");
    o[0] = __builtin_amdgcn_mfma_f32_32x32x16_bf16(__builtin_shufflevector(d0, d1, 0, 1, 2, 3, 4, 5, 6, 7), pf, o[0], 0, 0, 0);
    o[1] = __builtin_amdgcn_mfma_f32_32x32x16_bf16(__builtin_shufflevector(d2, d3, 0, 1, 2, 3, 4, 5, 6, 7), pf, o[1], 0, 0, 0);
    o[2] = __builtin_amdgcn_mfma_f32_32x32x16_bf16(__builtin_shufflevector(d4, d5, 0, 1, 2, 3, 4, 5, 6, 7), pf, o[2], 0, 0, 0);
    o[3] = __builtin_amdgcn_mfma_f32_32x32x16_bf16(__builtin_shufflevector(d6, d7, 0, 1, 2, 3, 4, 5, 6, 7), pf, o[3], 0, 0, 0);
}
__device__ __forceinline__ f32x16 qk_block(const LAS unsigned char* ktile, int kb, const bf16x8 (&qf)[8], int lane) {
    f32x16 acc;
#pragma unroll
    for (int i = 0; i < 16; ++i) acc[i] = 0.f;
#pragma unroll
    for (int s = 0; s < 8; ++s) acc = __builtin_amdgcn_mfma_f32_32x32x16_bf16(row_frag(ktile, 32 * kb, s, lane), qf[s], acc, 0, 0, 0);
    return acc;
}
__device__ __forceinline__ void qk_tile(const LAS unsigned char* ktile, const bf16x8 (&qf)[8], int lane, f32x16& s0, f32x16& s1) {
#pragma unroll
    for (int i = 0; i < 16; ++i) { s0[i] = 0.f; s1[i] = 0.f; }
#pragma unroll
    for (int s = 0; s < 8; ++s) {
        const bf16x8 a0 = row_frag(ktile, 0, s, lane), a1 = row_frag(ktile, 32, s, lane);
        s0 = __builtin_amdgcn_mfma_f32_32x32x16_bf16(a0, qf[s], s0, 0, 0, 0);
        s1 = __builtin_amdgcn_mfma_f32_32x32x16_bf16(a1, qf[s], s1, 0, 0, 0);
    }
}
struct KFrag4 { bf16x8 a, b, c, d; };
__device__ __forceinline__ void k_issue4(KFrag4& f, unsigned a0, unsigned a1, unsigned a2, unsigned a3) {
    asm volatile("ds_read_b128 %0, %4\n\tds_read_b128 %1, %5\n\tds_read_b128 %2, %6\n\tds_read_b128 %3, %7" : "=&v"(f.a), "=&v"(f.b), "=&v"(f.c), "=&v"(f.d) : "v"(a0), "v"(a1), "v"(a2), "v"(a3) : "memory");
}
__device__ __forceinline__ void k_wait4(KFrag4& f) { asm volatile("s_waitcnt lgkmcnt(4)" : "+v"(f.a), "+v"(f.b), "+v"(f.c), "+v"(f.d) :: "memory"); }
__device__ __forceinline__ void k_wait0(KFrag4& f) { asm volatile("s_waitcnt lgkmcnt(0)" : "+v"(f.a), "+v"(f.b), "+v"(f.c), "+v"(f.d) :: "memory"); }
__device__ __forceinline__ void qk_tile_pipe(const LAS unsigned char* ktile, const bf16x8 (&qf)[8], int lane, f32x16& s0, f32x16& s1) {
#pragma unroll
    for (int i = 0; i < 16; ++i) { s0[i] = 0.f; s1[i] = 0.f; }
    const unsigned kb = lds_addr(ktile), r0 = (unsigned)(lane & 31), h = (unsigned)(lane >> 5);
#define KA_(row_, s_) (kb + off_b((row_), 2u * (s_) + h))
    KFrag4 A, B;
    k_issue4(A, KA_(r0, 0), KA_(r0, 1), KA_(r0, 2), KA_(r0, 3));
    k_issue4(B, KA_(r0, 4), KA_(r0, 5), KA_(r0, 6), KA_(r0, 7));
    k_wait4(A);
    s0 = __builtin_amdgcn_mfma_f32_32x32x16_bf16(A.a, qf[0], s0, 0, 0, 0); s0 = __builtin_amdgcn_mfma_f32_32x32x16_bf16(A.b, qf[1], s0, 0, 0, 0);
    s0 = __builtin_amdgcn_mfma_f32_32x32x16_bf16(A.c, qf[2], s0, 0, 0, 0); s0 = __builtin_amdgcn_mfma_f32_32x32x16_bf16(A.d, qf[3], s0, 0, 0, 0);
    k_issue4(A, KA_(r0 + 32u, 0), KA_(r0 + 32u, 1), KA_(r0 + 32u, 2), KA_(r0 + 32u, 3));
    k_wait4(B);
    s0 = __builtin_amdgcn_mfma_f32_32x32x16_bf16(B.a, qf[4], s0, 0, 0, 0); s0 = __builtin_amdgcn_mfma_f32_32x32x16_bf16(B.b, qf[5], s0, 0, 0, 0);
    s0 = __builtin_amdgcn_mfma_f32_32x32x16_bf16(B.c, qf[6], s0, 0, 0, 0); s0 = __builtin_amdgcn_mfma_f32_32x32x16_bf16(B.d, qf[7], s0, 0, 0, 0);
    k_issue4(B, KA_(r0 + 32u, 4), KA_(r0 + 32u, 5), KA_(r0 + 32u, 6), KA_(r0 + 32u, 7));
    k_wait4(A);
    s1 = __builtin_amdgcn_mfma_f32_32x32x16_bf16(A.a, qf[0], s1, 0, 0, 0); s1 = __builtin_amdgcn_mfma_f32_32x32x16_bf16(A.b, qf[1], s1, 0, 0, 0);
    s1 = __builtin_amdgcn_mfma_f32_32x32x16_bf16(A.c, qf[2], s1, 0, 0, 0); s1 = __builtin_amdgcn_mfma_f32_32x32x16_bf16(A.d, qf[3], s1, 0, 0, 0);
    k_wait0(B);
    s1 = __builtin_amdgcn_mfma_f32_32x32x16_bf16(B.a, qf[4], s1, 0, 0, 0); s1 = __builtin_amdgcn_mfma_f32_32x32x16_bf16(B.b, qf[5], s1, 0, 0, 0);
    s1 = __builtin_amdgcn_mfma_f32_32x32x16_bf16(B.c, qf[6], s1, 0, 0, 0); s1 = __builtin_amdgcn_mfma_f32_32x32x16_bf16(B.d, qf[7], s1, 0, 0, 0);
#undef KA_
}
__device__ __forceinline__ f32x16 qk_block_pipe(const LAS unsigned char* ktile, int kb, const bf16x8 (&qf)[8], int lane) {
    f32x16 acc;
#pragma unroll
    for (int i = 0; i < 16; ++i) acc[i] = 0.f;
    const unsigned kbase = lds_addr(ktile), r0 = (unsigned)(32 * kb + (lane & 31)), h = (unsigned)(lane >> 5);
#define KA_(s_) (kbase + off_b(r0, 2u * (s_) + h))
    KFrag4 A, B;
    k_issue4(A, KA_(0), KA_(1), KA_(2), KA_(3));
    k_issue4(B, KA_(4), KA_(5), KA_(6), KA_(7));
    k_wait4(A);
    acc = __builtin_amdgcn_mfma_f32_32x32x16_bf16(A.a, qf[0], acc, 0, 0, 0); acc = __builtin_amdgcn_mfma_f32_32x32x16_bf16(A.b, qf[1], acc, 0, 0, 0);
    acc = __builtin_amdgcn_mfma_f32_32x32x16_bf16(A.c, qf[2], acc, 0, 0, 0); acc = __builtin_amdgcn_mfma_f32_32x32x16_bf16(A.d, qf[3], acc, 0, 0, 0);
    k_wait0(B);
    acc = __builtin_amdgcn_mfma_f32_32x32x16_bf16(B.a, qf[4], acc, 0, 0, 0); acc = __builtin_amdgcn_mfma_f32_32x32x16_bf16(B.b, qf[5], acc, 0, 0, 0);
    acc = __builtin_amdgcn_mfma_f32_32x32x16_bf16(B.c, qf[6], acc, 0, 0, 0); acc = __builtin_amdgcn_mfma_f32_32x32x16_bf16(B.d, qf[7], acc, 0, 0, 0);
#undef KA_
    return acc;
}
__device__ __forceinline__ bf16x8 pack8(const f32x16& p, int s2) {
    u32x4 w; w.x = cvt_pk(p[8 * s2 + 0], p[8 * s2 + 1]); w.y = cvt_pk(p[8 * s2 + 2], p[8 * s2 + 3]); w.z = cvt_pk(p[8 * s2 + 4], p[8 * s2 + 5]); w.w = cvt_pk(p[8 * s2 + 6], p[8 * s2 + 7]);
    return __builtin_bit_cast(bf16x8, w);
}
template <int ROWS> struct TileRegs { u32x4 r[ROWS * 16 / NTHR]; };
template <int ROWS> __device__ __forceinline__ void tile_load(TileRegs<ROWS>& R, const bf16_t* src, size_t ld, int tid) {
#pragma unroll
    for (int i = 0; i < ROWS * 16 / NTHR; ++i) { const int c = tid + NTHR * i; R.r[i] = *(const u32x4*)(src + (size_t)(c >> 4) * ld + (c & 15) * 8); }
}
template <int ROWS> __device__ __forceinline__ void tile_store(LAS unsigned char* tile, const TileRegs<ROWS>& R, int tid) {
#pragma unroll
    for (int i = 0; i < ROWS * 16 / NTHR; ++i) { const int c = tid + NTHR * i; *(LAS u32x4*)(tile + off_b((unsigned)(c >> 4), (unsigned)(c & 15))) = R.r[i]; }
}
template <int ROWS> __device__ __forceinline__ void tile_stage(LAS unsigned char* tile, const bf16_t* src, size_t ld, int tid) {
    TileRegs<ROWS> R; tile_load<ROWS>(R, src, ld, tid); tile_store<ROWS>(tile, R, tid);
}
__device__ __forceinline__ void unpack8(const u32x4 v, float (&x)[8]) {
    x[0] = bflo(v.x); x[1] = bfhi(v.x); x[2] = bflo(v.y); x[3] = bfhi(v.y); x[4] = bflo(v.z); x[5] = bfhi(v.z); x[6] = bflo(v.w); x[7] = bfhi(v.w);
}
__device__ __forceinline__ u32x4 pack8f(const float (&x)[8]) {
    u32x4 w; w.x = cvt_pk(x[0], x[1]); w.y = cvt_pk(x[2], x[3]); w.z = cvt_pk(x[4], x[5]); w.w = cvt_pk(x[6], x[7]); return w;
}
__device__ __forceinline__ void ld8f(const float* src, float (&x)[8]) {
    const f32x4 a = *(const f32x4*)src, b = *(const f32x4*)(src + 4);
    x[0] = a[0]; x[1] = a[1]; x[2] = a[2]; x[3] = a[3]; x[4] = b[0]; x[5] = b[1]; x[6] = b[2]; x[7] = b[3];
}
__device__ __forceinline__ void tile_dma64(LAS unsigned char* tile, const bf16_t* src, size_t ld, int tid, int wave) {
#pragma unroll
    for (int i = 0; i < 2; ++i) {
        const int c = tid + NTHR * i, row = c >> 4, pos = c & 15, ch = pos ^ (((row & 3) << 2) | ((row >> 2) & 3));
        __builtin_amdgcn_global_load_lds((const unsigned*)(src + (size_t)row * ld + ch * 8), (LAS unsigned*)(tile + (wave * 64 + NTHR * i) * 16), 16, 0, 0);
    }
}
__device__ __forceinline__ int lane_id_now() { int l; asm volatile("v_mbcnt_lo_u32_b32 %0, -1, 0\n\tv_mbcnt_hi_u32_b32 %0, -1, %0" : "=v"(l)); return l; }
__device__ __forceinline__ int next_task_n(unsigned* ctr, int n, volatile LAS int* slot, int tid) {
    __syncthreads();
    if (tid == 0) { int v = (int)__hip_atomic_load(ctr, __ATOMIC_RELAXED, __HIP_MEMORY_SCOPE_AGENT); if (v < n) v = (int)__hip_atomic_fetch_add(ctr, 1u, __ATOMIC_RELAXED, __HIP_MEMORY_SCOPE_AGENT); *slot = v < n ? v : n; }
    __syncthreads();
    return *slot;
}
__device__ __forceinline__ int next_task(unsigned* ctr, volatile LAS int* slot, int tid) {
    __syncthreads();
    if (tid == 0) *slot = (int)__hip_atomic_fetch_add(ctr, 1u, __ATOMIC_RELAXED, __HIP_MEMORY_SCOPE_AGENT);
    __syncthreads();
    return *slot;
}
#define QUEUE_LOOP(ctr_, n_, ...) do { int t = next_task((ctr_), slot, tid); while (t < (n_)) { \
        int nx_ = 0; if (tid == 0) nx_ = (int)__hip_atomic_fetch_add((ctr_), 1u, __ATOMIC_RELAXED, __HIP_MEMORY_SCOPE_AGENT); \
        { __VA_ARGS__; } \
        __syncthreads(); if (tid == 0) *slot = nx_; __syncthreads(); t = *slot; } } while (0)

struct CvTask { const float* W; const float* gain; bf16_t* Bt; int K, N, k0, n0, gu; };
__device__ __forceinline__ CvTask cv_task(KP p, int l, int t8) {
    CvTask c; int tt = t8, ntn;
    c.gu = 0;
    c.gain = nullptr;
    if (tt < 1504) { c.W = p->in[I_WIN] + (size_t)l * 4096 * NIN; c.K = 4096; c.N = NIN; c.Bt = (bf16_t*)(p->ws + WS_WIN); ntn = 47; c.gain = p->in[I_ANW] + (size_t)l * DM; }
    else if ((tt -= 1504) < 512) { c.W = p->in[I_WOUT] + (size_t)l * 4096 * 4096; c.K = 4096; c.N = 4096; c.Bt = (bf16_t*)(p->ws + WS_WOUT); ntn = 16; }
    else if ((tt -= 512) < 1376) { c.W = p->in[I_WG] + (size_t)l * 4096 * DFF; c.K = 4096; c.N = DFF; c.Bt = (bf16_t*)(p->ws + WS_WGU); ntn = 43; c.gain = p->in[I_MNW] + (size_t)l * DM; c.gu = 1; }
    else if ((tt -= 1376) < 1376) { c.W = p->in[I_WU] + (size_t)l * 4096 * DFF; c.K = 4096; c.N = DFF; c.Bt = (bf16_t*)(p->ws + WS_WGU); ntn = 43; c.gain = p->in[I_MNW] + (size_t)l * DM; c.gu = 2; }
    else { tt -= 1376; c.W = p->in[I_WD] + (size_t)l * DFF * 4096; c.K = DFF; c.N = 4096; c.Bt = (bf16_t*)(p->ws + ((l & 1) ? WS_WDN2 : WS_WDN)); ntn = 16; }
    const int kt = tt / ntn, nt = tt - kt * ntn; c.k0 = kt * 128; c.n0 = nt * 256;
    return c;
}
__device__ __forceinline__ void cv_load(const CvTask& c, f32x4 (&v)[2][4][2], int tid) {
    const int r = tid >> 4, c4 = (tid & 15) * 4;
#pragma unroll
    for (int kk = 0; kk < 2; ++kk)
#pragma unroll
        for (int sub = 0; sub < 4; ++sub)
#pragma unroll
            for (int i = 0; i < 2; ++i) {
                const int k = c.k0 + 64 * kk + 2 * r + i, n = c.n0 + 64 * sub + c4;
                v[kk][sub][i] = (f32x4){0.f, 0.f, 0.f, 0.f};
                if (n < c.N) v[kk][sub][i] = __builtin_nontemporal_load((const f32x4*)(c.W + (size_t)k * c.N + n));
            }
}
__device__ __forceinline__ void cv_store(const CvTask& c, const f32x4 (&v)[2][4][2], LAS unsigned* T, int tid) {
    const int r = tid >> 4, c4 = (tid & 15) * 4;
#pragma unroll
    for (int kk = 0; kk < 2; ++kk) {
        float g0 = 1.f, g1 = 1.f;
        if (c.gain) { g0 = c.gain[c.k0 + 64 * kk + 2 * r]; g1 = c.gain[c.k0 + 64 * kk + 2 * r + 1]; }
#pragma unroll
        for (int sub = 0; sub < 4; ++sub)
#pragma unroll
            for (int j = 0; j < 4; ++j) T[((kk * 4 + sub) * 64 + c4 + j) * 33 + r] = cvt_pk(v[kk][sub][0][j] * g0, v[kk][sub][1][j] * g1);
    }
    __syncthreads();
    {
        const int nl = tid >> 3, kq = (tid & 7) * 4;
#pragma unroll
        for (int kk = 0; kk < 2; ++kk)
#pragma unroll
            for (int sub = 0; sub < 4; ++sub) {
                const LAS unsigned* s = T + ((kk * 4 + sub) * 64 + nl) * 33 + kq;
                u32x4 w; w.x = s[0]; w.y = s[1]; w.z = s[2]; w.w = s[3];
                const int n = c.n0 + 64 * sub;
                const int drow = c.gu ? 256 * (n >> 7) + 128 * (c.gu - 1) + (n & 127) + nl : n + nl;
                *(u32x4*)(c.Bt + (size_t)drow * c.K + c.k0 + 64 * kk + 2 * kq) = w;
            }
    }
    __syncthreads();
}
__device__ __forceinline__ void convert_range(KP p, int l, int t, int tend, int step, LAS unsigned char* lds, int tid) {
    asm volatile("" : "+v"(tid), "+s"(p));
    if (t >= tend) return;
    LAS unsigned* T0 = (LAS unsigned*)lds;
    f32x4 va[2][4][2], vb[2][4][2];
    __syncthreads();
    CvTask A = cv_task(p, l, t), B = A; cv_load(A, va, tid);
    for (;;) {
        const int t1 = t + step; const bool h1 = t1 < tend;
        if (h1) { B = cv_task(p, l, t1); cv_load(B, vb, tid); }
        cv_store(A, va, T0, tid);
        if (!h1) break;
        t = t1 + step; const bool h0 = t < tend;
        if (h0) { A = cv_task(p, l, t); cv_load(A, va, tid); }
        cv_store(B, vb, T0, tid);
        if (!h0) break;
    }
}
__device__ __forceinline__ void convert_small(KP p, int l, int tid, int bid, int G) {
    asm volatile("" : "+v"(tid), "+s"(p));
    {
        const size_t gtid = (size_t)bid * NTHR + tid, gstride = (size_t)G * NTHR;
        const float* s1 = p->in[I_CW1] + (size_t)l * 2 * 4096 * 256; bf16_t* d1 = (bf16_t*)(p->ws + WS_CW1);
        for (size_t i = gtid; i < (size_t)2 * 4096 * 256 / 4; i += gstride) { const f32x4 v = *(const f32x4*)(s1 + i * 4); u32x2 w; w.x = cvt_pk(v[0], v[1]); w.y = cvt_pk(v[2], v[3]); *(u32x2*)(d1 + i * 4) = w; }
        const float* s2 = p->in[I_CW2] + (size_t)l * 2 * 256 * 128; bf16_t* d2 = (bf16_t*)(p->ws + WS_CW2);
        for (size_t i = gtid; i < (size_t)2 * 256 * 128 / 4; i += gstride) { const f32x4 v = *(const f32x4*)(s2 + i * 4); u32x2 w; w.x = cvt_pk(v[0], v[1]); w.y = cvt_pk(v[2], v[3]); *(u32x2*)(d2 + i * 4) = w; }
        const float* s3 = p->in[I_LWA] + (size_t)l * 8 * 128 * 128; bf16_t* d3 = (bf16_t*)(p->ws + WS_LWA);
        for (size_t i = gtid; i < (size_t)8 * 128 * 128 / 4; i += gstride) { const f32x4 v = *(const f32x4*)(s3 + i * 4); u32x2 w; w.x = cvt_pk(v[0], v[1]); w.y = cvt_pk(v[2], v[3]); *(u32x2*)(d3 + i * 4) = w; }
        {
            const int lane = tid & 63, wave = tid >> 6; float* cp = (float*)(p->ws + WS_CPOS);
            for (int o = bid * NWAVE + wave; o < 512; o += G * NWAVE) {
                const int kv = o >> 8, h = o & 255; const float* ps = p->in[I_CPOS] + ((size_t)l * 2 + kv) * 4096; const float* w = s1 + (size_t)kv * 4096 * 256 + h;
                float a = 0.f;
                for (int k = lane; k < 4096; k += 64) a += ps[k] * w[(size_t)k * 256];
                a = wave_sum(a);
                if (lane == 0) cp[o] = a;
            }
        }
        const float* s4 = p->in[I_LWX] + (size_t)l * 8 * 128 * 128; bf16_t* d4 = (bf16_t*)(p->ws + WS_LWX);
        for (size_t i = gtid; i < (size_t)8 * 128 * 128 / 4; i += gstride) { const f32x4 v = *(const f32x4*)(s4 + i * 4); u32x2 w; w.x = cvt_pk(v[0], v[1]); w.y = cvt_pk(v[2], v[3]); *(u32x2*)(d4 + i * 4) = w; }
    }
}

__device__ __forceinline__ void sincos_acc(double x, float& sn, float& cs) {
    const double kf = rint(x * 0.63661977236758134308);
    const double r = fma(-kf, 6.123233995736766036e-17, fma(-kf, 1.5707963267948965580, x));
    const double z = r * r;
    const double sr = r + r * z * (-0.166666666416265235595 + z * (0.0083333293858894631756 + z * (-0.000198393348360966317347 + z * 0.0000027183114939898219064)));
    const double cr = 1.0 + z * (-0.499999997251031003120 + z * (0.0416666233237390631894 + z * (-0.00138867637746099294692 + z * 0.0000243904487962774090654)));
    const int n = ((int)kf) & 3;
    const double s = (n == 0) ? sr : (n == 1) ? cr : (n == 2) ? -sr : -cr;
    const double c = (n == 0) ? cr : (n == 1) ? -sr : (n == 2) ? -cr : sr;
    sn = (float)s; cs = (float)c;
}
__device__ __forceinline__ void ph_tables(KP p, int tid, int bid, int G) {
    asm volatile("" : "+v"(tid), "+s"(p));
    float* rc = (float*)(p->ws + WS_TAB_RC); float* rs = (float*)(p->ws + WS_TAB_RS); float* nc = (float*)(p->ws + WS_TAB_NC); float* ns = (float*)(p->ws + WS_TAB_NS);
    const int gtid = bid * NTHR + tid, gstride = G * NTHR;
    for (int i = gtid; i < SEQ * 64; i += gstride) {
        const int pos = i >> 6, f = i & 63;
        const double inv = exp2(-((double)f / 63.0) * 13.287712379549449);
        float s, c; sincos_acc((double)pos * inv, s, c); rc[i] = c; rs[i] = s;
    }
    for (int i = gtid; i < SEQ * 16; i += gstride) {
        const int pos = i >> 4, f = i & 15;
        const double inv = exp2(-((double)f / 16.0) * 18.931568569324174);
        float s, c; sincos_acc((double)pos * inv, s, c); nc[i] = c; ns[i] = s;
    }
}

__device__ __forceinline__ void ph_rmsnorm(const float* x, const float* w, bf16_t* hn, int tid, int bid, int G) {
    asm volatile("" : "+v"(tid));
    const int lane = tid & 63, wave = tid >> 6;
    for (int row = bid * NWAVE + wave; row < MT; row += G * NWAVE) {
        const float* xr = x + (size_t)row * DM;
        f32x4 v[16]; float ss = 0.f;
#pragma unroll
        for (int i = 0; i < 16; ++i) { v[i] = *(const f32x4*)(xr + (i * 64 + lane) * 4); ss += v[i][0] * v[i][0] + v[i][1] * v[i][1] + v[i][2] * v[i][2] + v[i][3] * v[i][3]; }
        ss = wave_sum(ss);
        const float r = 1.0f / sqrtf(ss * (1.0f / DM) + 1e-6f);
#pragma unroll
        for (int i = 0; i < 16; ++i) {
            const f32x4 g = *(const f32x4*)(w + (i * 64 + lane) * 4);
            u32x2 o; o.x = cvt_pk(v[i][0] * r * g[0], v[i][1] * r * g[1]); o.y = cvt_pk(v[i][2] * r * g[2], v[i][3] * r * g[3]);
            *(u32x2*)(hn + (size_t)row * DM + (i * 64 + lane) * 4) = o;
        }
    }
}

__device__ __forceinline__ void ph_mlp_act(KP p, int l, int tid, int bid, int G) {
    asm volatile("" : "+v"(tid), "+s"(p));
    const bf16_t* GU = (const bf16_t*)(p->ws + WS_GU); bf16_t* H = (bf16_t*)(p->ws + WS_H);
    const float* cw = p->in[I_MCW] + (size_t)l * 3 * DFF; const float* cb = p->in[I_MCB] + (size_t)l * DFF;
    constexpr int NFG = DFF / 8, NTG = MT / 8;
    for (int it = bid * NTHR + tid; it < NFG * NTG; it += G * NTHR) {
        const int tg = it / NFG, fg = it - tg * NFG, f0 = fg * 8, t0 = tg * 8;
        float w0[8], w1[8], w2[8], bb[8];
#pragma unroll
        for (int j = 0; j < 8; j += 4) {
            const f32x4 a = *(const f32x4*)(cw + f0 + j), b = *(const f32x4*)(cw + DFF + f0 + j), c = *(const f32x4*)(cw + 2 * DFF + f0 + j), d = *(const f32x4*)(cb + f0 + j);
#pragma unroll
            for (int q = 0; q < 4; ++q) { w0[j + q] = a[q]; w1[j + q] = b[q]; w2[j + q] = c[q]; bb[j + q] = d[q]; }
        }
        float gm2[8], gm1[8];
        const bool first = (t0 & (SEQ - 1)) == 0;
        {
            u32x4 a = (u32x4){0u, 0u, 0u, 0u}, b = (u32x4){0u, 0u, 0u, 0u};
            if (!first) { a = *(const u32x4*)(GU + (size_t)(t0 - 2) * NGU + f0); b = *(const u32x4*)(GU + (size_t)(t0 - 1) * NGU + f0); }
#pragma unroll
            for (int q = 0; q < 4; ++q) { gm2[2 * q] = bflo(a[q]); gm2[2 * q + 1] = bfhi(a[q]); gm1[2 * q] = bflo(b[q]); gm1[2 * q + 1] = bfhi(b[q]); }
        }
#pragma unroll
        for (int i = 0; i < 8; ++i) {
            const u32x4 gv = *(const u32x4*)(GU + (size_t)(t0 + i) * NGU + f0), uv = *(const u32x4*)(GU + (size_t)(t0 + i) * NGU + DFF + f0);
            float g0[8], up[8], hv[8];
#pragma unroll
            for (int q = 0; q < 4; ++q) { g0[2 * q] = bflo(gv[q]); g0[2 * q + 1] = bfhi(gv[q]); up[2 * q] = bflo(uv[q]); up[2 * q + 1] = bfhi(uv[q]); }
#pragma unroll
            for (int j = 0; j < 8; ++j) { const float y = bb[j] + w0[j] * gm2[j] + w1[j] * gm1[j] + w2[j] * g0[j]; hv[j] = y * sigmoidf_(y) * up[j]; gm2[j] = gm1[j]; gm1[j] = g0[j]; }
            u32x4 o; o.x = cvt_pk(hv[0], hv[1]); o.y = cvt_pk(hv[2], hv[3]); o.z = cvt_pk(hv[4], hv[5]); o.w = cvt_pk(hv[6], hv[7]);
            *(u32x4*)(H + (size_t)(t0 + i) * DFF + f0) = o;
        }
    }
}

struct EpiResid {
    static constexpr bool PERM = false, AFTER_DRAIN = false;
    const float* base; float* out; int ldc;
    __device__ __forceinline__ void operator()(const pg8::f32x4 (&acc)[2][2][4][2], const pg8::Unit& u, int wr, int wc, int fr, int fq) const {
        const int row0 = u.pm * 256 + wr * 64 + fr, col0 = u.pn * 256 + wc * 32 + 4 * fq;
#pragma unroll
        for (int ai = 0; ai < 2; ++ai)
#pragma unroll
            for (int m = 0; m < 4; ++m) { const size_t off = (size_t)(row0 + ai * 128 + m * 16) * ldc + col0;
#pragma unroll
                for (int bj = 0; bj < 2; ++bj)
#pragma unroll
                    for (int n = 0; n < 2; ++n) { const pg8::f32x4 bs = *(const pg8::f32x4*)(base + off + bj * 128 + n * 16); *(pg8::f32x4*)(out + off + bj * 128 + n * 16) = bs + acc[ai][bj][m][n]; }
                asm volatile("" ::: "memory"); }
    }
};

__device__ __forceinline__ void ph_xcvt(const float* x, bf16_t* xb, float* rowss, int tid, int bid, int G) {
    asm volatile("" : "+v"(tid));
    const int lane = tid & 63, wave = tid >> 6;
    for (int row = bid * NWAVE + wave; row < MT; row += G * NWAVE) {
        const float* xr = x + (size_t)row * DM;
        float ss = 0.f;
#pragma unroll
        for (int i = 0; i < 16; ++i) { const f32x4 v = *(const f32x4*)(xr + (i * 64 + lane) * 4); ss += v[0] * v[0] + v[1] * v[1] + v[2] * v[2] + v[3] * v[3];
            u32x2 o; o.x = cvt_pk(v[0], v[1]); o.y = cvt_pk(v[2], v[3]); *(u32x2*)(xb + (size_t)row * DM + (i * 64 + lane) * 4) = o; }
        ss = wave_sum(ss);
        rowss[(size_t)lane * MT + row] = (lane == 0) ? ss : 0.f;
    }
}
#ifdef EPI_NT
#define EPI_STORE16(ptr_, v_) __builtin_nontemporal_store((v_), (u32x4*)(ptr_))
#else
#define EPI_STORE16(ptr_, v_) (*(u32x4*)(ptr_) = (v_))
#endif
struct EpiBf16RS {
    static constexpr bool PERM = true, AFTER_DRAIN = false;
    bf16_t* O; int ldc; const LAS float* rt; int rbase;
    __device__ __forceinline__ void operator()(const pg8::f32x4 (&acc)[2][2][4][2], const pg8::Unit& u, int wr, int wc, int fr, int fq) const {
        const int row0 = u.pm * 256 + wr * 64 + fr, col0 = u.pn * 256 + wc * 32 + 8 * fq;
#pragma unroll
        for (int ai = 0; ai < 2; ++ai)
#pragma unroll
            for (int m = 0; m < 4; ++m) { const int row = row0 + ai * 128 + m * 16; const float rs = rt[row - rbase]; bf16_t* rowp = O + (size_t)row * ldc + col0;
#pragma unroll
                for (int bj = 0; bj < 2; ++bj) { const pg8::f32x4 v0 = acc[ai][bj][m][0] * rs, v1 = acc[ai][bj][m][1] * rs;
                    u32x4 w; w.x = cvt_pk(v0[0], v0[1]); w.y = cvt_pk(v0[2], v0[3]); w.z = cvt_pk(v1[0], v1[1]); w.w = cvt_pk(v1[2], v1[3]);
                    EPI_STORE16(rowp + bj * 128, w); } }
    }
};
__device__ __forceinline__ void in_gate_cols(KP p, int row0, const float* rowss, LAS unsigned char* lds, int tid) {
    asm volatile("" : "+v"(tid), "+s"(p));
    const int lane = tid & 63, wave = __builtin_amdgcn_readfirstlane(tid >> 6), hh = lane >> 5, rb = wave & 3, kh = wave >> 2;
    const bf16_t* arow = (const bf16_t*)(p->ws + WS_HN) + (size_t)(row0 + 32 * rb + (lane & 31)) * DM + kh * 2048 + 8 * hh;
    const bf16_t* brow = (const bf16_t*)(p->ws + WS_WIN) + (size_t)(C_NG + (lane & 31)) * DM + kh * 2048 + 8 * hh;
    f32x16 acc;
#pragma unroll
    for (int i = 0; i < 16; ++i) acc[i] = 0.f;
    bf16x8 a0[4], b0[4], a1[4], b1[4];
#pragma unroll
    for (int s8 = 0; s8 < 4; ++s8) { a0[s8] = *(const bf16x8*)(arow + 16 * s8); b0[s8] = *(const bf16x8*)(brow + 16 * s8); }
#pragma unroll 1
    for (int k0 = 0; k0 < 2048; k0 += 128) {
#pragma unroll
        for (int s8 = 0; s8 < 4; ++s8) { a1[s8] = *(const bf16x8*)(arow + k0 + 64 + 16 * s8); b1[s8] = *(const bf16x8*)(brow + k0 + 64 + 16 * s8); }
#pragma unroll
        for (int s8 = 0; s8 < 4; ++s8) acc = __builtin_amdgcn_mfma_f32_32x32x16_bf16(a0[s8], b0[s8], acc, 0, 0, 0);
        if (k0 + 128 < 2048) {
#pragma unroll
            for (int s8 = 0; s8 < 4; ++s8) { a0[s8] = *(const bf16x8*)(arow + k0 + 128 + 16 * s8); b0[s8] = *(const bf16x8*)(brow + k0 + 128 + 16 * s8); }
        }
#pragma unroll
        for (int s8 = 0; s8 < 4; ++s8) acc = __builtin_amdgcn_mfma_f32_32x32x16_bf16(a1[s8], b1[s8], acc, 0, 0, 0);
    }
    __syncthreads();
    LAS float* RED = (LAS float*)lds;
    LAS float* RS = RED + 4 * 16 * 64;
    if (tid < 128) { float t = 0.f;
#pragma unroll 16
        for (int i = 0; i < 64; ++i) t += rowss[(size_t)i * MT + row0 + tid];
        RS[tid] = 1.0f / sqrtf(t * (1.0f / DM) + 1e-6f); }
    if (kh == 1) {
#pragma unroll
        for (int r = 0; r < 16; ++r) RED[(rb * 16 + r) * 64 + lane] = acc[r];
    }
    __syncthreads();
    if (kh == 0) {
        bf16_t* PROJ = (bf16_t*)(p->ws + WS_PROJ);
        const int n = lane & 31;
#pragma unroll
        for (int r = 0; r < 16; ++r) {
            const int rl = 32 * rb + (r & 3) + 8 * (r >> 2) + 4 * hh;
            const float v = (acc[r] + RED[(rb * 16 + r) * 64 + lane]) * RS[rl];
            if (n < 24) PROJ[(size_t)(row0 + rl) * NINP + C_NG + n] = f2bf(v);
        }
    }
    __syncthreads();
}
struct EpiResid2 {
    static constexpr bool PERM = false, AFTER_DRAIN = false;
    const float* base; float* out; bf16_t* xb; float* rowss; int ldc; int wx;
    __device__ __forceinline__ void operator()(const pg8::f32x4 (&acc)[2][2][4][2], const pg8::Unit& u, int wr, int wc, int fr, int fq) const {
        const int row0 = u.pm * 256 + wr * 64 + fr, col0 = u.pn * 256 + wc * 32 + 4 * fq;
#pragma unroll
        for (int ai = 0; ai < 2; ++ai)
#pragma unroll
            for (int m = 0; m < 4; ++m) { const int row = row0 + ai * 128 + m * 16; const size_t off = (size_t)row * ldc + col0; float ss = 0.f;
#pragma unroll
                for (int bj = 0; bj < 2; ++bj)
#pragma unroll
                    for (int n = 0; n < 2; ++n) { const pg8::f32x4 bs = *(const pg8::f32x4*)(base + off + bj * 128 + n * 16); const pg8::f32x4 o = bs + acc[ai][bj][m][n];
                        *(pg8::f32x4*)(out + off + bj * 128 + n * 16) = o;
                        if (wx) { u32x2 w; w.x = cvt_pk(o[0], o[1]); w.y = cvt_pk(o[2], o[3]); *(u32x2*)(xb + off + bj * 128 + n * 16) = w; ss += (o[0] * o[0] + o[1] * o[1]) + (o[2] * o[2] + o[3] * o[3]); } }
                if (wx) { ss += __shfl_xor(ss, 16); ss += __shfl_xor(ss, 32); if (fq == 0) rowss[(size_t)(u.pn * 4 + wc) * MT + row] = ss; }
                asm volatile("" ::: "memory"); }
    }
};

template <class Sched> __device__ __forceinline__ int fill_rstd_table(const Sched& S, const float* rowss, LAS float* rt, int tid) {
    int lo = 1 << 30, hi = -1; pg8::Unit u;
    for (int i = 0; S.next(i, u); ++i) { lo = u.pm < lo ? u.pm : lo; hi = u.pm > hi ? u.pm : hi; }
    if (hi < 0) return 0;
    int n = (hi - lo + 1) * 256; if (n > RT_PANELS * 256) n = RT_PANELS * 256;
    for (int r4 = tid * 4; r4 < n; r4 += NTHR * 4) {
        const float* s = rowss + (size_t)lo * 256 + r4; f32x4 t = (f32x4){0.f, 0.f, 0.f, 0.f};
#pragma unroll 16
        for (int i = 0; i < 64; ++i) t += *(const f32x4*)(s + (size_t)i * MT);
#pragma unroll
        for (int q = 0; q < 4; ++q) rt[r4 + q] = 1.0f / sqrtf(t[q] * (1.0f / DM) + 1e-6f);
    }
    __syncthreads();
    return lo * 256;
}

__device__ __forceinline__ float dpp_ror1(float v) { return __int_as_float(__builtin_amdgcn_update_dpp(0, __float_as_int(v), 0x121, 0xf, 0xf, false)); }
__device__ __forceinline__ float dpp_ror2(float v) { return __int_as_float(__builtin_amdgcn_update_dpp(0, __float_as_int(v), 0x122, 0xf, 0xf, false)); }
struct EpiGateUp {
    static constexpr bool PERM = true, AFTER_DRAIN = false;
    bf16_t* H; const LAS float* rt; int rbase; const float* cw; const float* cb; bf16_t* GT; bf16_t* GH; bf16_t* UH;
    __device__ __forceinline__ void operator()(const pg8::f32x4 (&acc)[2][2][4][2], const pg8::Unit& u, int wr, int wc, int fr, int fq) const {
        const int f0 = u.pn * 128 + wc * 32 + 8 * fq;
        float w0[8], w1[8], w2[8], bb[8];
#pragma unroll
        for (int j = 0; j < 8; j += 4) {
            const f32x4 a = *(const f32x4*)(cw + f0 + j), b = *(const f32x4*)(cw + DFF + f0 + j), c = *(const f32x4*)(cw + 2 * DFF + f0 + j), d = *(const f32x4*)(cb + f0 + j);
#pragma unroll
            for (int q = 0; q < 4; ++q) { w0[j + q] = a[q]; w1[j + q] = b[q]; w2[j + q] = c[q]; bb[j + q] = d[q]; }
        }
#pragma unroll
        for (int ai = 0; ai < 2; ++ai) {
            const int c64 = u.pm * 4 + ai * 2 + wr;
            float gp[8];
#pragma unroll
            for (int j = 0; j < 8; ++j) gp[j] = 0.f;
#pragma unroll
            for (int m = 0; m < 4; ++m) {
                const int row = u.pm * 256 + ai * 128 + wr * 64 + m * 16 + fr;
                const float rs = rt[row - rbase];
                float g[8], uu[8], hv[8];
#pragma unroll
                for (int j = 0; j < 8; ++j) { g[j] = acc[ai][0][m][j >> 2][j & 3] * rs; uu[j] = acc[ai][1][m][j >> 2][j & 3] * rs; }
#pragma unroll
                for (int j = 0; j < 8; ++j) {
                    const float a1 = dpp_ror1(g[j]), a2 = dpp_ror2(g[j]), b1 = dpp_ror1(gp[j]), b2 = dpp_ror2(gp[j]);
                    const float g1 = (fr >= 1) ? a1 : b1, g2 = (fr >= 2) ? a2 : b2;
                    const float y = bb[j] + w0[j] * g2 + w1[j] * g1 + w2[j] * g[j];
                    hv[j] = y * sigmoidf_(y) * uu[j];
                }
                u32x4 hw; hw.x = cvt_pk(hv[0], hv[1]); hw.y = cvt_pk(hv[2], hv[3]); hw.z = cvt_pk(hv[4], hv[5]); hw.w = cvt_pk(hv[6], hv[7]);
                if (m > 0 || fr >= 2) EPI_STORE16(H + (size_t)row * DFF + f0, hw);
                if ((m == 0 && fr < 2) || (m == 3 && fr >= 14)) {
                    u32x4 gw; gw.x = cvt_pk(g[0], g[1]); gw.y = cvt_pk(g[2], g[3]); gw.z = cvt_pk(g[4], g[5]); gw.w = cvt_pk(g[6], g[7]);
                    if (m == 0) { u32x4 uw; uw.x = cvt_pk(uu[0], uu[1]); uw.y = cvt_pk(uu[2], uu[3]); uw.z = cvt_pk(uu[4], uu[5]); uw.w = cvt_pk(uu[6], uu[7]);
                        *(u32x4*)(GH + ((size_t)c64 * 2 + fr) * DFF + f0) = gw; *(u32x4*)(UH + ((size_t)c64 * 2 + fr) * DFF + f0) = uw; }
                    else *(u32x4*)(GT + ((size_t)c64 * 2 + (fr - 14)) * DFF + f0) = gw;
                }
#pragma unroll
                for (int j = 0; j < 8; ++j) gp[j] = g[j];
            }
        }
    }
};
__device__ __forceinline__ void ph_mlp_fix(KP p, int l, int tid, int bid, int G) {
    asm volatile("" : "+v"(tid), "+s"(p));
    const bf16_t* GT = (const bf16_t*)(p->ws + WS_GT); const bf16_t* GH = (const bf16_t*)(p->ws + WS_GH); const bf16_t* UH = (const bf16_t*)(p->ws + WS_UH); bf16_t* H = (bf16_t*)(p->ws + WS_H);
    const float* cw = p->in[I_MCW] + (size_t)l * 3 * DFF; const float* cb = p->in[I_MCB] + (size_t)l * DFF;
    constexpr int NFG = DFF / 8;
    for (int it = bid * NTHR + tid; it < NFG * 256; it += G * NTHR) {
        const int c64 = it / NFG, fg = it - c64 * NFG, f0 = fg * 8;
        float w0[8], w1[8], w2[8], bb[8], gm2[8], gm1[8], g0[8], g1[8], u0[8], u1[8], h0[8], h1[8];
        ld8f(cw + f0, w0); ld8f(cw + DFF + f0, w1); ld8f(cw + 2 * DFF + f0, w2); ld8f(cb + f0, bb);
        if ((c64 & 63) == 0) {
#pragma unroll
            for (int j = 0; j < 8; ++j) { gm2[j] = 0.f; gm1[j] = 0.f; }
        } else { unpack8(*(const u32x4*)(GT + ((size_t)(c64 - 1) * 2 + 0) * DFF + f0), gm2); unpack8(*(const u32x4*)(GT + ((size_t)(c64 - 1) * 2 + 1) * DFF + f0), gm1); }
        unpack8(*(const u32x4*)(GH + ((size_t)c64 * 2 + 0) * DFF + f0), g0); unpack8(*(const u32x4*)(GH + ((size_t)c64 * 2 + 1) * DFF + f0), g1);
        unpack8(*(const u32x4*)(UH + ((size_t)c64 * 2 + 0) * DFF + f0), u0); unpack8(*(const u32x4*)(UH + ((size_t)c64 * 2 + 1) * DFF + f0), u1);
#pragma unroll
        for (int j = 0; j < 8; ++j) {
            const float y0 = bb[j] + w0[j] * gm2[j] + w1[j] * gm1[j] + w2[j] * g0[j], y1 = bb[j] + w0[j] * gm1[j] + w1[j] * g0[j] + w2[j] * g1[j];
            h0[j] = y0 * sigmoidf_(y0) * u0[j]; h1[j] = y1 * sigmoidf_(y1) * u1[j];
        }
        *(u32x4*)(H + (size_t)(c64 * 64) * DFF + f0) = pack8f(h0); *(u32x4*)(H + (size_t)(c64 * 64 + 1) * DFF + f0) = pack8f(h1);
    }
}

struct EpiResid3 {
    static constexpr bool PERM = true, AFTER_DRAIN = false;
    const float* basef; bf16_t* xb; float* outf; float* rowss; int dry = 0;
    __device__ __forceinline__ void operator()(const pg8::f32x4 (&acc)[2][2][4][2], const pg8::Unit& u, int wr, int wc, int fr, int fq) const {
        const int row0 = u.pm * 256 + wr * 64 + fr, col0 = u.pn * 256 + wc * 32 + 8 * fq;
#pragma unroll
        for (int ai = 0; ai < 2; ++ai) {
            u32x4 bw[4][2];
            if (!basef) {
#pragma unroll
                for (int m = 0; m < 4; ++m) { const size_t off = (size_t)(row0 + ai * 128 + m * 16) * DM + col0;
#pragma unroll
                    for (int bj = 0; bj < 2; ++bj) bw[m][bj] = *(const u32x4*)(xb + off + bj * 128); }
            }
#pragma unroll
            for (int m = 0; m < 4; ++m) { const int row = row0 + ai * 128 + m * 16; const size_t off = (size_t)row * DM + col0; float ss = 0.f;
#pragma unroll
                for (int bj = 0; bj < 2; ++bj) {
                    float x[8];
                    if (basef) ld8f(basef + off + bj * 128, x); else unpack8(bw[m][bj], x);
#pragma unroll
                    for (int j = 0; j < 8; ++j) { x[j] += acc[ai][bj][m][j >> 2][j & 3]; ss += x[j] * x[j]; }
                    if (outf) { *(f32x4*)(outf + off + bj * 128) = (f32x4){x[0], x[1], x[2], x[3]}; *(f32x4*)(outf + off + bj * 128 + 4) = (f32x4){x[4], x[5], x[6], x[7]}; }
                    if (!outf) *(u32x4*)(xb + off + bj * 128) = pack8f(x);
                }
                if (!outf) { ss += __shfl_xor(ss, 16); ss += __shfl_xor(ss, 32); if (fq == 0) rowss[(size_t)(u.pn * 4 + wc) * MT + row] = ss; }
            }
        }
    }
};

__device__ __forceinline__ void ph_prep_elem(KP p, int l, int tid, int bid, int G) {
    asm volatile("" : "+v"(tid), "+s"(p));
    const int lane = tid & 63, wave = tid >> 6, hi = lane >> 3, j = lane & 7;
    const bf16_t* PROJ = (const bf16_t*)(p->ws + WS_PROJ);
    const float* rc = (const float*)(p->ws + WS_TAB_RC); const float* rs = (const float*)(p->ws + WS_TAB_RS); const float* nc = (const float*)(p->ws + WS_TAB_NC); const float* ns = (const float*)(p->ws + WS_TAB_NS);
    for (int it = bid * NWAVE + wave; it < MT * 2; it += G * NWAVE) {
        const int tok = it >> 1, grp = (it & 1) ? 3 : 1, b = tok >> 12, s = tok & (SEQ - 1);
        const bf16_t* prow = PROJ + (size_t)tok * NINP;
        if (grp < 2) {
            const int h = hi;
            const bf16_t* src = prow + (grp ? C_RK : C_RQ) + h * 128 + 8 * j;
            float x1[8], x2[8], c[8], sn[8];
            unpack8(*(const u32x4*)src, x1); unpack8(*(const u32x4*)(src + 64), x2);
            ld8f(rc + s * 64 + 8 * j, c); ld8f(rs + s * 64 + 8 * j, sn);
            const float lg2 = log2f(1.0f - exp2f(-5.0f - (float)h));
            const float e = (float)((s & 127) + 1) * lg2;
            const float d = grp ? fexp2(-e) * 0.08838834764831845f : fexp2(e);
            float o1[8], o2[8];
#pragma unroll
            for (int i = 0; i < 8; ++i) { o1[i] = (x1[i] * c[i] - x2[i] * sn[i]) * d; o2[i] = (x2[i] * c[i] + x1[i] * sn[i]) * d; }
            bf16_t* dst = (bf16_t*)(p->ws + (grp ? WS_KR : WS_QR)) + ((size_t)(b * 8 + h) * SEQ + s) * 128 + 8 * j;
            *(u32x4*)dst = pack8f(o1); *(u32x4*)(dst + 64) = pack8f(o2);
        } else {
            int col; const float* w; bf16_t* dst; bool act = true;
            if (grp == 2) { col = C_NQ + hi * 128; w = p->in[I_NQW] + (size_t)l * 128; dst = (bf16_t*)(p->ws + WS_QN) + ((size_t)(b * 8 + hi) * SEQ + s) * 128; }
            else if (hi < 2) { col = C_NKS + hi * 128; w = p->in[I_NKW] + (size_t)l * 3 * 128 + 128; dst = (bf16_t*)(p->ws + WS_KSN) + ((size_t)(b * 2 + hi) * SEQ + s) * 128; }
            else if (hi < 4) { col = C_NKW + (hi - 2) * 128; w = p->in[I_NKW] + (size_t)l * 3 * 128 + 256; dst = (bf16_t*)(p->ws + WS_KWN) + ((size_t)(b * 2 + hi - 2) * SEQ + s) * 128; }
            else { act = false; col = C_NQ; w = p->in[I_NQW]; dst = (bf16_t*)(p->ws + WS_QN); }
            float x1[8], x2[8], w1[8], w2[8];
            unpack8(*(const u32x4*)(prow + col + 8 * j), x1); unpack8(*(const u32x4*)(prow + col + 64 + 8 * j), x2);
            ld8f(w + 8 * j, w1); ld8f(w + 64 + 8 * j, w2);
            float ss = 0.f;
#pragma unroll
            for (int i = 0; i < 8; ++i) ss += x1[i] * x1[i] + x2[i] * x2[i];
            ss += __shfl_xor(ss, 1); ss += __shfl_xor(ss, 2); ss += __shfl_xor(ss, 4);
            const float r = 1.0f / sqrtf(ss * (1.0f / 128.0f) + 1e-6f);
            const float qs = (grp == 2) ? 0.08838834764831845f * 1.4426950408889634f : 1.0f;
            float c[8], sn[8], y1[8], y2[8], pr[8];
            ld8f(nc + s * 16 + 8 * (j & 1), c); ld8f(ns + s * 16 + 8 * (j & 1), sn);
#pragma unroll
            for (int i = 0; i < 8; ++i) { y1[i] = x1[i] * (r * qs) * w1[i]; y2[i] = x2[i] * (r * qs) * w2[i]; }
#pragma unroll
            for (int i = 0; i < 8; ++i) pr[i] = __shfl_xor(y1[i], 2);
            if (j < 4) {
#pragma unroll
                for (int i = 0; i < 8; ++i) y1[i] = (j < 2) ? (y1[i] * c[i] - pr[i] * sn[i]) : (y1[i] * c[i] + pr[i] * sn[i]);
            }
            if (act) { *(u32x4*)(dst + 8 * j) = pack8f(y1); *(u32x4*)(dst + 64 + 8 * j) = pack8f(y2); }
        }
    }
}

__device__ __forceinline__ void lru_c1_task(KP p, int l, int task, LAS unsigned char* lds, int tid) {
    asm volatile("" : "+v"(tid), "+s"(p));
    const int lane = tid & 63, wave = __builtin_amdgcn_readfirstlane(tid >> 6), hh = lane >> 5;
    const int grp = task & 15, n = (task >> 4) & 7, b = task >> 7;
    const bf16_t* PROJ = (const bf16_t*)(p->ws + WS_PROJ);
    LAS unsigned char* XB = lds;
    LAS float* AA = (LAS float*)lds;
    LAS float* X32 = (LAS float*)(lds + 32768);
    LAS unsigned char* WA = lds + 65536;
    LAS unsigned char* WX = lds + 98304;
    LAS float* SM = (LAS float*)(lds + LDS_STAGE + LDS_CTL);
    LAS float* CH = SM; LAS float* CP = SM + 128; LAS float* SH = SM + 256; LAS float* SP = SM + 768;
    tile_stage<128>(WA, (const bf16_t*)(p->ws + WS_LWA) + (size_t)n * 128 * 128, 128, tid);
    tile_stage<128>(WX, (const bf16_t*)(p->ws + WS_LWX) + (size_t)n * 128 * 128, 128, tid);
    if (tid < 128) { CH[tid] = 0.f; CP[tid] = 1.f; }
    const int tb = wave >> 2, db = wave & 3, dd = 32 * db + (lane & 31), chd = n * 128 + dd;
    const float ba = p->in[I_LBA][(size_t)l * 1024 + chd], bx = p->in[I_LBX][(size_t)l * 1024 + chd], lam = p->in[I_LLAM][(size_t)l * 1024 + chd];
    const float lsl = fminf(lam, 0.f) - log1pf(expf(-fabsf(lam)));
    const int ctt = tid >> 3, cc0 = (tid & 7) * 16, cch0 = n * 128 + cc0;
    float cwr[4][16], cbr[16];
    {
        const float* cw = p->in[I_LCW] + (size_t)l * 4 * 1024; const float* cb = p->in[I_LCB] + (size_t)l * 1024;
#pragma unroll
        for (int j = 0; j < 16; j += 4) { const f32x4 v = *(const f32x4*)(cb + cch0 + j); cbr[j] = v[0]; cbr[j + 1] = v[1]; cbr[j + 2] = v[2]; cbr[j + 3] = v[3]; }
#pragma unroll
        for (int k = 0; k < 4; ++k)
#pragma unroll
            for (int j = 0; j < 16; j += 4) { const f32x4 v = *(const f32x4*)(cw + k * 1024 + cch0 + j); cwr[k][j] = v[0]; cwr[k][j + 1] = v[1]; cwr[k][j + 2] = v[2]; cwr[k][j + 3] = v[3]; }
    }
    u32x4 rw[4][2];
#define C1_LOADROWS(s0_) do { _Pragma("unroll") for (int k = 0; k < 4; ++k) { const int s_ = (s0_) + ctt - 3 + k; rw[k][0] = (u32x4){0u, 0u, 0u, 0u}; rw[k][1] = (u32x4){0u, 0u, 0u, 0u}; \
        if (s_ >= 0) { const bf16_t* src = PROJ + (size_t)(b * SEQ + s_) * NINP + C_LR + cch0; rw[k][0] = *(const u32x4*)src; rw[k][1] = *(const u32x4*)(src + 8); } } } while (0)
    C1_LOADROWS(grp * 4 * 64);
    for (int ck = 0; ck < 4; ++ck) {
        const int s0 = (grp * 4 + ck) * 64;
        __syncthreads();
        {
            float acc[16];
#pragma unroll
            for (int j = 0; j < 16; ++j) acc[j] = cbr[j];
#pragma unroll
            for (int k = 0; k < 4; ++k)
#pragma unroll
                for (int j = 0; j < 16; j += 2) { const unsigned w = rw[k][j >> 3][(j >> 1) & 3]; acc[j] += cwr[k][j] * bflo(w); acc[j + 1] += cwr[k][j + 1] * bfhi(w); }
            if (ck + 1 < 4) C1_LOADROWS(s0 + 64);
#pragma unroll
            for (int j = 0; j < 16; j += 4) *(LAS f32x4*)(X32 + ctt * 128 + cc0 + j) = (f32x4){acc[j], acc[j + 1], acc[j + 2], acc[j + 3]};
            u32x4 o0, o1;
            o0.x = cvt_pk(acc[0], acc[1]); o0.y = cvt_pk(acc[2], acc[3]); o0.z = cvt_pk(acc[4], acc[5]); o0.w = cvt_pk(acc[6], acc[7]);
            o1.x = cvt_pk(acc[8], acc[9]); o1.y = cvt_pk(acc[10], acc[11]); o1.z = cvt_pk(acc[12], acc[13]); o1.w = cvt_pk(acc[14], acc[15]);
            *(LAS u32x4*)(XB + off_b((unsigned)ctt, (unsigned)(cc0 >> 3))) = o0; *(LAS u32x4*)(XB + off_b((unsigned)ctt, (unsigned)(cc0 >> 3) + 1u)) = o1;
        }
        __syncthreads();
        f32x16 ca, cx;
#pragma unroll
        for (int i = 0; i < 16; ++i) { ca[i] = 0.f; cx[i] = 0.f; }
#pragma unroll
        for (int s = 0; s < 8; ++s) {
            const bf16x8 a = row_frag(XB, 32 * tb, s, lane);
            bf16x8 bfa, bfx; tr_frag_nat2(WA, WX, db, s, lane, bfa, bfx);
            ca = __builtin_amdgcn_mfma_f32_32x32x16_bf16(a, bfa, ca, 0, 0, 0);
            cx = __builtin_amdgcn_mfma_f32_32x32x16_bf16(a, bfx, cx, 0, 0, 0);
        }
        __syncthreads();
#pragma unroll
        for (int r = 0; r < 16; ++r) {
            const int tok = 32 * tb + (r & 3) + 8 * (r >> 2) + 4 * hh;
            const float rg = sigmoidf_(ca[r] + ba), ig = sigmoidf_(cx[r] + bx);
            const float la = 8.0f * rg * lsl;
            const float a = expf(la);
            const float x2 = 2.0f * la;
            const float em1 = (x2 > -0.1f) ? x2 * (1.f + x2 * 0.5f * (1.f + x2 * (1.f / 3.f) * (1.f + x2 * 0.25f * (1.f + x2 * 0.2f)))) : (expf(x2) - 1.0f);
            float mult = sqrtf(fmaxf(-em1, 0.f));
            if (s0 + tok == 0) mult = 1.0f;
            AA[tok * 128 + dd] = a; X32[tok * 128 + dd] = mult * ig * X32[tok * 128 + dd];
        }
        __syncthreads();
        {
            const int ch = tid & 127, seg = tid >> 7;
            float hl[16], pl[16]; float h = 0.f, P = 1.f;
#pragma unroll
            for (int t = 0; t < 16; ++t) { const float a = AA[(16 * seg + t) * 128 + ch], u = X32[(16 * seg + t) * 128 + ch]; h = a * h + u; P *= a; hl[t] = h; pl[t] = P; }
            SH[seg * 128 + ch] = h; SP[seg * 128 + ch] = P;
            __syncthreads();
            float Hin = CH[ch], Pin = CP[ch];
#pragma unroll
            for (int s2 = 0; s2 < 3; ++s2) if (s2 < seg) { const float sp = SP[s2 * 128 + ch]; Hin = sp * Hin + SH[s2 * 128 + ch]; Pin *= sp; }
            bf16_t* hlg = (bf16_t*)(p->ws + WS_HLOC) + (size_t)(b * SEQ + s0 + 16 * seg) * 1024 + n * 128 + ch;
            bf16_t* cug = (bf16_t*)(p->ws + WS_CUMA) + (size_t)(b * SEQ + s0 + 16 * seg) * 1024 + n * 128 + ch;
            float hlast = 0.f, plast = 0.f;
#pragma unroll
            for (int t = 0; t < 16; ++t) { hlast = hl[t] + pl[t] * Hin; plast = pl[t] * Pin; hlg[(size_t)t * 1024] = f2bf(hlast); cug[(size_t)t * 1024] = f2bf(plast); }
            __syncthreads();
            if (seg == 3) { CH[ch] = hlast; CP[ch] = plast; }
        }
    }
#undef C1_LOADROWS
}

__device__ __forceinline__ void lru_c3_task(KP p, int task, LAS unsigned char* lds, int tid) {
    asm volatile("" : "+v"(tid), "+s"(p));
    const int grp = task & 15, n = (task >> 4) & 7, b = task >> 7, s0 = grp * 256;
    const bf16_t* HL = (const bf16_t*)(p->ws + WS_HLOC); const bf16_t* CU = (const bf16_t*)(p->ws + WS_CUMA);
    const bf16_t* PROJ = (const bf16_t*)(p->ws + WS_PROJ); bf16_t* MIX = (bf16_t*)(p->ws + WS_MIX);
    LAS float* Hin = (LAS float*)lds;
    if (tid < 128) {
        float H = 0.f;
        const size_t base = (size_t)(b * SEQ + 255) * 1024 + n * 128 + tid;
        for (int c = 0; c < grp; ++c) { const float a = bf2f(CU[base + (size_t)c * 256 * 1024]), hv = bf2f(HL[base + (size_t)c * 256 * 1024]); H = a * H + hv; }
        Hin[tid] = H;
    }
    __syncthreads();
    const int c4 = (tid & 31) * 4;
    const f32x4 hin = *(const LAS f32x4*)(Hin + c4);
#pragma unroll 4
    for (int i = 0; i < 16; ++i) {
        const int tok = (tid >> 5) + 16 * i;
        const size_t row = (size_t)(b * SEQ + s0 + tok);
        const u32x2 hlw = *(const u32x2*)(HL + row * 1024 + n * 128 + c4), cuw = *(const u32x2*)(CU + row * 1024 + n * 128 + c4);
        const f32x4 hl = (f32x4){bflo(hlw.x), bfhi(hlw.x), bflo(hlw.y), bfhi(hlw.y)}, cu = (f32x4){bflo(cuw.x), bfhi(cuw.x), bflo(cuw.y), bfhi(cuw.y)};
        const u32x2 gv = *(const u32x2*)(PROJ + row * NINP + C_LG + n * 128 + c4);
        const float g0 = bflo(gv.x), g1 = bfhi(gv.x), g2 = bflo(gv.y), g3 = bfhi(gv.y);
        u32x2 o; o.x = cvt_pk((hl[0] + cu[0] * hin[0]) * gelu_tanh(g0), (hl[1] + cu[1] * hin[1]) * gelu_tanh(g1));
        o.y = cvt_pk((hl[2] + cu[2] * hin[2]) * gelu_tanh(g2), (hl[3] + cu[3] * hin[3]) * gelu_tanh(g3));
        *(u32x2*)(MIX + row * DM + MIX_LRU + n * 128 + c4) = o;
    }
}

__device__ __forceinline__ void tr_nat4(const LAS unsigned char* tile, int ks, int lane, bf16x8 (&f)[4]) {
    const unsigned b = lds_addr(tile);
    s16x4 d0, d1, d2, d3, d4, d5, d6, d7;
    asm volatile("ds_read_b64_tr_b16 %0, %8\n\tds_read_b64_tr_b16 %1, %9\n\tds_read_b64_tr_b16 %2, %10\n\tds_read_b64_tr_b16 %3, %11\n\t"
                 "ds_read_b64_tr_b16 %4, %12\n\tds_read_b64_tr_b16 %5, %13\n\tds_read_b64_tr_b16 %6, %14\n\tds_read_b64_tr_b16 %7, %15\n\ts_waitcnt lgkmcnt(0)"
                 : "=&v"(d0), "=&v"(d1), "=&v"(d2), "=&v"(d3), "=&v"(d4), "=&v"(d5), "=&v"(d6), "=&v"(d7)
                 : "v"(b + tr_off_nat(lane, 0, ks, 0)), "v"(b + tr_off_nat(lane, 0, ks, 1)), "v"(b + tr_off_nat(lane, 1, ks, 0)), "v"(b + tr_off_nat(lane, 1, ks, 1)),
                   "v"(b + tr_off_nat(lane, 2, ks, 0)), "v"(b + tr_off_nat(lane, 2, ks, 1)), "v"(b + tr_off_nat(lane, 3, ks, 0)), "v"(b + tr_off_nat(lane, 3, ks, 1)) : "memory");
    f[0] = __builtin_shufflevector(d0, d1, 0, 1, 2, 3, 4, 5, 6, 7); f[1] = __builtin_shufflevector(d2, d3, 0, 1, 2, 3, 4, 5, 6, 7);
    f[2] = __builtin_shufflevector(d4, d5, 0, 1, 2, 3, 4, 5, 6, 7); f[3] = __builtin_shufflevector(d6, d7, 0, 1, 2, 3, 4, 5, 6, 7);
}
__device__ __forceinline__ void cmp_task(KP p, int l, int task, LAS unsigned char* lds, int tid) {
    asm volatile("" : "+v"(tid), "+s"(p));
    const int lane = tid & 63, wave = __builtin_amdgcn_readfirstlane(tid >> 6), hh = lane >> 5;
    const int rh = task & 1, bg = (task >> 1) & 7, kv = task >> 4, b = bg >> 1, g = bg & 1, n0 = rh * 128;
    const bf16_t* PROJ = (const bf16_t*)(p->ws + WS_PROJ);
    const bf16_t* W1 = (const bf16_t*)(p->ws + WS_CW1) + (size_t)kv * 4096 * 256;
    const bf16_t* W2 = (const bf16_t*)(p->ws + WS_CW2) + (size_t)kv * 256 * 128;
    const int col = (kv ? C_NVC : C_NKC) + g * 128;
    const int rb = wave & 3, kh = wave >> 2, hc = kh, nrow = n0 + 32 * rb + (lane & 31);
    const bool rowok = nrow < 255;
    const bf16_t* arow = PROJ + (size_t)(b * SEQ + 16 * (rowok ? nrow : 0)) * NINP + col + 64 * kh + 8 * hh;
    f32x16 ac8[8];
#pragma unroll
    for (int c = 0; c < 8; ++c)
#pragma unroll
        for (int i = 0; i < 16; ++i) ac8[c][i] = 0.f;
#define CMP_ISSUE(li_, buf_) do { _Pragma("unroll") for (int hf = 0; hf < 2; ++hf) _Pragma("unroll") for (int rr = 0; rr < 2; ++rr) \
        tile_dma64(lds + (buf_) * 65536 + hf * 32768 + rr * 16384, W1 + (size_t)((li_) * 128 + rr * 64) * 256 + hf * 128, 256, tid, wave); } while (0)
    bf16x8 af[4], an[4];
    CMP_ISSUE(0, 0);
#pragma unroll
    for (int s = 0; s < 4; ++s) af[s] = *(const bf16x8*)(arow + 16 * s);
    asm volatile("s_waitcnt vmcnt(0)" ::: "memory");
    __syncthreads();
    for (int li = 0; li < 32; ++li) {
        const int buf = li & 1;
        if (li + 1 < 32) {
            CMP_ISSUE(li + 1, buf ^ 1);
#pragma unroll
            for (int s = 0; s < 4; ++s) an[s] = *(const bf16x8*)(arow + (size_t)(li + 1) * NINP + 16 * s);
        }
        int lane_o = lane; asm volatile("" : "+v"(lane_o));
#pragma unroll
        for (int hf = 0; hf < 2; ++hf) {
            const LAS unsigned char* Bt = lds + buf * 65536 + hf * 32768;
#pragma unroll
            for (int s = 0; s < 4; ++s) {
                bf16x8 bf[4]; tr_nat4(Bt, 4 * kh + s, lane_o, bf);
#pragma unroll
                for (int c = 0; c < 4; ++c) ac8[4 * hf + c] = __builtin_amdgcn_mfma_f32_32x32x16_bf16(af[s], bf[c], ac8[4 * hf + c], 0, 0, 0);
            }
        }
        if (li + 1 < 32) {
            asm volatile("s_waitcnt vmcnt(0)" ::: "memory");
#pragma unroll
            for (int s = 0; s < 4; ++s) af[s] = an[s];
            __syncthreads();
        }
    }
#undef CMP_ISSUE
    __syncthreads();
    f32x16 acc[4];
    {
        LAS float* EX = (LAS float*)lds;
        if (kh == 0) {
#pragma unroll
            for (int c = 0; c < 4; ++c)
#pragma unroll
                for (int r = 0; r < 16; ++r) EX[((wave * 4 + c) * 16 + r) * 64 + lane] = ac8[4 + c][r];
        } else {
#pragma unroll
            for (int c = 0; c < 4; ++c)
#pragma unroll
                for (int r = 0; r < 16; ++r) EX[((wave * 4 + c) * 16 + r) * 64 + lane] = ac8[c][r];
        }
        __syncthreads();
        const int pw = wave ^ 4;
        if (kh == 0) {
#pragma unroll
            for (int c = 0; c < 4; ++c)
#pragma unroll
                for (int r = 0; r < 16; ++r) acc[c][r] = ac8[c][r] + EX[((pw * 4 + c) * 16 + r) * 64 + lane];
        } else {
#pragma unroll
            for (int c = 0; c < 4; ++c)
#pragma unroll
                for (int r = 0; r < 16; ++r) acc[c][r] = ac8[4 + c][r] + EX[((pw * 4 + c) * 16 + r) * 64 + lane];
        }
        __syncthreads();
    }
    LAS unsigned char* HI = lds;
    LAS unsigned char* W2I = lds + 65536;
#pragma unroll
    for (int hf = 0; hf < 2; ++hf)
#pragma unroll
        for (int rr = 0; rr < 2; ++rr) tile_dma64(W2I + hf * 32768 + rr * 16384, W2 + (size_t)(hf * 128 + rr * 64) * 128, 128, tid, wave);
    {
        const float* cp = (const float*)(p->ws + WS_CPOS) + kv * 256 + hc * 128;
        LAS unsigned char* Ht = HI + hc * 32768;
#pragma unroll
        for (int c = 0; c < 4; ++c) {
            const int cc = 32 * c + (lane & 31); const float cpv = cp[cc];
#pragma unroll
            for (int r = 0; r < 16; ++r) {
                const int n = 32 * rb + (r & 3) + 8 * (r >> 2) + 4 * hh;
                const bool ok = n0 + n < 255;
                *(LAS unsigned short*)(Ht + off_b((unsigned)n, (unsigned)(cc >> 3)) + 2 * (cc & 7)) = ok ? f2bf(gelu_tanh(acc[c][r] + cpv)) : (unsigned short)0;
            }
        }
    }
    asm volatile("s_waitcnt vmcnt(0)" ::: "memory");
    __syncthreads();
    {
        const int nb = wave & 3, dh = wave >> 2;
        f32x16 o[2];
#pragma unroll
        for (int q = 0; q < 2; ++q) {
#pragma unroll
            for (int i = 0; i < 16; ++i) o[q][i] = 0.f;
#pragma unroll
            for (int ks = 0; ks < 16; ++ks)
                o[q] = __builtin_amdgcn_mfma_f32_32x32x16_bf16(tr_frag_nat(W2I + (ks >> 3) * 32768, 2 * dh + q, ks & 7, lane), row_frag(HI + (ks >> 3) * 32768, 32 * nb, ks & 7, lane), o[q], 0, 0, 0);
        }
        const int n = n0 + 32 * nb + (lane & 31);
        bf16_t* dst = (bf16_t*)(p->ws + (kv ? WS_VCMP : WS_KCMP)) + ((size_t)bg * 256 + n) * 128;
        if (kv == 0) {
            LAS float* SS = (LAS float*)(lds + LDS_STAGE + LDS_CTL);
            float ss = 0.f;
#pragma unroll
            for (int q = 0; q < 2; ++q)
#pragma unroll
                for (int r = 0; r < 16; ++r) ss += o[q][r] * o[q][r];
            ss = half_sum(ss);
            if (hh == 0) SS[dh * 128 + 32 * nb + (lane & 31)] = ss;
            __syncthreads();
            const float tot = SS[32 * nb + (lane & 31)] + SS[128 + 32 * nb + (lane & 31)];
            const float rn = 1.0f / sqrtf(tot * (1.0f / 128.0f) + 1e-6f);
            const float* kw = p->in[I_NKW] + (size_t)l * 3 * 128;
#pragma unroll
            for (int q = 0; q < 2; ++q)
#pragma unroll
                for (int r = 0; r < 16; ++r) o[q][r] *= rn * kw[32 * (2 * dh + q) + (r & 3) + 8 * (r >> 2) + 4 * hh];
            if (dh == 0 && n < 255) {
                const int cpz = 16 * n + 31;
                const float* nc = (const float*)(p->ws + WS_TAB_NC) + cpz * 16; const float* ns = (const float*)(p->ws + WS_TAB_NS) + cpz * 16;
#pragma unroll
                for (int a = 0; a < 2; ++a)
#pragma unroll
                    for (int q = 0; q < 4; ++q) {
                        const int i = 8 * a + 4 * hh + q;
                        const float c = nc[i], sn = ns[i], x1 = o[0][4 * a + q], x2 = o[0][4 * (a + 2) + q];
                        o[0][4 * a + q] = x1 * c - x2 * sn; o[0][4 * (a + 2) + q] = x2 * c + x1 * sn;
                    }
            }
        }
#pragma unroll
        for (int q = 0; q < 2; ++q)
#pragma unroll
            for (int a = 0; a < 4; ++a) {
                u32x2 w; w.x = cvt_pk(o[q][4 * a], o[q][4 * a + 1]); w.y = cvt_pk(o[q][4 * a + 2], o[q][4 * a + 3]);
                if (n >= 255) { w.x = 0u; w.y = 0u; }
                *(u32x2*)(dst + 32 * (2 * dh + q) + 8 * a + 4 * hh) = w;
            }
    }
}

__device__ __forceinline__ float softmax_block(f32x16& sa, float& m, float& l) {
    float mx = m;
#pragma unroll
    for (int r = 0; r < 16; ++r) mx = fmaxf(mx, sa[r]);
    mx = half_max(mx);
    const float alpha = fexp2(m - mx);
    float ps = 0.f;
#pragma unroll
    for (int r = 0; r < 16; ++r) { const float pv = fexp2(sa[r] - mx); sa[r] = pv; ps += pv; }
    l = l * alpha + ps; m = mx;
    return alpha;
}
__device__ __forceinline__ void scale_o(f32x16 (&o)[4], float a) {
#pragma unroll
    for (int c = 0; c < 4; ++c)
#pragma unroll
        for (int r = 0; r < 16; ++r) o[c][r] *= a;
}
__device__ __forceinline__ void zero_o(f32x16 (&o)[4]) {
#pragma unroll
    for (int c = 0; c < 4; ++c)
#pragma unroll
        for (int r = 0; r < 16; ++r) o[c][r] = 0.f;
}
__device__ __forceinline__ void pv_block(f32x16 (&o)[4], const LAS unsigned char* vt, const TrAcc& TA, const f32x16& pp, int kb) {
    const unsigned vb = lds_addr(vt);
    pv_step(o, vb + 4096u * (unsigned)(2 * kb), TA, pack8(pp, 0));
    pv_step(o, vb + 4096u * (unsigned)(2 * kb + 1), TA, pack8(pp, 1));
}

struct VFrag { s16x4 d0, d1, d2, d3, d4, d5, d6, d7; };
__device__ __forceinline__ void v_issue(VFrag& f, unsigned vb, const TrAcc& A) {
    asm volatile("ds_read_b64_tr_b16 %0, %8\n\tds_read_b64_tr_b16 %1, %9\n\tds_read_b64_tr_b16 %2, %10\n\tds_read_b64_tr_b16 %3, %11\n\t"
                 "ds_read_b64_tr_b16 %4, %12\n\tds_read_b64_tr_b16 %5, %13\n\tds_read_b64_tr_b16 %6, %14\n\tds_read_b64_tr_b16 %7, %15"
                 : "=&v"(f.d0), "=&v"(f.d1), "=&v"(f.d2), "=&v"(f.d3), "=&v"(f.d4), "=&v"(f.d5), "=&v"(f.d6), "=&v"(f.d7)
                 : "v"(vb + A.a[0][0]), "v"(vb + A.a[0][1]), "v"(vb + A.a[1][0]), "v"(vb + A.a[1][1]), "v"(vb + A.a[2][0]), "v"(vb + A.a[2][1]), "v"(vb + A.a[3][0]), "v"(vb + A.a[3][1]) : "memory");
}
__device__ __forceinline__ void v_wait(VFrag& f) {
    asm volatile("s_waitcnt lgkmcnt(0)" : "+v"(f.d0), "+v"(f.d1), "+v"(f.d2), "+v"(f.d3), "+v"(f.d4), "+v"(f.d5), "+v"(f.d6), "+v"(f.d7) :: "memory");
}
__device__ __forceinline__ void v_mma(f32x16 (&o)[4], const VFrag& f, bf16x8 pf) {
    o[0] = __builtin_amdgcn_mfma_f32_32x32x16_bf16(__builtin_shufflevector(f.d0, f.d1, 0, 1, 2, 3, 4, 5, 6, 7), pf, o[0], 0, 0, 0);
    o[1] = __builtin_amdgcn_mfma_f32_32x32x16_bf16(__builtin_shufflevector(f.d2, f.d3, 0, 1, 2, 3, 4, 5, 6, 7), pf, o[1], 0, 0, 0);
    o[2] = __builtin_amdgcn_mfma_f32_32x32x16_bf16(__builtin_shufflevector(f.d4, f.d5, 0, 1, 2, 3, 4, 5, 6, 7), pf, o[2], 0, 0, 0);
    o[3] = __builtin_amdgcn_mfma_f32_32x32x16_bf16(__builtin_shufflevector(f.d6, f.d7, 0, 1, 2, 3, 4, 5, 6, 7), pf, o[3], 0, 0, 0);
}

constexpr float NSA_DEFER = 8.0f;
template <int MODE>
__device__ __forceinline__ void nsa_branch(unsigned long long tmask, const bf16_t* ksrc, size_t kld, const bf16_t* vsrc, size_t vld, const bf16_t* nk, size_t nkld, const bf16_t* nv, size_t nvld, int& buf,
                                           LAS unsigned char* lds, const bf16x8 (&qf)[8], const TrAcc& TA,
                                           f32x16 (&o)[4], float& m, float& lsum, float inv, int tq, unsigned long long mysel, LAS unsigned* PS, int ql, int tid, int lane, int wave) {
    constexpr bool HASV = MODE != 0;
    const int hh = lane >> 5;
    const int qb = tq >> 6, tqmin = tq & ~31;
    int j = __builtin_ctzll(tmask); tmask &= tmask - 1;
    asm volatile("s_waitcnt vmcnt(0)" ::: "memory");
    __syncthreads();
    for (;;) {
        const bool more = tmask != 0ull;
        const int jn = more ? __builtin_ctzll(tmask) : 0; tmask &= tmask - 1;
        {
            LAS unsigned char* nb = lds + (buf ^ 1) * 32768;
            if (more) { tile_dma64(nb, ksrc + (size_t)jn * 64 * kld, kld, tid, wave); if (HASV) tile_dma64(nb + 16384, vsrc + (size_t)jn * 64 * vld, vld, tid, wave); }
            else if (nk) { tile_dma64(nb, nk, nkld, tid, wave); if (nv) tile_dma64(nb + 16384, nv, nvld, tid, wave); }
        }
        const LAS unsigned char* KT = lds + buf * 32768; const LAS unsigned char* VT = KT + 16384;
        const bool sel = MODE == 3 ? (bool)((mysel >> j) & 1ull) : true;
        f32x16 sa[2];
        qk_tile_pipe(KT, qf, lane, sa[0], sa[1]);
        VFrag fa;
        if (HASV) v_issue(fa, lds_addr(VT), TA);
#pragma unroll
        for (int kb = 0; kb < 2; ++kb) {
            bool need_mask;
            if (MODE < 2) need_mask = 16 * (64 * j + 32 * kb + 31) + 31 > tqmin; else if (MODE == 2) need_mask = (j == qb) || (j + 8 == qb); else need_mask = (j == qb);
            if (need_mask) {
#pragma unroll
                for (int r = 0; r < 16; ++r) {
                    const int kp = 64 * j + 32 * kb + (r & 3) + 8 * (r >> 2) + 4 * hh;
                    bool ok;
                    if (MODE < 2) ok = 16 * kp + 31 <= tq; else if (MODE == 2) ok = (tq - kp >= 0) && (tq - kp < 512); else ok = kp <= tq;
                    sa[kb][r] = ok ? sa[kb][r] : -__builtin_inff();
                }
            }
        }
        if (MODE == 3 && !__all(sel)) {
#pragma unroll
            for (int kb = 0; kb < 2; ++kb)
#pragma unroll
                for (int r = 0; r < 16; ++r) sa[kb][r] = sel ? sa[kb][r] : -__builtin_inff();
        }
        if (MODE == 1) {
#pragma unroll
            for (int kb = 0; kb < 2; ++kb) {
#pragma unroll
                for (int r = 0; r < 16; ++r) sa[kb][r] = fexp2(sa[kb][r] - m) * inv;
#pragma unroll
                for (int a = 0; a < 4; ++a) {
                    const int jj = 16 * j + 8 * kb + 2 * a + hh;
                    const float p3 = sa[kb][4 * a + 3], mainv = 2.0f * (sa[kb][4 * a] + sa[kb][4 * a + 1] + sa[kb][4 * a + 2]) + p3;
                    __hip_atomic_fetch_add(PS + ql * 66 + jj, (unsigned)(mainv * 268435456.0f + 0.5f), __ATOMIC_RELAXED, __HIP_MEMORY_SCOPE_WORKGROUP);
                    __hip_atomic_fetch_add(PS + ql * 66 + jj + 1, (unsigned)(p3 * 268435456.0f + 0.5f), __ATOMIC_RELAXED, __HIP_MEMORY_SCOPE_WORKGROUP);
                }
            }
        } else {
            float mx = m;
#pragma unroll
            for (int r = 0; r < 16; ++r) mx = fmaxf(mx, fmaxf(sa[0][r], sa[1][r]));
            mx = half_max(mx);
            float alpha = 1.0f;
            if (!__all(mx - m <= NSA_DEFER)) { alpha = fexp2(m - mx); m = mx; if (HASV) scale_o(o, alpha); }
            float ps = 0.f;
#pragma unroll
            for (int kb = 0; kb < 2; ++kb)
#pragma unroll
                for (int r = 0; r < 16; ++r) { const float pv = fexp2(sa[kb][r] - m); sa[kb][r] = pv; ps += pv; }
            lsum = lsum * alpha + ps;
        }
        if (HASV) {
            const unsigned vb = lds_addr(VT);
            VFrag fb;
            v_wait(fa); v_issue(fb, vb + 4096u, TA); v_mma(o, fa, pack8(sa[0], 0));
            v_wait(fb); v_issue(fa, vb + 8192u, TA); v_mma(o, fb, pack8(sa[0], 1));
            v_wait(fa); v_issue(fb, vb + 12288u, TA); v_mma(o, fa, pack8(sa[1], 0));
            v_wait(fb); v_mma(o, fb, pack8(sa[1], 1));
        }
        buf ^= 1;
        if (!more) break;
        asm volatile("s_waitcnt vmcnt(0)" ::: "memory");
        __syncthreads();
        j = jn;
    }
}

__device__ __forceinline__ void nsa_task(KP p, int nsa_layer, int task, LAS unsigned char* lds, int tid) {
    asm volatile("" : "+v"(tid), "+s"(p));
    const int lane = tid & 63, wave = __builtin_amdgcn_readfirstlane(tid >> 6), hh = lane >> 5;
    const int qb = 63 - (task >> 3), bg = task & 7, b = bg >> 1, g = bg & 1, t0 = qb * 64;
    const int hd = g * 4 + (wave >> 1), ql = 32 * (wave & 1) + (lane & 31), tq = t0 + ql;
    const bf16_t* PROJ = (const bf16_t*)(p->ws + WS_PROJ);
    LAS unsigned* PS = (LAS unsigned*)(lds + 65536);
    LAS unsigned* SM = (LAS unsigned*)(lds + LDS_STAGE + LDS_CTL);
    LAS u32x2* YL = (LAS u32x2*)(lds + 65536) + wave * 1024 + lane;
    LAS unsigned* UN = SM + 128;
    const bf16_t* kc = (const bf16_t*)(p->ws + WS_KCMP) + (size_t)bg * 256 * 128; const bf16_t* vc = (const bf16_t*)(p->ws + WS_VCMP) + (size_t)bg * 256 * 128;
    const bf16_t* kw = (const bf16_t*)(p->ws + WS_KWN) + (size_t)bg * SEQ * 128; const bf16_t* vw = PROJ + (size_t)b * SEQ * NINP + C_NVW + g * 128;
    const bf16_t* ks = (const bf16_t*)(p->ws + WS_KSN) + (size_t)bg * SEQ * 128; const bf16_t* vs = PROJ + (size_t)b * SEQ * NINP + C_NVS + g * 128;
    int buf = 0;
    tile_dma64(lds, kc, 128, tid, wave);
    bf16x8 qf[8];
    {
        const bf16_t* qsrc = PROJ + (size_t)(b * SEQ + tq) * NINP + C_NQ + hd * 128 + 8 * hh;
        const float* qw = p->in[I_NQW] + (size_t)nsa_layer * 128 + 8 * hh;
        float x[8][8]; float ss = 0.f;
#pragma unroll
        for (int s8 = 0; s8 < 8; ++s8) { unpack8(*(const u32x4*)(qsrc + 16 * s8), x[s8]);
#pragma unroll
            for (int j = 0; j < 8; ++j) ss += x[s8][j] * x[s8][j]; }
        ss = half_sum(ss);
        const float r = (1.0f / sqrtf(ss * (1.0f / 128.0f) + 1e-6f)) * (0.08838834764831845f * 1.4426950408889634f);
#pragma unroll
        for (int s8 = 0; s8 < 8; ++s8) { float w[8]; ld8f(qw + 16 * s8, w);
#pragma unroll
            for (int j = 0; j < 8; ++j) x[s8][j] *= r * w[j]; }
        {
            float c[8], sn[8]; ld8f((const float*)(p->ws + WS_TAB_NC) + tq * 16 + 8 * hh, c); ld8f((const float*)(p->ws + WS_TAB_NS) + tq * 16 + 8 * hh, sn);
#pragma unroll
            for (int j = 0; j < 8; ++j) { const float x1 = x[0][j], x2 = x[1][j]; x[0][j] = x1 * c[j] - x2 * sn[j]; x[1][j] = x2 * c[j] + x1 * sn[j]; }
        }
#pragma unroll
        for (int s8 = 0; s8 < 8; ++s8) qf[s8] = __builtin_bit_cast(bf16x8, pack8f(x[s8]));
    }
    const size_t tokrow = (size_t)(b * SEQ + tq);
    const unsigned short graw0 = PROJ[tokrow * NINP + C_NG + hd * 3 + 0], graw1 = PROJ[tokrow * NINP + C_NG + hd * 3 + 1], graw2 = PROJ[tokrow * NINP + C_NG + hd * 3 + 2];
    TrAcc TA; tr_acc_init(TA, lane);
    if (wave >= 4) __builtin_amdgcn_s_setprio(1);
    for (int i = tid; i < 64 * 66; i += NTHR) PS[i] = 0u;
    if (tid < 2) UN[tid] = 0u;
    f32x16 o[4];
    const int jw0 = (qb >= 8 ? qb - 8 : 0);
    {
        const int nv = ((t0 + 32) >> 4) + 1, ntile = (nv + 63) >> 6;
        const unsigned long long tm = (1ull << ntile) - 1ull;
        float m = -1e30f, lsum = 0.f;
        nsa_branch<0>(tm, kc, 128, vc, 128, kc, 128, vc, 128, buf, lds, qf, TA, o, m, lsum, 0.f, tq, 0ull, PS, ql, tid, lane, wave);
        lsum = half_sum(lsum);
        const float inv = lsum > 0.f ? 1.0f / lsum : 0.f;
        zero_o(o);
        nsa_branch<1>(tm, kc, 128, vc, 128, kw + (size_t)jw0 * 64 * 128, 128, vw + (size_t)jw0 * 64 * NINP, NINP, buf, lds, qf, TA, o, m, lsum, inv, tq, 0ull, PS, ql, tid, lane, wave);
    }
    __syncthreads();
    for (int qi = 0; qi < 8; ++qi) {
        const int q = 8 * wave + qi, cur = qb;
        const unsigned v = PS[q * 66 + lane];
        const bool forced = (lane == 0) || (lane == cur) || (lane == cur - 1);
        const unsigned key = forced ? 0xffffffffu : ((lane <= cur) ? v + 1u : 0u);
        int rank = 0;
#pragma unroll
        for (int i = 0; i < 64; ++i) { const unsigned ki = (unsigned)__builtin_amdgcn_readlane((int)key, i); rank += ((ki > key) || (ki == key && i < lane)) ? 1 : 0; }
        const unsigned long long msk = __ballot(rank < 16);
        if (lane == 0) { SM[2 * q] = (unsigned)msk; SM[2 * q + 1] = (unsigned)(msk >> 32); __hip_atomic_fetch_or(UN, (unsigned)msk, __ATOMIC_RELAXED, __HIP_MEMORY_SCOPE_WORKGROUP); __hip_atomic_fetch_or(UN + 1, (unsigned)(msk >> 32), __ATOMIC_RELAXED, __HIP_MEMORY_SCOPE_WORKGROUP); }
    }
    const unsigned long long upto = (qb == 63) ? ~0ull : ((2ull << qb) - 1ull);
    __syncthreads();
    {
        const float gt0 = sigmoidf_(bf2f(graw0));
#pragma unroll
        for (int c = 0; c < 4; ++c)
#pragma unroll
            for (int a = 0; a < 4; ++a) { u32x2 w; w.x = cvt_pk(o[c][4 * a] * gt0, o[c][4 * a + 1] * gt0); w.y = cvt_pk(o[c][4 * a + 2] * gt0, o[c][4 * a + 3] * gt0); YL[(c * 4 + a) * 64] = w; }
    }
    const unsigned long long mysel = (unsigned long long)SM[2 * ql] | ((unsigned long long)SM[2 * ql + 1] << 32);
    const unsigned long long un = ((unsigned long long)UN[0] | ((unsigned long long)UN[1] << 32)) & upto;
    const int js0 = __builtin_ctzll(un);
    {
        float m = -1e30f, lsum = 0.f; zero_o(o);
        const unsigned long long tm = upto & ~((qb >= 8) ? ((1ull << (qb - 8)) - 1ull) : 0ull);
        nsa_branch<2>(tm, kw, 128, vw, NINP, ks + (size_t)js0 * 64 * 128, 128, vs + (size_t)js0 * 64 * NINP, NINP, buf, lds, qf, TA, o, m, lsum, 0.f, tq, 0ull, PS, ql, tid, lane, wave);
        lsum = half_sum(lsum);
        const float sc = sigmoidf_(bf2f(graw2)) / lsum;
#pragma unroll
        for (int c = 0; c < 4; ++c)
#pragma unroll
            for (int a = 0; a < 4; ++a) { const u32x2 y = YL[(c * 4 + a) * 64];
                u32x2 w; w.x = cvt_pk(bflo(y.x) + o[c][4 * a] * sc, bfhi(y.x) + o[c][4 * a + 1] * sc); w.y = cvt_pk(bflo(y.y) + o[c][4 * a + 2] * sc, bfhi(y.y) + o[c][4 * a + 3] * sc); YL[(c * 4 + a) * 64] = w; }
    }
    {
        float m = -1e30f, lsum = 0.f; zero_o(o);
        nsa_branch<3>(un, ks, 128, vs, NINP, nullptr, 0, nullptr, 0, buf, lds, qf, TA, o, m, lsum, 0.f, tq, mysel, PS, ql, tid, lane, wave);
        lsum = half_sum(lsum);
        const float sc = sigmoidf_(bf2f(graw1)) / lsum;
        bf16_t* mrow = (bf16_t*)(p->ws + WS_MIX) + tokrow * DM + MIX_NSA + hd * 128;
#pragma unroll
        for (int c = 0; c < 4; ++c)
#pragma unroll
            for (int a = 0; a < 4; ++a) {
                const u32x2 y = YL[(c * 4 + a) * 64];
                u32x2 w; w.x = cvt_pk(bflo(y.x) + o[c][4 * a] * sc, bfhi(y.x) + o[c][4 * a + 1] * sc); w.y = cvt_pk(bflo(y.y) + o[c][4 * a + 2] * sc, bfhi(y.y) + o[c][4 * a + 3] * sc);
                *(u32x2*)(mrow + 32 * c + 8 * a + 4 * hh) = w;
            }
    }
    __builtin_amdgcn_s_setprio(0);
}

constexpr float SB_THR = 40.0f;
__device__ __forceinline__ void sb_task(KP p, int task, LAS unsigned char* lds, int tid) {
    asm volatile("" : "+v"(tid), "+s"(p));
    const int lane = tid & 63, wave = __builtin_amdgcn_readfirstlane(tid >> 6), hh = lane >> 5;
    const int bh = task >> 4, b = bh >> 3, h = bh & 7, Q0 = (task & 15) * 256;
    const bf16_t* PROJ = (const bf16_t*)(p->ws + WS_PROJ);
    const bf16_t* base = PROJ + (size_t)b * SEQ * NINP + h * 128;
    volatile LAS int* FL = (volatile LAS int*)(lds + 65536);
    const int tq = Q0 + 32 * wave + (lane & 31);
    int jt = (Q0 >> 6) + 3, buf = 0;
    tile_dma64(lds, base + (size_t)jt * 64 * NINP + C_SK, NINP, tid, wave); tile_dma64(lds + 16384, base + (size_t)jt * 64 * NINP + C_SV, NINP, tid, wave);
    bf16x8 qf[8];
#ifndef REPS_SBQ
#define REPS_SBQ 1
#endif
    for (int rr = 0; rr < REPS_SBQ; ++rr) {
#pragma unroll
        for (int s = 0; s < 8; ++s) qf[s] = *(const bf16x8*)(base + (size_t)tq * NINP + C_SQ + 16 * s + 8 * hh);
        if (REPS_SBQ > 1) {
#pragma unroll
            for (int s = 0; s < 8; ++s) asm volatile("" : "+v"(qf[s]));
        }
    }
    TrAcc TA; tr_acc_init(TA, lane);
    f32x16 o[4]; zero_o(o);
    float Lc = 0.f; bool wdone = false;
    if (tid < 8) FL[tid] = 0;
    const float SC = 0.08838834764831845f, L2E = 1.4426950408889634f, LN2 = 0.6931471805599453f;
    asm volatile("s_waitcnt vmcnt(0)" ::: "memory");
    __syncthreads();
    for (;;) {
        if (FL[0] & FL[1] & FL[2] & FL[3] & FL[4] & FL[5] & FL[6] & FL[7]) break;
        if (jt > 0) { LAS unsigned char* nb = lds + (buf ^ 1) * 32768; tile_dma64(nb, base + (size_t)(jt - 1) * 64 * NINP + C_SK, NINP, tid, wave); tile_dma64(nb + 16384, base + (size_t)(jt - 1) * 64 * NINP + C_SV, NINP, tid, wave); }
        const LAS unsigned char* KT = lds + buf * 32768; const LAS unsigned char* VT = KT + 16384;
        const int k0 = jt * 64;
        if (!wdone && k0 < Q0 + 32 * wave + 31) {
            const unsigned vb = lds_addr(VT);
#pragma unroll 1
            for (int kbi = 0; kbi < 2; ++kbi) {
                const int kb = 1 - kbi;
                f32x16 sa = qk_block(KT, kb, qf, lane), ls;
#pragma unroll
                for (int r = 0; r < 16; ++r) {
                    const int key = k0 + 32 * kb + (r & 3) + 8 * (r >> 2) + 4 * hh;
                    const float z = sa[r] * SC;
                    const float lp = flog2(1.0f + fexp2(-fabsf(z) * L2E)) * LN2;
                    const float lb = fminf(z, 0.f) - lp;
                    sa[r] = lb; ls[r] = (key < tq) ? (lb - z) : 0.f;
                }
                float gsum[4], ghi[4], after[4];
#pragma unroll
                for (int a = 0; a < 4; ++a) { const float gsv = (ls[4 * a] + ls[4 * a + 1]) + (ls[4 * a + 2] + ls[4 * a + 3]);
                    auto rr = __builtin_amdgcn_permlane32_swap(__float_as_uint(gsv), __float_as_uint(gsv), false, false);
                    ghi[a] = __uint_as_float(rr[1]); gsum[a] = __uint_as_float(rr[0]) + ghi[a]; }
                float run = 0.f;
#pragma unroll
                for (int a = 3; a >= 0; --a) { after[a] = run; run += gsum[a]; }
#pragma unroll
                for (int a = 0; a < 4; ++a) {
                    float suf = Lc + after[a] + (hh == 0 ? ghi[a] : 0.f);
#pragma unroll
                    for (int q = 3; q >= 0; --q) {
                        const int r = 4 * a + q, key = k0 + 32 * kb + q + 8 * a + 4 * hh;
                        const float w = (key < tq) ? fexp2((sa[r] + suf) * L2E) : 0.f;
                        suf += ls[r];
                        sa[r] = w;
                    }
                }
                Lc += run;
                pv_step(o, vb + 4096u * (unsigned)(2 * kb), TA, pack8(sa, 0));
                pv_step(o, vb + 4096u * (unsigned)(2 * kb + 1), TA, pack8(sa, 1));
            }
            wdone = __all(Lc < -SB_THR);
            if (lane == 0) FL[wave] = wdone ? 1 : 0;
        }
        if (jt == 0) break;
        asm volatile("s_waitcnt vmcnt(0)" ::: "memory");
        __syncthreads();
        --jt; buf ^= 1;
    }
    bf16_t* mrow = (bf16_t*)(p->ws + WS_MIX) + (size_t)(b * SEQ + tq) * DM + MIX_SB + h * 128;
#pragma unroll
    for (int c = 0; c < 4; ++c)
#pragma unroll
        for (int a = 0; a < 4; ++a) { u32x2 w; w.x = cvt_pk(o[c][4 * a], o[c][4 * a + 1]); w.y = cvt_pk(o[c][4 * a + 2], o[c][4 * a + 3]); *(u32x2*)(mrow + 32 * c + 8 * a + 4 * hh) = w; }
}

__device__ __forceinline__ void ret_state_task(KP p, int task, LAS unsigned char* lds, int tid, unsigned* rsflag) {
    asm volatile("" : "+v"(tid), "+s"(p));
    const int lane = tid & 63, wave = __builtin_amdgcn_readfirstlane(tid >> 6), hh = lane >> 5;
    const int eh = task & 1, bh = task >> 1, b = bh >> 3, h = bh & 7;
    const bf16_t* KR = (const bf16_t*)(p->ws + WS_KR) + (size_t)bh * SEQ * 128;
    const bf16_t* V = (const bf16_t*)(p->ws + WS_PROJ) + (size_t)b * SEQ * NINP + C_RV + h * 128;
    bf16_t* ST = (bf16_t*)(p->ws + WS_ST) + (size_t)bh * 32 * 128 * 128;
    const int eb = wave >> 2, db = wave & 3;
    const float gC = exp2f(128.0f * log2f(1.0f - exp2f(-5.0f - (float)h)));
    f32x16 acc;
#pragma unroll
    for (int i = 0; i < 16; ++i) acc[i] = 0.f;
#define RS_ISSUE(c_, nb_) do { _Pragma("unroll") for (int rr = 0; rr < 2; ++rr) { tile_dma64((nb_) + rr * 16384, KR + ((size_t)(c_) * 128 + rr * 64) * 128, 128, tid, wave); \
        tile_dma64((nb_) + 32768 + rr * 16384, V + ((size_t)(c_) * 128 + rr * 64) * NINP, NINP, tid, wave); } } while (0)
    __syncthreads();
    RS_ISSUE(0, lds);
    for (int c = 0; c < 32; ++c) {
        {
            bf16_t* dst = ST + (size_t)c * 128 * 128 + 32 * db + (lane & 31);
#pragma unroll
            for (int r = 0; r < 16; ++r) { const int e = 64 * eh + 32 * eb + (r & 3) + 8 * (r >> 2) + 4 * hh; dst[(size_t)e * 128] = f2bf(acc[r]); }
        }
        if (c == 31) break;
        asm volatile("s_waitcnt vmcnt(0)" ::: "memory");
        __syncthreads();
        if (c + 1 < 31) { LAS unsigned char* nb = lds + ((c + 1) & 1) * 65536; RS_ISSUE(c + 1, nb); }
        const LAS unsigned char* KT = lds + (c & 1) * 65536; const LAS unsigned char* VT = KT + 32768;
#pragma unroll
        for (int ks = 0; ks < 8; ++ks) {
            const unsigned ov0 = tr_off_nat(lane, 2 * eh + eb, ks, 0), ov1 = tr_off_nat(lane, 2 * eh + eb, ks, 1), ok0 = tr_off_nat(lane, db, ks, 0), ok1 = tr_off_nat(lane, db, ks, 1);
            s16x4 v0, v1, k0, k1;
            asm volatile("ds_read_b64_tr_b16 %0, %4\n\tds_read_b64_tr_b16 %1, %5\n\tds_read_b64_tr_b16 %2, %6\n\tds_read_b64_tr_b16 %3, %7\n\ts_waitcnt lgkmcnt(0)"
                         : "=&v"(v0), "=&v"(v1), "=&v"(k0), "=&v"(k1) : "v"(lds_addr(VT) + ov0), "v"(lds_addr(VT) + ov1), "v"(lds_addr(KT) + ok0), "v"(lds_addr(KT) + ok1) : "memory");
            acc = __builtin_amdgcn_mfma_f32_32x32x16_bf16(__builtin_shufflevector(v0, v1, 0, 1, 2, 3, 4, 5, 6, 7), __builtin_shufflevector(k0, k1, 0, 1, 2, 3, 4, 5, 6, 7), acc, 0, 0, 0);
        }
#pragma unroll
        for (int i = 0; i < 16; ++i) acc[i] *= gC;
    }
#undef RS_ISSUE
    asm volatile("s_waitcnt vmcnt(0)" ::: "memory");
    __syncthreads();
    if (tid == 0) { __builtin_amdgcn_fence(__ATOMIC_RELEASE, "agent"); asm volatile("s_waitcnt vmcnt(0)" ::: "memory"); __hip_atomic_fetch_add(rsflag + 64 * bh, 1u, __ATOMIC_RELAXED, __HIP_MEMORY_SCOPE_AGENT); }
}

__device__ __forceinline__ void ret_out_task(KP p, int task, LAS unsigned char* lds, int tid, unsigned* rsflag) {
    asm volatile("" : "+v"(tid), "+s"(p));
    const int lane = tid & 63, wave = __builtin_amdgcn_readfirstlane(tid >> 6), hh = lane >> 5;
    const int bh = task >> 4, cp = task & 15, b = bh >> 3, h = bh & 7;
    const int cw = wave >> 2, ib = wave & 3, c = 2 * cp + cw, s = 128 * c + 32 * ib + (lane & 31);
    const bf16_t* PROJ = (const bf16_t*)(p->ws + WS_PROJ);
    const bf16_t* KR = (const bf16_t*)(p->ws + WS_KR) + (size_t)bh * SEQ * 128;
    const bf16_t* V = PROJ + (size_t)b * SEQ * NINP + C_RV + h * 128;
    const bf16_t* ST = (const bf16_t*)(p->ws + WS_ST) + (size_t)bh * 32 * 128 * 128;
#define RET_ISSUE(st_, nb_) do { _Pragma("unroll") for (int cwi = 0; cwi < 2; ++cwi) { const size_t cc_ = (size_t)(2 * cp + cwi); \
        if ((st_) < 2) { const size_t krow = cc_ * 128 + (st_) * 64; tile_dma64((nb_) + cwi * 32768, KR + krow * 128, 128, tid, wave); tile_dma64((nb_) + cwi * 32768 + 16384, V + krow * NINP, NINP, tid, wave); } \
        else tile_dma64((nb_) + cwi * 32768, ST + (cc_ * 128 + ((st_) - 2) * 64) * 128, 128, tid, wave); } } while (0)
    RET_ISSUE(0, lds);
    bf16x8 qf[8];
    {
        LAS unsigned char* W = lds + 65536 + wave * 8192;
        const int sb0 = 128 * c + 32 * ib, ch = lane & 15, r0 = lane >> 4, row = lane & 31;
        const unsigned char* qsrc = (const unsigned char*)(PROJ + (size_t)(b * SEQ + sb0) * NINP + C_RQ + h * 128) + 16 * ch;
        const unsigned char* csrc = (const unsigned char*)((const float*)(p->ws + WS_TAB_RC) + sb0 * 64) + 16 * ch;
        const unsigned char* ssrc = (const unsigned char*)((const float*)(p->ws + WS_TAB_RS) + sb0 * 64) + 16 * ch;
        u32x4 vq[8], vc[8], vs[8];
#pragma unroll
        for (int i = 0; i < 8; ++i) { vq[i] = *(const u32x4*)(qsrc + (size_t)(r0 + 4 * i) * (NINP * 2)); vc[i] = *(const u32x4*)(csrc + (size_t)(r0 + 4 * i) * 256); vs[i] = *(const u32x4*)(ssrc + (size_t)(r0 + 4 * i) * 256); }
        const float dq = fexp2((float)((s & 127) + 1) * log2f(1.0f - exp2f(-5.0f - (float)h)));
        u32x4 xq[8]; f32x4 cf[8], sf[8];
#pragma unroll
        for (int i = 0; i < 8; ++i) *(LAS u32x4*)(W + off_b((unsigned)(r0 + 4 * i), (unsigned)ch)) = vq[i];
        asm volatile("s_waitcnt lgkmcnt(0)" ::: "memory");
#pragma unroll
        for (int s8 = 0; s8 < 8; ++s8) xq[s8] = *(const LAS u32x4*)(W + off_b((unsigned)row, (unsigned)(2 * s8 + hh)));
        asm volatile("s_waitcnt lgkmcnt(0)" ::: "memory");
#pragma unroll
        for (int i = 0; i < 8; ++i) *(LAS u32x4*)(W + off_b((unsigned)(r0 + 4 * i), (unsigned)ch)) = vc[i];
        asm volatile("s_waitcnt lgkmcnt(0)" ::: "memory");
#pragma unroll
        for (int s8 = 0; s8 < 4; ++s8) { cf[2 * s8] = *(const LAS f32x4*)(W + off_b((unsigned)row, (unsigned)(4 * s8 + 2 * hh))); cf[2 * s8 + 1] = *(const LAS f32x4*)(W + off_b((unsigned)row, (unsigned)(4 * s8 + 2 * hh + 1))); }
        asm volatile("s_waitcnt lgkmcnt(0)" ::: "memory");
#pragma unroll
        for (int i = 0; i < 8; ++i) *(LAS u32x4*)(W + off_b((unsigned)(r0 + 4 * i), (unsigned)ch)) = vs[i];
        asm volatile("s_waitcnt lgkmcnt(0)" ::: "memory");
#pragma unroll
        for (int s8 = 0; s8 < 4; ++s8) { sf[2 * s8] = *(const LAS f32x4*)(W + off_b((unsigned)row, (unsigned)(4 * s8 + 2 * hh))); sf[2 * s8 + 1] = *(const LAS f32x4*)(W + off_b((unsigned)row, (unsigned)(4 * s8 + 2 * hh + 1))); }
        asm volatile("s_waitcnt lgkmcnt(0)" ::: "memory");
#pragma unroll
        for (int s8 = 0; s8 < 4; ++s8) {
            float x1[8], x2[8], o1[8], o2[8];
            unpack8(xq[s8], x1); unpack8(xq[s8 + 4], x2);
#pragma unroll
            for (int j = 0; j < 8; ++j) { const float cj = cf[2 * s8 + (j >> 2)][j & 3], sj = sf[2 * s8 + (j >> 2)][j & 3]; o1[j] = (x1[j] * cj - x2[j] * sj) * dq; o2[j] = (x2[j] * cj + x1[j] * sj) * dq; }
            qf[s8] = __builtin_bit_cast(bf16x8, pack8f(o1)); qf[s8 + 4] = __builtin_bit_cast(bf16x8, pack8f(o2));
        }
    }
    TrAcc TA; tr_acc_init(TA, lane);
    f32x16 o[4]; zero_o(o);
    if (tid == 0) {
        unsigned spins = 0;
        while (__hip_atomic_load(rsflag + 64 * bh, __ATOMIC_RELAXED, __HIP_MEMORY_SCOPE_AGENT) < 2u && ++spins < (1u << 24)) __builtin_amdgcn_s_sleep(8);
        __builtin_amdgcn_fence(__ATOMIC_ACQUIRE, "agent");
        asm volatile("s_waitcnt vmcnt(0)" ::: "memory");
    }
    const size_t tok = (size_t)(b * SEQ + s);
    u32x2 gvr[4][4];
    {
        const bf16_t* grow = PROJ + tok * NINP + C_RG + h * 128;
#pragma unroll
        for (int cc = 0; cc < 4; ++cc)
#pragma unroll
            for (int a = 0; a < 4; ++a) gvr[cc][a] = *(const u32x2*)(grow + 32 * cc + 8 * a + 4 * hh);
    }
    asm volatile("s_waitcnt vmcnt(0)" ::: "memory");
    __syncthreads();
#pragma unroll
    for (int st = 0; st < 4; ++st) {
        if (st + 1 < 4) { LAS unsigned char* nb = lds + ((st + 1) & 1) * 65536; RET_ISSUE(st + 1, nb); }
        const LAS unsigned char* KT = lds + (st & 1) * 65536 + cw * 32768; const LAS unsigned char* VT = KT + 16384;
        if (st < 2) {
#pragma unroll
            for (int kb = 0; kb < 2; ++kb) {
                const int jb = 2 * st + kb;
                if (jb <= ib) {
                    f32x16 sa = qk_block(KT, kb, qf, lane);
                    if (jb == ib) {
#pragma unroll
                        for (int r = 0; r < 16; ++r) { const int kl = (r & 3) + 8 * (r >> 2) + 4 * hh; if (kl > (lane & 31)) sa[r] = 0.f; }
                    }
                    const unsigned vb = lds_addr(VT);
                    pv_step(o, vb + 4096u * (unsigned)(2 * kb), TA, pack8(sa, 0));
                    pv_step(o, vb + 4096u * (unsigned)(2 * kb + 1), TA, pack8(sa, 1));
                }
            }
        } else {
#pragma unroll
            for (int eb = 0; eb < 2; ++eb)
#pragma unroll
                for (int k = 0; k < 8; ++k) o[2 * (st - 2) + eb] = __builtin_amdgcn_mfma_f32_32x32x16_bf16(row_frag(KT, 32 * eb, k, lane), qf[k], o[2 * (st - 2) + eb], 0, 0, 0);
        }
        if (st + 1 < 4) { asm volatile("s_waitcnt vmcnt(0)" ::: "memory"); __syncthreads(); }
    }
#undef RET_ISSUE
    float ss = 0.f;
#pragma unroll
    for (int cc = 0; cc < 4; ++cc)
#pragma unroll
        for (int r = 0; r < 16; ++r) ss += o[cc][r] * o[cc][r];
    ss = half_sum(ss);
    const float rn = 1.0f / sqrtf(ss * (1.0f / 128.0f) + 1e-6f);
    bf16_t* mrow = (bf16_t*)(p->ws + WS_MIX) + tok * DM + MIX_RET + h * 128;
#ifndef REPS_RETEPI
#define REPS_RETEPI 1
#endif
    for (int rr = 0; rr < REPS_RETEPI; ++rr)
#pragma unroll
    for (int cc = 0; cc < 4; ++cc)
#pragma unroll
        for (int a = 0; a < 4; ++a) {
            const u32x2 gv = gvr[cc][a];
            const float g0 = bflo(gv.x), g1 = bfhi(gv.x), g2 = bflo(gv.y), g3 = bfhi(gv.y);
            u32x2 w; w.x = cvt_pk(o[cc][4 * a] * rn * g0 * sigmoidf_(g0), o[cc][4 * a + 1] * rn * g1 * sigmoidf_(g1));
            w.y = cvt_pk(o[cc][4 * a + 2] * rn * g2 * sigmoidf_(g2), o[cc][4 * a + 3] * rn * g3 * sigmoidf_(g3));
            *(u32x2*)(mrow + 32 * cc + 8 * a + 4 * hh) = w;
        }
}

#ifndef HP_SP2
#define HP_SP2 true
#endif
#ifndef HP_ALIGN
#define HP_ALIGN true
#endif
#ifndef REPS_CMP
#define REPS_CMP 1
#endif
#ifndef REPS_C1
#define REPS_C1 1
#endif
#ifndef REPS_RS
#define REPS_RS 1
#endif
#ifndef REPS_NSA
#define REPS_NSA 1
#endif
#ifndef REPS_SB
#define REPS_SB 1
#endif
#ifndef REPS_C3
#define REPS_C3 1
#endif
#ifndef REPS_PE
#define REPS_PE 1
#endif
#ifndef REP_CONV
#define REP_CONV 1
#endif
#ifndef REP_GIN
#define REP_GIN 1
#endif
#ifndef REPS_RO
#define REPS_RO 1
#endif
#ifndef REP_PREP
#define REP_PREP 1
#endif
#ifndef REP_MIX1
#define REP_MIX1 1
#endif
#ifndef REP_MIX2
#define REP_MIX2 1
#endif
#ifndef REP_NORM2
#define REP_NORM2 1
#endif
#ifndef REP_GGU
#define REP_GGU 1
#endif
#ifndef REP_ACT
#define REP_ACT 1
#endif
#ifndef IN_MIDCONV
#define IN_MIDCONV 0
#endif
struct SegOrder {
    pg8::StaticOrder S; int i0, n;
    __device__ __forceinline__ bool next(int i, pg8::Unit& u) const { return i < n && S.next(i0 + i, u); }
    __device__ __forceinline__ void a_ready(const pg8::Unit&) const {}
    __device__ __forceinline__ void done(const pg8::Unit&) const {}
};
#ifndef IN_SKINNY
#define IN_SKINNY 0
#endif
#ifndef GU_TAIL_N
#define GU_TAIL_N 2016
#endif
#ifndef IN_TAIL_N
#define IN_TAIL_N 1024
#endif
#ifndef IN_TAIL_N0
#define IN_TAIL_N0 1024
#endif
static_assert(GU_TAIL_N <= 2016 && IN_TAIL_N0 >= 512 && (GU_TAIL_N > 1504 ? GU_TAIL_N : 1504) + IN_TAIL_N >= 2016, "conversion task placement");
enum { PH_CONV = 0, PH_GEMM_IN, PH_PREP, PH_MIX1, PH_MIX2, PH_GEMM_OUT, PH_GEMM_GU, PH_ACT, PH_GEMM_DN, N_PHASES };

__global__ void __launch_bounds__(NTHR, 2) hybrid_fwd(Params p_arg) {
    extern __shared__ __attribute__((aligned(16))) unsigned char lds_raw[];
    LAS unsigned char* lds = (LAS unsigned char*)lds_raw;
    const int wave0 = __builtin_amdgcn_readfirstlane(threadIdx.x >> 6), bid = blockIdx.x, G = gridDim.x;
#define TID0() (wave0 * 64 + lane_id_now())
    volatile LAS unsigned* CT = (volatile LAS unsigned*)(lds + LDS_STAGE);
    { const int t0_ = TID0(); if (t0_ < 8) CT[t0_] = 0u; }
    __syncthreads();
    const KP kp = (KP)__builtin_amdgcn_kernarg_segment_ptr();
    unsigned* ctl = (unsigned*)(kp->ws + WS_CTL);
    const int l_lo = kp->l_lo, l_hi = kp->l_hi, ph_lo = kp->ph_lo, ph_hi = kp->ph_hi;
    const bool multi = (l_hi - l_lo) > 1 || (ph_hi - ph_lo) > 1;
    XcdBarrier bar; bar.bar = ctl + CW_BAR; bar.x = 0; bar.st = CT;
    if (multi) bar = xcd_barrier_post(ctl + CW_BAR, CT);
    volatile LAS int* slot = (volatile LAS int*)(CT + 4);

#define PH_ON(k) (ph_lo <= (k) && (k) < ph_hi)
#define WSP(T, off) ((T*)(p->ws + (off)))
#ifndef REP_SEAM
#define REP_SEAM 1
#endif
#define SEAM() do { if (multi) for (int sr_ = 0; sr_ < REP_SEAM; ++sr_) xcd_barrier(bar); } while (0)
#define ARRIVE_ALL(ctr_, tid_) do { asm volatile("s_waitcnt vmcnt(0)" ::: "memory"); __syncthreads(); \
        if ((tid_) == 0) { __builtin_amdgcn_fence(__ATOMIC_RELEASE, "agent"); asm volatile("s_waitcnt vmcnt(0)" ::: "memory"); __hip_atomic_fetch_add((ctr_), 1u, __ATOMIC_RELAXED, __HIP_MEMORY_SCOPE_AGENT); } } while (0)
#define WAIT_ALL(ctr_, tid_) do { if ((tid_) == 0) { unsigned spins_ = 0; \
            while (__hip_atomic_load((ctr_), __ATOMIC_RELAXED, __HIP_MEMORY_SCOPE_AGENT) < (unsigned)G && ++spins_ < (1u << 24)) __builtin_amdgcn_s_sleep(8); \
            __builtin_amdgcn_fence(__ATOMIC_ACQUIRE, "agent"); asm volatile("s_waitcnt vmcnt(0)" ::: "memory"); } \
        __syncthreads(); } while (0)
#ifndef SPLIT_SEAMS
#define SPLIT_SEAMS 1
#endif
#define SEAM_FILL(i_, lo_, hi_, last_rep_) do { const int tid_s = TID0(); \
        if (multi && SPLIT_SEAMS && (last_rep_)) { ARRIVE_ALL(qctr + 448 + 16 * (i_), tid_s); convert_range(p, l, (lo_) + bid, (hi_), G, lds, tid_s); WAIT_ALL(qctr + 448 + 16 * (i_), tid_s); } \
        else { convert_range(p, l, (lo_) + bid, (hi_), G, lds, tid_s); SEAM(); } } while (0)
#ifndef DIS_TAB
    if (l_lo == 0 && PH_ON(PH_CONV)) ph_tables(kp, TID0(), bid, G);
#endif
    for (int l = l_lo; l < l_hi; ++l) {
        KP p = kp; asm volatile("" : "+s"(p));
        const int vis_lo = (l == 0) ? 1504 + IN_TAIL_N0 : (GU_TAIL_N > 1504 ? GU_TAIL_N : 1504) + IN_TAIL_N, vis_mid = (vis_lo + 4768) / 2;
        unsigned* qctr = ctl + CW_QUEUE + 1024 * l;
        if (PH_ON(PH_CONV)) for (int rep = 0; rep < REP_CONV; ++rep) {
            const int tid = TID0();
#ifndef DIS_CONV
            convert_range(p, l, ((l == 0) ? 0 : (GU_TAIL_N < 1504 ? GU_TAIL_N : 1504)) + bid, 1504, G, lds, tid);
            convert_small(p, l, tid, bid, G);
#endif
            if (l == 0) ph_xcvt(p->in[I_X], WSP(bf16_t, WS_HN), WSP(float, WS_RSS), tid, bid, G);
            SEAM();
        }
        if (PH_ON(PH_GEMM_IN)) for (int rep = 0; rep < REP_GIN; ++rep) {
            const int tid = TID0();
            constexpr int nin_g = IN_SKINNY ? C_NG : NINP;
            pg8::Gemm g{WSP(bf16_t, WS_HN), WSP(bf16_t, WS_WIN), MT, nin_g, DM}; pg8::StaticOrder S; S.init(MT, nin_g, G, bid);
            LAS float* rt = (LAS float*)(lds + LDS_STAGE + LDS_CTL);
            const int rbase = fill_rstd_table(S, WSP(float, WS_RSS), rt, tid);
            EpiBf16RS E{WSP(bf16_t, WS_PROJ), NINP, rt, rbase};
#if !defined(DIS_GEMM) && !defined(DIS_G1)
#if IN_MIDCONV
            {
                const int cut = 1 + (bid & 7);
                SegOrder Sa{S, 0, cut}, Sb{S, cut, 1 << 20};
                pg8::gemm_phase<EpiBf16RS, SegOrder, HP_ALIGN, HP_SP2>(lds, g, Sa, E, tid);
                convert_range(p, l, vis_lo + bid, 4768, G, lds, tid);
                __syncthreads();
                pg8::gemm_phase<EpiBf16RS, SegOrder, HP_ALIGN, HP_SP2>(lds, g, Sb, E, tid);
            }
#else
            pg8::gemm_phase<EpiBf16RS, pg8::StaticOrder, HP_ALIGN, HP_SP2>(lds, g, S, E, tid);
#endif
#endif
#ifndef DIS_CONV
            {
                const int nwg = (MT / 256) * (nin_g / 256), first_short = nwg - ((nwg + G - 1) / G - 1) * G;
                if (IN_SKINNY) {
                    int rp0, rstep;
                    if (G == 256) { const int j = bid >> 3, x = bid & 7; rp0 = bid >= 128 ? 2 * (8 * x + (j & 7)) + ((j >> 3) & 1) : 128; rstep = 128; }
                    else if (first_short < G) { rp0 = bid >= first_short ? bid - first_short : 128; rstep = G - first_short; }
                    else { rp0 = bid; rstep = G; }
                    for (int rp = rp0; rp < 128; rp += rstep) in_gate_cols(p, rp * 128, WSP(float, WS_RSS), lds, tid);
                }
                const int in_lo = (l == 0) ? 1504 : (GU_TAIL_N > 1504 ? GU_TAIL_N : 1504), in_hi = in_lo + ((l == 0) ? IN_TAIL_N0 : IN_TAIL_N);
                if (first_short < G && bid >= first_short) convert_range(p, l, in_lo + (bid - first_short), in_hi, G - first_short, lds, tid);
                else if (first_short >= G) convert_range(p, l, in_lo + bid, in_hi, G, lds, tid);
            }
#endif
#if IN_MIDCONV
            SEAM();
#else
            SEAM_FILL(1, vis_lo, vis_mid, rep + 1 == REP_GIN);
#endif
        }
        if (PH_ON(PH_PREP)) for (int rep = 0; rep < REP_PREP; ++rep) {
            unsigned* qc = qctr + 512 * rep;
            for (int r2 = 0; r2 < REPS_PE; ++r2) ph_prep_elem(p, l, TID0(), bid, G);
#ifndef DIS_CMP
            { const int tid = TID0();
            for (int r2 = 0; r2 < REPS_CMP; ++r2) for (;;) { const int t = next_task(qc + 512 * r2, slot, tid); if (t >= 32) break; cmp_task(p, l, t, lds, tid); }
            }
#endif
#ifndef DIS_C1
            { const int tid = TID0();
            for (int r2 = 0; r2 < REPS_C1; ++r2) for (;;) { const int t = next_task(qc + 64 + 512 * r2, slot, tid); if (t >= 512) break; lru_c1_task(p, l, t, lds, tid); }
            }
#endif
            const bool split_pm = multi && PH_ON(PH_MIX1) && rep + 1 == REP_PREP;
            if (split_pm) { const int tid = TID0(); ARRIVE_ALL(qctr + 448, tid); }
#ifndef DIS_SB
            { const int tid = TID0();
            for (int r2 = 0; r2 < REPS_SB; ++r2) for (;;) { const int t = next_task(qc + 256 + 512 * r2, slot, tid); if (t >= 512) break; sb_task(p, t, lds, tid); }
            }
#endif
            if (split_pm) { const int tid = TID0(); WAIT_ALL(qctr + 448, tid);
            } else SEAM();
        }
        if (PH_ON(PH_MIX1)) for (int rep = 0; rep < REP_MIX1; ++rep) {
            unsigned* qc = qctr + 512 * rep;
#ifndef DIS_RS
            { const int tid = TID0();
            for (int r2 = 0; r2 < REPS_RS; ++r2) for (;;) { const int t = next_task(qc + 128 + 512 * r2, slot, tid); if (t >= 64) break; ret_state_task(p, t, lds, tid, ctl + CW_RSFLAG + 2048 * l); }
            }
#endif
#ifndef DIS_NSA
            { const int tid = TID0();
            for (int r2 = 0; r2 < REPS_NSA; ++r2) for (;;) { const int t = next_task(qc + 192 + 512 * r2, slot, tid); if (t >= 512) break; nsa_task(p, l, t, lds, tid); }
            }
#endif
#ifndef DIS_RO
            { const int tid = TID0();
            for (int r2 = 0; r2 < REPS_RO; ++r2) for (;;) { const int t = next_task(qc + 384 + 512 * r2, slot, tid); if (t >= 512) break; ret_out_task(p, t, lds, tid, ctl + CW_RSFLAG + 2048 * l); }
            }
#endif
#ifndef DIS_C3
            { const int tid = TID0();
            for (int r2 = 0; r2 < REPS_C3; ++r2) for (;;) { const int t = next_task(qc + 320 + 512 * r2, slot, tid); if (t >= 512) break; lru_c3_task(p, t, lds, tid); }
            }
#endif
#if IN_MIDCONV
            SEAM();
#else
            SEAM_FILL(2, vis_mid, 4768, rep + 1 == REP_MIX1);
#endif
        }
        if (PH_ON(PH_GEMM_OUT)) {
            const int tid = TID0();
            pg8::Gemm g{WSP(bf16_t, WS_MIX), WSP(bf16_t, WS_WOUT), MT, DM, DM}; pg8::StaticOrder S; S.init(MT, DM, G, bid);
            EpiResid3 E{(l == 0) ? p->in[I_X] : nullptr, WSP(bf16_t, WS_HN), nullptr, WSP(float, WS_RSS) + (size_t)MT * 64};
#if !defined(DIS_GEMM) && !defined(DIS_G2)
#ifdef REP_GOUT
            for (int rp = 1; rp < REP_GOUT; ++rp) { EpiResid3 E2{(l == 0) ? p->in[I_X] : nullptr, WSP(bf16_t, WS_HN), WSP(float, WS_PROJ), WSP(float, WS_RSS) + (size_t)MT * 64, 1};
                pg8::gemm_phase<EpiResid3, pg8::StaticOrder, HP_ALIGN, HP_SP2>(lds, g, S, E2, tid); SEAM(); }
#endif
            pg8::gemm_phase<EpiResid3, pg8::StaticOrder, HP_ALIGN, HP_SP2>(lds, g, S, E, tid);
#endif
            SEAM_FILL(3, 4768, (l + 1 == NL) ? 4768 : 6144, true);
        }
        if (PH_ON(PH_GEMM_GU)) for (int rep = 0; rep < REP_GGU; ++rep) {
            const int tid = TID0();
            pg8::Gemm g{WSP(bf16_t, WS_HN), WSP(bf16_t, WS_WGU), MT, NGU, DM}; pg8::StaticOrder S; S.init(MT, NGU, G, bid);
            LAS float* rt = (LAS float*)(lds + LDS_STAGE + LDS_CTL);
            const int rbase = fill_rstd_table(S, WSP(float, WS_RSS) + (size_t)MT * 64, rt, tid);
            EpiGateUp E{WSP(bf16_t, WS_H), rt, rbase, p->in[I_MCW] + (size_t)l * 3 * DFF, p->in[I_MCB] + (size_t)l * DFF, WSP(bf16_t, WS_GT), WSP(bf16_t, WS_GH), WSP(bf16_t, WS_UH)};
#if !defined(DIS_GEMM) && !defined(DIS_G3)
            pg8::gemm_phase<EpiGateUp, pg8::StaticOrder, HP_ALIGN, HP_SP2>(lds, g, S, E, tid);
#endif
#ifndef DIS_CONV
            if (rep == 0) {
                const int nwg = (MT / 256) * (NGU / 256), first_short = nwg - ((nwg + G - 1) / G - 1) * G;
                const int ll = (l + 1 < NL) ? l + 1 : l, t_lo = (l + 1 < NL) ? 0 : 4768, t_hi = (l + 1 < NL) ? GU_TAIL_N : 6144;
                if (first_short < G && bid >= first_short) convert_range(p, ll, t_lo + bid - first_short, t_hi, G - first_short, lds, tid);
                else if (first_short >= G) convert_range(p, ll, t_lo + bid, t_hi, G, lds, tid);
            }
#endif
            SEAM();
        }
        if (PH_ON(PH_ACT)) for (int rep = 0; rep < REP_ACT; ++rep) {
            const int tid = TID0();
            ph_mlp_fix(p, l, tid, bid, G);
            SEAM();
        }
        if (PH_ON(PH_GEMM_DN)) {
            const int tid = TID0();
            pg8::Gemm g{WSP(bf16_t, WS_H), WSP(bf16_t, (l & 1) ? WS_WDN2 : WS_WDN), MT, DM, DFF}; pg8::StaticOrder S; S.init(MT, DM, G, bid);
            EpiResid3 E{nullptr, WSP(bf16_t, WS_HN), (l + 1 < NL) ? nullptr : p->out, WSP(float, WS_RSS)};
#if !defined(DIS_GEMM) && !defined(DIS_G4)
#ifdef REP_GDN
            for (int rp = 1; rp < REP_GDN; ++rp) { EpiResid3 E2{nullptr, WSP(bf16_t, WS_HN), WSP(float, WS_PROJ), WSP(float, WS_RSS), 1};
                pg8::gemm_phase<EpiResid3, pg8::StaticOrder, HP_ALIGN, HP_SP2>(lds, g, S, E2, tid); SEAM(); }
#endif
            pg8::gemm_phase<EpiResid3, pg8::StaticOrder, HP_ALIGN, HP_SP2>(lds, g, S, E, tid);
#endif
            if (l + 1 < l_hi && !(multi && PH_ON(PH_CONV) && REP_CONV == 1)) SEAM();
        }
    }
#undef PH_ON
#undef SEAM
#undef WSP
#undef TID0
}
}

#ifndef HP_N_LAUNCH_MODE
#define HP_N_LAUNCH_MODE 0
#endif
extern "C" void kernel_launch(void* const* d_in, const int* in_sizes, int n_in, void* d_out, int out_size, void* d_ws, size_t ws_size, hipStream_t stream) {
    using namespace hp;
    static int grid = 0;
    if (grid == 0) {
        if (n_in != N_INPUTS || out_size != MT * DM || ws_size < WS_END) { fprintf(stderr, "kernel_launch: unexpected problem (n_in %d, out %d, ws %zu, need %zu)\n", n_in, out_size, ws_size, (size_t)WS_END); grid = -1; return; }
        int dev = 0, cus = 0, per_cu = 0;
        if (hipGetDevice(&dev) != hipSuccess || hipDeviceGetAttribute(&cus, hipDeviceAttributeMultiprocessorCount, dev) != hipSuccess) { grid = -1; return; }
        if (hipFuncSetAttribute((const void*)hybrid_fwd, hipFuncAttributeMaxDynamicSharedMemorySize, LDS_BYTES) != hipSuccess) { fprintf(stderr, "kernel_launch: hipFuncSetAttribute failed\n"); grid = -1; return; }
        if (hipOccupancyMaxActiveBlocksPerMultiprocessor(&per_cu, (const void*)hybrid_fwd, NTHR, LDS_BYTES) != hipSuccess || per_cu < 1) { fprintf(stderr, "kernel_launch: occupancy query says %d\n", per_cu); (void)hipGetLastError(); per_cu = 1; }
        grid = cus;
    }
    if (grid < 0) return;
    (void)hipMemsetAsync((char*)d_ws + WS_CTL, 0, CTL_BYTES, stream);
    Params p{};
    for (int i = 0; i < N_INPUTS; ++i) p.in[i] = (const float*)d_in[i];
    p.out = (float*)d_out; p.ws = (unsigned char*)d_ws;
#if HP_N_LAUNCH_MODE == 0
    p.l_lo = 0; p.l_hi = NL; p.ph_lo = 0; p.ph_hi = N_PHASES;
    hipLaunchKernelGGL(hybrid_fwd, dim3(grid), dim3(NTHR), LDS_BYTES, stream, p);
#else
    for (int l = 0; l < NL; ++l)
        for (int ph = 0; ph < N_PHASES; ++ph) { p.l_lo = l; p.l_hi = l + 1; p.ph_lo = ph; p.ph_hi = ph + 1; hipLaunchKernelGGL(hybrid_fwd, dim3(grid), dim3(NTHR), LDS_BYTES, stream, p); }
#endif
}
```

```cpp
#include <hip/hip_runtime.h>
#include <stdint.h>
#include <stdio.h>
#define XB_TMO      128
#define XB_XCNT(j)  (256  + 64 * (j))
#define XB_XSUB(j)  (1280 + 64 * (j))
#define XB_XGEN(j)  (2304 + 64 * (j))
#define XB_TOP      3328
#define XB_TOPGEN   3392
#define XCD_BAR_WORDS 3456
#define XB_SPIN_CAP (1u << 22)
#define LAS __attribute__((address_space(3)))

__device__ __forceinline__ unsigned xb_ld(unsigned* p)              { return __hip_atomic_load(p, __ATOMIC_RELAXED, __HIP_MEMORY_SCOPE_AGENT); }
__device__ __forceinline__ unsigned xb_add(unsigned* p, unsigned v) { return __hip_atomic_fetch_add(p, v, __ATOMIC_RELAXED, __HIP_MEMORY_SCOPE_AGENT); }
__device__ __forceinline__ unsigned xb_xcc_id() { return (unsigned)__builtin_amdgcn_s_getreg((3 << 11) | 20) & 0xFu; }
#define XB_SPIN(cond, bar) do { unsigned _sp = 0; while (cond) { __builtin_amdgcn_s_sleep(1); \
    if ((++_sp & 255u) == 0u) { if (xb_ld(&(bar)[XB_TMO])) break; if (_sp > XB_SPIN_CAP) { atomicAdd(&(bar)[XB_TMO], 1u); break; } } } } while (0)

struct XcdBarrier {
    unsigned* bar; unsigned x;
    volatile LAS unsigned* st;
};

__device__ __forceinline__ XcdBarrier xcd_barrier_post(unsigned* bar, volatile LAS unsigned* st) {
    XcdBarrier b; b.bar = bar; b.x = xb_xcc_id(); b.st = st;
    if (threadIdx.x == 0) (void)xb_add(&bar[XB_XCNT(b.x)], 1u);
    return b;
}
__device__ __forceinline__ void xcd_barrier_complete(unsigned* bar, unsigned x, unsigned& nloc, unsigned& nx) {
    const unsigned G = gridDim.x * gridDim.y * gridDim.z;
    unsigned sum, cnt, mine, sp = 0u;
    for (;;) {
        sum = 0u; cnt = 0u; mine = 0u;
#pragma unroll
        for (unsigned j = 0; j < 16; ++j) { const unsigned c = xb_ld(&bar[XB_XCNT(j)]); sum += c; cnt += (c > 0u) ? 1u : 0u; mine = (j == x) ? c : mine; }
        if (sum == G) break;
        __builtin_amdgcn_s_sleep(1);
        if ((++sp & 255u) == 0u) { if (xb_ld(&bar[XB_TMO])) break; if (sp > XB_SPIN_CAP) { atomicAdd(&bar[XB_TMO], 1u); break; } }
    }
    nloc = mine > 0u ? mine : 1u; nx = cnt > 0u ? cnt : 1u;
}

__device__ __forceinline__ void xcd_barrier(const XcdBarrier& b) {
    asm volatile("s_waitcnt vmcnt(0)" ::: "memory");
    __syncthreads();
    if (threadIdx.x == 0) {
        unsigned* bar = b.bar;
        __builtin_amdgcn_s_waitcnt(0);
        unsigned nloc = b.st[0], nx = b.st[1];
        if (nloc == 0u) { xcd_barrier_complete(bar, b.x, nloc, nx); b.st[0] = nloc; b.st[1] = nx; }
        const unsigned old = xb_add(&bar[XB_XSUB(b.x)], 1u);
        const unsigned gen = old / nloc;
        if (old + 1u == (gen + 1u) * nloc) {
            __builtin_amdgcn_fence(__ATOMIC_RELEASE, "agent");
            asm volatile("s_waitcnt vmcnt(0)" ::: "memory");
            const unsigned og = xb_add(&bar[XB_TOP], 1u);
            const unsigned tg = og / nx;
            if (og + 1u == (tg + 1u) * nx) xb_add(&bar[XB_TOPGEN], 1u);
            else XB_SPIN(xb_ld(&bar[XB_TOPGEN]) == tg, bar);
            __builtin_amdgcn_fence(__ATOMIC_ACQUIRE, "agent");
            xb_add(&bar[XB_XGEN(b.x)], 1u);
            asm volatile("s_waitcnt vmcnt(0)" ::: "memory");
        } else {
            XB_SPIN(xb_ld(&bar[XB_XGEN(b.x)]) == gen, bar);
            __builtin_amdgcn_fence(__ATOMIC_ACQUIRE, "agent");
            asm volatile("s_waitcnt vmcnt(0)" ::: "memory");
        }
    }
    __syncthreads();
}
#ifndef PG8_WGM
#define PG8_WGM 8
#endif
namespace pg8 {
#define PG8_LAS __attribute__((address_space(3)))
typedef unsigned short bf16_t;
typedef short bf16x8 __attribute__((ext_vector_type(8)));
typedef float f32x4 __attribute__((ext_vector_type(4)));
typedef unsigned u32x4 __attribute__((ext_vector_type(4)));
constexpr int BM = 256, BK = 64, HALF = 128, HTB = HALF * BK * 2  , STAGE_BYTES = 8 * HTB, NXCD = 8, WGM = PG8_WGM;

__host__ __device__ __forceinline__ int lds_byte(int r, int c) { const int st = (r >> 4) * 2 + (c >> 5), rr = r & 15, cc = c & 31, ob = rr * 64 + cc * 2; return st * 1024 + (ob ^ (((ob >> 9) & 1) << 5)); }
__host__ __device__ __forceinline__ void stage_rc(int b, int& R, int& C) { const int st = b / 1024, sb = b % 1024, swz = sb ^ (((sb >> 9) & 1) << 5); R = (st >> 1) * 16 + swz / 64; C = (st & 1) * 32 + (swz % 64) / 2; }
__host__ __device__ __forceinline__ int perm32(int rho) { const int n = rho >> 4, i = rho & 15; return 8 * (i >> 2) + 4 * n + (i & 3); }

struct Unit { int pm, pn; };
struct Gemm { const bf16_t* A; const bf16_t* Bt; int M, N, K; };

struct StaticOrder {
    int nM, nN, nwg, G, c;
    __host__ __device__ void init(int M, int N, int G_, int c_) { nM = M / BM; nN = N / BM; nwg = nM * nN; G = G_; c = c_; }
    __host__ __device__ bool next(int i, Unit& u) const {
        const long L = (long)i * G + c; if (L >= nwg) return false;
        int wgid = (int)L; { const int q = nwg / NXCD, r = nwg % NXCD, xcd = wgid % NXCD, off = wgid / NXCD; wgid = (xcd < r ? xcd * (q + 1) : r * (q + 1) + (xcd - r) * q) + off; }
        const int nig = WGM * nN, gid = wgid / nig, fm = gid * WGM, gsz = (nM - fm) < WGM ? (nM - fm) : WGM;
        u.pm = fm + ((wgid % nig) % gsz); u.pn = (wgid % nig) / gsz; return true;
    }
    __device__ __forceinline__ void a_ready(const Unit&) const {}
    __device__ __forceinline__ void done(const Unit&) const {}
};

__device__ __forceinline__ unsigned cvt_pk_bf16(float lo, float hi) { unsigned r; asm volatile("v_cvt_pk_bf16_f32 %0, %1, %2" : "=v"(r) : "v"(lo), "v"(hi)); return r; }
typedef float f32x2 __attribute__((ext_vector_type(2)));
__device__ __forceinline__ f32x2 gelu_pk(f32x2 v) {
    const f32x2 av = __builtin_elementwise_abs(v), d = av * 0.2316418882f + 1.0f;
    f32x2 t; t.x = __builtin_amdgcn_rcpf(d.x); t.y = __builtin_amdgcn_rcpf(d.y);
    f32x2 q = t * 0.5307027145f + (-0.7265760135f); q = q * t + 0.7107068705f; q = q * t + (-0.142248368f); q = q * t + 0.127414796f; q = q * t;
    const f32x2 s = (v * v) * (-0.72134752044f);
    f32x2 e; e.x = __builtin_amdgcn_exp2f(s.x); e.y = __builtin_amdgcn_exp2f(s.y);
    const f32x2 m = v * (q * e), r = v - m;
    f32x2 o; o.x = v.x < 0.f ? m.x : r.x; o.y = v.y < 0.f ? m.y : r.y; return o;
}

template <int ACT  > struct EpiBf16 {
    static constexpr bool PERM = true, AFTER_DRAIN = false; static_assert(ACT == 0 || ACT == 1, "EpiBf16: ACT is 0 (none) or 1 (gelu_pk)");
    bf16_t* O; int ldc; const float* bias; int split_cols; size_t split_stride; float scale0;
    __device__ __forceinline__ void operator()(const f32x4 (&acc)[2][2][4][2], const Unit& u, int wr, int wc, int fr, int fq) const {
        const int row0 = u.pm * BM + wr * 64 + fr; int colt = u.pn * BM; bf16_t* base = O;
        float sc = 1.f; if (split_cols) { const int t = colt / split_cols; base += (size_t)t * split_stride; colt -= t * split_cols; if (t == 0) sc = scale0; }
        const int col0 = colt + wc * 32 + 8 * fq, bcol0 = u.pn * BM + wc * 32 + 8 * fq;
        f32x4 bv[2][2];
#pragma unroll
        for (int bj = 0; bj < 2; ++bj)
#pragma unroll
            for (int n = 0; n < 2; ++n) bv[bj][n] = bias ? *(const f32x4*)(bias + bcol0 + bj * HALF + 4 * n) : (f32x4){0.f, 0.f, 0.f, 0.f};
#pragma unroll
        for (int ai = 0; ai < 2; ++ai)
#pragma unroll
            for (int m = 0; m < 4; ++m) { bf16_t* rowp = base + (size_t)(row0 + ai * HALF + m * 16) * ldc + col0;
#pragma unroll
                for (int bj = 0; bj < 2; ++bj) { f32x4 v0 = acc[ai][bj][m][0] + bv[bj][0], v1 = acc[ai][bj][m][1] + bv[bj][1];
                    if (ACT == 1) { f32x2 a = gelu_pk((f32x2){v0[0], v0[1]}), b = gelu_pk((f32x2){v0[2], v0[3]}), c = gelu_pk((f32x2){v1[0], v1[1]}), d = gelu_pk((f32x2){v1[2], v1[3]});
                        v0 = (f32x4){a.x, a.y, b.x, b.y}; v1 = (f32x4){c.x, c.y, d.x, d.y}; }
                    v0 = v0 * sc; v1 = v1 * sc; u32x4 w; w.x = cvt_pk_bf16(v0[0], v0[1]); w.y = cvt_pk_bf16(v0[2], v0[3]); w.z = cvt_pk_bf16(v1[0], v1[1]); w.w = cvt_pk_bf16(v1[2], v1[3]);
                    *(u32x4*)(rowp + bj * HALF) = w; } }
    }
};

struct PanelStats {
    unsigned* xbuf;
    unsigned* cnt;
    unsigned* tmo;
    int ntn; float eps;
    unsigned code;
    __device__ __forceinline__ bool run(const f32x4 (&v)[2][2][4][2], const Unit& u, int wr, int wc, int fr, int fq, PG8_LAS unsigned char* lds, int wid, int lane) const {
        typedef float f32x2v __attribute__((ext_vector_type(2)));
        PG8_LAS f32x2v* P = (PG8_LAS f32x2v*)lds;
        PG8_LAS f32x2v* S = (PG8_LAS f32x2v*)(lds + 8192);
        PG8_LAS unsigned* flag = (PG8_LAS unsigned*)(lds + 8192 + 2048);
#pragma unroll
        for (int ai = 0; ai < 2; ++ai)
#pragma unroll
            for (int m = 0; m < 4; ++m) {
                float s = 0.f;
#pragma unroll
                for (int bj = 0; bj < 2; ++bj)
#pragma unroll
                    for (int n = 0; n < 2; ++n) { const f32x4 x = v[ai][bj][m][n]; s += (x[0] + x[1]) + (x[2] + x[3]); }
                s += __shfl_xor(s, 16); s += __shfl_xor(s, 32);
                const float mw = s * (1.0f / 64.0f); float q = 0.f;
#pragma unroll
                for (int bj = 0; bj < 2; ++bj)
#pragma unroll
                    for (int n = 0; n < 2; ++n) { const f32x4 d = v[ai][bj][m][n] - mw; q += (d[0] * d[0] + d[1] * d[1]) + (d[2] * d[2] + d[3] * d[3]); }
                q += __shfl_xor(q, 16); q += __shfl_xor(q, 32);
                if (fq == 0) P[(ai * HALF + wr * 64 + m * 16 + fr) * 4 + wc] = (f32x2v){mw, q};
            }
        asm volatile("s_waitcnt lgkmcnt(0)" ::: "memory"); __builtin_amdgcn_s_barrier(); asm volatile("" ::: "memory");
#if defined(BROKEN_EXCHANGE_NO_WAIT)
#warning BROKEN CONTROL BUILD: the row-statistics exchange does not wait; results are wrong by design
        if (blockIdx.x >= 64) { const long long t0_ = clock64(); while (clock64() - t0_ < 60000) __builtin_amdgcn_s_sleep(8); }
#endif
        const int row = wid * 32 + (lane & 31);
        if (lane < 32) {
            const f32x2v a = P[row * 4 + 0], b = P[row * 4 + 1], c = P[row * 4 + 2], d = P[row * 4 + 3];
            const float mt = (a.x + b.x + c.x + d.x) * 0.25f;
            const float da = a.x - mt, db = b.x - mt, dc = c.x - mt, dd = d.x - mt;
            const float m2 = (a.y + b.y) + (c.y + d.y) + 64.0f * ((da * da + db * db) + (dc * dc + dd * dd));
            unsigned long long* slot = (unsigned long long*)xbuf + ((size_t)(u.pm * BM + row) * 4 + u.pn);
            __hip_atomic_store(slot, ((unsigned long long)__float_as_uint(m2) << 32) | __float_as_uint(mt), __ATOMIC_RELAXED, __HIP_MEMORY_SCOPE_AGENT);
        }
        asm volatile("s_waitcnt vmcnt(0)" ::: "memory");
        if (lane == 0) __hip_atomic_fetch_add(cnt + 64 * u.pm, 1u, __ATOMIC_RELAXED, __HIP_MEMORY_SCOPE_AGENT);
        if (wid == 0) {
            bool dead = false; const unsigned long long t0 = __builtin_amdgcn_s_memrealtime(); const unsigned want = 8u * (unsigned)ntn;
            for (;;) {
#if defined(BROKEN_EXCHANGE_NO_WAIT)
                break;
#endif
                if ((unsigned)__builtin_amdgcn_readfirstlane(__hip_atomic_load(cnt + 64 * u.pm, __ATOMIC_RELAXED, __HIP_MEMORY_SCOPE_AGENT)) >= want) break;
                if (__builtin_amdgcn_s_memrealtime() - t0 > 2000000ull) {
                    if (lane == 0) { unsigned expect = 0u; __hip_atomic_compare_exchange_strong(tmo + 1, &expect, code | (unsigned)(u.pm & 0xff), __ATOMIC_RELAXED, __ATOMIC_RELAXED, __HIP_MEMORY_SCOPE_AGENT);
                                     __hip_atomic_store(tmo, 1u, __ATOMIC_RELAXED, __HIP_MEMORY_SCOPE_AGENT); }
                    dead = true; break; }
                __builtin_amdgcn_s_sleep(2);
            }
            __builtin_amdgcn_fence(__ATOMIC_ACQUIRE, "agent");
            if (lane == 0) flag[0] = dead ? 1u : 0u;
        }
        asm volatile("s_waitcnt vmcnt(0) lgkmcnt(0)" ::: "memory"); __builtin_amdgcn_s_barrier(); asm volatile("" ::: "memory");
        const bool bad = flag[0] != 0u;
        if (lane < 32) {
            const unsigned long long* slot = (const unsigned long long*)xbuf + (size_t)(u.pm * BM + row) * 4; float mt[4], m2[4]; float ms = 0.f;
#pragma unroll
            for (int t = 0; t < 4; ++t) { if (t < ntn) { const unsigned long long w = __hip_atomic_load(slot + t, __ATOMIC_RELAXED, __HIP_MEMORY_SCOPE_AGENT); mt[t] = __uint_as_float((unsigned)w); m2[t] = __uint_as_float((unsigned)(w >> 32)); } else { mt[t] = 0.f; m2[t] = 0.f; } ms += mt[t]; }
            const float mean = ms / (float)ntn; float q = 0.f;
#pragma unroll
            for (int t = 0; t < 4; ++t) if (t < ntn) { const float dm = mt[t] - mean; q += m2[t] + 256.0f * dm * dm; }
            S[row] = (f32x2v){mean, 1.0f / sqrtf(q / (256.0f * (float)ntn) + eps)};
        }
        asm volatile("s_waitcnt lgkmcnt(0)" ::: "memory"); __builtin_amdgcn_s_barrier(); asm volatile("" ::: "memory");
        return bad;
    }
};
struct EpiLnRes {
    static constexpr bool PERM = false, AFTER_DRAIN = true;
    const float* base; float* out; int ldc; const float* bias; PanelStats st; unsigned poison;
    __device__ __forceinline__ void fused(f32x4 (&acc)[2][2][4][2], const Unit& u, int wr, int wc, int fr, int fq, PG8_LAS unsigned char* lds, int wid, int lane) const {
        typedef float f32x2v __attribute__((ext_vector_type(2)));
        const PG8_LAS f32x2v* S = (const PG8_LAS f32x2v*)(lds + 8192);
        const int col0 = u.pn * BM + wc * 32 + 4 * fq;
#pragma unroll
        for (int bj = 0; bj < 2; ++bj)
#pragma unroll
            for (int n = 0; n < 2; ++n) { const f32x4 bv = bias ? *(const f32x4*)(bias + col0 + bj * HALF + n * 16) : (f32x4){0.f, 0.f, 0.f, 0.f};
#pragma unroll
                for (int ai = 0; ai < 2; ++ai)
#pragma unroll
                    for (int m = 0; m < 4; ++m) acc[ai][bj][m][n] += bv; }
        f32x4 pre[4][2][2];
#pragma unroll
        for (int m = 0; m < 4; ++m) { const size_t off = (size_t)(u.pm * BM + wr * 64 + m * 16 + fr) * ldc + col0;
#pragma unroll
            for (int bj = 0; bj < 2; ++bj)
#pragma unroll
                for (int n = 0; n < 2; ++n) pre[m][bj][n] = *(const f32x4*)(base + off + bj * HALF + n * 16); }
        const bool bad = st.run(acc, u, wr, wc, fr, fq, lds, wid, lane) || poison != 0u;
        const float qnan = __builtin_nanf("");
#pragma unroll
        for (int ai = 0; ai < 2; ++ai)
#pragma unroll
            for (int m = 0; m < 4; ++m) { const int r = ai * HALF + wr * 64 + m * 16 + fr; const f32x2v sr = S[r]; const size_t off = (size_t)(u.pm * BM + r) * ldc + col0;
#pragma unroll
                for (int bj = 0; bj < 2; ++bj)
#pragma unroll
                    for (int n = 0; n < 2; ++n) { const f32x4 bs = ai == 0 ? pre[m][bj][n] : *(const f32x4*)(base + off + bj * HALF + n * 16); f32x4 o = bs + (acc[ai][bj][m][n] - sr.x) * sr.y;
                        if (bad) o = (f32x4){qnan, qnan, qnan, qnan}; *(f32x4*)(out + off + bj * HALF + n * 16) = o; }
                if (m & 1) asm volatile("" ::: "memory"); }
    }
};
struct EpiLnResLn {
    static constexpr bool PERM = false, AFTER_DRAIN = true;
    const float* base; float* out; bf16_t* xn; int ldc; const float* bias; PanelStats st1, st2; unsigned poison;
    __device__ __forceinline__ void fused(f32x4 (&acc)[2][2][4][2], const Unit& u, int wr, int wc, int fr, int fq, PG8_LAS unsigned char* lds, int wid, int lane) const {
        typedef float f32x2v __attribute__((ext_vector_type(2))); typedef unsigned u32x2v __attribute__((ext_vector_type(2)));
        const PG8_LAS f32x2v* S = (const PG8_LAS f32x2v*)(lds + 8192);
        const int col0 = u.pn * BM + wc * 32 + 4 * fq;
#pragma unroll
        for (int bj = 0; bj < 2; ++bj)
#pragma unroll
            for (int n = 0; n < 2; ++n) { const f32x4 bv = bias ? *(const f32x4*)(bias + col0 + bj * HALF + n * 16) : (f32x4){0.f, 0.f, 0.f, 0.f};
#pragma unroll
                for (int ai = 0; ai < 2; ++ai)
#pragma unroll
                    for (int m = 0; m < 4; ++m) acc[ai][bj][m][n] += bv; }
        bool bad = st1.run(acc, u, wr, wc, fr, fq, lds, wid, lane) || poison != 0u;
        const float qnan = __builtin_nanf("");
#pragma unroll
        for (int ai = 0; ai < 2; ++ai)
#pragma unroll
            for (int m = 0; m < 4; ++m) { const int r = ai * HALF + wr * 64 + m * 16 + fr; const f32x2v sr = S[r]; const size_t off = (size_t)(u.pm * BM + r) * ldc + col0;
#pragma unroll
                for (int bj = 0; bj < 2; ++bj)
#pragma unroll
                    for (int n = 0; n < 2; ++n) { const f32x4 bs = *(const f32x4*)(base + off + bj * HALF + n * 16); acc[ai][bj][m][n] = bs + (acc[ai][bj][m][n] - sr.x) * sr.y; }
                asm volatile("" : "+v"(acc[ai][0][m][0]), "+v"(acc[ai][0][m][1]), "+v"(acc[ai][1][m][0]), "+v"(acc[ai][1][m][1]));
                if (m & 1) asm volatile("" ::: "memory"); }
        const bool bad1 = bad;
        bad = st2.run(acc, u, wr, wc, fr, fq, lds, wid, lane) || bad;
#pragma unroll
        for (int ai = 0; ai < 2; ++ai)
#pragma unroll
            for (int m = 0; m < 4; ++m) { const int r = ai * HALF + wr * 64 + m * 16 + fr; const f32x2v sr = S[r]; const size_t off = (size_t)(u.pm * BM + r) * ldc + col0;
#pragma unroll
                for (int bj = 0; bj < 2; ++bj)
#pragma unroll
                    for (int n = 0; n < 2; ++n) { const f32x4 x1 = acc[ai][bj][m][n]; *(f32x4*)(out + off + bj * HALF + n * 16) = bad1 ? (f32x4){qnan, qnan, qnan, qnan} : x1;
                        const f32x4 o = (x1 - sr.x) * sr.y; u32x2v w; w.x = cvt_pk_bf16(o[0], o[1]); w.y = cvt_pk_bf16(o[2], o[3]);
                        if (bad) { w.x = 0x7fc07fc0u; w.y = 0x7fc07fc0u; } *(u32x2v*)(xn + off + bj * HALF + n * 16) = w; }
                asm volatile("" ::: "memory"); }
    }
};

template <class Epi, class Sched, bool ALIGN_EPI = false, bool SP2 = false>
__device__ __forceinline__ void gemm_phase(PG8_LAS unsigned char* lds, const Gemm g, const Sched& S, const Epi& E, int tid_) {
    asm volatile("" : "+v"(tid_));
    const int tid = tid_, wid = __builtin_amdgcn_readfirstlane(tid >> 6), lane = tid & 63, wr = wid >> 2, wc = wid & 3, fr = lane & 15, fq = lane >> 4;
    const int K = g.K, nt = K / BK;
    unsigned voffA[2], voffB[2];
#pragma unroll
    for (int i = 0; i < 2; ++i) { int R, C; stage_rc(tid * 16 + i * 8192, R, C); const int Rb = Epi::PERM ? ((R & ~31) + perm32(R & 31)) : R;
        voffA[i] = (unsigned)(R * K + C) * 2u; voffB[i] = (unsigned)(Rb * K + C) * 2u; }
    const size_t kstep = (size_t)(BK * 2);
    const size_t hstep = (size_t)HALF * K * 2;
    const size_t tstep = 2 * hstep;
    const unsigned ldsw = (unsigned)wid * 1024u;
    const int aoff = lds_byte(wr * 64 + fr, fq * 8), boff = lds_byte(wc * 32 + fr, fq * 8);
#define PG8_SA(b, h) (((b) * 2 + (h)) * HTB)
#define PG8_SB(b, h) ((4 + (b) * 2 + (h)) * HTB)
#define PG8_STAGE(bufoff, gbase, voff) do { _Pragma("unroll") for (int _i = 0; _i < 2; ++_i) \
        __builtin_amdgcn_global_load_lds((const unsigned*)((const char*)(gbase) + (voff)[_i]), (PG8_LAS unsigned*)(lds + (bufoff) + ldsw + _i * 8192), 16, 0, 0); } while (0)
#define PG8_LDA(dst, b, h) do { _Pragma("unroll") for (int m = 0; m < 4; ++m) _Pragma("unroll") for (int k = 0; k < 2; ++k) dst[m][k] = *(const PG8_LAS bf16x8*)(lds + PG8_SA(b, h) + aoff + m * 2048 + k * 1024); } while (0)
#define PG8_LDB(dst, b, h) do { _Pragma("unroll") for (int n = 0; n < 2; ++n) _Pragma("unroll") for (int k = 0; k < 2; ++k) dst[n][k] = *(const PG8_LAS bf16x8*)(lds + PG8_SB(b, h) + boff + n * 2048 + k * 1024); } while (0)
#define PG8_MMA(ai, bj, At, Bt) do { __builtin_amdgcn_s_setprio(1); _Pragma("unroll") for (int m = 0; m < 4; ++m) _Pragma("unroll") for (int n = 0; n < 2; ++n) _Pragma("unroll") for (int k = 0; k < 2; ++k) \
        acc[ai][bj][m][n] = __builtin_amdgcn_mfma_f32_16x16x32_bf16(Bt[n][k], At[m][k], acc[ai][bj][m][n], 0, 0, 0); __builtin_amdgcn_s_setprio(0); } while (0)
#define PG8_WAIT_V(n) asm volatile("s_waitcnt vmcnt(" #n ")" ::: "memory")
#define PG8_WAIT_L(n) asm volatile("s_waitcnt lgkmcnt(" #n ")" ::: "memory")
#define PG8_BAR __builtin_amdgcn_s_barrier()
#define PG8_SCHED __builtin_amdgcn_sched_barrier(0)
    Unit cur, nxt; int ui = 0;
    if (!S.next(0, cur)) return;
    f32x4 acc[2][2][4][2];
#pragma unroll
    for (int a = 0; a < 2; ++a)
#pragma unroll
        for (int b = 0; b < 2; ++b)
#pragma unroll
            for (int m = 0; m < 4; ++m)
#pragma unroll
                for (int n = 0; n < 2; ++n) acc[a][b][m][n] = (f32x4){0.f, 0.f, 0.f, 0.f};
    bf16x8 At[4][2], B0[2][2], B1[2][2];
    const char* cA = (const char*)g.A + (size_t)cur.pm * tstep; const char* cB = (const char*)g.Bt + (size_t)cur.pn * tstep;
    S.a_ready(cur);
    if constexpr (SP2) {
        PG8_STAGE(PG8_SB(0, 0), cB, voffB); PG8_STAGE(PG8_SB(0, 1), cB + hstep, voffB); PG8_STAGE(PG8_SA(0, 0), cA, voffA); PG8_STAGE(PG8_SA(0, 1), cA + hstep, voffA);
        if (wr == 1) PG8_BAR;
        PG8_WAIT_V(2); PG8_BAR;
        PG8_STAGE(PG8_SB(1, 0), cB + kstep, voffB); PG8_STAGE(PG8_SA(1, 0), cA + kstep, voffA); PG8_STAGE(PG8_SB(1, 1), cB + hstep + kstep, voffB);
        PG8_WAIT_V(6); PG8_BAR;
    } else {
        PG8_STAGE(PG8_SB(0, 0), cB, voffB); PG8_STAGE(PG8_SA(0, 0), cA, voffA); PG8_STAGE(PG8_SB(0, 1), cB + hstep, voffB); PG8_STAGE(PG8_SA(0, 1), cA + hstep, voffA);
        if (wr == 1) PG8_BAR;
        PG8_WAIT_V(4); PG8_BAR;
        PG8_STAGE(PG8_SB(1, 0), cB + kstep, voffB); PG8_STAGE(PG8_SA(1, 0), cA + kstep, voffA); PG8_STAGE(PG8_SB(1, 1), cB + hstep + kstep, voffB);
        PG8_WAIT_V(6); PG8_BAR;
    }
    for (;;) {
        const bool has_next = S.next(ui + 1, nxt);
        const char* nA = has_next ? (const char*)g.A + (size_t)nxt.pm * tstep : cA; const char* nB = has_next ? (const char*)g.Bt + (size_t)nxt.pn * tstep : cB;
        for (int t = 0; t < nt; t += 2) {
            const bool last = (t == nt - 2);
            const char* a1 = cA + (size_t)(t + 1) * kstep;
            const char* a2 = last ? nA : cA + (size_t)(t + 2) * kstep; const char* b2 = last ? nB : cB + (size_t)(t + 2) * kstep;
            const char* a3 = a2 + kstep; const char* b3 = b2 + kstep;
            if (last && has_next) S.a_ready(nxt);
            if constexpr (SP2) {
            PG8_LDB(B0, 0, 0); PG8_LDB(B1, 0, 1); PG8_SCHED; PG8_LDA(At, 0, 0); PG8_STAGE(PG8_SA(1, 1), a1 + hstep, voffA);
            PG8_WAIT_V(8); PG8_WAIT_L(0); PG8_BAR; PG8_MMA(0, 0, At, B0); PG8_MMA(0, 1, At, B1); PG8_BAR; PG8_SCHED;
            PG8_LDA(At, 0, 1); PG8_STAGE(PG8_SB(0, 0), b2, voffB); PG8_STAGE(PG8_SB(0, 1), b2 + hstep, voffB); PG8_STAGE(PG8_SA(0, 0), a2, voffA);
            PG8_WAIT_V(8); PG8_WAIT_L(0); PG8_BAR; PG8_MMA(1, 0, At, B0); PG8_MMA(1, 1, At, B1); PG8_BAR; PG8_SCHED;
            PG8_LDB(B0, 1, 0); PG8_LDB(B1, 1, 1); PG8_SCHED; PG8_LDA(At, 1, 0); PG8_STAGE(PG8_SA(0, 1), a2 + hstep, voffA);
            PG8_WAIT_V(8); PG8_WAIT_L(0); PG8_BAR; PG8_MMA(0, 0, At, B0); PG8_MMA(0, 1, At, B1); PG8_BAR; PG8_SCHED;
            PG8_LDA(At, 1, 1); PG8_STAGE(PG8_SB(1, 0), b3, voffB); PG8_STAGE(PG8_SB(1, 1), b3 + hstep, voffB); PG8_STAGE(PG8_SA(1, 0), a3, voffA);
            PG8_WAIT_V(8); PG8_WAIT_L(0); PG8_BAR; PG8_MMA(1, 0, At, B0); PG8_MMA(1, 1, At, B1); PG8_BAR; PG8_SCHED;
            } else {
            PG8_LDB(B0, 0, 0); PG8_SCHED; PG8_LDA(At, 0, 0); PG8_STAGE(PG8_SA(1, 1), a1 + hstep, voffA);
            PG8_WAIT_L(8); PG8_BAR; PG8_WAIT_L(0); PG8_MMA(0, 0, At, B0); PG8_BAR; PG8_SCHED;
            PG8_LDB(B1, 0, 1); PG8_STAGE(PG8_SB(0, 0), b2, voffB);
            PG8_BAR; PG8_WAIT_L(0); PG8_MMA(0, 1, At, B1); PG8_BAR;
            PG8_LDA(At, 0, 1); PG8_STAGE(PG8_SA(0, 0), a2, voffA);
            PG8_BAR; PG8_WAIT_L(0); PG8_MMA(1, 0, At, B0); PG8_BAR; PG8_SCHED;
            PG8_STAGE(PG8_SB(0, 1), b2 + hstep, voffB);
            PG8_WAIT_V(6); PG8_BAR; PG8_MMA(1, 1, At, B1); PG8_BAR;
            PG8_LDB(B0, 1, 0); PG8_SCHED; PG8_LDA(At, 1, 0); PG8_STAGE(PG8_SA(0, 1), a2 + hstep, voffA);
            PG8_WAIT_L(8); PG8_BAR; PG8_WAIT_L(0); PG8_MMA(0, 0, At, B0); PG8_BAR; PG8_SCHED;
            PG8_LDB(B1, 1, 1); PG8_STAGE(PG8_SB(1, 0), b3, voffB);
            PG8_BAR; PG8_WAIT_L(0); PG8_MMA(0, 1, At, B1); PG8_BAR;
            PG8_LDA(At, 1, 1); PG8_STAGE(PG8_SA(1, 0), a3, voffA);
            PG8_BAR; PG8_WAIT_L(0); PG8_MMA(1, 0, At, B0); PG8_BAR; PG8_SCHED;
            PG8_STAGE(PG8_SB(1, 1), b3 + hstep, voffB);
            PG8_WAIT_V(6); PG8_BAR; PG8_MMA(1, 1, At, B1); PG8_BAR;
            }
        }
        if constexpr (ALIGN_EPI) { if (wr == 0) PG8_BAR; }
        if constexpr (!Epi::AFTER_DRAIN) { E(acc, cur, wr, wc, fr, fq); S.done(cur); }
        if (!has_next) break;
#pragma unroll
        for (int a = 0; a < 2; ++a)
#pragma unroll
            for (int b = 0; b < 2; ++b)
#pragma unroll
                for (int m = 0; m < 4; ++m)
#pragma unroll
                    for (int n = 0; n < 2; ++n) acc[a][b][m][n] = (f32x4){0.f, 0.f, 0.f, 0.f};
        cur = nxt; cA = nA; cB = nB; ++ui;
        if constexpr (ALIGN_EPI) { if (wr == 1) PG8_BAR; }
    }
    PG8_WAIT_V(0);
    if constexpr (!ALIGN_EPI) { if (wr == 0) PG8_BAR; }
    PG8_BAR;
    if constexpr (Epi::AFTER_DRAIN) { E.fused(acc, cur, wr, wc, fr, fq, lds, wid, lane); S.done(cur); }
#undef PG8_SA
#undef PG8_SB
#undef PG8_STAGE
#undef PG8_LDA
#undef PG8_LDB
#undef PG8_MMA
#undef PG8_WAIT_V
#undef PG8_WAIT_L
#undef PG8_BAR
#undef PG8_SCHED
}
}

namespace hp {
typedef unsigned short bf16_t;
typedef short bf16x8 __attribute__((ext_vector_type(8)));
typedef short s16x4 __attribute__((ext_vector_type(4)));
typedef float f32x4 __attribute__((ext_vector_type(4)));
typedef float f32x16 __attribute__((ext_vector_type(16)));
typedef unsigned u32x4 __attribute__((ext_vector_type(4)));
typedef unsigned u32x2 __attribute__((ext_vector_type(2)));

constexpr int NB = 4, SEQ = 4096, DM = 4096, NL = 4, MT = NB * SEQ;
constexpr int NIN = 11800, NINP = 12032, DFF = 11008, NGU = 2 * DFF;
constexpr int C_RQ = 0, C_RK = 1024, C_RV = 2048, C_RG = 3072, C_SQ = 4096, C_SK = 5120, C_SV = 6144, C_LG = 7168, C_LR = 8192,
              C_NQ = 9216, C_NKC = 10240, C_NVC = 10496, C_NKS = 10752, C_NVS = 11008, C_NKW = 11264, C_NVW = 11520, C_NG = 11776;
constexpr int MIX_RET = 0, MIX_SB = 1024, MIX_LRU = 2048, MIX_NSA = 3072;
constexpr int NTHR = 512, NWAVE = 8;
constexpr int LDS_STAGE = 131072, LDS_CTL = 256, RT_PANELS = 24, LDS_RT = RT_PANELS * 256 * 4, LDS_BYTES = LDS_STAGE + LDS_CTL + LDS_RT;

enum { I_X = 0, I_ANW, I_WIN, I_LCW, I_LCB, I_LWA, I_LBA, I_LWX, I_LBX, I_LLAM, I_NQW, I_NKW, I_CPOS, I_CW1, I_CW2, I_WOUT, I_MNW, I_WG, I_WU, I_MCW, I_MCB, I_WD, N_INPUTS };

constexpr size_t al256(size_t x) { return (x + 255) & ~(size_t)255; }
constexpr size_t WS_CTL   = 0;
constexpr size_t CTL_BYTES = 65536;
constexpr size_t WS_RSS   = WS_CTL + CTL_BYTES;
constexpr size_t WS_TAB_RC = WS_RSS + (size_t)2 * MT * 64 * 4;
constexpr size_t WS_TAB_RS = WS_TAB_RC + (size_t)SEQ * 64 * 4;
constexpr size_t WS_TAB_NC = WS_TAB_RS + (size_t)SEQ * 64 * 4;
constexpr size_t WS_TAB_NS = WS_TAB_NC + (size_t)SEQ * 16 * 4;
constexpr size_t WS_WIN   = WS_TAB_NS + (size_t)SEQ * 16 * 4;
constexpr size_t WS_WOUT  = WS_WIN  + (size_t)NINP * DM * 2;
constexpr size_t WS_WGU   = WS_WOUT + (size_t)DM * DM * 2;
constexpr size_t WS_WDN   = WS_WGU  + (size_t)NGU * DM * 2;
constexpr size_t WS_CW1   = WS_WDN  + (size_t)DM * DFF * 2;
constexpr size_t WS_CW2   = WS_CW1  + (size_t)2 * 4096 * 256 * 2;
constexpr size_t WS_LWA   = WS_CW2  + (size_t)2 * 256 * 128 * 2;
constexpr size_t WS_LWX   = WS_LWA  + (size_t)8 * 128 * 128 * 2;
constexpr size_t WS_HN    = WS_LWX  + (size_t)8 * 128 * 128 * 2;
constexpr size_t WS_MIX   = WS_HN   + (size_t)MT * DM * 2;
constexpr size_t WS_PROJ  = WS_MIX  + (size_t)MT * DM * 2;
constexpr size_t WS_GU    = WS_PROJ;
constexpr size_t WS_H     = WS_PROJ + (size_t)MT * NGU * 2;
constexpr size_t WS_QR    = WS_H    + (size_t)MT * DFF * 2;
constexpr size_t WS_KR    = WS_QR   + (size_t)MT * 1024 * 2;
constexpr size_t WS_QN    = WS_KR   + (size_t)MT * 1024 * 2;
constexpr size_t WS_KSN   = WS_QN   + (size_t)MT * 1024 * 2;
constexpr size_t WS_KWN   = WS_KSN  + (size_t)MT * 256 * 2;
constexpr size_t WS_KCMP  = WS_KWN  + (size_t)MT * 256 * 2;
constexpr size_t WS_VCMP  = WS_KCMP + (size_t)8 * 256 * 128 * 2;
constexpr size_t WS_ST    = WS_VCMP + (size_t)8 * 256 * 128 * 2;
constexpr size_t WS_HLOC  = WS_ST   + (size_t)32 * 32 * 128 * 128 * 2;
constexpr size_t WS_CUMA  = WS_HLOC + (size_t)MT * 1024 * 4;
constexpr size_t WS_YNSA  = WS_CUMA + (size_t)MT * 1024 * 4;
constexpr size_t WS_GT    = WS_YNSA + (size_t)MT * 1024 * 4;
constexpr size_t WS_GH    = WS_GT   + (size_t)256 * 2 * DFF * 2;
constexpr size_t WS_UH    = WS_GH   + (size_t)256 * 2 * DFF * 2;
constexpr size_t WS_CPOS  = WS_UH   + (size_t)256 * 2 * DFF * 2;
constexpr size_t WS_WDN2  = WS_CPOS + 2 * 256 * 4;
constexpr size_t WS_END   = WS_WDN2 + (size_t)DM * DFF * 2;
constexpr int CW_BAR = 0;
constexpr int CW_RSFLAG = 8192;
constexpr int CW_QUEUE = 4096;

struct Params {
    const float* in[N_INPUTS];
    float* out;
    unsigned char* ws;
    int l_lo, l_hi, ph_lo, ph_hi;
};
typedef const __attribute__((address_space(4))) Params* KP;

__device__ __forceinline__ float bf2f(unsigned short v) { return __uint_as_float(((unsigned)v) << 16); }
__device__ __forceinline__ float bflo(unsigned w) { return __uint_as_float(w << 16); }
__device__ __forceinline__ float bfhi(unsigned w) { return __uint_as_float(w & 0xffff0000u); }
__device__ __forceinline__ unsigned cvt_pk(float lo, float hi) { unsigned r; asm volatile("v_cvt_pk_bf16_f32 %0, %1, %2" : "=v"(r) : "v"(lo), "v"(hi)); return r; }
__device__ __forceinline__ unsigned short f2bf(float f) { return (unsigned short)(cvt_pk(f, 0.f) & 0xffffu); }
__device__ __forceinline__ float fexp2(float x) { return __builtin_amdgcn_exp2f(x); }
__device__ __forceinline__ float flog2(float x) { return __builtin_amdgcn_logf(x); }
__device__ __forceinline__ float frcp(float x) { return __builtin_amdgcn_rcpf(x); }
__device__ __forceinline__ float sigmoidf_(float x) { return frcp(1.f + fexp2(-x * 1.4426950408889634f)); }
__device__ __forceinline__ float gelu_tanh(float x) {
    const float u = 0.7978845608028654f * (x + 0.044715f * x * x * x);
    const float t = 1.f - 2.f * frcp(1.f + fexp2(2.f * 1.4426950408889634f * u));
    return 0.5f * x * (1.f + t);
}
__device__ __forceinline__ float half_max(float v) { auto r = __builtin_amdgcn_permlane32_swap(__float_as_uint(v), __float_as_uint(v), false, false); return fmaxf(__uint_as_float(r[0]), __uint_as_float(r[1])); }
__device__ __forceinline__ float half_sum(float v) { auto r = __builtin_amdgcn_permlane32_swap(__float_as_uint(v), __float_as_uint(v), false, false); return __uint_as_float(r[0]) + __uint_as_float(r[1]); }
__device__ __forceinline__ float wave_sum(float v) {
#pragma unroll
    for (int o = 32; o >= 1; o >>= 1) v += __shfl_xor(v, o);
    return v;
}

__device__ __forceinline__ unsigned off_b(unsigned row, unsigned ch) { return 256u * row + 16u * (ch ^ (((row & 3u) << 2) | ((row >> 2) & 3u))); }
__device__ __forceinline__ void rows32_load(u32x4 (&v)[8], const void* src, size_t ld, int lane) {
    const unsigned char* s = (const unsigned char*)src + (size_t)(lane >> 4) * ld + 16 * (lane & 15);
#pragma unroll
    for (int i = 0; i < 8; ++i) v[i] = *(const u32x4*)(s + (size_t)(4 * i) * ld);
}
__device__ __forceinline__ void rows32_put(LAS unsigned char* W, const u32x4 (&v)[8], int lane) {
#pragma unroll
    for (int i = 0; i < 8; ++i) *(LAS u32x4*)(W + off_b((unsigned)((lane >> 4) + 4 * i), (unsigned)(lane & 15))) = v[i];
    asm volatile("s_waitcnt lgkmcnt(0)" ::: "memory");
}
__device__ __forceinline__ bf16x8 row_frag(const LAS unsigned char* tile, int r0, int s, int lane) {
    return *(const LAS bf16x8*)(tile + off_b((unsigned)(r0 + (lane & 31)), (unsigned)(2 * s + (lane >> 5))));
}
__device__ __forceinline__ unsigned lds_addr(const LAS unsigned char* p) { return (unsigned)(size_t)p; }
__device__ __forceinline__ unsigned tr_off_nat(int lane, int c, int ks, int t) {
    const unsigned h = lane >> 5, blk = (lane >> 4) & 1, q = (lane & 15) >> 2, p = lane & 3;
    return off_b(16u * ks + 8u * h + 4u * t + q, 4u * c + 2u * blk + (p >> 1)) + 8u * (p & 1);
}
__device__ __forceinline__ unsigned tr_off_acc(int lane, int c, int ks, int t) {
    const unsigned h = lane >> 5, blk = (lane >> 4) & 1, q = (lane & 15) >> 2, p = lane & 3;
    return off_b(16u * ks + 8u * t + 4u * h + q, 4u * c + 2u * blk + (p >> 1)) + 8u * (p & 1);
}
__device__ __forceinline__ bf16x8 tr_read2(unsigned a0, unsigned a1) {
    s16x4 lo, hi;
    asm volatile("ds_read_b64_tr_b16 %0, %2\n\tds_read_b64_tr_b16 %1, %3\n\ts_waitcnt lgkmcnt(0)" : "=&v"(lo), "=&v"(hi) : "v"(a0), "v"(a1) : "memory");
    return __builtin_shufflevector(lo, hi, 0, 1, 2, 3, 4, 5, 6, 7);
}
__device__ __forceinline__ void tr_frag_nat2(const LAS unsigned char* t0, const LAS unsigned char* t1, int c, int ks, int lane, bf16x8& f0, bf16x8& f1) {
    const unsigned o0 = tr_off_nat(lane, c, ks, 0), o1 = tr_off_nat(lane, c, ks, 1), b0 = lds_addr(t0), b1 = lds_addr(t1);
    s16x4 l0, h0, l1, h1;
    asm volatile("ds_read_b64_tr_b16 %0, %4\n\tds_read_b64_tr_b16 %1, %5\n\tds_read_b64_tr_b16 %2, %6\n\tds_read_b64_tr_b16 %3, %7\n\ts_waitcnt lgkmcnt(0)"
                 : "=&v"(l0), "=&v"(h0), "=&v"(l1), "=&v"(h1) : "v"(b0 + o0), "v"(b0 + o1), "v"(b1 + o0), "v"(b1 + o1) : "memory");
    f0 = __builtin_shufflevector(l0, h0, 0, 1, 2, 3, 4, 5, 6, 7); f1 = __builtin_shufflevector(l1, h1, 0, 1, 2, 3, 4, 5, 6, 7);
}
__device__ __forceinline__ bf16x8 tr_frag_nat(const LAS unsigned char* tile, int c, int ks, int lane) {
    const unsigned b = lds_addr(tile);
    return tr_read2(b + tr_off_nat(lane, c, ks, 0), b + tr_off_nat(lane, c, ks, 1));
}
struct TrAcc { unsigned a[4][2]; };
__device__ __forceinline__ void tr_acc_init(TrAcc& A, int lane) {
#pragma unroll
    for (int c = 0; c < 4; ++c)
#pragma unroll
        for (int t = 0; t < 2; ++t) A.a[c][t] = tr_off_acc(lane, c, 0, t);
}
__device__ __forceinline__ void pv_step(f32x16 (&o)[4], unsigned vb  , const TrAcc& A, bf16x8 pf) {
    s16x4 d0, d1, d2, d3, d4, d5, d6, d7;
    asm volatile("ds_read_b64_tr_b16 %0, %8\n\tds_read_b64_tr_b16 %1, %9\n\tds_read_b64_tr_b16 %2, %10\n\tds_read_b64_tr_b16 %3, %11\n\t"
                 "ds_read_b64_tr_b16 %4, %12\n\tds_read_b64_tr_b16 %5, %13\n\tds_read_b64_tr_b16 %6, %14\n\tds_read_b64_tr_b16 %7, %15\n\ts_waitcnt lgkmcnt(0)"
                 : "=&v"(d0), "=&v"(d1), "=&v"(d2), "=&v"(d3), "=&v"(d4), "=&v"(d5), "=&v"(d6), "=&v"(d7)
                 : "v"(vb + A.a[0][0]), "v"(vb + A.a[0][1]), "v"(vb + A.a[1][0]), "v"(vb + A.a[1][1]), "v"(vb + A.a[2][0]), "v"(vb + A.a[2][1]), "v"(vb + A.a[3][0]), "v"(vb + A.a[3][1]) : "memory");
    o[0] = __builtin_amdgcn_mfma_f32_32x32x16_bf16(__builtin_shufflevector(d0, d1, 0, 1, 2, 3, 4, 5, 6, 7), pf, o[0], 0, 0, 0);
    o[1] = __builtin_amdgcn_mfma_f32_32x32x16_bf16(__builtin_shufflevector(d2, d3, 0, 1, 2, 3, 4, 5, 6, 7), pf, o[1], 0, 0, 0);
    o[2] = __builtin_amdgcn_mfma_f32_32x32x16_bf16(__builtin_shufflevector(d4, d5, 0, 1, 2, 3, 4, 5, 6, 7), pf, o[2], 0, 0, 0);
    o[3] = __builtin_amdgcn_mfma_f32_32x32x16_bf16(__builtin_shufflevector(d6, d7, 0, 1, 2, 3, 4, 5, 6, 7), pf, o[3], 0, 0, 0);
}
__device__ __forceinline__ f32x16 qk_block(const LAS unsigned char* ktile, int kb, const bf16x8 (&qf)[8], int lane) {
    f32x16 acc;
#pragma unroll
    for (int i = 0; i < 16; ++i) acc[i] = 0.f;
#pragma unroll
    for (int s = 0; s < 8; ++s) acc = __builtin_amdgcn_mfma_f32_32x32x16_bf16(row_frag(ktile, 32 * kb, s, lane), qf[s], acc, 0, 0, 0);
    return acc;
}
__device__ __forceinline__ void qk_tile(const LAS unsigned char* ktile, const bf16x8 (&qf)[8], int lane, f32x16& s0, f32x16& s1) {
#pragma unroll
    for (int i = 0; i < 16; ++i) { s0[i] = 0.f; s1[i] = 0.f; }
#pragma unroll
    for (int s = 0; s < 8; ++s) {
        const bf16x8 a0 = row_frag(ktile, 0, s, lane), a1 = row_frag(ktile, 32, s, lane);
        s0 = __builtin_amdgcn_mfma_f32_32x32x16_bf16(a0, qf[s], s0, 0, 0, 0);
        s1 = __builtin_amdgcn_mfma_f32_32x32x16_bf16(a1, qf[s], s1, 0, 0, 0);
    }
}
struct KFrag4 { bf16x8 a, b, c, d; };
__device__ __forceinline__ void k_issue4(KFrag4& f, unsigned a0, unsigned a1, unsigned a2, unsigned a3) {
    asm volatile("ds_read_b128 %0, %4\n\tds_read_b128 %1, %5\n\tds_read_b128 %2, %6\n\tds_read_b128 %3, %7" : "=&v"(f.a), "=&v"(f.b), "=&v"(f.c), "=&v"(f.d) : "v"(a0), "v"(a1), "v"(a2), "v"(a3) : "memory");
}
__device__ __forceinline__ void k_wait4(KFrag4& f) { asm volatile("s_waitcnt lgkmcnt(4)" : "+v"(f.a), "+v"(f.b), "+v"(f.c), "+v"(f.d) :: "memory"); }
__device__ __forceinline__ void k_wait0(KFrag4& f) { asm volatile("s_waitcnt lgkmcnt(0)" : "+v"(f.a), "+v"(f.b), "+v"(f.c), "+v"(f.d) :: "memory"); }
__device__ __forceinline__ void qk_tile_pipe(const LAS unsigned char* ktile, const bf16x8 (&qf)[8], int lane, f32x16& s0, f32x16& s1) {
#pragma unroll
    for (int i = 0; i < 16; ++i) { s0[i] = 0.f; s1[i] = 0.f; }
    const unsigned kb = lds_addr(ktile), r0 = (unsigned)(lane & 31), h = (unsigned)(lane >> 5);
#define KA_(row_, s_) (kb + off_b((row_), 2u * (s_) + h))
    KFrag4 A, B;
    k_issue4(A, KA_(r0, 0), KA_(r0, 1), KA_(r0, 2), KA_(r0, 3));
    k_issue4(B, KA_(r0, 4), KA_(r0, 5), KA_(r0, 6), KA_(r0, 7));
    k_wait4(A);
    s0 = __builtin_amdgcn_mfma_f32_32x32x16_bf16(A.a, qf[0], s0, 0, 0, 0); s0 = __builtin_amdgcn_mfma_f32_32x32x16_bf16(A.b, qf[1], s0, 0, 0, 0);
    s0 = __builtin_amdgcn_mfma_f32_32x32x16_bf16(A.c, qf[2], s0, 0, 0, 0); s0 = __builtin_amdgcn_mfma_f32_32x32x16_bf16(A.d, qf[3], s0, 0, 0, 0);
    k_issue4(A, KA_(r0 + 32u, 0), KA_(r0 + 32u, 1), KA_(r0 + 32u, 2), KA_(r0 + 32u, 3));
    k_wait4(B);
    s0 = __builtin_amdgcn_mfma_f32_32x32x16_bf16(B.a, qf[4], s0, 0, 0, 0); s0 = __builtin_amdgcn_mfma_f32_32x32x16_bf16(B.b, qf[5], s0, 0, 0, 0);
    s0 = __builtin_amdgcn_mfma_f32_32x32x16_bf16(B.c, qf[6], s0, 0, 0, 0); s0 = __builtin_amdgcn_mfma_f32_32x32x16_bf16(B.d, qf[7], s0, 0, 0, 0);
    k_issue4(B, KA_(r0 + 32u, 4), KA_(r0 + 32u, 5), KA_(r0 + 32u, 6), KA_(r0 + 32u, 7));
    k_wait4(A);
    s1 = __builtin_amdgcn_mfma_f32_32x32x16_bf16(A.a, qf[0], s1, 0, 0, 0); s1 = __builtin_amdgcn_mfma_f32_32x32x16_bf16(A.b, qf[1], s1, 0, 0, 0);
    s1 = __builtin_amdgcn_mfma_f32_32x32x16_bf16(A.c, qf[2], s1, 0, 0, 0); s1 = __builtin_amdgcn_mfma_f32_32x32x16_bf16(A.d, qf[3], s1, 0, 0, 0);
    k_wait0(B);
    s1 = __builtin_amdgcn_mfma_f32_32x32x16_bf16(B.a, qf[4], s1, 0, 0, 0); s1 = __builtin_amdgcn_mfma_f32_32x32x16_bf16(B.b, qf[5], s1, 0, 0, 0);
    s1 = __builtin_amdgcn_mfma_f32_32x32x16_bf16(B.c, qf[6], s1, 0, 0, 0); s1 = __builtin_amdgcn_mfma_f32_32x32x16_bf16(B.d, qf[7], s1, 0, 0, 0);
#undef KA_
}
__device__ __forceinline__ f32x16 qk_block_pipe(const LAS unsigned char* ktile, int kb, const bf16x8 (&qf)[8], int lane) {
    f32x16 acc;
#pragma unroll
    for (int i = 0; i < 16; ++i) acc[i] = 0.f;
    const unsigned kbase = lds_addr(ktile), r0 = (unsigned)(32 * kb + (lane & 31)), h = (unsigned)(lane >> 5);
#define KA_(s_) (kbase + off_b(r0, 2u * (s_) + h))
    KFrag4 A, B;
    k_issue4(A, KA_(0), KA_(1), KA_(2), KA_(3));
    k_issue4(B, KA_(4), KA_(5), KA_(6), KA_(7));
    k_wait4(A);
    acc = __builtin_amdgcn_mfma_f32_32x32x16_bf16(A.a, qf[0], acc, 0, 0, 0); acc = __builtin_amdgcn_mfma_f32_32x32x16_bf16(A.b, qf[1], acc, 0, 0, 0);
    acc = __builtin_amdgcn_mfma_f32_32x32x16_bf16(A.c, qf[2], acc, 0, 0, 0); acc = __builtin_amdgcn_mfma_f32_32x32x16_bf16(A.d, qf[3], acc, 0, 0, 0);
    k_wait0(B);
    acc = __builtin_amdgcn_mfma_f32_32x32x16_bf16(B.a, qf[4], acc, 0, 0, 0); acc = __builtin_amdgcn_mfma_f32_32x32x16_bf16(B.b, qf[5], acc, 0, 0, 0);
    acc = __builtin_amdgcn_mfma_f32_32x32x16_bf16(B.c, qf[6], acc, 0, 0, 0); acc = __builtin_amdgcn_mfma_f32_32x32x16_bf16(B.d, qf[7], acc, 0, 0, 0);
#undef KA_
    return acc;
}
__device__ __forceinline__ bf16x8 pack8(const f32x16& p, int s2) {
    u32x4 w; w.x = cvt_pk(p[8 * s2 + 0], p[8 * s2 + 1]); w.y = cvt_pk(p[8 * s2 + 2], p[8 * s2 + 3]); w.z = cvt_pk(p[8 * s2 + 4], p[8 * s2 + 5]); w.w = cvt_pk(p[8 * s2 + 6], p[8 * s2 + 7]);
    return __builtin_bit_cast(bf16x8, w);
}
template <int ROWS> struct TileRegs { u32x4 r[ROWS * 16 / NTHR]; };
template <int ROWS> __device__ __forceinline__ void tile_load(TileRegs<ROWS>& R, const bf16_t* src, size_t ld, int tid) {
#pragma unroll
    for (int i = 0; i < ROWS * 16 / NTHR; ++i) { const int c = tid + NTHR * i; R.r[i] = *(const u32x4*)(src + (size_t)(c >> 4) * ld + (c & 15) * 8); }
}
template <int ROWS> __device__ __forceinline__ void tile_store(LAS unsigned char* tile, const TileRegs<ROWS>& R, int tid) {
#pragma unroll
    for (int i = 0; i < ROWS * 16 / NTHR; ++i) { const int c = tid + NTHR * i; *(LAS u32x4*)(tile + off_b((unsigned)(c >> 4), (unsigned)(c & 15))) = R.r[i]; }
}
template <int ROWS> __device__ __forceinline__ void tile_stage(LAS unsigned char* tile, const bf16_t* src, size_t ld, int tid) {
    TileRegs<ROWS> R; tile_load<ROWS>(R, src, ld, tid); tile_store<ROWS>(tile, R, tid);
}
__device__ __forceinline__ void unpack8(const u32x4 v, float (&x)[8]) {
    x[0] = bflo(v.x); x[1] = bfhi(v.x); x[2] = bflo(v.y); x[3] = bfhi(v.y); x[4] = bflo(v.z); x[5] = bfhi(v.z); x[6] = bflo(v.w); x[7] = bfhi(v.w);
}
__device__ __forceinline__ u32x4 pack8f(const float (&x)[8]) {
    u32x4 w; w.x = cvt_pk(x[0], x[1]); w.y = cvt_pk(x[2], x[3]); w.z = cvt_pk(x[4], x[5]); w.w = cvt_pk(x[6], x[7]); return w;
}
__device__ __forceinline__ void ld8f(const float* src, float (&x)[8]) {
    const f32x4 a = *(const f32x4*)src, b = *(const f32x4*)(src + 4);
    x[0] = a[0]; x[1] = a[1]; x[2] = a[2]; x[3] = a[3]; x[4] = b[0]; x[5] = b[1]; x[6] = b[2]; x[7] = b[3];
}
__device__ __forceinline__ void tile_dma64(LAS unsigned char* tile, const bf16_t* src, size_t ld, int tid, int wave) {
#pragma unroll
    for (int i = 0; i < 2; ++i) {
        const int c = tid + NTHR * i, row = c >> 4, pos = c & 15, ch = pos ^ (((row & 3) << 2) | ((row >> 2) & 3));
        __builtin_amdgcn_global_load_lds((const unsigned*)(src + (size_t)row * ld + ch * 8), (LAS unsigned*)(tile + (wave * 64 + NTHR * i) * 16), 16, 0, 0);
    }
}
__device__ __forceinline__ int lane_id_now() { int l; asm volatile("v_mbcnt_lo_u32_b32 %0, -1, 0\n\tv_mbcnt_hi_u32_b32 %0, -1, %0" : "=v"(l)); return l; }
__device__ __forceinline__ int next_task_n(unsigned* ctr, int n, volatile LAS int* slot, int tid) {
    __syncthreads();
    if (tid == 0) { int v = (int)__hip_atomic_load(ctr, __ATOMIC_RELAXED, __HIP_MEMORY_SCOPE_AGENT); if (v < n) v = (int)__hip_atomic_fetch_add(ctr, 1u, __ATOMIC_RELAXED, __HIP_MEMORY_SCOPE_AGENT); *slot = v < n ? v : n; }
    __syncthreads();
    return *slot;
}
__device__ __forceinline__ int next_task(unsigned* ctr, volatile LAS int* slot, int tid) {
    __syncthreads();
    if (tid == 0) *slot = (int)__hip_atomic_fetch_add(ctr, 1u, __ATOMIC_RELAXED, __HIP_MEMORY_SCOPE_AGENT);
    __syncthreads();
    return *slot;
}
#define QUEUE_LOOP(ctr_, n_, ...) do { int t = next_task((ctr_), slot, tid); while (t < (n_)) { \
        int nx_ = 0; if (tid == 0) nx_ = (int)__hip_atomic_fetch_add((ctr_), 1u, __ATOMIC_RELAXED, __HIP_MEMORY_SCOPE_AGENT); \
        { __VA_ARGS__; } \
        __syncthreads(); if (tid == 0) *slot = nx_; __syncthreads(); t = *slot; } } while (0)

struct CvTask { const float* W; const float* gain; bf16_t* Bt; int K, N, k0, n0, gu; };
__device__ __forceinline__ CvTask cv_task(KP p, int l, int t8) {
    CvTask c; int tt = t8, ntn;
    c.gu = 0;
    c.gain = nullptr;
    if (tt < 1504) { c.W = p->in[I_WIN] + (size_t)l * 4096 * NIN; c.K = 4096; c.N = NIN; c.Bt = (bf16_t*)(p->ws + WS_WIN); ntn = 47; c.gain = p->in[I_ANW] + (size_t)l * DM; }
    else if ((tt -= 1504) < 512) { c.W = p->in[I_WOUT] + (size_t)l * 4096 * 4096; c.K = 4096; c.N = 4096; c.Bt = (bf16_t*)(p->ws + WS_WOUT); ntn = 16; }
    else if ((tt -= 512) < 1376) { c.W = p->in[I_WG] + (size_t)l * 4096 * DFF; c.K = 4096; c.N = DFF; c.Bt = (bf16_t*)(p->ws + WS_WGU); ntn = 43; c.gain = p->in[I_MNW] + (size_t)l * DM; c.gu = 1; }
    else if ((tt -= 1376) < 1376) { c.W = p->in[I_WU] + (size_t)l * 4096 * DFF; c.K = 4096; c.N = DFF; c.Bt = (bf16_t*)(p->ws + WS_WGU); ntn = 43; c.gain = p->in[I_MNW] + (size_t)l * DM; c.gu = 2; }
    else { tt -= 1376; c.W = p->in[I_WD] + (size_t)l * DFF * 4096; c.K = DFF; c.N = 4096; c.Bt = (bf16_t*)(p->ws + ((l & 1) ? WS_WDN2 : WS_WDN)); ntn = 16; }
    const int kt = tt / ntn, nt = tt - kt * ntn; c.k0 = kt * 128; c.n0 = nt * 256;
    return c;
}
__device__ __forceinline__ void cv_load(const CvTask& c, f32x4 (&v)[2][4][2], int tid) {
    const int r = tid >> 4, c4 = (tid & 15) * 4;
#pragma unroll
    for (int kk = 0; kk < 2; ++kk)
#pragma unroll
        for (int sub = 0; sub < 4; ++sub)
#pragma unroll
            for (int i = 0; i < 2; ++i) {
                const int k = c.k0 + 64 * kk + 2 * r + i, n = c.n0 + 64 * sub + c4;
                v[kk][sub][i] = (f32x4){0.f, 0.f, 0.f, 0.f};
                if (n < c.N) v[kk][sub][i] = __builtin_nontemporal_load((const f32x4*)(c.W + (size_t)k * c.N + n));
            }
}
__device__ __forceinline__ void cv_store(const CvTask& c, const f32x4 (&v)[2][4][2], LAS unsigned* T, int tid) {
    const int r = tid >> 4, c4 = (tid & 15) * 4;
#pragma unroll
    for (int kk = 0; kk < 2; ++kk) {
        float g0 = 1.f, g1 = 1.f;
        if (c.gain) { g0 = c.gain[c.k0 + 64 * kk + 2 * r]; g1 = c.gain[c.k0 + 64 * kk + 2 * r + 1]; }
#pragma unroll
        for (int sub = 0; sub < 4; ++sub)
#pragma unroll
            for (int j = 0; j < 4; ++j) T[((kk * 4 + sub) * 64 + c4 + j) * 33 + r] = cvt_pk(v[kk][sub][0][j] * g0, v[kk][sub][1][j] * g1);
    }
    __syncthreads();
    {
        const int nl = tid >> 3, kq = (tid & 7) * 4;
#pragma unroll
        for (int kk = 0; kk < 2; ++kk)
#pragma unroll
            for (int sub = 0; sub < 4; ++sub) {
                const LAS unsigned* s = T + ((kk * 4 + sub) * 64 + nl) * 33 + kq;
                u32x4 w; w.x = s[0]; w.y = s[1]; w.z = s[2]; w.w = s[3];
                const int n = c.n0 + 64 * sub;
                const int drow = c.gu ? 256 * (n >> 7) + 128 * (c.gu - 1) + (n & 127) + nl : n + nl;
                *(u32x4*)(c.Bt + (size_t)drow * c.K + c.k0 + 64 * kk + 2 * kq) = w;
            }
    }
    __syncthreads();
}
__device__ __forceinline__ void convert_range(KP p, int l, int t, int tend, int step, LAS unsigned char* lds, int tid) {
    asm volatile("" : "+v"(tid), "+s"(p));
    if (t >= tend) return;
    LAS unsigned* T0 = (LAS unsigned*)lds;
    f32x4 va[2][4][2], vb[2][4][2];
    __syncthreads();
    CvTask A = cv_task(p, l, t), B = A; cv_load(A, va, tid);
    for (;;) {
        const int t1 = t + step; const bool h1 = t1 < tend;
        if (h1) { B = cv_task(p, l, t1); cv_load(B, vb, tid); }
        cv_store(A, va, T0, tid);
        if (!h1) break;
        t = t1 + step; const bool h0 = t < tend;
        if (h0) { A = cv_task(p, l, t); cv_load(A, va, tid); }
        cv_store(B, vb, T0, tid);
        if (!h0) break;
    }
}
__device__ __forceinline__ void convert_small(KP p, int l, int tid, int bid, int G) {
    asm volatile("" : "+v"(tid), "+s"(p));
    {
        const size_t gtid = (size_t)bid * NTHR + tid, gstride = (size_t)G * NTHR;
        const float* s1 = p->in[I_CW1] + (size_t)l * 2 * 4096 * 256; bf16_t* d1 = (bf16_t*)(p->ws + WS_CW1);
        for (size_t i = gtid; i < (size_t)2 * 4096 * 256 / 4; i += gstride) { const f32x4 v = *(const f32x4*)(s1 + i * 4); u32x2 w; w.x = cvt_pk(v[0], v[1]); w.y = cvt_pk(v[2], v[3]); *(u32x2*)(d1 + i * 4) = w; }
        const float* s2 = p->in[I_CW2] + (size_t)l * 2 * 256 * 128; bf16_t* d2 = (bf16_t*)(p->ws + WS_CW2);
        for (size_t i = gtid; i < (size_t)2 * 256 * 128 / 4; i += gstride) { const f32x4 v = *(const f32x4*)(s2 + i * 4); u32x2 w; w.x = cvt_pk(v[0], v[1]); w.y = cvt_pk(v[2], v[3]); *(u32x2*)(d2 + i * 4) = w; }
        const float* s3 = p->in[I_LWA] + (size_t)l * 8 * 128 * 128; bf16_t* d3 = (bf16_t*)(p->ws + WS_LWA);
        for (size_t i = gtid; i < (size_t)8 * 128 * 128 / 4; i += gstride) { const f32x4 v = *(const f32x4*)(s3 + i * 4); u32x2 w; w.x = cvt_pk(v[0], v[1]); w.y = cvt_pk(v[2], v[3]); *(u32x2*)(d3 + i * 4) = w; }
        {
            const int lane = tid & 63, wave = tid >> 6; float* cp = (float*)(p->ws + WS_CPOS);
            for (int o = bid * NWAVE + wave; o < 512; o += G * NWAVE) {
                const int kv = o >> 8, h = o & 255; const float* ps = p->in[I_CPOS] + ((size_t)l * 2 + kv) * 4096; const float* w = s1 + (size_t)kv * 4096 * 256 + h;
                float a = 0.f;
                for (int k = lane; k < 4096; k += 64) a += ps[k] * w[(size_t)k * 256];
                a = wave_sum(a);
                if (lane == 0) cp[o] = a;
            }
        }
        const float* s4 = p->in[I_LWX] + (size_t)l * 8 * 128 * 128; bf16_t* d4 = (bf16_t*)(p->ws + WS_LWX);
        for (size_t i = gtid; i < (size_t)8 * 128 * 128 / 4; i += gstride) { const f32x4 v = *(const f32x4*)(s4 + i * 4); u32x2 w; w.x = cvt_pk(v[0], v[1]); w.y = cvt_pk(v[2], v[3]); *(u32x2*)(d4 + i * 4) = w; }
    }
}

__device__ __forceinline__ void sincos_acc(double x, float& sn, float& cs) {
    const double kf = rint(x * 0.63661977236758134308);
    const double r = fma(-kf, 6.123233995736766036e-17, fma(-kf, 1.5707963267948965580, x));
    const double z = r * r;
    const double sr = r + r * z * (-0.166666666416265235595 + z * (0.0083333293858894631756 + z * (-0.000198393348360966317347 + z * 0.0000027183114939898219064)));
    const double cr = 1.0 + z * (-0.499999997251031003120 + z * (0.0416666233237390631894 + z * (-0.00138867637746099294692 + z * 0.0000243904487962774090654)));
    const int n = ((int)kf) & 3;
    const double s = (n == 0) ? sr : (n == 1) ? cr : (n == 2) ? -sr : -cr;
    const double c = (n == 0) ? cr : (n == 1) ? -sr : (n == 2) ? -cr : sr;
    sn = (float)s; cs = (float)c;
}
__device__ __forceinline__ void ph_tables(KP p, int tid, int bid, int G) {
    asm volatile("" : "+v"(tid), "+s"(p));
    float* rc = (float*)(p->ws + WS_TAB_RC); float* rs = (float*)(p->ws + WS_TAB_RS); float* nc = (float*)(p->ws + WS_TAB_NC); float* ns = (float*)(p->ws + WS_TAB_NS);
    const int gtid = bid * NTHR + tid, gstride = G * NTHR;
    for (int i = gtid; i < SEQ * 64; i += gstride) {
        const int pos = i >> 6, f = i & 63;
        const double inv = exp2(-((double)f / 63.0) * 13.287712379549449);
        float s, c; sincos_acc((double)pos * inv, s, c); rc[i] = c; rs[i] = s;
    }
    for (int i = gtid; i < SEQ * 16; i += gstride) {
        const int pos = i >> 4, f = i & 15;
        const double inv = exp2(-((double)f / 16.0) * 18.931568569324174);
        float s, c; sincos_acc((double)pos * inv, s, c); nc[i] = c; ns[i] = s;
    }
}

__device__ __forceinline__ void ph_rmsnorm(const float* x, const float* w, bf16_t* hn, int tid, int bid, int G) {
    asm volatile("" : "+v"(tid));
    const int lane = tid & 63, wave = tid >> 6;
    for (int row = bid * NWAVE + wave; row < MT; row += G * NWAVE) {
        const float* xr = x + (size_t)row * DM;
        f32x4 v[16]; float ss = 0.f;
#pragma unroll
        for (int i = 0; i < 16; ++i) { v[i] = *(const f32x4*)(xr + (i * 64 + lane) * 4); ss += v[i][0] * v[i][0] + v[i][1] * v[i][1] + v[i][2] * v[i][2] + v[i][3] * v[i][3]; }
        ss = wave_sum(ss);
        const float r = 1.0f / sqrtf(ss * (1.0f / DM) + 1e-6f);
#pragma unroll
        for (int i = 0; i < 16; ++i) {
            const f32x4 g = *(const f32x4*)(w + (i * 64 + lane) * 4);
            u32x2 o; o.x = cvt_pk(v[i][0] * r * g[0], v[i][1] * r * g[1]); o.y = cvt_pk(v[i][2] * r * g[2], v[i][3] * r * g[3]);
            *(u32x2*)(hn + (size_t)row * DM + (i * 64 + lane) * 4) = o;
        }
    }
}

__device__ __forceinline__ void ph_mlp_act(KP p, int l, int tid, int bid, int G) {
    asm volatile("" : "+v"(tid), "+s"(p));
    const bf16_t* GU = (const bf16_t*)(p->ws + WS_GU); bf16_t* H = (bf16_t*)(p->ws + WS_H);
    const float* cw = p->in[I_MCW] + (size_t)l * 3 * DFF; const float* cb = p->in[I_MCB] + (size_t)l * DFF;
    constexpr int NFG = DFF / 8, NTG = MT / 8;
    for (int it = bid * NTHR + tid; it < NFG * NTG; it += G * NTHR) {
        const int tg = it / NFG, fg = it - tg * NFG, f0 = fg * 8, t0 = tg * 8;
        float w0[8], w1[8], w2[8], bb[8];
#pragma unroll
        for (int j = 0; j < 8; j += 4) {
            const f32x4 a = *(const f32x4*)(cw + f0 + j), b = *(const f32x4*)(cw + DFF + f0 + j), c = *(const f32x4*)(cw + 2 * DFF + f0 + j), d = *(const f32x4*)(cb + f0 + j);
#pragma unroll
            for (int q = 0; q < 4; ++q) { w0[j + q] = a[q]; w1[j + q] = b[q]; w2[j + q] = c[q]; bb[j + q] = d[q]; }
        }
        float gm2[8], gm1[8];
        const bool first = (t0 & (SEQ - 1)) == 0;
        {
            u32x4 a = (u32x4){0u, 0u, 0u, 0u}, b = (u32x4){0u, 0u, 0u, 0u};
            if (!first) { a = *(const u32x4*)(GU + (size_t)(t0 - 2) * NGU + f0); b = *(const u32x4*)(GU + (size_t)(t0 - 1) * NGU + f0); }
#pragma unroll
            for (int q = 0; q < 4; ++q) { gm2[2 * q] = bflo(a[q]); gm2[2 * q + 1] = bfhi(a[q]); gm1[2 * q] = bflo(b[q]); gm1[2 * q + 1] = bfhi(b[q]); }
        }
#pragma unroll
        for (int i = 0; i < 8; ++i) {
            const u32x4 gv = *(const u32x4*)(GU + (size_t)(t0 + i) * NGU + f0), uv = *(const u32x4*)(GU + (size_t)(t0 + i) * NGU + DFF + f0);
            float g0[8], up[8], hv[8];
#pragma unroll
            for (int q = 0; q < 4; ++q) { g0[2 * q] = bflo(gv[q]); g0[2 * q + 1] = bfhi(gv[q]); up[2 * q] = bflo(uv[q]); up[2 * q + 1] = bfhi(uv[q]); }
#pragma unroll
            for (int j = 0; j < 8; ++j) { const float y = bb[j] + w0[j] * gm2[j] + w1[j] * gm1[j] + w2[j] * g0[j]; hv[j] = y * sigmoidf_(y) * up[j]; gm2[j] = gm1[j]; gm1[j] = g0[j]; }
            u32x4 o; o.x = cvt_pk(hv[0], hv[1]); o.y = cvt_pk(hv[2], hv[3]); o.z = cvt_pk(hv[4], hv[5]); o.w = cvt_pk(hv[6], hv[7]);
            *(u32x4*)(H + (size_t)(t0 + i) * DFF + f0) = o;
        }
    }
}

struct EpiResid {
    static constexpr bool PERM = false, AFTER_DRAIN = false;
    const float* base; float* out; int ldc;
    __device__ __forceinline__ void operator()(const pg8::f32x4 (&acc)[2][2][4][2], const pg8::Unit& u, int wr, int wc, int fr, int fq) const {
        const int row0 = u.pm * 256 + wr * 64 + fr, col0 = u.pn * 256 + wc * 32 + 4 * fq;
#pragma unroll
        for (int ai = 0; ai < 2; ++ai)
#pragma unroll
            for (int m = 0; m < 4; ++m) { const size_t off = (size_t)(row0 + ai * 128 + m * 16) * ldc + col0;
#pragma unroll
                for (int bj = 0; bj < 2; ++bj)
#pragma unroll
                    for (int n = 0; n < 2; ++n) { const pg8::f32x4 bs = *(const pg8::f32x4*)(base + off + bj * 128 + n * 16); *(pg8::f32x4*)(out + off + bj * 128 + n * 16) = bs + acc[ai][bj][m][n]; }
                asm volatile("" ::: "memory"); }
    }
};

__device__ __forceinline__ void ph_xcvt(const float* x, bf16_t* xb, float* rowss, int tid, int bid, int G) {
    asm volatile("" : "+v"(tid));
    const int lane = tid & 63, wave = tid >> 6;
    for (int row = bid * NWAVE + wave; row < MT; row += G * NWAVE) {
        const float* xr = x + (size_t)row * DM;
        float ss = 0.f;
#pragma unroll
        for (int i = 0; i < 16; ++i) { const f32x4 v = *(const f32x4*)(xr + (i * 64 + lane) * 4); ss += v[0] * v[0] + v[1] * v[1] + v[2] * v[2] + v[3] * v[3];
            u32x2 o; o.x = cvt_pk(v[0], v[1]); o.y = cvt_pk(v[2], v[3]); *(u32x2*)(xb + (size_t)row * DM + (i * 64 + lane) * 4) = o; }
        ss = wave_sum(ss);
        rowss[(size_t)lane * MT + row] = (lane == 0) ? ss : 0.f;
    }
}
#ifdef EPI_NT
#define EPI_STORE16(ptr_, v_) __builtin_nontemporal_store((v_), (u32x4*)(ptr_))
#else
#define EPI_STORE16(ptr_, v_) (*(u32x4*)(ptr_) = (v_))
#endif
struct EpiBf16RS {
    static constexpr bool PERM = true, AFTER_DRAIN = false;
    bf16_t* O; int ldc; const LAS float* rt; int rbase;
    __device__ __forceinline__ void operator()(const pg8::f32x4 (&acc)[2][2][4][2], const pg8::Unit& u, int wr, int wc, int fr, int fq) const {
        const int row0 = u.pm * 256 + wr * 64 + fr, col0 = u.pn * 256 + wc * 32 + 8 * fq;
#pragma unroll
        for (int ai = 0; ai < 2; ++ai)
#pragma unroll
            for (int m = 0; m < 4; ++m) { const int row = row0 + ai * 128 + m * 16; const float rs = rt[row - rbase]; bf16_t* rowp = O + (size_t)row * ldc + col0;
#pragma unroll
                for (int bj = 0; bj < 2; ++bj) { const pg8::f32x4 v0 = acc[ai][bj][m][0] * rs, v1 = acc[ai][bj][m][1] * rs;
                    u32x4 w; w.x = cvt_pk(v0[0], v0[1]); w.y = cvt_pk(v0[2], v0[3]); w.z = cvt_pk(v1[0], v1[1]); w.w = cvt_pk(v1[2], v1[3]);
                    EPI_STORE16(rowp + bj * 128, w); } }
    }
};
__device__ __forceinline__ void in_gate_cols(KP p, int row0, const float* rowss, LAS unsigned char* lds, int tid) {
    asm volatile("" : "+v"(tid), "+s"(p));
    const int lane = tid & 63, wave = __builtin_amdgcn_readfirstlane(tid >> 6), hh = lane >> 5, rb = wave & 3, kh = wave >> 2;
    const bf16_t* arow = (const bf16_t*)(p->ws + WS_HN) + (size_t)(row0 + 32 * rb + (lane & 31)) * DM + kh * 2048 + 8 * hh;
    const bf16_t* brow = (const bf16_t*)(p->ws + WS_WIN) + (size_t)(C_NG + (lane & 31)) * DM + kh * 2048 + 8 * hh;
    f32x16 acc;
#pragma unroll
    for (int i = 0; i < 16; ++i) acc[i] = 0.f;
    bf16x8 a0[4], b0[4], a1[4], b1[4];
#pragma unroll
    for (int s8 = 0; s8 < 4; ++s8) { a0[s8] = *(const bf16x8*)(arow + 16 * s8); b0[s8] = *(const bf16x8*)(brow + 16 * s8); }
#pragma unroll 1
    for (int k0 = 0; k0 < 2048; k0 += 128) {
#pragma unroll
        for (int s8 = 0; s8 < 4; ++s8) { a1[s8] = *(const bf16x8*)(arow + k0 + 64 + 16 * s8); b1[s8] = *(const bf16x8*)(brow + k0 + 64 + 16 * s8); }
#pragma unroll
        for (int s8 = 0; s8 < 4; ++s8) acc = __builtin_amdgcn_mfma_f32_32x32x16_bf16(a0[s8], b0[s8], acc, 0, 0, 0);
        if (k0 + 128 < 2048) {
#pragma unroll
            for (int s8 = 0; s8 < 4; ++s8) { a0[s8] = *(const bf16x8*)(arow + k0 + 128 + 16 * s8); b0[s8] = *(const bf16x8*)(brow + k0 + 128 + 16 * s8); }
        }
#pragma unroll
        for (int s8 = 0; s8 < 4; ++s8) acc = __builtin_amdgcn_mfma_f32_32x32x16_bf16(a1[s8], b1[s8], acc, 0, 0, 0);
    }
    __syncthreads();
    LAS float* RED = (LAS float*)lds;
    LAS float* RS = RED + 4 * 16 * 64;
    if (tid < 128) { float t = 0.f;
#pragma unroll 16
        for (int i = 0; i < 64; ++i) t += rowss[(size_t)i * MT + row0 + tid];
        RS[tid] = 1.0f / sqrtf(t * (1.0f / DM) + 1e-6f); }
    if (kh == 1) {
#pragma unroll
        for (int r = 0; r < 16; ++r) RED[(rb * 16 + r) * 64 + lane] = acc[r];
    }
    __syncthreads();
    if (kh == 0) {
        bf16_t* PROJ = (bf16_t*)(p->ws + WS_PROJ);
        const int n = lane & 31;
#pragma unroll
        for (int r = 0; r < 16; ++r) {
            const int rl = 32 * rb + (r & 3) + 8 * (r >> 2) + 4 * hh;
            const float v = (acc[r] + RED[(rb * 16 + r) * 64 + lane]) * RS[rl];
            if (n < 24) PROJ[(size_t)(row0 + rl) * NINP + C_NG + n] = f2bf(v);
        }
    }
    __syncthreads();
}
struct EpiResid2 {
    static constexpr bool PERM = false, AFTER_DRAIN = false;
    const float* base; float* out; bf16_t* xb; float* rowss; int ldc; int wx;
    __device__ __forceinline__ void operator()(const pg8::f32x4 (&acc)[2][2][4][2], const pg8::Unit& u, int wr, int wc, int fr, int fq) const {
        const int row0 = u.pm * 256 + wr * 64 + fr, col0 = u.pn * 256 + wc * 32 + 4 * fq;
#pragma unroll
        for (int ai = 0; ai < 2; ++ai)
#pragma unroll
            for (int m = 0; m < 4; ++m) { const int row = row0 + ai * 128 + m * 16; const size_t off = (size_t)row * ldc + col0; float ss = 0.f;
#pragma unroll
                for (int bj = 0; bj < 2; ++bj)
#pragma unroll
                    for (int n = 0; n < 2; ++n) { const pg8::f32x4 bs = *(const pg8::f32x4*)(base + off + bj * 128 + n * 16); const pg8::f32x4 o = bs + acc[ai][bj][m][n];
                        *(pg8::f32x4*)(out + off + bj * 128 + n * 16) = o;
                        if (wx) { u32x2 w; w.x = cvt_pk(o[0], o[1]); w.y = cvt_pk(o[2], o[3]); *(u32x2*)(xb + off + bj * 128 + n * 16) = w; ss += (o[0] * o[0] + o[1] * o[1]) + (o[2] * o[2] + o[3] * o[3]); } }
                if (wx) { ss += __shfl_xor(ss, 16); ss += __shfl_xor(ss, 32); if (fq == 0) rowss[(size_t)(u.pn * 4 + wc) * MT + row] = ss; }
                asm volatile("" ::: "memory"); }
    }
};

template <class Sched> __device__ __forceinline__ int fill_rstd_table(const Sched& S, const float* rowss, LAS float* rt, int tid) {
    int lo = 1 << 30, hi = -1; pg8::Unit u;
    for (int i = 0; S.next(i, u); ++i) { lo = u.pm < lo ? u.pm : lo; hi = u.pm > hi ? u.pm : hi; }
    if (hi < 0) return 0;
    int n = (hi - lo + 1) * 256; if (n > RT_PANELS * 256) n = RT_PANELS * 256;
    for (int r4 = tid * 4; r4 < n; r4 += NTHR * 4) {
        const float* s = rowss + (size_t)lo * 256 + r4; f32x4 t = (f32x4){0.f, 0.f, 0.f, 0.f};
#pragma unroll 16
        for (int i = 0; i < 64; ++i) t += *(const f32x4*)(s + (size_t)i * MT);
#pragma unroll
        for (int q = 0; q < 4; ++q) rt[r4 + q] = 1.0f / sqrtf(t[q] * (1.0f / DM) + 1e-6f);
    }
    __syncthreads();
    return lo * 256;
}

__device__ __forceinline__ float dpp_ror1(float v) { return __int_as_float(__builtin_amdgcn_update_dpp(0, __float_as_int(v), 0x121, 0xf, 0xf, false)); }
__device__ __forceinline__ float dpp_ror2(float v) { return __int_as_float(__builtin_amdgcn_update_dpp(0, __float_as_int(v), 0x122, 0xf, 0xf, false)); }
struct EpiGateUp {
    static constexpr bool PERM = true, AFTER_DRAIN = false;
    bf16_t* H; const LAS float* rt; int rbase; const float* cw; const float* cb; bf16_t* GT; bf16_t* GH; bf16_t* UH;
    __device__ __forceinline__ void operator()(const pg8::f32x4 (&acc)[2][2][4][2], const pg8::Unit& u, int wr, int wc, int fr, int fq) const {
        const int f0 = u.pn * 128 + wc * 32 + 8 * fq;
        float w0[8], w1[8], w2[8], bb[8];
#pragma unroll
        for (int j = 0; j < 8; j += 4) {
            const f32x4 a = *(const f32x4*)(cw + f0 + j), b = *(const f32x4*)(cw + DFF + f0 + j), c = *(const f32x4*)(cw + 2 * DFF + f0 + j), d = *(const f32x4*)(cb + f0 + j);
#pragma unroll
            for (int q = 0; q < 4; ++q) { w0[j + q] = a[q]; w1[j + q] = b[q]; w2[j + q] = c[q]; bb[j + q] = d[q]; }
        }
#pragma unroll
        for (int ai = 0; ai < 2; ++ai) {
            const int c64 = u.pm * 4 + ai * 2 + wr;
            float gp[8];
#pragma unroll
            for (int j = 0; j < 8; ++j) gp[j] = 0.f;
#pragma unroll
            for (int m = 0; m < 4; ++m) {
                const int row = u.pm * 256 + ai * 128 + wr * 64 + m * 16 + fr;
                const float rs = rt[row - rbase];
                float g[8], uu[8], hv[8];
#pragma unroll
                for (int j = 0; j < 8; ++j) { g[j] = acc[ai][0][m][j >> 2][j & 3] * rs; uu[j] = acc[ai][1][m][j >> 2][j & 3] * rs; }
#pragma unroll
                for (int j = 0; j < 8; ++j) {
                    const float a1 = dpp_ror1(g[j]), a2 = dpp_ror2(g[j]), b1 = dpp_ror1(gp[j]), b2 = dpp_ror2(gp[j]);
                    const float g1 = (fr >= 1) ? a1 : b1, g2 = (fr >= 2) ? a2 : b2;
                    const float y = bb[j] + w0[j] * g2 + w1[j] * g1 + w2[j] * g[j];
                    hv[j] = y * sigmoidf_(y) * uu[j];
                }
                u32x4 hw; hw.x = cvt_pk(hv[0], hv[1]); hw.y = cvt_pk(hv[2], hv[3]); hw.z = cvt_pk(hv[4], hv[5]); hw.w = cvt_pk(hv[6], hv[7]);
                if (m > 0 || fr >= 2) EPI_STORE16(H + (size_t)row * DFF + f0, hw);
                if ((m == 0 && fr < 2) || (m == 3 && fr >= 14)) {
                    u32x4 gw; gw.x = cvt_pk(g[0], g[1]); gw.y = cvt_pk(g[2], g[3]); gw.z = cvt_pk(g[4], g[5]); gw.w = cvt_pk(g[6], g[7]);
                    if (m == 0) { u32x4 uw; uw.x = cvt_pk(uu[0], uu[1]); uw.y = cvt_pk(uu[2], uu[3]); uw.z = cvt_pk(uu[4], uu[5]); uw.w = cvt_pk(uu[6], uu[7]);
                        *(u32x4*)(GH + ((size_t)c64 * 2 + fr) * DFF + f0) = gw; *(u32x4*)(UH + ((size_t)c64 * 2 + fr) * DFF + f0) = uw; }
                    else *(u32x4*)(GT + ((size_t)c64 * 2 + (fr - 14)) * DFF + f0) = gw;
                }
#pragma unroll
                for (int j = 0; j < 8; ++j) gp[j] = g[j];
            }
        }
    }
};
__device__ __forceinline__ void ph_mlp_fix(KP p, int l, int tid, int bid, int G) {
    asm volatile("" : "+v"(tid), "+s"(p));
    const bf16_t* GT = (const bf16_t*)(p->ws + WS_GT); const bf16_t* GH = (const bf16_t*)(p->ws + WS_GH); const bf16_t* UH = (const bf16_t*)(p->ws + WS_UH); bf16_t* H = (bf16_t*)(p->ws + WS_H);
    const float* cw = p->in[I_MCW] + (size_t)l * 3 * DFF; const float* cb = p->in[I_MCB] + (size_t)l * DFF;
    constexpr int NFG = DFF / 8;
    for (int it = bid * NTHR + tid; it < NFG * 256; it += G * NTHR) {
        const int c64 = it / NFG, fg = it - c64 * NFG, f0 = fg * 8;
        float w0[8], w1[8], w2[8], bb[8], gm2[8], gm1[8], g0[8], g1[8], u0[8], u1[8], h0[8], h1[8];
        ld8f(cw + f0, w0); ld8f(cw + DFF + f0, w1); ld8f(cw + 2 * DFF + f0, w2); ld8f(cb + f0, bb);
        if ((c64 & 63) == 0) {
#pragma unroll
            for (int j = 0; j < 8; ++j) { gm2[j] = 0.f; gm1[j] = 0.f; }
        } else { unpack8(*(const u32x4*)(GT + ((size_t)(c64 - 1) * 2 + 0) * DFF + f0), gm2); unpack8(*(const u32x4*)(GT + ((size_t)(c64 - 1) * 2 + 1) * DFF + f0), gm1); }
        unpack8(*(const u32x4*)(GH + ((size_t)c64 * 2 + 0) * DFF + f0), g0); unpack8(*(const u32x4*)(GH + ((size_t)c64 * 2 + 1) * DFF + f0), g1);
        unpack8(*(const u32x4*)(UH + ((size_t)c64 * 2 + 0) * DFF + f0), u0); unpack8(*(const u32x4*)(UH + ((size_t)c64 * 2 + 1) * DFF + f0), u1);
#pragma unroll
        for (int j = 0; j < 8; ++j) {
            const float y0 = bb[j] + w0[j] * gm2[j] + w1[j] * gm1[j] + w2[j] * g0[j], y1 = bb[j] + w0[j] * gm1[j] + w1[j] * g0[j] + w2[j] * g1[j];
            h0[j] = y0 * sigmoidf_(y0) * u0[j]; h1[j] = y1 * sigmoidf_(y1) * u1[j];
        }
        *(u32x4*)(H + (size_t)(c64 * 64) * DFF + f0) = pack8f(h0); *(u32x4*)(H + (size_t)(c64 * 64 + 1) * DFF + f0) = pack8f(h1);
    }
}

struct EpiResid3 {
    static constexpr bool PERM = true, AFTER_DRAIN = false;
    const float* basef; bf16_t* xb; float* outf; float* rowss; int dry = 0;
    __device__ __forceinline__ void operator()(const pg8::f32x4 (&acc)[2][2][4][2], const pg8::Unit& u, int wr, int wc, int fr, int fq) const {
        const int row0 = u.pm * 256 + wr * 64 + fr, col0 = u.pn * 256 + wc * 32 + 8 * fq;
#pragma unroll
        for (int ai = 0; ai < 2; ++ai) {
            u32x4 bw[4][2];
            if (!basef) {
#pragma unroll
                for (int m = 0; m < 4; ++m) { const size_t off = (size_t)(row0 + ai * 128 + m * 16) * DM + col0;
#pragma unroll
                    for (int bj = 0; bj < 2; ++bj) bw[m][bj] = *(const u32x4*)(xb + off + bj * 128); }
            }
#pragma unroll
            for (int m = 0; m < 4; ++m) { const int row = row0 + ai * 128 + m * 16; const size_t off = (size_t)row * DM + col0; float ss = 0.f;
#pragma unroll
                for (int bj = 0; bj < 2; ++bj) {
                    float x[8];
                    if (basef) ld8f(basef + off + bj * 128, x); else unpack8(bw[m][bj], x);
#pragma unroll
                    for (int j = 0; j < 8; ++j) { x[j] += acc[ai][bj][m][j >> 2][j & 3]; ss += x[j] * x[j]; }
                    if (outf) { *(f32x4*)(outf + off + bj * 128) = (f32x4){x[0], x[1], x[2], x[3]}; *(f32x4*)(outf + off + bj * 128 + 4) = (f32x4){x[4], x[5], x[6], x[7]}; }
                    if (!outf) *(u32x4*)(xb + off + bj * 128) = pack8f(x);
                }
                if (!outf) { ss += __shfl_xor(ss, 16); ss += __shfl_xor(ss, 32); if (fq == 0) rowss[(size_t)(u.pn * 4 + wc) * MT + row] = ss; }
            }
        }
    }
};

__device__ __forceinline__ void ph_prep_elem(KP p, int l, int tid, int bid, int G) {
    asm volatile("" : "+v"(tid), "+s"(p));
    const int lane = tid & 63, wave = tid >> 6, hi = lane >> 3, j = lane & 7;
    const bf16_t* PROJ = (const bf16_t*)(p->ws + WS_PROJ);
    const float* rc = (const float*)(p->ws + WS_TAB_RC); const float* rs = (const float*)(p->ws + WS_TAB_RS); const float* nc = (const float*)(p->ws + WS_TAB_NC); const float* ns = (const float*)(p->ws + WS_TAB_NS);
    for (int it = bid * NWAVE + wave; it < MT * 2; it += G * NWAVE) {
        const int tok = it >> 1, grp = (it & 1) ? 3 : 1, b = tok >> 12, s = tok & (SEQ - 1);
        const bf16_t* prow = PROJ + (size_t)tok * NINP;
        if (grp < 2) {
            const int h = hi;
            const bf16_t* src = prow + (grp ? C_RK : C_RQ) + h * 128 + 8 * j;
            float x1[8], x2[8], c[8], sn[8];
            unpack8(*(const u32x4*)src, x1); unpack8(*(const u32x4*)(src + 64), x2);
            ld8f(rc + s * 64 + 8 * j, c); ld8f(rs + s * 64 + 8 * j, sn);
            const float lg2 = log2f(1.0f - exp2f(-5.0f - (float)h));
            const float e = (float)((s & 127) + 1) * lg2;
            const float d = grp ? fexp2(-e) * 0.08838834764831845f : fexp2(e);
            float o1[8], o2[8];
#pragma unroll
            for (int i = 0; i < 8; ++i) { o1[i] = (x1[i] * c[i] - x2[i] * sn[i]) * d; o2[i] = (x2[i] * c[i] + x1[i] * sn[i]) * d; }
            bf16_t* dst = (bf16_t*)(p->ws + (grp ? WS_KR : WS_QR)) + ((size_t)(b * 8 + h) * SEQ + s) * 128 + 8 * j;
            *(u32x4*)dst = pack8f(o1); *(u32x4*)(dst + 64) = pack8f(o2);
        } else {
            int col; const float* w; bf16_t* dst; bool act = true;
            if (grp == 2) { col = C_NQ + hi * 128; w = p->in[I_NQW] + (size_t)l * 128; dst = (bf16_t*)(p->ws + WS_QN) + ((size_t)(b * 8 + hi) * SEQ + s) * 128; }
            else if (hi < 2) { col = C_NKS + hi * 128; w = p->in[I_NKW] + (size_t)l * 3 * 128 + 128; dst = (bf16_t*)(p->ws + WS_KSN) + ((size_t)(b * 2 + hi) * SEQ + s) * 128; }
            else if (hi < 4) { col = C_NKW + (hi - 2) * 128; w = p->in[I_NKW] + (size_t)l * 3 * 128 + 256; dst = (bf16_t*)(p->ws + WS_KWN) + ((size_t)(b * 2 + hi - 2) * SEQ + s) * 128; }
            else { act = false; col = C_NQ; w = p->in[I_NQW]; dst = (bf16_t*)(p->ws + WS_QN); }
            float x1[8], x2[8], w1[8], w2[8];
            unpack8(*(const u32x4*)(prow + col + 8 * j), x1); unpack8(*(const u32x4*)(prow + col + 64 + 8 * j), x2);
            ld8f(w + 8 * j, w1); ld8f(w + 64 + 8 * j, w2);
            float ss = 0.f;
#pragma unroll
            for (int i = 0; i < 8; ++i) ss += x1[i] * x1[i] + x2[i] * x2[i];
            ss += __shfl_xor(ss, 1); ss += __shfl_xor(ss, 2); ss += __shfl_xor(ss, 4);
            const float r = 1.0f / sqrtf(ss * (1.0f / 128.0f) + 1e-6f);
            const float qs = (grp == 2) ? 0.08838834764831845f * 1.4426950408889634f : 1.0f;
            float c[8], sn[8], y1[8], y2[8], pr[8];
            ld8f(nc + s * 16 + 8 * (j & 1), c); ld8f(ns + s * 16 + 8 * (j & 1), sn);
#pragma unroll
            for (int i = 0; i < 8; ++i) { y1[i] = x1[i] * (r * qs) * w1[i]; y2[i] = x2[i] * (r * qs) * w2[i]; }
#pragma unroll
            for (int i = 0; i < 8; ++i) pr[i] = __shfl_xor(y1[i], 2);
            if (j < 4) {
#pragma unroll
                for (int i = 0; i < 8; ++i) y1[i] = (j < 2) ? (y1[i] * c[i] - pr[i] * sn[i]) : (y1[i] * c[i] + pr[i] * sn[i]);
            }
            if (act) { *(u32x4*)(dst + 8 * j) = pack8f(y1); *(u32x4*)(dst + 64 + 8 * j) = pack8f(y2); }
        }
    }
}

__device__ __forceinline__ void lru_c1_task(KP p, int l, int task, LAS unsigned char* lds, int tid) {
    asm volatile("" : "+v"(tid), "+s"(p));
    const int lane = tid & 63, wave = __builtin_amdgcn_readfirstlane(tid >> 6), hh = lane >> 5;
    const int grp = task & 15, n = (task >> 4) & 7, b = task >> 7;
    const bf16_t* PROJ = (const bf16_t*)(p->ws + WS_PROJ);
    LAS unsigned char* XB = lds;
    LAS float* AA = (LAS float*)lds;
    LAS float* X32 = (LAS float*)(lds + 32768);
    LAS unsigned char* WA = lds + 65536;
    LAS unsigned char* WX = lds + 98304;
    LAS float* SM = (LAS float*)(lds + LDS_STAGE + LDS_CTL);
    LAS float* CH = SM; LAS float* CP = SM + 128; LAS float* SH = SM + 256; LAS float* SP = SM + 768;
    tile_stage<128>(WA, (const bf16_t*)(p->ws + WS_LWA) + (size_t)n * 128 * 128, 128, tid);
    tile_stage<128>(WX, (const bf16_t*)(p->ws + WS_LWX) + (size_t)n * 128 * 128, 128, tid);
    if (tid < 128) { CH[tid] = 0.f; CP[tid] = 1.f; }
    const int tb = wave >> 2, db = wave & 3, dd = 32 * db + (lane & 31), chd = n * 128 + dd;
    const float ba = p->in[I_LBA][(size_t)l * 1024 + chd], bx = p->in[I_LBX][(size_t)l * 1024 + chd], lam = p->in[I_LLAM][(size_t)l * 1024 + chd];
    const float lsl = fminf(lam, 0.f) - log1pf(expf(-fabsf(lam)));
    const int ctt = tid >> 3, cc0 = (tid & 7) * 16, cch0 = n * 128 + cc0;
    float cwr[4][16], cbr[16];
    {
        const float* cw = p->in[I_LCW] + (size_t)l * 4 * 1024; const float* cb = p->in[I_LCB] + (size_t)l * 1024;
#pragma unroll
        for (int j = 0; j < 16; j += 4) { const f32x4 v = *(const f32x4*)(cb + cch0 + j); cbr[j] = v[0]; cbr[j + 1] = v[1]; cbr[j + 2] = v[2]; cbr[j + 3] = v[3]; }
#pragma unroll
        for (int k = 0; k < 4; ++k)
#pragma unroll
            for (int j = 0; j < 16; j += 4) { const f32x4 v = *(const f32x4*)(cw + k * 1024 + cch0 + j); cwr[k][j] = v[0]; cwr[k][j + 1] = v[1]; cwr[k][j + 2] = v[2]; cwr[k][j + 3] = v[3]; }
    }
    u32x4 rw[4][2];
#define C1_LOADROWS(s0_) do { _Pragma("unroll") for (int k = 0; k < 4; ++k) { const int s_ = (s0_) + ctt - 3 + k; rw[k][0] = (u32x4){0u, 0u, 0u, 0u}; rw[k][1] = (u32x4){0u, 0u, 0u, 0u}; \
        if (s_ >= 0) { const bf16_t* src = PROJ + (size_t)(b * SEQ + s_) * NINP + C_LR + cch0; rw[k][0] = *(const u32x4*)src; rw[k][1] = *(const u32x4*)(src + 8); } } } while (0)
    C1_LOADROWS(grp * 4 * 64);
    for (int ck = 0; ck < 4; ++ck) {
        const int s0 = (grp * 4 + ck) * 64;
        __syncthreads();
        {
            float acc[16];
#pragma unroll
            for (int j = 0; j < 16; ++j) acc[j] = cbr[j];
#pragma unroll
            for (int k = 0; k < 4; ++k)
#pragma unroll
                for (int j = 0; j < 16; j += 2) { const unsigned w = rw[k][j >> 3][(j >> 1) & 3]; acc[j] += cwr[k][j] * bflo(w); acc[j + 1] += cwr[k][j + 1] * bfhi(w); }
            if (ck + 1 < 4) C1_LOADROWS(s0 + 64);
#pragma unroll
            for (int j = 0; j < 16; j += 4) *(LAS f32x4*)(X32 + ctt * 128 + cc0 + j) = (f32x4){acc[j], acc[j + 1], acc[j + 2], acc[j + 3]};
            u32x4 o0, o1;
            o0.x = cvt_pk(acc[0], acc[1]); o0.y = cvt_pk(acc[2], acc[3]); o0.z = cvt_pk(acc[4], acc[5]); o0.w = cvt_pk(acc[6], acc[7]);
            o1.x = cvt_pk(acc[8], acc[9]); o1.y = cvt_pk(acc[10], acc[11]); o1.z = cvt_pk(acc[12], acc[13]); o1.w = cvt_pk(acc[14], acc[15]);
            *(LAS u32x4*)(XB + off_b((unsigned)ctt, (unsigned)(cc0 >> 3))) = o0; *(LAS u32x4*)(XB + off_b((unsigned)ctt, (unsigned)(cc0 >> 3) + 1u)) = o1;
        }
        __syncthreads();
        f32x16 ca, cx;
#pragma unroll
        for (int i = 0; i < 16; ++i) { ca[i] = 0.f; cx[i] = 0.f; }
#pragma unroll
        for (int s = 0; s < 8; ++s) {
            const bf16x8 a = row_frag(XB, 32 * tb, s, lane);
            bf16x8 bfa, bfx; tr_frag_nat2(WA, WX, db, s, lane, bfa, bfx);
            ca = __builtin_amdgcn_mfma_f32_32x32x16_bf16(a, bfa, ca, 0, 0, 0);
            cx = __builtin_amdgcn_mfma_f32_32x32x16_bf16(a, bfx, cx, 0, 0, 0);
        }
        __syncthreads();
#pragma unroll
        for (int r = 0; r < 16; ++r) {
            const int tok = 32 * tb + (r & 3) + 8 * (r >> 2) + 4 * hh;
            const float rg = sigmoidf_(ca[r] + ba), ig = sigmoidf_(cx[r] + bx);
            const float la = 8.0f * rg * lsl;
            const float a = expf(la);
            const float x2 = 2.0f * la;
            const float em1 = (x2 > -0.1f) ? x2 * (1.f + x2 * 0.5f * (1.f + x2 * (1.f / 3.f) * (1.f + x2 * 0.25f * (1.f + x2 * 0.2f)))) : (expf(x2) - 1.0f);
            float mult = sqrtf(fmaxf(-em1, 0.f));
            if (s0 + tok == 0) mult = 1.0f;
            AA[tok * 128 + dd] = a; X32[tok * 128 + dd] = mult * ig * X32[tok * 128 + dd];
        }
        __syncthreads();
        {
            const int ch = tid & 127, seg = tid >> 7;
            float hl[16], pl[16]; float h = 0.f, P = 1.f;
#pragma unroll
            for (int t = 0; t < 16; ++t) { const float a = AA[(16 * seg + t) * 128 + ch], u = X32[(16 * seg + t) * 128 + ch]; h = a * h + u; P *= a; hl[t] = h; pl[t] = P; }
            SH[seg * 128 + ch] = h; SP[seg * 128 + ch] = P;
            __syncthreads();
            float Hin = CH[ch], Pin = CP[ch];
#pragma unroll
            for (int s2 = 0; s2 < 3; ++s2) if (s2 < seg) { const float sp = SP[s2 * 128 + ch]; Hin = sp * Hin + SH[s2 * 128 + ch]; Pin *= sp; }
            bf16_t* hlg = (bf16_t*)(p->ws + WS_HLOC) + (size_t)(b * SEQ + s0 + 16 * seg) * 1024 + n * 128 + ch;
            bf16_t* cug = (bf16_t*)(p->ws + WS_CUMA) + (size_t)(b * SEQ + s0 + 16 * seg) * 1024 + n * 128 + ch;
            float hlast = 0.f, plast = 0.f;
#pragma unroll
            for (int t = 0; t < 16; ++t) { hlast = hl[t] + pl[t] * Hin; plast = pl[t] * Pin; hlg[(size_t)t * 1024] = f2bf(hlast); cug[(size_t)t * 1024] = f2bf(plast); }
            __syncthreads();
            if (seg == 3) { CH[ch] = hlast; CP[ch] = plast; }
        }
    }
#undef C1_LOADROWS
}

__device__ __forceinline__ void lru_c3_task(KP p, int task, LAS unsigned char* lds, int tid) {
    asm volatile("" : "+v"(tid), "+s"(p));
    const int grp = task & 15, n = (task >> 4) & 7, b = task >> 7, s0 = grp * 256;
    const bf16_t* HL = (const bf16_t*)(p->ws + WS_HLOC); const bf16_t* CU = (const bf16_t*)(p->ws + WS_CUMA);
    const bf16_t* PROJ = (const bf16_t*)(p->ws + WS_PROJ); bf16_t* MIX = (bf16_t*)(p->ws + WS_MIX);
    LAS float* Hin = (LAS float*)lds;
    if (tid < 128) {
        float H = 0.f;
        const size_t base = (size_t)(b * SEQ + 255) * 1024 + n * 128 + tid;
        unsigned short av[15], hv[15];
#pragma unroll
        for (int c = 0; c < 15; ++c) { av[c] = CU[base + (size_t)c * 256 * 1024]; hv[c] = HL[base + (size_t)c * 256 * 1024]; }
#pragma unroll
        for (int c = 0; c < 15; ++c) { const float hn = bf2f(av[c]) * H + bf2f(hv[c]); H = (c < grp) ? hn : H; }
        Hin[tid] = H;
    }
    __syncthreads();
    const int c4 = (tid & 31) * 4;
    const f32x4 hin = *(const LAS f32x4*)(Hin + c4);
#pragma unroll 4
    for (int i = 0; i < 16; ++i) {
        const int tok = (tid >> 5) + 16 * i;
        const size_t row = (size_t)(b * SEQ + s0 + tok);
        const u32x2 hlw = *(const u32x2*)(HL + row * 1024 + n * 128 + c4), cuw = *(const u32x2*)(CU + row * 1024 + n * 128 + c4);
        const f32x4 hl = (f32x4){bflo(hlw.x), bfhi(hlw.x), bflo(hlw.y), bfhi(hlw.y)}, cu = (f32x4){bflo(cuw.x), bfhi(cuw.x), bflo(cuw.y), bfhi(cuw.y)};
        const u32x2 gv = *(const u32x2*)(PROJ + row * NINP + C_LG + n * 128 + c4);
        const float g0 = bflo(gv.x), g1 = bfhi(gv.x), g2 = bflo(gv.y), g3 = bfhi(gv.y);
        u32x2 o; o.x = cvt_pk((hl[0] + cu[0] * hin[0]) * gelu_tanh(g0), (hl[1] + cu[1] * hin[1]) * gelu_tanh(g1));
        o.y = cvt_pk((hl[2] + cu[2] * hin[2]) * gelu_tanh(g2), (hl[3] + cu[3] * hin[3]) * gelu_tanh(g3));
        *(u32x2*)(MIX + row * DM + MIX_LRU + n * 128 + c4) = o;
    }
}

__device__ __forceinline__ void tr_nat4(const LAS unsigned char* tile, int ks, int lane, bf16x8 (&f)[4]) {
    const unsigned b = lds_addr(tile);
    s16x4 d0, d1, d2, d3, d4, d5, d6, d7;
    asm volatile("ds_read_b64_tr_b16 %0, %8\n\tds_read_b64_tr_b16 %1, %9\n\tds_read_b64_tr_b16 %2, %10\n\tds_read_b64_tr_b16 %3, %11\n\t"
                 "ds_read_b64_tr_b16 %4, %12\n\tds_read_b64_tr_b16 %5, %13\n\tds_read_b64_tr_b16 %6, %14\n\tds_read_b64_tr_b16 %7, %15\n\ts_waitcnt lgkmcnt(0)"
                 : "=&v"(d0), "=&v"(d1), "=&v"(d2), "=&v"(d3), "=&v"(d4), "=&v"(d5), "=&v"(d6), "=&v"(d7)
                 : "v"(b + tr_off_nat(lane, 0, ks, 0)), "v"(b + tr_off_nat(lane, 0, ks, 1)), "v"(b + tr_off_nat(lane, 1, ks, 0)), "v"(b + tr_off_nat(lane, 1, ks, 1)),
                   "v"(b + tr_off_nat(lane, 2, ks, 0)), "v"(b + tr_off_nat(lane, 2, ks, 1)), "v"(b + tr_off_nat(lane, 3, ks, 0)), "v"(b + tr_off_nat(lane, 3, ks, 1)) : "memory");
    f[0] = __builtin_shufflevector(d0, d1, 0, 1, 2, 3, 4, 5, 6, 7); f[1] = __builtin_shufflevector(d2, d3, 0, 1, 2, 3, 4, 5, 6, 7);
    f[2] = __builtin_shufflevector(d4, d5, 0, 1, 2, 3, 4, 5, 6, 7); f[3] = __builtin_shufflevector(d6, d7, 0, 1, 2, 3, 4, 5, 6, 7);
}
__device__ __forceinline__ void cmp_task(KP p, int l, int task, LAS unsigned char* lds, int tid) {
    asm volatile("" : "+v"(tid), "+s"(p));
    const int lane = tid & 63, wave = __builtin_amdgcn_readfirstlane(tid >> 6), hh = lane >> 5;
    const int rh = task & 1, bg = (task >> 1) & 7, kv = task >> 4, b = bg >> 1, g = bg & 1, n0 = rh * 128;
    const bf16_t* PROJ = (const bf16_t*)(p->ws + WS_PROJ);
    const bf16_t* W1 = (const bf16_t*)(p->ws + WS_CW1) + (size_t)kv * 4096 * 256;
    const bf16_t* W2 = (const bf16_t*)(p->ws + WS_CW2) + (size_t)kv * 256 * 128;
    const int col = (kv ? C_NVC : C_NKC) + g * 128;
    const int rb = wave & 3, kh = wave >> 2, hc = kh, nrow = n0 + 32 * rb + (lane & 31);
    const bool rowok = nrow < 255;
    const bf16_t* arow = PROJ + (size_t)(b * SEQ + 16 * (rowok ? nrow : 0)) * NINP + col + 64 * kh + 8 * hh;
    f32x16 ac8[8];
#pragma unroll
    for (int c = 0; c < 8; ++c)
#pragma unroll
        for (int i = 0; i < 16; ++i) ac8[c][i] = 0.f;
#define CMP_ISSUE(li_, buf_) do { _Pragma("unroll") for (int hf = 0; hf < 2; ++hf) _Pragma("unroll") for (int rr = 0; rr < 2; ++rr) \
        tile_dma64(lds + (buf_) * 65536 + hf * 32768 + rr * 16384, W1 + (size_t)((li_) * 128 + rr * 64) * 256 + hf * 128, 256, tid, wave); } while (0)
    bf16x8 af[4], an[4];
    CMP_ISSUE(0, 0);
#pragma unroll
    for (int s = 0; s < 4; ++s) af[s] = *(const bf16x8*)(arow + 16 * s);
    asm volatile("s_waitcnt vmcnt(0)" ::: "memory");
    __syncthreads();
    for (int li = 0; li < 32; ++li) {
        const int buf = li & 1;
        if (li + 1 < 32) {
            CMP_ISSUE(li + 1, buf ^ 1);
#pragma unroll
            for (int s = 0; s < 4; ++s) an[s] = *(const bf16x8*)(arow + (size_t)(li + 1) * NINP + 16 * s);
        }
        int lane_o = lane; asm volatile("" : "+v"(lane_o));
#pragma unroll
        for (int hf = 0; hf < 2; ++hf) {
            const LAS unsigned char* Bt = lds + buf * 65536 + hf * 32768;
#pragma unroll
            for (int s = 0; s < 4; ++s) {
                bf16x8 bf[4]; tr_nat4(Bt, 4 * kh + s, lane_o, bf);
#pragma unroll
                for (int c = 0; c < 4; ++c) ac8[4 * hf + c] = __builtin_amdgcn_mfma_f32_32x32x16_bf16(af[s], bf[c], ac8[4 * hf + c], 0, 0, 0);
            }
        }
        if (li + 1 < 32) {
            asm volatile("s_waitcnt vmcnt(0)" ::: "memory");
#pragma unroll
            for (int s = 0; s < 4; ++s) af[s] = an[s];
            __syncthreads();
        }
    }
#undef CMP_ISSUE
    __syncthreads();
    f32x16 acc[4];
    {
        LAS float* EX = (LAS float*)lds;
        if (kh == 0) {
#pragma unroll
            for (int c = 0; c < 4; ++c)
#pragma unroll
                for (int r = 0; r < 16; ++r) EX[((wave * 4 + c) * 16 + r) * 64 + lane] = ac8[4 + c][r];
        } else {
#pragma unroll
            for (int c = 0; c < 4; ++c)
#pragma unroll
                for (int r = 0; r < 16; ++r) EX[((wave * 4 + c) * 16 + r) * 64 + lane] = ac8[c][r];
        }
        __syncthreads();
        const int pw = wave ^ 4;
        if (kh == 0) {
#pragma unroll
            for (int c = 0; c < 4; ++c)
#pragma unroll
                for (int r = 0; r < 16; ++r) acc[c][r] = ac8[c][r] + EX[((pw * 4 + c) * 16 + r) * 64 + lane];
        } else {
#pragma unroll
            for (int c = 0; c < 4; ++c)
#pragma unroll
                for (int r = 0; r < 16; ++r) acc[c][r] = ac8[4 + c][r] + EX[((pw * 4 + c) * 16 + r) * 64 + lane];
        }
        __syncthreads();
    }
    LAS unsigned char* HI = lds;
    LAS unsigned char* W2I = lds + 65536;
#pragma unroll
    for (int hf = 0; hf < 2; ++hf)
#pragma unroll
        for (int rr = 0; rr < 2; ++rr) tile_dma64(W2I + hf * 32768 + rr * 16384, W2 + (size_t)(hf * 128 + rr * 64) * 128, 128, tid, wave);
    {
        const float* cp = (const float*)(p->ws + WS_CPOS) + kv * 256 + hc * 128;
        LAS unsigned char* Ht = HI + hc * 32768;
#pragma unroll
        for (int c = 0; c < 4; ++c) {
            const int cc = 32 * c + (lane & 31); const float cpv = cp[cc];
#pragma unroll
            for (int r = 0; r < 16; ++r) {
                const int n = 32 * rb + (r & 3) + 8 * (r >> 2) + 4 * hh;
                const bool ok = n0 + n < 255;
                *(LAS unsigned short*)(Ht + off_b((unsigned)n, (unsigned)(cc >> 3)) + 2 * (cc & 7)) = ok ? f2bf(gelu_tanh(acc[c][r] + cpv)) : (unsigned short)0;
            }
        }
    }
    asm volatile("s_waitcnt vmcnt(0)" ::: "memory");
    __syncthreads();
    {
        const int nb = wave & 3, dh = wave >> 2;
        f32x16 o[2];
#pragma unroll
        for (int q = 0; q < 2; ++q) {
#pragma unroll
            for (int i = 0; i < 16; ++i) o[q][i] = 0.f;
#pragma unroll
            for (int ks = 0; ks < 16; ++ks)
                o[q] = __builtin_amdgcn_mfma_f32_32x32x16_bf16(tr_frag_nat(W2I + (ks >> 3) * 32768, 2 * dh + q, ks & 7, lane), row_frag(HI + (ks >> 3) * 32768, 32 * nb, ks & 7, lane), o[q], 0, 0, 0);
        }
        const int n = n0 + 32 * nb + (lane & 31);
        bf16_t* dst = (bf16_t*)(p->ws + (kv ? WS_VCMP : WS_KCMP)) + ((size_t)bg * 256 + n) * 128;
        if (kv == 0) {
            LAS float* SS = (LAS float*)(lds + LDS_STAGE + LDS_CTL);
            float ss = 0.f;
#pragma unroll
            for (int q = 0; q < 2; ++q)
#pragma unroll
                for (int r = 0; r < 16; ++r) ss += o[q][r] * o[q][r];
            ss = half_sum(ss);
            if (hh == 0) SS[dh * 128 + 32 * nb + (lane & 31)] = ss;
            __syncthreads();
            const float tot = SS[32 * nb + (lane & 31)] + SS[128 + 32 * nb + (lane & 31)];
            const float rn = 1.0f / sqrtf(tot * (1.0f / 128.0f) + 1e-6f);
            const float* kw = p->in[I_NKW] + (size_t)l * 3 * 128;
#pragma unroll
            for (int q = 0; q < 2; ++q)
#pragma unroll
                for (int r = 0; r < 16; ++r) o[q][r] *= rn * kw[32 * (2 * dh + q) + (r & 3) + 8 * (r >> 2) + 4 * hh];
            if (dh == 0 && n < 255) {
                const int cpz = 16 * n + 31;
                const float* nc = (const float*)(p->ws + WS_TAB_NC) + cpz * 16; const float* ns = (const float*)(p->ws + WS_TAB_NS) + cpz * 16;
#pragma unroll
                for (int a = 0; a < 2; ++a)
#pragma unroll
                    for (int q = 0; q < 4; ++q) {
                        const int i = 8 * a + 4 * hh + q;
                        const float c = nc[i], sn = ns[i], x1 = o[0][4 * a + q], x2 = o[0][4 * (a + 2) + q];
                        o[0][4 * a + q] = x1 * c - x2 * sn; o[0][4 * (a + 2) + q] = x2 * c + x1 * sn;
                    }
            }
        }
#pragma unroll
        for (int q = 0; q < 2; ++q)
#pragma unroll
            for (int a = 0; a < 4; ++a) {
                u32x2 w; w.x = cvt_pk(o[q][4 * a], o[q][4 * a + 1]); w.y = cvt_pk(o[q][4 * a + 2], o[q][4 * a + 3]);
                if (n >= 255) { w.x = 0u; w.y = 0u; }
                *(u32x2*)(dst + 32 * (2 * dh + q) + 8 * a + 4 * hh) = w;
            }
    }
}

__device__ __forceinline__ float softmax_block(f32x16& sa, float& m, float& l) {
    float mx = m;
#pragma unroll
    for (int r = 0; r < 16; ++r) mx = fmaxf(mx, sa[r]);
    mx = half_max(mx);
    const float alpha = fexp2(m - mx);
    float ps = 0.f;
#pragma unroll
    for (int r = 0; r < 16; ++r) { const float pv = fexp2(sa[r] - mx); sa[r] = pv; ps += pv; }
    l = l * alpha + ps; m = mx;
    return alpha;
}
__device__ __forceinline__ void scale_o(f32x16 (&o)[4], float a) {
#pragma unroll
    for (int c = 0; c < 4; ++c)
#pragma unroll
        for (int r = 0; r < 16; ++r) o[c][r] *= a;
}
__device__ __forceinline__ void zero_o(f32x16 (&o)[4]) {
#pragma unroll
    for (int c = 0; c < 4; ++c)
#pragma unroll
        for (int r = 0; r < 16; ++r) o[c][r] = 0.f;
}
__device__ __forceinline__ void pv_block(f32x16 (&o)[4], const LAS unsigned char* vt, const TrAcc& TA, const f32x16& pp, int kb) {
    const unsigned vb = lds_addr(vt);
    pv_step(o, vb + 4096u * (unsigned)(2 * kb), TA, pack8(pp, 0));
    pv_step(o, vb + 4096u * (unsigned)(2 * kb + 1), TA, pack8(pp, 1));
}

struct VFrag { s16x4 d0, d1, d2, d3, d4, d5, d6, d7; };
__device__ __forceinline__ void v_issue(VFrag& f, unsigned vb, const TrAcc& A) {
    asm volatile("ds_read_b64_tr_b16 %0, %8\n\tds_read_b64_tr_b16 %1, %9\n\tds_read_b64_tr_b16 %2, %10\n\tds_read_b64_tr_b16 %3, %11\n\t"
                 "ds_read_b64_tr_b16 %4, %12\n\tds_read_b64_tr_b16 %5, %13\n\tds_read_b64_tr_b16 %6, %14\n\tds_read_b64_tr_b16 %7, %15"
                 : "=&v"(f.d0), "=&v"(f.d1), "=&v"(f.d2), "=&v"(f.d3), "=&v"(f.d4), "=&v"(f.d5), "=&v"(f.d6), "=&v"(f.d7)
                 : "v"(vb + A.a[0][0]), "v"(vb + A.a[0][1]), "v"(vb + A.a[1][0]), "v"(vb + A.a[1][1]), "v"(vb + A.a[2][0]), "v"(vb + A.a[2][1]), "v"(vb + A.a[3][0]), "v"(vb + A.a[3][1]) : "memory");
}
__device__ __forceinline__ void v_wait(VFrag& f) {
    asm volatile("s_waitcnt lgkmcnt(0)" : "+v"(f.d0), "+v"(f.d1), "+v"(f.d2), "+v"(f.d3), "+v"(f.d4), "+v"(f.d5), "+v"(f.d6), "+v"(f.d7) :: "memory");
}
__device__ __forceinline__ void v_mma(f32x16 (&o)[4], const VFrag& f, bf16x8 pf) {
    o[0] = __builtin_amdgcn_mfma_f32_32x32x16_bf16(__builtin_shufflevector(f.d0, f.d1, 0, 1, 2, 3, 4, 5, 6, 7), pf, o[0], 0, 0, 0);
    o[1] = __builtin_amdgcn_mfma_f32_32x32x16_bf16(__builtin_shufflevector(f.d2, f.d3, 0, 1, 2, 3, 4, 5, 6, 7), pf, o[1], 0, 0, 0);
    o[2] = __builtin_amdgcn_mfma_f32_32x32x16_bf16(__builtin_shufflevector(f.d4, f.d5, 0, 1, 2, 3, 4, 5, 6, 7), pf, o[2], 0, 0, 0);
    o[3] = __builtin_amdgcn_mfma_f32_32x32x16_bf16(__builtin_shufflevector(f.d6, f.d7, 0, 1, 2, 3, 4, 5, 6, 7), pf, o[3], 0, 0, 0);
}

constexpr float NSA_DEFER = 8.0f;
template <int MODE>
__device__ __forceinline__ void nsa_branch(unsigned long long tmask, const bf16_t* ksrc, size_t kld, const bf16_t* vsrc, size_t vld, const bf16_t* nk, size_t nkld, const bf16_t* nv, size_t nvld, int& buf,
                                           LAS unsigned char* lds, const bf16x8 (&qf)[8], const TrAcc& TA,
                                           f32x16 (&o)[4], float& m, float& lsum, float inv, int tq, unsigned long long mysel, LAS unsigned* PS, int ql, int tid, int lane, int wave) {
    constexpr bool HASV = MODE != 0;
    const int hh = lane >> 5;
    const int qb = tq >> 6, tqmin = tq & ~31;
    int j = __builtin_ctzll(tmask); tmask &= tmask - 1;
    asm volatile("s_waitcnt vmcnt(0)" ::: "memory");
    __syncthreads();
    for (;;) {
        const bool more = tmask != 0ull;
        const int jn = more ? __builtin_ctzll(tmask) : 0; tmask &= tmask - 1;
        {
            LAS unsigned char* nb = lds + (buf ^ 1) * 32768;
            if (more) { tile_dma64(nb, ksrc + (size_t)jn * 64 * kld, kld, tid, wave); if (HASV) tile_dma64(nb + 16384, vsrc + (size_t)jn * 64 * vld, vld, tid, wave); }
            else if (nk) { tile_dma64(nb, nk, nkld, tid, wave); if (nv) tile_dma64(nb + 16384, nv, nvld, tid, wave); }
        }
        const LAS unsigned char* KT = lds + buf * 32768; const LAS unsigned char* VT = KT + 16384;
        const bool sel = MODE == 3 ? (bool)((mysel >> j) & 1ull) : true;
        f32x16 sa[2];
        qk_tile_pipe(KT, qf, lane, sa[0], sa[1]);
        VFrag fa;
        if (HASV) v_issue(fa, lds_addr(VT), TA);
#pragma unroll
        for (int kb = 0; kb < 2; ++kb) {
            bool need_mask;
            if (MODE < 2) need_mask = 16 * (64 * j + 32 * kb + 31) + 31 > tqmin; else if (MODE == 2) need_mask = (j == qb) || (j + 8 == qb); else need_mask = (j == qb);
            if (need_mask) {
#pragma unroll
                for (int r = 0; r < 16; ++r) {
                    const int kp = 64 * j + 32 * kb + (r & 3) + 8 * (r >> 2) + 4 * hh;
                    bool ok;
                    if (MODE < 2) ok = 16 * kp + 31 <= tq; else if (MODE == 2) ok = (tq - kp >= 0) && (tq - kp < 512); else ok = kp <= tq;
                    sa[kb][r] = ok ? sa[kb][r] : -__builtin_inff();
                }
            }
        }
        if (MODE == 3 && !__all(sel)) {
#pragma unroll
            for (int kb = 0; kb < 2; ++kb)
#pragma unroll
                for (int r = 0; r < 16; ++r) sa[kb][r] = sel ? sa[kb][r] : -__builtin_inff();
        }
        if (MODE == 1) {
#pragma unroll
            for (int kb = 0; kb < 2; ++kb) {
#pragma unroll
                for (int r = 0; r < 16; ++r) sa[kb][r] = fexp2(sa[kb][r] - m) * inv;
#pragma unroll
                for (int a = 0; a < 4; ++a) {
                    const int jj = 16 * j + 8 * kb + 2 * a + hh;
                    const float p3 = sa[kb][4 * a + 3], mainv = 2.0f * (sa[kb][4 * a] + sa[kb][4 * a + 1] + sa[kb][4 * a + 2]) + p3;
                    __hip_atomic_fetch_add(PS + ql * 66 + jj, (unsigned)(mainv * 268435456.0f + 0.5f), __ATOMIC_RELAXED, __HIP_MEMORY_SCOPE_WORKGROUP);
                    __hip_atomic_fetch_add(PS + ql * 66 + jj + 1, (unsigned)(p3 * 268435456.0f + 0.5f), __ATOMIC_RELAXED, __HIP_MEMORY_SCOPE_WORKGROUP);
                }
            }
        } else {
            float mx = m;
#pragma unroll
            for (int r = 0; r < 16; ++r) mx = fmaxf(mx, fmaxf(sa[0][r], sa[1][r]));
            mx = half_max(mx);
            float alpha = 1.0f;
            if (!__all(mx - m <= NSA_DEFER)) { alpha = fexp2(m - mx); m = mx; if (HASV) scale_o(o, alpha); }
            float ps = 0.f;
#pragma unroll
            for (int kb = 0; kb < 2; ++kb)
#pragma unroll
                for (int r = 0; r < 16; ++r) { const float pv = fexp2(sa[kb][r] - m); sa[kb][r] = pv; ps += pv; }
            lsum = lsum * alpha + ps;
        }
        if (HASV) {
            const unsigned vb = lds_addr(VT);
            VFrag fb;
            v_wait(fa); v_issue(fb, vb + 4096u, TA); v_mma(o, fa, pack8(sa[0], 0));
            v_wait(fb); v_issue(fa, vb + 8192u, TA); v_mma(o, fb, pack8(sa[0], 1));
            v_wait(fa); v_issue(fb, vb + 12288u, TA); v_mma(o, fa, pack8(sa[1], 0));
            v_wait(fb); v_mma(o, fb, pack8(sa[1], 1));
        }
        buf ^= 1;
        if (!more) break;
        asm volatile("s_waitcnt vmcnt(0)" ::: "memory");
        __syncthreads();
        j = jn;
    }
}

__device__ __forceinline__ void nsa_task(KP p, int nsa_layer, int task, LAS unsigned char* lds, int tid) {
    asm volatile("" : "+v"(tid), "+s"(p));
    const int lane = tid & 63, wave = __builtin_amdgcn_readfirstlane(tid >> 6), hh = lane >> 5;
    const int qb = 63 - (task >> 3), bg = task & 7, b = bg >> 1, g = bg & 1, t0 = qb * 64;
    const int hd = g * 4 + (wave >> 1), ql = 32 * (wave & 1) + (lane & 31), tq = t0 + ql;
    const bf16_t* PROJ = (const bf16_t*)(p->ws + WS_PROJ);
    LAS unsigned* PS = (LAS unsigned*)(lds + 65536);
    LAS unsigned* SM = (LAS unsigned*)(lds + LDS_STAGE + LDS_CTL);
    LAS u32x2* YL = (LAS u32x2*)(lds + 65536) + wave * 1024 + lane;
    LAS unsigned* UN = SM + 128;
    const bf16_t* kc = (const bf16_t*)(p->ws + WS_KCMP) + (size_t)bg * 256 * 128; const bf16_t* vc = (const bf16_t*)(p->ws + WS_VCMP) + (size_t)bg * 256 * 128;
    const bf16_t* kw = (const bf16_t*)(p->ws + WS_KWN) + (size_t)bg * SEQ * 128; const bf16_t* vw = PROJ + (size_t)b * SEQ * NINP + C_NVW + g * 128;
    const bf16_t* ks = (const bf16_t*)(p->ws + WS_KSN) + (size_t)bg * SEQ * 128; const bf16_t* vs = PROJ + (size_t)b * SEQ * NINP + C_NVS + g * 128;
    int buf = 0;
    tile_dma64(lds, kc, 128, tid, wave);
    bf16x8 qf[8];
    {
        u32x4 vq[8]; rows32_load(vq, PROJ + (size_t)(b * SEQ + t0 + 32 * (wave & 1)) * NINP + C_NQ + hd * 128, (size_t)NINP * 2, lane);
        const unsigned char* tcs = (const unsigned char*)((const float*)(p->ws + WS_TAB_NC) + (size_t)(t0 + 32 * (wave & 1)) * 16) + 32 * lane;
        const unsigned char* tss = (const unsigned char*)((const float*)(p->ws + WS_TAB_NS) + (size_t)(t0 + 32 * (wave & 1)) * 16) + 32 * lane;
        const f32x4 tc0 = *(const f32x4*)tcs, tc1 = *(const f32x4*)(tcs + 16), ts0 = *(const f32x4*)tss, ts1 = *(const f32x4*)(tss + 16);
        LAS unsigned char* W = (wave < 6) ? lds + 16384 + wave * 8192 : lds + 83968 + (wave - 6) * 8192;
        rows32_put(W, vq, lane);
        const float* qw = p->in[I_NQW] + (size_t)nsa_layer * 128 + 8 * hh;
        float x[8][8]; float ss = 0.f;
#pragma unroll
        for (int s8 = 0; s8 < 8; ++s8) { unpack8(*(const LAS u32x4*)(W + off_b((unsigned)(lane & 31), (unsigned)(2 * s8 + hh))), x[s8]);
#pragma unroll
            for (int j = 0; j < 8; ++j) ss += x[s8][j] * x[s8][j]; }
        ss = half_sum(ss);
        const float r = (1.0f / sqrtf(ss * (1.0f / 128.0f) + 1e-6f)) * (0.08838834764831845f * 1.4426950408889634f);
#pragma unroll
        for (int s8 = 0; s8 < 8; ++s8) { float w[8]; ld8f(qw + 16 * s8, w);
#pragma unroll
            for (int j = 0; j < 8; ++j) x[s8][j] *= r * w[j]; }
        {
            asm volatile("s_waitcnt lgkmcnt(0)" ::: "memory");
            *(LAS f32x4*)(W + 32 * lane) = tc0; *(LAS f32x4*)(W + 32 * lane + 16) = tc1; *(LAS f32x4*)(W + 2048 + 32 * lane) = ts0; *(LAS f32x4*)(W + 2048 + 32 * lane + 16) = ts1;
            asm volatile("s_waitcnt lgkmcnt(0)" ::: "memory");
            float c[8], sn[8];
            {
                const unsigned o_ = 64u * (unsigned)(lane & 31) + 32u * (unsigned)hh;
                const f32x4 a0 = *(const LAS f32x4*)(W + o_), a1 = *(const LAS f32x4*)(W + o_ + 16), b0 = *(const LAS f32x4*)(W + 2048 + o_), b1 = *(const LAS f32x4*)(W + 2048 + o_ + 16);
#pragma unroll
                for (int j = 0; j < 4; ++j) { c[j] = a0[j]; c[4 + j] = a1[j]; sn[j] = b0[j]; sn[4 + j] = b1[j]; }
            }
#pragma unroll
            for (int j = 0; j < 8; ++j) { const float x1 = x[0][j], x2 = x[1][j]; x[0][j] = x1 * c[j] - x2 * sn[j]; x[1][j] = x2 * c[j] + x1 * sn[j]; }
        }
#pragma unroll
        for (int s8 = 0; s8 < 8; ++s8) qf[s8] = __builtin_bit_cast(bf16x8, pack8f(x[s8]));
    }
    const size_t tokrow = (size_t)(b * SEQ + tq);
    const unsigned short graw0 = PROJ[tokrow * NINP + C_NG + hd * 3 + 0], graw1 = PROJ[tokrow * NINP + C_NG + hd * 3 + 1], graw2 = PROJ[tokrow * NINP + C_NG + hd * 3 + 2];
    TrAcc TA; tr_acc_init(TA, lane);
    if (wave >= 4) __builtin_amdgcn_s_setprio(1);
    for (int i = tid; i < 64 * 66; i += NTHR) PS[i] = 0u;
    if (tid < 2) UN[tid] = 0u;
    f32x16 o[4];
    const int jw0 = (qb >= 8 ? qb - 8 : 0);
    {
        const int nv = ((t0 + 32) >> 4) + 1, ntile = (nv + 63) >> 6;
        const unsigned long long tm = (1ull << ntile) - 1ull;
        float m = -1e30f, lsum = 0.f;
        nsa_branch<0>(tm, kc, 128, vc, 128, kc, 128, vc, 128, buf, lds, qf, TA, o, m, lsum, 0.f, tq, 0ull, PS, ql, tid, lane, wave);
        lsum = half_sum(lsum);
        const float inv = lsum > 0.f ? 1.0f / lsum : 0.f;
        zero_o(o);
        nsa_branch<1>(tm, kc, 128, vc, 128, kw + (size_t)jw0 * 64 * 128, 128, vw + (size_t)jw0 * 64 * NINP, NINP, buf, lds, qf, TA, o, m, lsum, inv, tq, 0ull, PS, ql, tid, lane, wave);
    }
    __syncthreads();
    for (int qi = 0; qi < 8; ++qi) {
        const int q = 8 * wave + qi, cur = qb;
        const unsigned v = PS[q * 66 + lane];
        const bool forced = (lane == 0) || (lane == cur) || (lane == cur - 1);
        const unsigned key = forced ? 0xffffffffu : ((lane <= cur) ? v + 1u : 0u);
        int rank = 0;
#pragma unroll
        for (int i = 0; i < 64; ++i) { const unsigned ki = (unsigned)__builtin_amdgcn_readlane((int)key, i); rank += ((ki > key) || (ki == key && i < lane)) ? 1 : 0; }
        const unsigned long long msk = __ballot(rank < 16);
        if (lane == 0) { SM[2 * q] = (unsigned)msk; SM[2 * q + 1] = (unsigned)(msk >> 32); __hip_atomic_fetch_or(UN, (unsigned)msk, __ATOMIC_RELAXED, __HIP_MEMORY_SCOPE_WORKGROUP); __hip_atomic_fetch_or(UN + 1, (unsigned)(msk >> 32), __ATOMIC_RELAXED, __HIP_MEMORY_SCOPE_WORKGROUP); }
    }
    const unsigned long long upto = (qb == 63) ? ~0ull : ((2ull << qb) - 1ull);
    __syncthreads();
    {
        const float gt0 = sigmoidf_(bf2f(graw0));
#pragma unroll
        for (int c = 0; c < 4; ++c)
#pragma unroll
            for (int a = 0; a < 4; ++a) { u32x2 w; w.x = cvt_pk(o[c][4 * a] * gt0, o[c][4 * a + 1] * gt0); w.y = cvt_pk(o[c][4 * a + 2] * gt0, o[c][4 * a + 3] * gt0); YL[(c * 4 + a) * 64] = w; }
    }
    const unsigned long long mysel = (unsigned long long)SM[2 * ql] | ((unsigned long long)SM[2 * ql + 1] << 32);
    const unsigned long long un = ((unsigned long long)UN[0] | ((unsigned long long)UN[1] << 32)) & upto;
    const int js0 = __builtin_ctzll(un);
    {
        float m = -1e30f, lsum = 0.f; zero_o(o);
        const unsigned long long tm = upto & ~((qb >= 8) ? ((1ull << (qb - 8)) - 1ull) : 0ull);
        nsa_branch<2>(tm, kw, 128, vw, NINP, ks + (size_t)js0 * 64 * 128, 128, vs + (size_t)js0 * 64 * NINP, NINP, buf, lds, qf, TA, o, m, lsum, 0.f, tq, 0ull, PS, ql, tid, lane, wave);
        lsum = half_sum(lsum);
        const float sc = sigmoidf_(bf2f(graw2)) / lsum;
#pragma unroll
        for (int c = 0; c < 4; ++c)
#pragma unroll
            for (int a = 0; a < 4; ++a) { const u32x2 y = YL[(c * 4 + a) * 64];
                u32x2 w; w.x = cvt_pk(bflo(y.x) + o[c][4 * a] * sc, bfhi(y.x) + o[c][4 * a + 1] * sc); w.y = cvt_pk(bflo(y.y) + o[c][4 * a + 2] * sc, bfhi(y.y) + o[c][4 * a + 3] * sc); YL[(c * 4 + a) * 64] = w; }
    }
    {
        float m = -1e30f, lsum = 0.f; zero_o(o);
        nsa_branch<3>(un, ks, 128, vs, NINP, nullptr, 0, nullptr, 0, buf, lds, qf, TA, o, m, lsum, 0.f, tq, mysel, PS, ql, tid, lane, wave);
        lsum = half_sum(lsum);
        const float sc = sigmoidf_(bf2f(graw1)) / lsum;
        bf16_t* mrow = (bf16_t*)(p->ws + WS_MIX) + tokrow * DM + MIX_NSA + hd * 128;
#pragma unroll
        for (int c = 0; c < 4; ++c)
#pragma unroll
            for (int a = 0; a < 4; ++a) {
                const u32x2 y = YL[(c * 4 + a) * 64];
                u32x2 w; w.x = cvt_pk(bflo(y.x) + o[c][4 * a] * sc, bfhi(y.x) + o[c][4 * a + 1] * sc); w.y = cvt_pk(bflo(y.y) + o[c][4 * a + 2] * sc, bfhi(y.y) + o[c][4 * a + 3] * sc);
                *(u32x2*)(mrow + 32 * c + 8 * a + 4 * hh) = w;
            }
    }
    __builtin_amdgcn_s_setprio(0);
}

constexpr float SB_THR = 40.0f;
__device__ __forceinline__ void sb_task(KP p, int task, LAS unsigned char* lds, int tid) {
    asm volatile("" : "+v"(tid), "+s"(p));
    const int lane = tid & 63, wave = __builtin_amdgcn_readfirstlane(tid >> 6), hh = lane >> 5;
    const int bh = task >> 4, b = bh >> 3, h = bh & 7, Q0 = (task & 15) * 256;
    const bf16_t* PROJ = (const bf16_t*)(p->ws + WS_PROJ);
    const bf16_t* base = PROJ + (size_t)b * SEQ * NINP + h * 128;
    volatile LAS int* FL = (volatile LAS int*)(lds + 65536);
    const int tq = Q0 + 32 * wave + (lane & 31);
    int jt = (Q0 >> 6) + 3, buf = 0;
    tile_dma64(lds, base + (size_t)jt * 64 * NINP + C_SK, NINP, tid, wave); tile_dma64(lds + 16384, base + (size_t)jt * 64 * NINP + C_SV, NINP, tid, wave);
    bf16x8 qf[8];
    {
        u32x4 vq[8]; rows32_load(vq, base + (size_t)(Q0 + 32 * wave) * NINP + C_SQ, (size_t)NINP * 2, lane);
        LAS unsigned char* W = (wave < 4) ? lds + 32768 + wave * 8192 : lds + 66048 + (wave - 4) * 8192;
        rows32_put(W, vq, lane);
#pragma unroll
        for (int s = 0; s < 8; ++s) qf[s] = row_frag(W, 0, s, lane);
        asm volatile("s_waitcnt lgkmcnt(0)" ::: "memory");
    }
    TrAcc TA; tr_acc_init(TA, lane);
    if (wave >= 4) __builtin_amdgcn_s_setprio(1);
    f32x16 o[4]; zero_o(o);
    float Lc = 0.f; bool wdone = false;
    if (tid < 8) FL[tid] = 0;
    const float SC = 0.08838834764831845f, L2E = 1.4426950408889634f, LN2 = 0.6931471805599453f;
    asm volatile("s_waitcnt vmcnt(0)" ::: "memory");
    __syncthreads();
    for (;;) {
        if (FL[0] & FL[1] & FL[2] & FL[3] & FL[4] & FL[5] & FL[6] & FL[7]) break;
        if (jt > 0) { LAS unsigned char* nb = lds + (buf ^ 1) * 32768; tile_dma64(nb, base + (size_t)(jt - 1) * 64 * NINP + C_SK, NINP, tid, wave); tile_dma64(nb + 16384, base + (size_t)(jt - 1) * 64 * NINP + C_SV, NINP, tid, wave); }
        const LAS unsigned char* KT = lds + buf * 32768; const LAS unsigned char* VT = KT + 16384;
        const int k0 = jt * 64;
        if (!wdone && k0 < Q0 + 32 * wave + 31) {
            const unsigned vb = lds_addr(VT);
#pragma unroll 1
            for (int kbi = 0; kbi < 2; ++kbi) {
                const int kb = 1 - kbi;
                f32x16 sa = qk_block(KT, kb, qf, lane), ls;
#pragma unroll
                for (int r = 0; r < 16; ++r) {
                    const int key = k0 + 32 * kb + (r & 3) + 8 * (r >> 2) + 4 * hh;
                    const float z = sa[r] * SC;
                    const float lp = flog2(1.0f + fexp2(-fabsf(z) * L2E)) * LN2;
                    const float lb = fminf(z, 0.f) - lp;
                    sa[r] = lb; ls[r] = (key < tq) ? (lb - z) : 0.f;
                }
                float gsum[4], ghi[4], after[4];
#pragma unroll
                for (int a = 0; a < 4; ++a) { const float gsv = (ls[4 * a] + ls[4 * a + 1]) + (ls[4 * a + 2] + ls[4 * a + 3]);
                    auto rr = __builtin_amdgcn_permlane32_swap(__float_as_uint(gsv), __float_as_uint(gsv), false, false);
                    ghi[a] = __uint_as_float(rr[1]); gsum[a] = __uint_as_float(rr[0]) + ghi[a]; }
                float run = 0.f;
#pragma unroll
                for (int a = 3; a >= 0; --a) { after[a] = run; run += gsum[a]; }
#pragma unroll
                for (int a = 0; a < 4; ++a) {
                    float suf = Lc + after[a] + (hh == 0 ? ghi[a] : 0.f);
#pragma unroll
                    for (int q = 3; q >= 0; --q) {
                        const int r = 4 * a + q, key = k0 + 32 * kb + q + 8 * a + 4 * hh;
                        const float w = (key < tq) ? fexp2((sa[r] + suf) * L2E) : 0.f;
                        suf += ls[r];
                        sa[r] = w;
                    }
                }
                Lc += run;
                pv_step(o, vb + 4096u * (unsigned)(2 * kb), TA, pack8(sa, 0));
                pv_step(o, vb + 4096u * (unsigned)(2 * kb + 1), TA, pack8(sa, 1));
            }
            wdone = __all(Lc < -SB_THR);
            if (lane == 0) FL[wave] = wdone ? 1 : 0;
        }
        if (jt == 0) break;
        asm volatile("s_waitcnt vmcnt(0)" ::: "memory");
        __syncthreads();
        --jt; buf ^= 1;
    }
    bf16_t* mrow = (bf16_t*)(p->ws + WS_MIX) + (size_t)(b * SEQ + tq) * DM + MIX_SB + h * 128;
#pragma unroll
    for (int c = 0; c < 4; ++c)
#pragma unroll
        for (int a = 0; a < 4; ++a) { u32x2 w; w.x = cvt_pk(o[c][4 * a], o[c][4 * a + 1]); w.y = cvt_pk(o[c][4 * a + 2], o[c][4 * a + 3]); *(u32x2*)(mrow + 32 * c + 8 * a + 4 * hh) = w; }
    __builtin_amdgcn_s_setprio(0);
}

__device__ __forceinline__ void ret_state_task(KP p, int task, LAS unsigned char* lds, int tid, unsigned* rsflag) {
    asm volatile("" : "+v"(tid), "+s"(p));
    const int lane = tid & 63, wave = __builtin_amdgcn_readfirstlane(tid >> 6), hh = lane >> 5;
    const int eh = task & 1, bh = task >> 1, b = bh >> 3, h = bh & 7;
    const bf16_t* KR = (const bf16_t*)(p->ws + WS_KR) + (size_t)bh * SEQ * 128;
    const bf16_t* V = (const bf16_t*)(p->ws + WS_PROJ) + (size_t)b * SEQ * NINP + C_RV + h * 128;
    bf16_t* ST = (bf16_t*)(p->ws + WS_ST) + (size_t)bh * 32 * 128 * 128;
    const int eb = wave >> 2, db = wave & 3;
    const float gC = exp2f(128.0f * log2f(1.0f - exp2f(-5.0f - (float)h)));
    f32x16 acc;
#pragma unroll
    for (int i = 0; i < 16; ++i) acc[i] = 0.f;
#define RS_ISSUE(c_, nb_) do { _Pragma("unroll") for (int rr = 0; rr < 2; ++rr) { tile_dma64((nb_) + rr * 16384, KR + ((size_t)(c_) * 128 + rr * 64) * 128, 128, tid, wave); \
        tile_dma64((nb_) + 32768 + rr * 16384, V + ((size_t)(c_) * 128 + rr * 64) * NINP, NINP, tid, wave); } } while (0)
    __syncthreads();
    RS_ISSUE(0, lds);
    for (int c = 0; c < 32; ++c) {
        {
            bf16_t* dst = ST + (size_t)c * 128 * 128 + 32 * db + (lane & 31);
#pragma unroll
            for (int r = 0; r < 16; ++r) { const int e = 64 * eh + 32 * eb + (r & 3) + 8 * (r >> 2) + 4 * hh; dst[(size_t)e * 128] = f2bf(acc[r]); }
        }
        if (c == 31) break;
        asm volatile("s_waitcnt vmcnt(0)" ::: "memory");
        __syncthreads();
        if (c + 1 < 31) { LAS unsigned char* nb = lds + ((c + 1) & 1) * 65536; RS_ISSUE(c + 1, nb); }
        const LAS unsigned char* KT = lds + (c & 1) * 65536; const LAS unsigned char* VT = KT + 32768;
#pragma unroll
        for (int ks = 0; ks < 8; ++ks) {
            const unsigned ov0 = tr_off_nat(lane, 2 * eh + eb, ks, 0), ov1 = tr_off_nat(lane, 2 * eh + eb, ks, 1), ok0 = tr_off_nat(lane, db, ks, 0), ok1 = tr_off_nat(lane, db, ks, 1);
            s16x4 v0, v1, k0, k1;
            asm volatile("ds_read_b64_tr_b16 %0, %4\n\tds_read_b64_tr_b16 %1, %5\n\tds_read_b64_tr_b16 %2, %6\n\tds_read_b64_tr_b16 %3, %7\n\ts_waitcnt lgkmcnt(0)"
                         : "=&v"(v0), "=&v"(v1), "=&v"(k0), "=&v"(k1) : "v"(lds_addr(VT) + ov0), "v"(lds_addr(VT) + ov1), "v"(lds_addr(KT) + ok0), "v"(lds_addr(KT) + ok1) : "memory");
            acc = __builtin_amdgcn_mfma_f32_32x32x16_bf16(__builtin_shufflevector(v0, v1, 0, 1, 2, 3, 4, 5, 6, 7), __builtin_shufflevector(k0, k1, 0, 1, 2, 3, 4, 5, 6, 7), acc, 0, 0, 0);
        }
#pragma unroll
        for (int i = 0; i < 16; ++i) acc[i] *= gC;
    }
#undef RS_ISSUE
    asm volatile("s_waitcnt vmcnt(0)" ::: "memory");
    __syncthreads();
    if (tid == 0) { __builtin_amdgcn_fence(__ATOMIC_RELEASE, "agent"); asm volatile("s_waitcnt vmcnt(0)" ::: "memory"); __hip_atomic_fetch_add(rsflag + 64 * bh, 1u, __ATOMIC_RELAXED, __HIP_MEMORY_SCOPE_AGENT); }
}

__device__ __forceinline__ void ret_out_task(KP p, int task, LAS unsigned char* lds, int tid, unsigned* rsflag) {
    asm volatile("" : "+v"(tid), "+s"(p));
    const int lane = tid & 63, wave = __builtin_amdgcn_readfirstlane(tid >> 6), hh = lane >> 5;
    const int bh = task >> 4, cp = task & 15, b = bh >> 3, h = bh & 7;
    const int cw = wave >> 2, ib = wave & 3, c = 2 * cp + cw, s = 128 * c + 32 * ib + (lane & 31);
    const bf16_t* PROJ = (const bf16_t*)(p->ws + WS_PROJ);
    const bf16_t* KR = (const bf16_t*)(p->ws + WS_KR) + (size_t)bh * SEQ * 128;
    const bf16_t* V = PROJ + (size_t)b * SEQ * NINP + C_RV + h * 128;
    const bf16_t* ST = (const bf16_t*)(p->ws + WS_ST) + (size_t)bh * 32 * 128 * 128;
#define RET_ISSUE(st_, nb_) do { _Pragma("unroll") for (int cwi = 0; cwi < 2; ++cwi) { const size_t cc_ = (size_t)(2 * cp + cwi); \
        if ((st_) < 2) { const size_t krow = cc_ * 128 + (st_) * 64; tile_dma64((nb_) + cwi * 32768, KR + krow * 128, 128, tid, wave); tile_dma64((nb_) + cwi * 32768 + 16384, V + krow * NINP, NINP, tid, wave); } \
        else tile_dma64((nb_) + cwi * 32768, ST + (cc_ * 128 + ((st_) - 2) * 64) * 128, 128, tid, wave); } } while (0)
    RET_ISSUE(0, lds);
    bf16x8 qf[8];
    {
        LAS unsigned char* W = lds + 65536 + wave * 8192;
        const int sb0 = 128 * c + 32 * ib, ch = lane & 15, r0 = lane >> 4, row = lane & 31;
        const unsigned char* qsrc = (const unsigned char*)(PROJ + (size_t)(b * SEQ + sb0) * NINP + C_RQ + h * 128) + 16 * ch;
        const unsigned char* csrc = (const unsigned char*)((const float*)(p->ws + WS_TAB_RC) + sb0 * 64) + 16 * ch;
        const unsigned char* ssrc = (const unsigned char*)((const float*)(p->ws + WS_TAB_RS) + sb0 * 64) + 16 * ch;
        u32x4 vq[8], vc[8], vs[8];
#pragma unroll
        for (int i = 0; i < 8; ++i) { vq[i] = *(const u32x4*)(qsrc + (size_t)(r0 + 4 * i) * (NINP * 2)); vc[i] = *(const u32x4*)(csrc + (size_t)(r0 + 4 * i) * 256); vs[i] = *(const u32x4*)(ssrc + (size_t)(r0 + 4 * i) * 256); }
        const float dq = fexp2((float)((s & 127) + 1) * log2f(1.0f - exp2f(-5.0f - (float)h)));
        u32x4 xq[8]; f32x4 cf[8], sf[8];
#pragma unroll
        for (int i = 0; i < 8; ++i) *(LAS u32x4*)(W + off_b((unsigned)(r0 + 4 * i), (unsigned)ch)) = vq[i];
        asm volatile("s_waitcnt lgkmcnt(0)" ::: "memory");
#pragma unroll
        for (int s8 = 0; s8 < 8; ++s8) xq[s8] = *(const LAS u32x4*)(W + off_b((unsigned)row, (unsigned)(2 * s8 + hh)));
        asm volatile("s_waitcnt lgkmcnt(0)" ::: "memory");
#pragma unroll
        for (int i = 0; i < 8; ++i) *(LAS u32x4*)(W + off_b((unsigned)(r0 + 4 * i), (unsigned)ch)) = vc[i];
        asm volatile("s_waitcnt lgkmcnt(0)" ::: "memory");
#pragma unroll
        for (int s8 = 0; s8 < 4; ++s8) { cf[2 * s8] = *(const LAS f32x4*)(W + off_b((unsigned)row, (unsigned)(4 * s8 + 2 * hh))); cf[2 * s8 + 1] = *(const LAS f32x4*)(W + off_b((unsigned)row, (unsigned)(4 * s8 + 2 * hh + 1))); }
        asm volatile("s_waitcnt lgkmcnt(0)" ::: "memory");
#pragma unroll
        for (int i = 0; i < 8; ++i) *(LAS u32x4*)(W + off_b((unsigned)(r0 + 4 * i), (unsigned)ch)) = vs[i];
        asm volatile("s_waitcnt lgkmcnt(0)" ::: "memory");
#pragma unroll
        for (int s8 = 0; s8 < 4; ++s8) { sf[2 * s8] = *(const LAS f32x4*)(W + off_b((unsigned)row, (unsigned)(4 * s8 + 2 * hh))); sf[2 * s8 + 1] = *(const LAS f32x4*)(W + off_b((unsigned)row, (unsigned)(4 * s8 + 2 * hh + 1))); }
        asm volatile("s_waitcnt lgkmcnt(0)" ::: "memory");
#pragma unroll
        for (int s8 = 0; s8 < 4; ++s8) {
            float x1[8], x2[8], o1[8], o2[8];
            unpack8(xq[s8], x1); unpack8(xq[s8 + 4], x2);
#pragma unroll
            for (int j = 0; j < 8; ++j) { const float cj = cf[2 * s8 + (j >> 2)][j & 3], sj = sf[2 * s8 + (j >> 2)][j & 3]; o1[j] = (x1[j] * cj - x2[j] * sj) * dq; o2[j] = (x2[j] * cj + x1[j] * sj) * dq; }
            qf[s8] = __builtin_bit_cast(bf16x8, pack8f(o1)); qf[s8 + 4] = __builtin_bit_cast(bf16x8, pack8f(o2));
        }
    }
    TrAcc TA; tr_acc_init(TA, lane);
    if (wave >= 4) __builtin_amdgcn_s_setprio(1);
    f32x16 o[4]; zero_o(o);
    if (tid == 0) {
        unsigned spins = 0;
        while (__hip_atomic_load(rsflag + 64 * bh, __ATOMIC_RELAXED, __HIP_MEMORY_SCOPE_AGENT) < 2u && ++spins < (1u << 24)) __builtin_amdgcn_s_sleep(8);
        __builtin_amdgcn_fence(__ATOMIC_ACQUIRE, "agent");
        asm volatile("s_waitcnt vmcnt(0)" ::: "memory");
    }
    const size_t tok = (size_t)(b * SEQ + s);
    u32x2 gvr[4][4];
    {
        u32x4 vg[8]; rows32_load(vg, PROJ + (size_t)(b * SEQ + 128 * c + 32 * ib) * NINP + C_RG + h * 128, (size_t)NINP * 2, lane);
        LAS unsigned char* W = lds + 65536 + wave * 8192;
        rows32_put(W, vg, lane);
#pragma unroll
        for (int cc = 0; cc < 4; ++cc)
#pragma unroll
            for (int a = 0; a < 4; ++a) gvr[cc][a] = *(const LAS u32x2*)(W + off_b((unsigned)(lane & 31), (unsigned)(4 * cc + a)) + 8 * hh);
        asm volatile("s_waitcnt lgkmcnt(0)" ::: "memory");
    }
    asm volatile("s_waitcnt vmcnt(0)" ::: "memory");
    __syncthreads();
#pragma unroll
    for (int st = 0; st < 4; ++st) {
        if (st + 1 < 4) { LAS unsigned char* nb = lds + ((st + 1) & 1) * 65536; RET_ISSUE(st + 1, nb); }
        const LAS unsigned char* KT = lds + (st & 1) * 65536 + cw * 32768; const LAS unsigned char* VT = KT + 16384;
        if (st < 2) {
#pragma unroll
            for (int kb = 0; kb < 2; ++kb) {
                const int jb = 2 * st + kb;
                if (jb <= ib) {
                    f32x16 sa = qk_block(KT, kb, qf, lane);
                    if (jb == ib) {
#pragma unroll
                        for (int r = 0; r < 16; ++r) { const int kl = (r & 3) + 8 * (r >> 2) + 4 * hh; if (kl > (lane & 31)) sa[r] = 0.f; }
                    }
                    const unsigned vb = lds_addr(VT);
                    pv_step(o, vb + 4096u * (unsigned)(2 * kb), TA, pack8(sa, 0));
                    pv_step(o, vb + 4096u * (unsigned)(2 * kb + 1), TA, pack8(sa, 1));
                }
            }
        } else {
#pragma unroll
            for (int eb = 0; eb < 2; ++eb)
#pragma unroll
                for (int k = 0; k < 8; ++k) o[2 * (st - 2) + eb] = __builtin_amdgcn_mfma_f32_32x32x16_bf16(row_frag(KT, 32 * eb, k, lane), qf[k], o[2 * (st - 2) + eb], 0, 0, 0);
        }
        if (st + 1 < 4) { asm volatile("s_waitcnt vmcnt(0)" ::: "memory"); __syncthreads(); }
    }
#undef RET_ISSUE
    float ss = 0.f;
#pragma unroll
    for (int cc = 0; cc < 4; ++cc)
#pragma unroll
        for (int r = 0; r < 16; ++r) ss += o[cc][r] * o[cc][r];
    ss = half_sum(ss);
    const float rn = 1.0f / sqrtf(ss * (1.0f / 128.0f) + 1e-6f);
    bf16_t* mrow = (bf16_t*)(p->ws + WS_MIX) + tok * DM + MIX_RET + h * 128;
#ifndef REPS_RETEPI
#define REPS_RETEPI 1
#endif
    for (int rr = 0; rr < REPS_RETEPI; ++rr)
#pragma unroll
    for (int cc = 0; cc < 4; ++cc)
#pragma unroll
        for (int a = 0; a < 4; ++a) {
            const u32x2 gv = gvr[cc][a];
            const float g0 = bflo(gv.x), g1 = bfhi(gv.x), g2 = bflo(gv.y), g3 = bfhi(gv.y);
            u32x2 w; w.x = cvt_pk(o[cc][4 * a] * rn * g0 * sigmoidf_(g0), o[cc][4 * a + 1] * rn * g1 * sigmoidf_(g1));
            w.y = cvt_pk(o[cc][4 * a + 2] * rn * g2 * sigmoidf_(g2), o[cc][4 * a + 3] * rn * g3 * sigmoidf_(g3));
            *(u32x2*)(mrow + 32 * cc + 8 * a + 4 * hh) = w;
        }
    __builtin_amdgcn_s_setprio(0);
}

#ifndef HP_SP2
#define HP_SP2 true
#endif
#ifndef HP_ALIGN
#define HP_ALIGN true
#endif
#ifndef REPS_CMP
#define REPS_CMP 1
#endif
#ifndef REPS_C1
#define REPS_C1 1
#endif
#ifndef REPS_RS
#define REPS_RS 1
#endif
#ifndef REPS_NSA
#define REPS_NSA 1
#endif
#ifndef REPS_SB
#define REPS_SB 1
#endif
#ifndef REPS_C3
#define REPS_C3 1
#endif
#ifndef REPS_PE
#define REPS_PE 1
#endif
#ifndef REP_CONV
#define REP_CONV 1
#endif
#ifndef REP_GIN
#define REP_GIN 1
#endif
#ifndef REPS_RO
#define REPS_RO 1
#endif
#ifndef REP_PREP
#define REP_PREP 1
#endif
#ifndef REP_MIX1
#define REP_MIX1 1
#endif
#ifndef REP_MIX2
#define REP_MIX2 1
#endif
#ifndef REP_NORM2
#define REP_NORM2 1
#endif
#ifndef REP_GGU
#define REP_GGU 1
#endif
#ifndef REP_ACT
#define REP_ACT 1
#endif
#ifndef IN_MIDCONV
#define IN_MIDCONV 0
#endif
struct SegOrder {
    pg8::StaticOrder S; int i0, n;
    __device__ __forceinline__ bool next(int i, pg8::Unit& u) const { return i < n && S.next(i0 + i, u); }
    __device__ __forceinline__ void a_ready(const pg8::Unit&) const {}
    __device__ __forceinline__ void done(const pg8::Unit&) const {}
};
#ifndef IN_SKINNY
#define IN_SKINNY 0
#endif
#ifndef GU_TAIL_N
#define GU_TAIL_N 2016
#endif
#ifndef IN_TAIL_N
#define IN_TAIL_N 1024
#endif
#ifndef IN_TAIL_N0
#define IN_TAIL_N0 1024
#endif
static_assert(GU_TAIL_N <= 2016 && IN_TAIL_N0 >= 512 && (GU_TAIL_N > 1504 ? GU_TAIL_N : 1504) + IN_TAIL_N >= 2016, "conversion task placement");
enum { PH_CONV = 0, PH_GEMM_IN, PH_PREP, PH_MIX1, PH_MIX2, PH_GEMM_OUT, PH_GEMM_GU, PH_ACT, PH_GEMM_DN, N_PHASES };

__global__ void __launch_bounds__(NTHR, 2) hybrid_fwd(Params p_arg) {
    extern __shared__ __attribute__((aligned(16))) unsigned char lds_raw[];
    LAS unsigned char* lds = (LAS unsigned char*)lds_raw;
    const int wave0 = __builtin_amdgcn_readfirstlane(threadIdx.x >> 6), bid = blockIdx.x, G = gridDim.x;
#define TID0() (wave0 * 64 + lane_id_now())
    volatile LAS unsigned* CT = (volatile LAS unsigned*)(lds + LDS_STAGE);
    { const int t0_ = TID0(); if (t0_ < 8) CT[t0_] = 0u; }
    __syncthreads();
    const KP kp = (KP)__builtin_amdgcn_kernarg_segment_ptr();
    unsigned* ctl = (unsigned*)(kp->ws + WS_CTL);
    const int l_lo = kp->l_lo, l_hi = kp->l_hi, ph_lo = kp->ph_lo, ph_hi = kp->ph_hi;
    const bool multi = (l_hi - l_lo) > 1 || (ph_hi - ph_lo) > 1;
    XcdBarrier bar; bar.bar = ctl + CW_BAR; bar.x = 0; bar.st = CT;
    if (multi) bar = xcd_barrier_post(ctl + CW_BAR, CT);
    volatile LAS int* slot = (volatile LAS int*)(CT + 4);

#define PH_ON(k) (ph_lo <= (k) && (k) < ph_hi)
#define WSP(T, off) ((T*)(p->ws + (off)))
#ifndef REP_SEAM
#define REP_SEAM 1
#endif
#define SEAM() do { if (multi) for (int sr_ = 0; sr_ < REP_SEAM; ++sr_) xcd_barrier(bar); } while (0)
#define ARRIVE_ALL(ctr_, tid_) do { asm volatile("s_waitcnt vmcnt(0)" ::: "memory"); __syncthreads(); \
        if ((tid_) == 0) { __builtin_amdgcn_fence(__ATOMIC_RELEASE, "agent"); asm volatile("s_waitcnt vmcnt(0)" ::: "memory"); __hip_atomic_fetch_add((ctr_), 1u, __ATOMIC_RELAXED, __HIP_MEMORY_SCOPE_AGENT); } } while (0)
#define WAIT_ALL(ctr_, tid_) do { if ((tid_) == 0) { unsigned spins_ = 0; \
            while (__hip_atomic_load((ctr_), __ATOMIC_RELAXED, __HIP_MEMORY_SCOPE_AGENT) < (unsigned)G && ++spins_ < (1u << 24)) __builtin_amdgcn_s_sleep(8); \
            __builtin_amdgcn_fence(__ATOMIC_ACQUIRE, "agent"); asm volatile("s_waitcnt vmcnt(0)" ::: "memory"); } \
        __syncthreads(); } while (0)
#ifndef SPLIT_SEAMS
#define SPLIT_SEAMS 1
#endif
#define SEAM_FILL(i_, lo_, hi_, last_rep_) do { const int tid_s = TID0(); \
        if (multi && SPLIT_SEAMS && (last_rep_)) { ARRIVE_ALL(qctr + 448 + 16 * (i_), tid_s); convert_range(p, l, (lo_) + bid, (hi_), G, lds, tid_s); WAIT_ALL(qctr + 448 + 16 * (i_), tid_s); } \
        else { convert_range(p, l, (lo_) + bid, (hi_), G, lds, tid_s); SEAM(); } } while (0)
#ifndef DIS_TAB
    if (l_lo == 0 && PH_ON(PH_CONV)) ph_tables(kp, TID0(), bid, G);
#endif
    for (int l = l_lo; l < l_hi; ++l) {
        KP p = kp; asm volatile("" : "+s"(p));
        const int vis_lo = (l == 0) ? 1504 + IN_TAIL_N0 : (GU_TAIL_N > 1504 ? GU_TAIL_N : 1504) + IN_TAIL_N, vis_mid = (vis_lo + 4768) / 2;
        unsigned* qctr = ctl + CW_QUEUE + 1024 * l;
        if (PH_ON(PH_CONV)) for (int rep = 0; rep < REP_CONV; ++rep) {
            const int tid = TID0();
#ifndef DIS_CONV
            convert_range(p, l, ((l == 0) ? 0 : (GU_TAIL_N < 1504 ? GU_TAIL_N : 1504)) + bid, 1504, G, lds, tid);
            convert_small(p, l, tid, bid, G);
#endif
            if (l == 0) ph_xcvt(p->in[I_X], WSP(bf16_t, WS_HN), WSP(float, WS_RSS), tid, bid, G);
            SEAM();
        }
        if (PH_ON(PH_GEMM_IN)) for (int rep = 0; rep < REP_GIN; ++rep) {
            const int tid = TID0();
            constexpr int nin_g = IN_SKINNY ? C_NG : NINP;
            pg8::Gemm g{WSP(bf16_t, WS_HN), WSP(bf16_t, WS_WIN), MT, nin_g, DM}; pg8::StaticOrder S; S.init(MT, nin_g, G, bid);
            LAS float* rt = (LAS float*)(lds + LDS_STAGE + LDS_CTL);
            const int rbase = fill_rstd_table(S, WSP(float, WS_RSS), rt, tid);
            EpiBf16RS E{WSP(bf16_t, WS_PROJ), NINP, rt, rbase};
#if !defined(DIS_GEMM) && !defined(DIS_G1)
#if IN_MIDCONV
            {
                const int cut = 1 + (bid & 7);
                SegOrder Sa{S, 0, cut}, Sb{S, cut, 1 << 20};
                pg8::gemm_phase<EpiBf16RS, SegOrder, HP_ALIGN, HP_SP2>(lds, g, Sa, E, tid);
                convert_range(p, l, vis_lo + bid, 4768, G, lds, tid);
                __syncthreads();
                pg8::gemm_phase<EpiBf16RS, SegOrder, HP_ALIGN, HP_SP2>(lds, g, Sb, E, tid);
            }
#else
            pg8::gemm_phase<EpiBf16RS, pg8::StaticOrder, HP_ALIGN, HP_SP2>(lds, g, S, E, tid);
#endif
#endif
#ifndef DIS_CONV
            {
                const int nwg = (MT / 256) * (nin_g / 256), first_short = nwg - ((nwg + G - 1) / G - 1) * G;
                if (IN_SKINNY) {
                    int rp0, rstep;
                    if (G == 256) { const int j = bid >> 3, x = bid & 7; rp0 = bid >= 128 ? 2 * (8 * x + (j & 7)) + ((j >> 3) & 1) : 128; rstep = 128; }
                    else if (first_short < G) { rp0 = bid >= first_short ? bid - first_short : 128; rstep = G - first_short; }
                    else { rp0 = bid; rstep = G; }
                    for (int rp = rp0; rp < 128; rp += rstep) in_gate_cols(p, rp * 128, WSP(float, WS_RSS), lds, tid);
                }
                const int in_lo = (l == 0) ? 1504 : (GU_TAIL_N > 1504 ? GU_TAIL_N : 1504), in_hi = in_lo + ((l == 0) ? IN_TAIL_N0 : IN_TAIL_N);
                if (first_short < G && bid >= first_short) convert_range(p, l, in_lo + (bid - first_short), in_hi, G - first_short, lds, tid);
                else if (first_short >= G) convert_range(p, l, in_lo + bid, in_hi, G, lds, tid);
            }
#endif
#if IN_MIDCONV
            SEAM();
#else
            SEAM_FILL(1, vis_lo, vis_mid, rep + 1 == REP_GIN);
#endif
        }
        if (PH_ON(PH_PREP)) for (int rep = 0; rep < REP_PREP; ++rep) {
            unsigned* qc = qctr + 512 * rep;
            for (int r2 = 0; r2 < REPS_PE; ++r2) ph_prep_elem(p, l, TID0(), bid, G);
#ifndef DIS_CMP
            { const int tid = TID0();
            for (int r2 = 0; r2 < REPS_CMP; ++r2) for (;;) { const int t = next_task(qc + 512 * r2, slot, tid); if (t >= 32) break; cmp_task(p, l, t, lds, tid); }
            }
#endif
#ifndef DIS_C1
            { const int tid = TID0();
            for (int r2 = 0; r2 < REPS_C1; ++r2) for (;;) { const int t = next_task(qc + 64 + 512 * r2, slot, tid); if (t >= 512) break; lru_c1_task(p, l, t, lds, tid); }
            }
#endif
            const bool split_pm = multi && PH_ON(PH_MIX1) && rep + 1 == REP_PREP;
            if (split_pm) { const int tid = TID0(); ARRIVE_ALL(qctr + 448, tid); }
#ifndef DIS_SB
            { const int tid = TID0();
            for (int r2 = 0; r2 < REPS_SB; ++r2) for (;;) { const int t = next_task(qc + 256 + 512 * r2, slot, tid); if (t >= 512) break; sb_task(p, t, lds, tid); }
            }
#endif
            if (split_pm) { const int tid = TID0(); WAIT_ALL(qctr + 448, tid);
            } else SEAM();
        }
        if (PH_ON(PH_MIX1)) for (int rep = 0; rep < REP_MIX1; ++rep) {
            unsigned* qc = qctr + 512 * rep;
#ifndef DIS_RS
            { const int tid = TID0();
            for (int r2 = 0; r2 < REPS_RS; ++r2) for (;;) { const int t = next_task(qc + 128 + 512 * r2, slot, tid); if (t >= 64) break; ret_state_task(p, t, lds, tid, ctl + CW_RSFLAG + 2048 * l); }
            }
#endif
#ifndef DIS_NSA
            { const int tid = TID0();
            for (int r2 = 0; r2 < REPS_NSA; ++r2) for (;;) { const int t = next_task(qc + 192 + 512 * r2, slot, tid); if (t >= 512) break; nsa_task(p, l, t, lds, tid); }
            }
#endif
#ifndef DIS_RO
            { const int tid = TID0();
            for (int r2 = 0; r2 < REPS_RO; ++r2) for (;;) { const int t = next_task(qc + 384 + 512 * r2, slot, tid); if (t >= 512) break; ret_out_task(p, t, lds, tid, ctl + CW_RSFLAG + 2048 * l); }
            }
#endif
#ifndef DIS_C3
            { const int tid = TID0();
            for (int r2 = 0; r2 < REPS_C3; ++r2) for (;;) { const int t = next_task(qc + 320 + 512 * r2, slot, tid); if (t >= 512) break; lru_c3_task(p, t, lds, tid); }
            }
#endif
#if IN_MIDCONV
            SEAM();
#else
            SEAM_FILL(2, vis_mid, 4768, rep + 1 == REP_MIX1);
#endif
        }
        if (PH_ON(PH_GEMM_OUT)) {
            const int tid = TID0();
            pg8::Gemm g{WSP(bf16_t, WS_MIX), WSP(bf16_t, WS_WOUT), MT, DM, DM}; pg8::StaticOrder S; S.init(MT, DM, G, bid);
            EpiResid3 E{(l == 0) ? p->in[I_X] : nullptr, WSP(bf16_t, WS_HN), nullptr, WSP(float, WS_RSS) + (size_t)MT * 64};
#if !defined(DIS_GEMM) && !defined(DIS_G2)
#ifdef REP_GOUT
            for (int rp = 1; rp < REP_GOUT; ++rp) { EpiResid3 E2{(l == 0) ? p->in[I_X] : nullptr, WSP(bf16_t, WS_HN), WSP(float, WS_PROJ), WSP(float, WS_RSS) + (size_t)MT * 64, 1};
                pg8::gemm_phase<EpiResid3, pg8::StaticOrder, HP_ALIGN, HP_SP2>(lds, g, S, E2, tid); SEAM(); }
#endif
            pg8::gemm_phase<EpiResid3, pg8::StaticOrder, HP_ALIGN, HP_SP2>(lds, g, S, E, tid);
#endif
            SEAM_FILL(3, 4768, (l + 1 == NL) ? 4768 : 6144, true);
        }
        if (PH_ON(PH_GEMM_GU)) for (int rep = 0; rep < REP_GGU; ++rep) {
            const int tid = TID0();
            pg8::Gemm g{WSP(bf16_t, WS_HN), WSP(bf16_t, WS_WGU), MT, NGU, DM}; pg8::StaticOrder S; S.init(MT, NGU, G, bid);
            LAS float* rt = (LAS float*)(lds + LDS_STAGE + LDS_CTL);
            const int rbase = fill_rstd_table(S, WSP(float, WS_RSS) + (size_t)MT * 64, rt, tid);
            EpiGateUp E{WSP(bf16_t, WS_H), rt, rbase, p->in[I_MCW] + (size_t)l * 3 * DFF, p->in[I_MCB] + (size_t)l * DFF, WSP(bf16_t, WS_GT), WSP(bf16_t, WS_GH), WSP(bf16_t, WS_UH)};
#if !defined(DIS_GEMM) && !defined(DIS_G3)
            pg8::gemm_phase<EpiGateUp, pg8::StaticOrder, HP_ALIGN, HP_SP2>(lds, g, S, E, tid);
#endif
#ifndef DIS_CONV
            if (rep == 0) {
                const int nwg = (MT / 256) * (NGU / 256), first_short = nwg - ((nwg + G - 1) / G - 1) * G;
                const int ll = (l + 1 < NL) ? l + 1 : l, t_lo = (l + 1 < NL) ? 0 : 4768, t_hi = (l + 1 < NL) ? GU_TAIL_N : 6144;
                if (first_short < G && bid >= first_short) convert_range(p, ll, t_lo + bid - first_short, t_hi, G - first_short, lds, tid);
                else if (first_short >= G) convert_range(p, ll, t_lo + bid, t_hi, G, lds, tid);
            }
#endif
            SEAM();
        }
        if (PH_ON(PH_ACT)) for (int rep = 0; rep < REP_ACT; ++rep) {
            const int tid = TID0();
            ph_mlp_fix(p, l, tid, bid, G);
            SEAM();
        }
        if (PH_ON(PH_GEMM_DN)) {
            const int tid = TID0();
            pg8::Gemm g{WSP(bf16_t, WS_H), WSP(bf16_t, (l & 1) ? WS_WDN2 : WS_WDN), MT, DM, DFF}; pg8::StaticOrder S; S.init(MT, DM, G, bid);
            EpiResid3 E{nullptr, WSP(bf16_t, WS_HN), (l + 1 < NL) ? nullptr : p->out, WSP(float, WS_RSS)};
#if !defined(DIS_GEMM) && !defined(DIS_G4)
#ifdef REP_GDN
            for (int rp = 1; rp < REP_GDN; ++rp) { EpiResid3 E2{nullptr, WSP(bf16_t, WS_HN), WSP(float, WS_PROJ), WSP(float, WS_RSS), 1};
                pg8::gemm_phase<EpiResid3, pg8::StaticOrder, HP_ALIGN, HP_SP2>(lds, g, S, E2, tid); SEAM(); }
#endif
            pg8::gemm_phase<EpiResid3, pg8::StaticOrder, HP_ALIGN, HP_SP2>(lds, g, S, E, tid);
#endif
            if (l + 1 < l_hi && !(multi && PH_ON(PH_CONV) && REP_CONV == 1)) SEAM();
        }
    }
#undef PH_ON
#undef SEAM
#undef WSP
#undef TID0
}
}

#ifndef HP_N_LAUNCH_MODE
#define HP_N_LAUNCH_MODE 0
#endif
extern "C" void kernel_launch(void* const* d_in, const int* in_sizes, int n_in, void* d_out, int out_size, void* d_ws, size_t ws_size, hipStream_t stream) {
    using namespace hp;
    static int grid = 0;
    if (grid == 0) {
        if (n_in != N_INPUTS || out_size != MT * DM || ws_size < WS_END) { fprintf(stderr, "kernel_launch: unexpected problem (n_in %d, out %d, ws %zu, need %zu)\n", n_in, out_size, ws_size, (size_t)WS_END); grid = -1; return; }
        int dev = 0, cus = 0, per_cu = 0;
        if (hipGetDevice(&dev) != hipSuccess || hipDeviceGetAttribute(&cus, hipDeviceAttributeMultiprocessorCount, dev) != hipSuccess) { grid = -1; return; }
        if (hipFuncSetAttribute((const void*)hybrid_fwd, hipFuncAttributeMaxDynamicSharedMemorySize, LDS_BYTES) != hipSuccess) { fprintf(stderr, "kernel_launch: hipFuncSetAttribute failed\n"); grid = -1; return; }
        if (hipOccupancyMaxActiveBlocksPerMultiprocessor(&per_cu, (const void*)hybrid_fwd, NTHR, LDS_BYTES) != hipSuccess || per_cu < 1) { fprintf(stderr, "kernel_launch: occupancy query says %d\n", per_cu); (void)hipGetLastError(); per_cu = 1; }
        grid = cus;
    }
    if (grid < 0) return;
    (void)hipMemsetAsync((char*)d_ws + WS_CTL, 0, CTL_BYTES, stream);
    Params p{};
    for (int i = 0; i < N_INPUTS; ++i) p.in[i] = (const float*)d_in[i];
    p.out = (float*)d_out; p.ws = (unsigned char*)d_ws;
#if HP_N_LAUNCH_MODE == 0
    p.l_lo = 0; p.l_hi = NL; p.ph_lo = 0; p.ph_hi = N_PHASES;
    hipLaunchKernelGGL(hybrid_fwd, dim3(grid), dim3(NTHR), LDS_BYTES, stream, p);
#else
    for (int l = 0; l < NL; ++l)
        for (int ph = 0; ph < N_PHASES; ++ph) { p.l_lo = l; p.l_hi = l + 1; p.ph_lo = ph; p.ph_hi = ph + 1; hipLaunchKernelGGL(hybrid_fwd, dim3(grid), dim3(NTHR), LDS_BYTES, stream, p); }
#endif
}
```
